# Optimizing an MI355X kernel written in HIP

```python
import jax, jax.numpy as jnp
from jax import lax
import numpy as np

D_MODEL = 1024
BATCH = 8
SEQ = 4096
DEPTH = 2

D_MIX = D_MODEL
FOX_HEADS = 6
FOX_HEAD_DIM = 64
FOX_WIDTH = FOX_HEADS * FOX_HEAD_DIM
Q_BLOCK = 128
FOX_F_BIAS_INIT = 2.0
S5_CH_PER_GROUP = 16
S5_GROUPS = 16
S5_WIDTH = S5_GROUPS * S5_CH_PER_GROUP
S5_STATE = 64
S5_DT_MIN = 0.001
S5_DT_MAX = 0.1
HGRN_HEADS = 6
HGRN_KEY_DIM = 64
HGRN_VAL_DIM = 64
HGRN_WIDTH = HGRN_HEADS * HGRN_VAL_DIM
HGRN_CHUNK = 64
N_EXPERTS = 16
N_EXPERT_GROUPS = 4
EXPERTS_PER_GROUP = N_EXPERTS // N_EXPERT_GROUPS
TOP_K = 2
D_FF_EXPERT = 256
EPS = 1e-6

IN_SPLITS = (FOX_WIDTH, FOX_WIDTH, FOX_WIDTH, FOX_HEADS, S5_WIDTH, HGRN_WIDTH, HGRN_WIDTH, HGRN_WIDTH, HGRN_WIDTH)
N_IN = sum(IN_SPLITS)
IN_OFFSETS = tuple(int(v) for v in np.cumsum(IN_SPLITS)[:-1])

kernel_name = "hybrid_fox_s5_hgrn2_moe_adaln"

F32 = jnp.float32


def rms_norm(x, w):
    x32 = x.astype(F32)
    y = x32 * lax.rsqrt(jnp.mean(x32 * x32, axis=-1, keepdims=True) + EPS)
    return (y * w.astype(F32)).astype(x.dtype)


def fox_attention(q, k, v, log_f):
    bsz, seq = q.shape[0], q.shape[1]
    q = jnp.transpose(q, (0, 2, 1, 3)).astype(F32)
    k = jnp.transpose(k, (0, 2, 1, 3)).astype(F32)
    v = jnp.transpose(v, (0, 2, 1, 3)).astype(F32)
    cum = jnp.transpose(jnp.cumsum(log_f, axis=1), (0, 2, 1))
    scale = FOX_HEAD_DIM ** -0.5
    outs = []
    for blk in range(seq // Q_BLOCK):
        lo, hi = blk * Q_BLOCK, (blk + 1) * Q_BLOCK
        logits = jnp.einsum('bhqd,bhkd->bhqk', q[:, :, lo:hi], k[:, :, :hi]) * scale
        logits = logits + cum[:, :, lo:hi, None] - cum[:, :, None, :hi]
        causal = (lo + jnp.arange(Q_BLOCK))[:, None] >= jnp.arange(hi)[None, :]
        probs = jax.nn.softmax(jnp.where(causal, logits, -jnp.inf), axis=-1)
        outs.append(jnp.einsum('bhqk,bhkd->bhqd', probs, v[:, :, :hi]))
    o = jnp.concatenate(outs, axis=2)
    return jnp.transpose(o, (0, 2, 1, 3)).reshape(bsz, seq, FOX_WIDTH)


def _diag_linear_combine(e1, e2):
    a1, b1 = e1
    a2, b2 = e2
    return a1 * a2, a2 * b1 + b2


def s5_mixer(u, a_re, a_im, b_re, b_im, c_re, c_im, d, log_dt, glu_w, glu_b):
    bsz, seq = u.shape[0], u.shape[1]
    u32 = u.astype(F32).reshape(bsz, seq, S5_GROUPS, S5_CH_PER_GROUP)
    lam = lax.complex(a_re.astype(F32), a_im.astype(F32))
    dt = jnp.exp(log_dt.astype(F32))[:, None]
    a_bar = jnp.exp(lam * dt)
    b_bar = ((a_bar - 1.0) / lam)[..., None] * lax.complex(b_re.astype(F32), b_im.astype(F32))
    bu = jnp.einsum('btgc,gpc->btgp', u32.astype(jnp.complex64), b_bar)
    a_seq = jnp.broadcast_to(a_bar, bu.shape)
    _, states = lax.associative_scan(_diag_linear_combine, (a_seq, bu), axis=1)
    c_mat = lax.complex(c_re.astype(F32), c_im.astype(F32))
    y = jnp.real(jnp.einsum('btgp,gcp->btgc', states, c_mat)) + d.astype(F32) * u32
    y = jax.nn.gelu(y.reshape(bsz, seq, S5_WIDTH))
    gate = jax.nn.sigmoid(y @ glu_w.astype(F32) + glu_b.astype(F32))
    return (y * gate).astype(u.dtype)


def _hgrn2_chunk(state, chunk):
    q, k, v, log_f = chunk
    n = q.shape[2]
    b = jnp.cumsum(log_f, axis=2)
    causal = jnp.tril(jnp.ones((n, n), dtype=bool))
    diff = b[:, :, :, None, :] - b[:, :, None, :, :]
    decay = jnp.exp(jnp.where(causal[:, :, None], diff, -jnp.inf))
    scores = jnp.einsum('bhtd,bhsd,bhtsd->bhts', q, k, decay)
    o = jnp.einsum('bhts,bhsv->bhtv', scores, v) + jnp.einsum('bhtd,bhdv->bhtv', q * jnp.exp(b), state)
    b_last = b[:, :, -1:, :]
    new_state = jnp.exp(b_last[:, :, 0, :])[..., None] * state + jnp.einsum('bhsd,bhsv->bhdv', k * jnp.exp(b_last - b), v)
    return new_state, o


def hgrn2_mixer(q, f_logit, inp, g, lower_bound, norm_w):
    bsz, seq = q.shape[0], q.shape[1]
    n_chunks = seq // HGRN_CHUNK
    z = f_logit.astype(F32)
    lb = lower_bound.astype(F32)
    log_f = jnp.logaddexp(jnp.log(lb), jnp.log1p(-lb) + jax.nn.log_sigmoid(z))
    key = (1.0 - lb) * jax.nn.sigmoid(-z)
    qf = jax.nn.silu(q.astype(F32))

    def to_chunks(t, dim):
        t = t.reshape(bsz, n_chunks, HGRN_CHUNK, HGRN_HEADS, dim)
        return jnp.transpose(t, (1, 0, 3, 2, 4))

    xs = (to_chunks(qf, HGRN_KEY_DIM), to_chunks(key, HGRN_KEY_DIM),
          to_chunks(inp.astype(F32), HGRN_VAL_DIM), to_chunks(log_f, HGRN_KEY_DIM))
    s0 = jnp.zeros((bsz, HGRN_HEADS, HGRN_KEY_DIM, HGRN_VAL_DIM), F32)
    _, o = lax.scan(_hgrn2_chunk, s0, xs)
    o = jnp.transpose(o, (1, 0, 3, 2, 4)).reshape(bsz, seq, HGRN_HEADS, HGRN_VAL_DIM)
    o = rms_norm(o, norm_w).reshape(bsz, seq, HGRN_WIDTH) * jax.nn.silu(g.astype(F32))
    return o.astype(q.dtype)


def moe_ffn(h, router_w, router_b, w_gate, w_up, w_down):
    bsz, seq, d = h.shape
    t = h.reshape(-1, d)
    logits = (t @ router_w + router_b).astype(F32)
    probs = jax.nn.softmax(logits, axis=-1)
    grouped = probs.reshape(-1, N_EXPERT_GROUPS, EXPERTS_PER_GROUP)
    group_score = lax.top_k(grouped, TOP_K)[0].sum(-1)
    best = jnp.argmax(group_score, axis=-1)
    in_group = jnp.take_along_axis(grouped, best[:, None, None], axis=1)[:, 0]
    top_w, top_i = lax.top_k(in_group, TOP_K)
    top_w = top_w / jnp.sum(top_w, axis=-1, keepdims=True)
    idx = best[:, None] * EXPERTS_PER_GROUP + top_i
    combine = jnp.sum(jax.nn.one_hot(idx, N_EXPERTS, dtype=F32) * top_w[..., None], axis=1)
    y = jnp.zeros(t.shape, F32)
    for e in range(N_EXPERTS):
        hid = jax.nn.silu(t @ w_gate[e]) * (t @ w_up[e])
        y = y + combine[:, e:e + 1] * (hid @ w_down[e]).astype(F32)
    return y.reshape(bsz, seq, d).astype(h.dtype)


def setup_inputs(seed: int = 0) -> dict:
    key = jax.random.key(seed)
    ks = jax.random.split(key, 32)

    def nrm(k, shape, scale):
        return scale * jax.random.normal(k, shape, F32)

    n_idx = jnp.arange(S5_STATE, dtype=F32)
    return {
        "x": nrm(ks[0], (BATCH, SEQ, D_MODEL), 1.0),
        "c": nrm(ks[1], (BATCH, D_MODEL), 1.0),
        "ada_w": nrm(ks[2], (DEPTH, D_MODEL, 6 * D_MODEL), 0.3 * D_MODEL ** -0.5),
        "ada_b": nrm(ks[3], (DEPTH, 6 * D_MODEL), 0.01),
        "norm_mix_w": 1.0 + nrm(ks[4], (DEPTH, D_MODEL), 0.02),
        "norm_ffn_w": 1.0 + nrm(ks[5], (DEPTH, D_MODEL), 0.02),
        "w_in": nrm(ks[6], (DEPTH, D_MODEL, N_IN), D_MODEL ** -0.5),
        "fox_f_bias": FOX_F_BIAS_INIT + nrm(ks[7], (DEPTH, FOX_HEADS), 0.1),
        "s5_a_re": -0.5 + nrm(ks[8], (DEPTH, S5_GROUPS, S5_STATE), 0.01),
        "s5_a_im": jnp.broadcast_to(jnp.pi * n_idx, (DEPTH, S5_GROUPS, S5_STATE)) + nrm(ks[9], (DEPTH, S5_GROUPS, S5_STATE), 0.01),
        "s5_b_re": nrm(ks[10], (DEPTH, S5_GROUPS, S5_STATE, S5_CH_PER_GROUP), (2 * S5_CH_PER_GROUP) ** -0.5),
        "s5_b_im": nrm(ks[11], (DEPTH, S5_GROUPS, S5_STATE, S5_CH_PER_GROUP), (2 * S5_CH_PER_GROUP) ** -0.5),
        "s5_c_re": nrm(ks[12], (DEPTH, S5_GROUPS, S5_CH_PER_GROUP, S5_STATE), 0.5),
        "s5_c_im": nrm(ks[13], (DEPTH, S5_GROUPS, S5_CH_PER_GROUP, S5_STATE), 0.5),
        "s5_d": nrm(ks[14], (DEPTH, S5_GROUPS, S5_CH_PER_GROUP), 1.0),
        "s5_log_dt": jax.random.uniform(ks[15], (DEPTH, S5_GROUPS), F32, float(np.log(S5_DT_MIN)), float(np.log(S5_DT_MAX))),
        "s5_glu_w": nrm(ks[16], (DEPTH, S5_WIDTH, S5_WIDTH), S5_WIDTH ** -0.5),
        "s5_glu_b": nrm(ks[17], (DEPTH, S5_WIDTH), 0.01),
        "hgrn_lb_logits": nrm(ks[18], (DEPTH, HGRN_WIDTH), 0.1),
        "hgrn_norm_w": 1.0 + nrm(ks[19], (DEPTH, HGRN_VAL_DIM), 0.02),
        "branch_norm_fox": 1.0 + nrm(ks[20], (DEPTH, FOX_WIDTH), 0.02),
        "branch_norm_s5": 1.0 + nrm(ks[21], (DEPTH, S5_WIDTH), 0.02),
        "w_out": nrm(ks[22], (DEPTH, D_MIX, D_MODEL), D_MIX ** -0.5),
        "router_w": nrm(ks[23], (D_MODEL, N_EXPERTS), D_MODEL ** -0.5),
        "router_b": nrm(ks[24], (N_EXPERTS,), 0.01),
        "moe_w_gate": nrm(ks[25], (DEPTH, N_EXPERTS, D_MODEL, D_FF_EXPERT), D_MODEL ** -0.5),
        "moe_w_up": nrm(ks[26], (DEPTH, N_EXPERTS, D_MODEL, D_FF_EXPERT), D_MODEL ** -0.5),
        "moe_w_down": nrm(ks[27], (DEPTH, N_EXPERTS, D_FF_EXPERT, D_MODEL), D_FF_EXPERT ** -0.5),
        "final_norm_w": 1.0 + nrm(ks[28], (D_MODEL,), 0.02),
    }


def reference(x, c, ada_w, ada_b, norm_mix_w, norm_ffn_w, w_in, fox_f_bias,
              s5_a_re, s5_a_im, s5_b_re, s5_b_im, s5_c_re, s5_c_im, s5_d, s5_log_dt,
              s5_glu_w, s5_glu_b, hgrn_lb_logits, hgrn_norm_w, branch_norm_fox, branch_norm_s5,
              w_out, router_w, router_b, moe_w_gate, moe_w_up, moe_w_down, final_norm_w):
    bsz, seq, _ = x.shape
    lb_cum = jnp.cumsum(jax.nn.softmax(hgrn_lb_logits.astype(F32), axis=0), axis=0)
    lower_bounds = lb_cum - lb_cum[0:1]
    c_act = jax.nn.silu(c)
    for layer in range(DEPTH):
        mod = c_act @ ada_w[layer] + ada_b[layer]
        sh_m, sc_m, g_m, sh_f, sc_f, g_f = [m[:, None, :] for m in jnp.split(mod, 6, axis=-1)]
        h = rms_norm(x, norm_mix_w[layer]) * (1 + sc_m) + sh_m
        z = h @ w_in[layer]
        fq, fk, fv, ff, su, hq, hf, hi, hg = jnp.split(z, IN_OFFSETS, axis=-1)
        heads4 = (bsz, seq, FOX_HEADS, FOX_HEAD_DIM)
        fox_log_f = jax.nn.log_sigmoid(ff.astype(F32) + fox_f_bias[layer].astype(F32))
        o_fox = fox_attention(fq.reshape(heads4), fk.reshape(heads4), fv.reshape(heads4), fox_log_f).astype(x.dtype)
        o_fox = rms_norm(o_fox, branch_norm_fox[layer])
        o_s5 = s5_mixer(su, s5_a_re[layer], s5_a_im[layer], s5_b_re[layer], s5_b_im[layer],
                        s5_c_re[layer], s5_c_im[layer], s5_d[layer], s5_log_dt[layer],
                        s5_glu_w[layer], s5_glu_b[layer]).astype(x.dtype)
        o_s5 = rms_norm(o_s5, branch_norm_s5[layer])
        o_hgrn = hgrn2_mixer(hq, hf, hi, hg, lower_bounds[layer], hgrn_norm_w[layer]).astype(x.dtype)
        mix = jnp.concatenate([o_fox, o_s5, o_hgrn], axis=-1) @ w_out[layer]
        x = x + g_m * mix
        h = rms_norm(x, norm_ffn_w[layer]) * (1 + sc_f) + sh_f
        x = x + g_f * moe_ffn(h, router_w, router_b, moe_w_gate[layer], moe_w_up[layer], moe_w_down[layer])
    return rms_norm(x, final_norm_w)
```

```cpp
#include <hip/hip_runtime.h>
namespace nv {
constexpr int B_ = 8, S_ = 4096, D_ = 1024, M_ = B_ * S_, NIN = 2950;
constexpr int OFF_FQ = 0, OFF_FK = 384, OFF_FV = 768, OFF_FF = 1152, OFF_SU = 1158, OFF_HQ = 1414, OFF_HF = 1798, OFF_HI = 2182, OFF_HG = 2566;
__device__ __forceinline__ float sigmoidf_(float x) { return 1.f / (1.f + expf(-x)); }
__device__ __forceinline__ float siluf_(float x) { return x / (1.f + expf(-x)); }
__device__ __forceinline__ float logsigmoidf_(float x) { return fminf(x, 0.f) - log1pf(expf(-fabsf(x))); }
__device__ __forceinline__ float gelu_tanhf_(float x) { return 0.5f * x * (1.f + tanhf(0.7978845608028654f * (x + 0.044715f * x * x * x))); }

__global__ void k_mod(const float* c, const float* ada_w, const float* ada_b, float* mod) {
    const int idx = blockIdx.x * blockDim.x + threadIdx.x; if (idx >= 2 * 8 * 6144) return;
    const int n = idx % 6144, b = (idx / 6144) % 8, l = idx / (6144 * 8);
    float acc = 0.f;
    for (int k = 0; k < 1024; ++k) acc += siluf_(c[b * 1024 + k]) * ada_w[((size_t)l * 1024 + k) * 6144 + n];
    mod[idx] = acc + ada_b[l * 6144 + n];
}
__global__ void k_lb(const float* lbl, float* lb) {
    const int j = blockIdx.x * blockDim.x + threadIdx.x; if (j >= 384) return;
    const float a = lbl[j], b = lbl[384 + j], m = fmaxf(a, b), ea = expf(a - m), eb = expf(b - m);
    lb[j] = 0.f; lb[384 + j] = eb / (ea + eb);
}
__global__ void k_norm_mod(const float* x, const float* w, const float* mod_l, int sh_off, int sc_off, float* out, int has_mod) {
    const int lane = threadIdx.x & 63, row = blockIdx.x * 4 + (threadIdx.x >> 6); if (row >= M_) return;
    const float* xr = x + (size_t)row * 1024; float s = 0.f;
    for (int j = lane; j < 1024; j += 64) s += xr[j] * xr[j];
    for (int o = 1; o < 64; o <<= 1) s += __shfl_xor(s, o);
    const float rstd = rsqrtf(s * (1.f / 1024.f) + 1e-6f); const int b = row / S_;
    for (int j = lane; j < 1024; j += 64) { float v = xr[j] * rstd * w[j]; if (has_mod) v = v * (1.f + mod_l[b * 6144 + sc_off + j]) + mod_l[b * 6144 + sh_off + j]; out[(size_t)row * 1024 + j] = v; }
}
__global__ void k_gemm(const float* A, int lda, const float* Bm, int ldb, float* C, int ldc, int M, int N, int K) {
    __shared__ float As[16][64 + 1], Bs[16][64 + 1];
    const int tx = threadIdx.x % 16, ty = threadIdx.x / 16, m0 = blockIdx.y * 64, n0 = blockIdx.x * 64;
    float acc[4][4] = {};
    for (int k0 = 0; k0 < K; k0 += 16) {
        for (int i = threadIdx.x; i < 64 * 16; i += 256) { const int r = i / 16, kk = i % 16; As[kk][r] = (m0 + r < M && k0 + kk < K) ? A[(size_t)(m0 + r) * lda + k0 + kk] : 0.f; }
        for (int i = threadIdx.x; i < 16 * 64; i += 256) { const int kk = i / 64, cc = i % 64; Bs[kk][cc] = (n0 + cc < N && k0 + kk < K) ? Bm[(size_t)(k0 + kk) * ldb + n0 + cc] : 0.f; }
        __syncthreads();
        for (int kk = 0; kk < 16; ++kk) { float a[4], b[4];
            for (int i = 0; i < 4; ++i) { a[i] = As[kk][ty * 4 + i]; b[i] = Bs[kk][tx * 4 + i]; }
            for (int i = 0; i < 4; ++i) for (int j = 0; j < 4; ++j) acc[i][j] += a[i] * b[j]; }
        __syncthreads();
    }
    for (int i = 0; i < 4; ++i) for (int j = 0; j < 4; ++j) { const int r = m0 + ty * 4 + i, cidx = n0 + tx * 4 + j; if (r < M && cidx < N) C[(size_t)r * ldc + cidx] = acc[i][j]; }
}
__global__ void k_cum(const float* Z, const float* fbias_l, float* cum) {
    const int bh = blockIdx.x * blockDim.x + threadIdx.x; if (bh >= 24) return; const int b = bh / 6, h = bh % 6; float s = 0.f;
    for (int t = 0; t < S_; ++t) { s += logsigmoidf_(Z[(size_t)(b * S_ + t) * NIN + OFF_FF + h] + fbias_l[h]); cum[(size_t)bh * S_ + t] = s; }
}
__global__ void __launch_bounds__(256) k_fox(const float* Z, const float* cum, float* O) {
    const int idx = blockIdx.x * blockDim.x + threadIdx.x; if (idx >= 24 * S_) return;
    const int t = idx % S_, bh = idx / S_, b = bh / 6, h = bh % 6;
    const float* q = Z + (size_t)(b * S_ + t) * NIN + OFF_FQ + h * 64; float qr[64];
#pragma unroll
    for (int d = 0; d < 64; ++d) qr[d] = q[d] * 0.125f;
    float m = -INFINITY, l = 0.f, o[64];
#pragma unroll
    for (int d = 0; d < 64; ++d) o[d] = 0.f;
    const float ct = cum[(size_t)bh * S_ + t];
    for (int s = 0; s <= t; ++s) {
        const float* k = Z + (size_t)(b * S_ + s) * NIN + OFF_FK + h * 64; const float* v = Z + (size_t)(b * S_ + s) * NIN + OFF_FV + h * 64;
        float lg = 0.f;
#pragma unroll
        for (int d = 0; d < 64; ++d) lg += qr[d] * k[d];
        lg += ct - cum[(size_t)bh * S_ + s];
        const float mn = fmaxf(m, lg), al = expf(m - mn), p = expf(lg - mn);
        l = l * al + p;
#pragma unroll
        for (int d = 0; d < 64; ++d) o[d] = o[d] * al + p * v[d];
        m = mn;
    }
#pragma unroll
    for (int d = 0; d < 64; ++d) O[(size_t)(b * S_ + t) * 384 + h * 64 + d] = o[d] / l;
}
__global__ void k_branch_norm(const float* in, int ncols, const float* w, float* mix, int off, int nrows) {
    const int lane = threadIdx.x & 63, row = blockIdx.x * 4 + (threadIdx.x >> 6); if (row >= nrows) return;
    const float* xr = in + (size_t)row * ncols; float s = 0.f;
    for (int j = lane; j < ncols; j += 64) s += xr[j] * xr[j];
    for (int o = 1; o < 64; o <<= 1) s += __shfl_xor(s, o);
    const float rstd = rsqrtf(s / (float)ncols + 1e-6f);
    for (int j = lane; j < ncols; j += 64) mix[(size_t)row * 1024 + off + j] = xr[j] * rstd * w[j];
}
__global__ void k_s5(const float* Z, const float* a_re, const float* a_im, const float* b_re, const float* b_im, const float* c_re, const float* c_im, const float* dd, const float* log_dt, float* Y) {
    const int bg = blockIdx.x, b = bg / 16, g = bg % 16, p = threadIdx.x;
    const float dt = expf(log_dt[g]); const float lr = a_re[g * 64 + p], li = a_im[g * 64 + p];
    const float er = expf(lr * dt), ar = er * cosf(li * dt), ai = er * sinf(li * dt);
    const float nr = ar - 1.f, ni = ai, den = lr * lr + li * li; const float fr = (nr * lr + ni * li) / den, fi = (ni * lr - nr * li) / den;
    float bbr[16], bbi[16], cr[16], ci[16];
    for (int c = 0; c < 16; ++c) { const float br = b_re[(g * 64 + p) * 16 + c], bi = b_im[(g * 64 + p) * 16 + c]; bbr[c] = fr * br - fi * bi; bbi[c] = fr * bi + fi * br;
        cr[c] = c_re[(g * 16 + c) * 64 + p]; ci[c] = c_im[(g * 16 + c) * 64 + p]; }
    float xr = 0.f, xi = 0.f;
    for (int t = 0; t < S_; ++t) {
        const float* u = Z + (size_t)(b * S_ + t) * NIN + OFF_SU + g * 16; float bur = 0.f, bui = 0.f;
        for (int c = 0; c < 16; ++c) { bur += bbr[c] * u[c]; bui += bbi[c] * u[c]; }
        const float nxr = ar * xr - ai * xi + bur, nxi = ar * xi + ai * xr + bui; xr = nxr; xi = nxi;
        for (int c = 0; c < 16; ++c) { float y = cr[c] * xr - ci[c] * xi;
            for (int o = 1; o < 64; o <<= 1) y += __shfl_xor(y, o);
            if (p == c) Y[(size_t)(b * S_ + t) * 256 + g * 16 + c] = gelu_tanhf_(y + dd[g * 16 + c] * u[c]); }
    }
}
__global__ void k_glu(const float* Y, const float* G, const float* gb, float* out, int nrows) {
    const size_t i = (size_t)blockIdx.x * blockDim.x + threadIdx.x; if (i >= (size_t)nrows * 256) return; const int n = i % 256;
    out[i] = Y[i] * sigmoidf_(G[i] + gb[n]);
}
__global__ void k_hgrn(const float* Z, const float* lb_l, const float* nw, float* mix) {
    const int bh = blockIdx.x, b = bh / 6, h = bh % 6, v = threadIdx.x % 64, dq = threadIdx.x / 64;
    __shared__ float sq[64], sf[64], sk[64], part[4][64], osh[64];
    float St[16]; for (int i = 0; i < 16; ++i) St[i] = 0.f;
    for (int t = 0; t < S_; ++t) {
        const float* zr = Z + (size_t)(b * S_ + t) * NIN;
        if (threadIdx.x < 64) { const int d = threadIdx.x; const float lbv = lb_l[h * 64 + d], z = zr[OFF_HF + h * 64 + d];
            sf[d] = lbv + (1.f - lbv) * sigmoidf_(z); sk[d] = (1.f - lbv) * sigmoidf_(-z); sq[d] = siluf_(zr[OFF_HQ + h * 64 + d]); }
        __syncthreads();
        const float vv = zr[OFF_HI + h * 64 + v]; float po = 0.f;
        for (int i = 0; i < 16; ++i) { const int d = dq * 16 + i; St[i] = sf[d] * St[i] + sk[d] * vv; po += sq[d] * St[i]; }
        part[dq][v] = po; __syncthreads();
        if (threadIdx.x < 64) { const float o = part[0][v] + part[1][v] + part[2][v] + part[3][v]; float s = o * o;
            for (int of = 1; of < 64; of <<= 1) s += __shfl_xor(s, of);
            const float rstd = rsqrtf(s * (1.f / 64.f) + 1e-6f); const float gq = zr[OFF_HG + h * 64 + v];
            mix[(size_t)(b * S_ + t) * 1024 + 640 + h * 64 + v] = o * rstd * nw[v] * siluf_(gq); }
        __syncthreads();
    }
}
__global__ void k_resid(const float* X, const float* T, const float* mod_l, int g_off, float* out) {
    const size_t i = (size_t)blockIdx.x * blockDim.x + threadIdx.x; if (i >= (size_t)M_ * 1024) return; const int n = i % 1024, b = (int)(i / 1024) / S_;
    out[i] = X[i] + mod_l[b * 6144 + g_off + n] * T[i];
}
__global__ void k_route(const float* H2, const float* rw, const float* rb, int* eidx, float* ew) {
    const int lane = threadIdx.x & 63, row = blockIdx.x * 4 + (threadIdx.x >> 6); if (row >= M_) return;
    float lg[16];
#pragma unroll
    for (int e = 0; e < 16; ++e) lg[e] = 0.f;
    for (int j = lane; j < 1024; j += 64) { const float hv = H2[(size_t)row * 1024 + j];
#pragma unroll
        for (int e = 0; e < 16; ++e) lg[e] += hv * rw[j * 16 + e]; }
#pragma unroll
    for (int e = 0; e < 16; ++e) { for (int o = 1; o < 64; o <<= 1) lg[e] += __shfl_xor(lg[e], o); lg[e] += rb[e]; }
    float mx = lg[0];
#pragma unroll
    for (int e = 1; e < 16; ++e) mx = fmaxf(mx, lg[e]);
    float sum = 0.f;
#pragma unroll
    for (int e = 0; e < 16; ++e) { lg[e] = expf(lg[e] - mx); sum += lg[e]; }
#pragma unroll
    for (int e = 0; e < 16; ++e) lg[e] /= sum;
    int best = 0, bi1 = 0, bi2 = 1; float bs = -1.f, bv1 = 0.f, bv2 = 0.f;
#pragma unroll
    for (int g = 0; g < 4; ++g) {
        int i1 = 0; float v1 = lg[g * 4];
#pragma unroll
        for (int i = 1; i < 4; ++i) if (lg[g * 4 + i] > v1) { v1 = lg[g * 4 + i]; i1 = i; }
        int i2 = -1; float v2 = -1.f;
#pragma unroll
        for (int i = 0; i < 4; ++i) if (i != i1 && lg[g * 4 + i] > v2) { v2 = lg[g * 4 + i]; i2 = i; }
        const float sc = v1 + v2; if (sc > bs) { bs = sc; best = g; bi1 = i1; bi2 = i2; bv1 = v1; bv2 = v2; }
    }
    if (lane == 0) { eidx[row * 2] = best * 4 + bi1; eidx[row * 2 + 1] = best * 4 + bi2; ew[row * 2] = bv1 / (bv1 + bv2); ew[row * 2 + 1] = bv2 / (bv1 + bv2); }
}
__global__ void k_moe_hid(const float* H2, const int* eidx, const float* ew, const float* wg_l, const float* wu_l, float* hid) {
    const int tok = blockIdx.x, slot = threadIdx.x / 256, f = threadIdx.x % 256; __shared__ float hs[1024];
    for (int j = threadIdx.x; j < 1024; j += 512) hs[j] = H2[(size_t)tok * 1024 + j]; __syncthreads();
    const int e = eidx[tok * 2 + slot]; const float* G = wg_l + (size_t)e * 1024 * 256 + f; const float* U = wu_l + (size_t)e * 1024 * 256 + f; float ag = 0.f, au = 0.f;
    for (int k = 0; k < 1024; ++k) { ag += hs[k] * G[(size_t)k * 256]; au += hs[k] * U[(size_t)k * 256]; }
    hid[(size_t)tok * 512 + threadIdx.x] = ew[tok * 2 + slot] * siluf_(ag) * au;
}
__global__ void k_moe_down(const float* X1, const float* hid, const int* eidx, const float* wd_l, const float* mod_l, float* out) {
    const int tok = blockIdx.x, b = tok / S_; __shared__ float hs[512];
    for (int j = threadIdx.x; j < 512; j += 256) hs[j] = hid[(size_t)tok * 512 + j]; __syncthreads();
    for (int n = threadIdx.x; n < 1024; n += 256) { float acc = 0.f;
        for (int slot = 0; slot < 2; ++slot) { const float* W = wd_l + (size_t)eidx[tok * 2 + slot] * 256 * 1024 + n; for (int f = 0; f < 256; ++f) acc += hs[slot * 256 + f] * W[(size_t)f * 1024]; }
        out[(size_t)tok * 1024 + n] = X1[(size_t)tok * 1024 + n] + mod_l[b * 6144 + 5 * 1024 + n] * acc; }
}
struct In { const float *x, *c, *ada_w, *ada_b, *norm_mix_w, *norm_ffn_w, *w_in, *fox_f_bias, *a_re, *a_im, *b_re, *b_im, *c_re, *c_im, *s5d, *log_dt, *glu_w, *glu_b, *lb_logits, *hgrn_nw, *bn_fox, *bn_s5, *w_out, *router_w, *router_b, *w_gate, *w_up, *w_down, *final_w; };
inline void run(const In& in, float* out, float* wsf, hipStream_t st, int nlayers = 2) {
    size_t o = 0; auto take = [&](size_t n) { float* p = wsf + o; o += (n + 63) / 64 * 64; return p; };
    const int HM = M_ / 2;
    float* mod = take(2 * 8 * 6144); float* lb = take(768); float* cum = take(24 * S_); float* ew = take(M_ * 2); int* eidx = (int*)take(M_ * 2);
    float* H = take((size_t)M_ * 1024); float* MIX = take((size_t)M_ * 1024); float* Z = take((size_t)HM * NIN);
    float* OF = H; float* Y = H + (size_t)HM * 384; float* G = Y + (size_t)HM * 256;
    float* T = Z; float* hid = Z;
    float* X1 = out;
    k_mod<<<(2 * 8 * 6144 + 255) / 256, 256, 0, st>>>(in.c, in.ada_w, in.ada_b, mod);
    k_lb<<<2, 256, 0, st>>>(in.lb_logits, lb);
    const float* X = in.x;
    for (int l = 0; l < nlayers; ++l) {
        const float* modl = mod + l * 8 * 6144;
        k_norm_mod<<<M_ / 4, 256, 0, st>>>(X, in.norm_mix_w + l * 1024, modl, 0, 1024, H, 1);
        for (int hf = 0; hf < 2; ++hf) {
            const float* Hh = H + (size_t)hf * HM * 1024; float* MIXh = MIX + (size_t)hf * HM * 1024; const float* modh = modl + hf * 4 * 6144;
            float* OFh = H + (size_t)hf * HM * 1024; float* Yh = OFh + (size_t)HM * 384; float* Gh = Yh + (size_t)HM * 256;
            k_gemm<<<dim3((NIN + 63) / 64, HM / 64), 256, 0, st>>>(Hh, 1024, in.w_in + (size_t)l * 1024 * NIN, NIN, Z, NIN, HM, NIN, 1024);
            k_cum<<<1, 64, 0, st>>>(Z, in.fox_f_bias + l * 6, cum);
            k_fox<<<24 * S_ / 256, 256, 0, st>>>(Z, cum, OFh);
            k_branch_norm<<<HM / 4, 256, 0, st>>>(OFh, 384, in.bn_fox + l * 384, MIXh, 0, HM);
            k_s5<<<64, 64, 0, st>>>(Z, in.a_re + l * 1024, in.a_im + l * 1024, in.b_re + l * 16384, in.b_im + l * 16384, in.c_re + l * 16384, in.c_im + l * 16384, in.s5d + l * 256, in.log_dt + l * 16, Yh);
            k_gemm<<<dim3(4, HM / 64), 256, 0, st>>>(Yh, 256, in.glu_w + l * 65536, 256, Gh, 256, HM, 256, 256);
            k_glu<<<HM, 256, 0, st>>>(Yh, Gh, in.glu_b + l * 256, Gh, HM);
            k_branch_norm<<<HM / 4, 256, 0, st>>>(Gh, 256, in.bn_s5 + l * 256, MIXh, 384, HM);
            k_hgrn<<<24, 256, 0, st>>>(Z, lb + l * 384, in.hgrn_nw + l * 64, MIXh);
            (void)modh; (void)OF; (void)Y; (void)G;
        }
        k_gemm<<<dim3(16, M_ / 64), 256, 0, st>>>(MIX, 1024, in.w_out + (size_t)l * 1024 * 1024, 1024, T, 1024, M_, 1024, 1024);
        k_resid<<<M_ * 4, 256, 0, st>>>(X, T, modl, 2 * 1024, X1);
        k_norm_mod<<<M_ / 4, 256, 0, st>>>(X1, in.norm_ffn_w + l * 1024, modl, 3 * 1024, 4 * 1024, H, 1);
        k_route<<<M_ / 4, 256, 0, st>>>(H, in.router_w, in.router_b, eidx, ew);
        k_moe_hid<<<M_, 512, 0, st>>>(H, eidx, ew, in.w_gate + (size_t)l * 16 * 1024 * 256, in.w_up + (size_t)l * 16 * 1024 * 256, hid);
        k_moe_down<<<M_, 256, 0, st>>>(X1, hid, eidx, in.w_down + (size_t)l * 16 * 256 * 1024, modl, X1);
        X = X1;
    }
    k_norm_mod<<<M_ / 4, 256, 0, st>>>(X, in.final_w, nullptr, 0, 0, out, 0);
}
}
extern "C" void kernel_launch(void* const* d_in, const int* in_sizes, int n_in, void* d_out, int out_size, void* d_ws, size_t ws_size, hipStream_t stream) {
    nv::In in;
    const float** p = (const float**)&in;
    for (int i = 0; i < 29; ++i) p[i] = (const float*)d_in[i];
    nv::run(in, (float*)d_out, (float*)d_ws, stream, 2);
}
```

```cpp
#include <hip/hip_runtime.h>
#include <hip/hip_bf16.h>
#include <cstdio>
#include <cstdint>
#include <cmath>
namespace fx {
constexpr int BATCH = 8, SEQ = 4096, DM = 1024, M = BATCH * SEQ, NZ = 3072, NIN = 2950;
constexpr int NWAVES = 8, NTHR = 512;
constexpr float LOG2E = 1.4426950408889634f;
constexpr float C2 = 0.125f * LOG2E;
constexpr int ZC_FQ = 0, ZC_FK = 384, ZC_FV = 768, ZC_SU = 1152, ZC_HQ = 1408, ZC_HF = 1792, ZC_HI = 2176, ZC_HG = 2560, ZC_FF = 2944;
constexpr size_t MiB = 1u << 20;
constexpr size_t WS_CTL = 0, CTL_ZERO_BYTES = 1 * MiB;
constexpr size_t WS_MOD = 1 * MiB;
constexpr size_t WS_LB = WS_MOD + 512 * 1024;
constexpr size_t WS_S5AL = WS_LB + 4096;
constexpr size_t WS_NLF = 2 * MiB;
constexpr size_t WS_G = WS_NLF + 48 * 4096 * 4;
constexpr size_t WS_KN = WS_G + 48 * 4096 * 4;
constexpr size_t WS_QN = WS_KN + 48 * 64 * 4;
constexpr size_t WS_WIN = 4 * MiB;
constexpr size_t WS_WOUT = WS_WIN + 2ull * 3072 * 1024 * 2;
constexpr size_t WS_W1 = WS_WOUT + 2ull * 1024 * 1024 * 2;
constexpr size_t WS_W2 = WS_W1 + 2ull * 8192 * 1024 * 2;
constexpr size_t WS_GLU = WS_W2 + 2ull * 1024 * 4096 * 2;
constexpr size_t WS_S5WO = WS_GLU + 2ull * 256 * 256 * 2;
constexpr size_t WS_S5WL = WS_S5WO + 2ull * 16 * 256 * 384 * 2;
constexpr size_t WS_H = 80 * MiB;
constexpr size_t WS_Z = WS_H + (size_t)M * 1024 * 2;
constexpr size_t WS_UP = WS_Z + (size_t)M * NZ * 2;
constexpr size_t WS_LOC = WS_UP + 16ull * 2048 * 384 * 2;
constexpr size_t WS_Y = WS_LOC + 16ull * 2048 * 128 * 4;
constexpr size_t WS_HLOC = WS_Y + (size_t)M * 256 * 2;
constexpr size_t WS_XB = WS_HLOC + 16 * MiB;
constexpr size_t WS_END = WS_XB + (size_t)M * 1024 * 2;
static_assert(WS_S5WL + 2ull * 16 * 256 * 256 * 2 <= WS_H, "weights fit below H");
static_assert(WS_QN + 48 * 16 * 4 <= WS_WIN, "norm tables fit below the weights");
static_assert(WS_END <= 512 * MiB, "workspace fits 512 MiB");

#define GAS __attribute__((address_space(1)))
#define LAS __attribute__((address_space(3)))
typedef unsigned short bf16;
typedef unsigned v4u __attribute__((ext_vector_type(4)));
typedef unsigned v2u __attribute__((ext_vector_type(2)));
typedef float f32x4 __attribute__((ext_vector_type(4)));
typedef GAS unsigned gu32;
#define RLX_AGENT __ATOMIC_RELAXED, __HIP_MEMORY_SCOPE_AGENT
#define LDS_WAIT() asm volatile("s_waitcnt lgkmcnt(0)" ::: "memory")
#define VM_WAIT() asm volatile("s_waitcnt vmcnt(0)" ::: "memory")
__device__ __forceinline__ unsigned f2bf(float f) { unsigned u = __builtin_bit_cast(unsigned, f); return (u + 0x7fffu + ((u >> 16) & 1u)) >> 16; }
typedef float f32x2_t_ __attribute__((ext_vector_type(2))); typedef __bf16 bf16x2_t_ __attribute__((ext_vector_type(2)));
__device__ __forceinline__ unsigned pk2(float lo, float hi) { const f32x2_t_ v = {lo, hi}; return __builtin_bit_cast(unsigned, __builtin_convertvector(v, bf16x2_t_)); }
__device__ __forceinline__ float bf2f(unsigned short h) { return __builtin_bit_cast(float, (unsigned)h << 16); }
__device__ __forceinline__ float bflo(unsigned w) { return __builtin_bit_cast(float, w << 16); }
__device__ __forceinline__ float bfhi(unsigned w) { return __builtin_bit_cast(float, w & 0xffff0000u); }
__device__ __forceinline__ float fsigmoid(float x) { return __builtin_amdgcn_rcpf(1.f + __builtin_amdgcn_exp2f(-LOG2E * x)); }
__device__ __forceinline__ float fsilu(float x) { return x * fsigmoid(x); }
__device__ __forceinline__ float lane_get(float v, int src_lane) { return __builtin_bit_cast(float, __builtin_amdgcn_ds_bpermute(src_lane << 2, __builtin_bit_cast(int, v))); }
__device__ __forceinline__ float wave_sum(float v, int  ) {
    v += __builtin_bit_cast(float, __builtin_amdgcn_update_dpp(0, __builtin_bit_cast(int, v), 0xB1, 0xF, 0xF, false));
    v += __builtin_bit_cast(float, __builtin_amdgcn_update_dpp(0, __builtin_bit_cast(int, v), 0x4E, 0xF, 0xF, false));
    v += __builtin_bit_cast(float, __builtin_amdgcn_update_dpp(0, __builtin_bit_cast(int, v), 0x141, 0xF, 0xF, false));
    v += __builtin_bit_cast(float, __builtin_amdgcn_update_dpp(0, __builtin_bit_cast(int, v), 0x140, 0xF, 0xF, false));
    v += __builtin_bit_cast(float, __builtin_amdgcn_update_dpp(0, __builtin_bit_cast(int, v), 0x142, 0xA, 0xF, false));
    v += __builtin_bit_cast(float, __builtin_amdgcn_update_dpp(0, __builtin_bit_cast(int, v), 0x143, 0xC, 0xF, false));
    return __builtin_bit_cast(float, __builtin_amdgcn_readlane(__builtin_bit_cast(int, v), 63));
}

__device__ __forceinline__ int lane_now() { int z = 0; asm volatile("" : "+v"(z)); return (int)__builtin_amdgcn_mbcnt_hi(~0u, __builtin_amdgcn_mbcnt_lo(~0u, (unsigned)z)); }

struct Params {
    const float* in[29]; float* out; unsigned char* ws; int ph_lo, ph_hi, li, pad;
};
enum { I_X = 0, I_C, I_ADAW, I_ADAB, I_NMW, I_NFW, I_WIN, I_FOXB, I_ARE, I_AIM, I_BRE, I_BIM, I_CRE, I_CIM, I_S5D, I_LOGDT, I_GLUW, I_GLUB, I_LBL, I_HNW, I_BNF, I_BNS, I_WOUT, I_RW, I_RB, I_WG, I_WU, I_WD, I_FINW };

__device__ __forceinline__ void transpose_item(const float* src, int ld_src, int c0, int nvalid, bf16* dst, int ldd, int k0, LAS float* scr, int lane) {
#pragma unroll 8
    for (int i = 0; i < 32; ++i) { const int kk = 2 * i + (lane >> 5), n = lane & 31; scr[kk * 33 + n] = (n < nvalid) ? src[(size_t)(k0 + kk) * ld_src + c0 + n] : 0.f; }
    LDS_WAIT(); asm volatile("" ::: "memory");
    const int c = lane & 7;
#pragma unroll
    for (int j = 0; j < 4; ++j) { const int n = (lane >> 3) + 8 * j; const LAS float* s = scr + (8 * c) * 33 + n;
        v4u o; o.x = pk2(s[0 * 33], s[1 * 33]); o.y = pk2(s[2 * 33], s[3 * 33]); o.z = pk2(s[4 * 33], s[5 * 33]); o.w = pk2(s[6 * 33], s[7 * 33]);
        *(GAS v4u*)(dst + (size_t)n * ldd + k0 + 8 * c) = o; }
    LDS_WAIT(); asm volatile("" ::: "memory");
}
__device__ __forceinline__ int win_src_col(int n) {
    if (n < 1152) return n;
    if (n < 1408) return 1158 + (n - 1152);
    if (n < 2944) return 1414 + (n - 1408);
    if (n < 2950) return 1152 + (n - 2944);
    return -1;
}
__device__ __forceinline__ void prologue_wave_items(const Params& p, int oz, LAS float* scr, int gw, int ngw, int lane) {
    unsigned char* ws = p.ws + oz;
    constexpr int IT_WIN = 2 * 16 * 96, IT_WOUT = 2 * 16 * 32, IT_W1 = 2 * 16 * 256, IT_W2 = 2 * 64 * 32, IT_GLU = 2 * 4 * 8;
    constexpr int NITEMS = IT_WIN + IT_WOUT + IT_W1 + IT_W2 + IT_GLU;
    for (int it = gw; it < NITEMS; it += ngw) {
        int r = it;
        if (r < IT_WIN) { const int l = r / (16 * 96), q = r % (16 * 96), kb = q / 96, nb = q % 96, n0 = nb * 32; const int sc = win_src_col(n0);
            int nvalid = 32; if (sc < 0) nvalid = 0; else if (n0 == 2944) nvalid = 6;
            transpose_item(p.in[I_WIN + oz] + (size_t)l * 1024 * NIN, NIN, sc < 0 ? 0 : sc, nvalid, (bf16*)(ws + WS_WIN) + ((size_t)l * 3072 + n0) * 1024, 1024, kb * 64, scr, lane); continue; }
        r -= IT_WIN;
        if (r < IT_WOUT) { const int l = r / (16 * 32), q = r % (16 * 32), kb = q / 32, nb = q % 32;
            transpose_item(p.in[I_WOUT + oz] + (size_t)l * 1024 * 1024, 1024, nb * 32, 32, (bf16*)(ws + WS_WOUT) + ((size_t)l * 1024 + nb * 32) * 1024, 1024, kb * 64, scr, lane); continue; }
        r -= IT_WOUT;
        if (r < IT_W1) {
            const int l = r / (16 * 256), q = r % (16 * 256), kb = q / 256, nb = q % 256, n0 = nb * 32; const int e = n0 / 512, j = (n0 % 512) / 256, w = n0 % 256; const bool up = w >= 128; const int f0 = j * 128 + (w % 128);
            const float* src = (up ? p.in[I_WU + oz] : p.in[I_WG + oz]) + ((size_t)l * 16 + e) * 1024 * 256;
            transpose_item(src, 256, f0, 32, (bf16*)(ws + WS_W1) + ((size_t)l * 8192 + n0) * 1024, 1024, kb * 64, scr, lane); continue; }
        r -= IT_W1;
        if (r < IT_W2) { const int l = r / (64 * 32), q = r % (64 * 32), kb = q / 32, nb = q % 32;
            transpose_item(p.in[I_WD + oz] + (size_t)l * 4096 * 1024, 1024, nb * 32, 32, (bf16*)(ws + WS_W2) + ((size_t)l * 1024 + nb * 32) * 4096, 4096, kb * 64, scr, lane); continue; }
        r -= IT_W2;
        { const int l = r / 32, q = r % 32, kb = q / 8, nb = q % 8;
            transpose_item(p.in[I_GLUW + oz] + (size_t)l * 65536, 256, nb * 32, 32, (bf16*)(ws + WS_GLU) + ((size_t)l * 256 + nb * 32) * 256, 256, kb * 64, scr, lane); }
    }
    if (gw == 0) { float* lb = (float*)(ws + WS_LB); for (int j = lane; j < 384; j += 64) { const float a = p.in[I_LBL + oz][j], b = p.in[I_LBL + oz][384 + j], m = fmaxf(a, b), ea = __expf(a - m), eb = __expf(b - m); lb[j] = 0.f; lb[384 + j] = eb / (ea + eb); } }
}
__device__ __forceinline__ void prologue_mod_item(const Params& p, int oz, int item, LAS float* lds, int tid, int lane, int wave) {
    LAS float* cact = lds; LAS float* part = lds + 8192;
    const int l = item / 96, nb = item % 96, n = nb * 64 + lane; const float* W = p.in[I_ADAW + oz] + ((size_t)l * 1024 + wave * 128) * 6144 + n;
    float acc[8];
#pragma unroll
    for (int b = 0; b < 8; ++b) acc[b] = 0.f;
    for (int k0 = 0; k0 < 128; k0 += 16) { float w[16];
#pragma unroll
        for (int u = 0; u < 16; ++u) w[u] = W[(size_t)(k0 + u) * 6144];
#pragma unroll
        for (int u = 0; u < 16; ++u)
#pragma unroll
            for (int b = 0; b < 8; ++b) acc[b] += cact[b * 1024 + wave * 128 + k0 + u] * w[u]; }
#pragma unroll
    for (int b = 0; b < 8; ++b) part[(wave * 8 + b) * 64 + lane] = acc[b];
    __syncthreads();
    { const int b = tid >> 6; float s = 0.f;
#pragma unroll
        for (int w = 0; w < 8; ++w) s += part[(w * 8 + b) * 64 + lane];
        ((float*)(p.ws + oz + WS_MOD))[(l * 8 + b) * 6144 + n] = s + p.in[I_ADAB + oz][l * 6144 + n]; }
    __syncthreads();
}
__device__ __forceinline__ void prologue_s5_item(const Params& p, int oz, int l, int g, LAS float* lds, int tid) {
    LAS float* apr = lds;
    LAS float* api = lds + 17 * 64;
    LAS float* bbr = lds + 34 * 64;
    LAS float* bbi = bbr + 1024;
    LAS float* ccr = bbi + 1024;
    LAS float* cci = ccr + 1024;
    LAS float* Kt = cci + 1024;
    unsigned char* ws = p.ws + oz;
    if (tid < 64) { const int q = tid; const float dt = __expf(p.in[I_LOGDT + oz][l * 16 + g]); const float lr = p.in[I_ARE + oz][(l * 16 + g) * 64 + q], li = p.in[I_AIM + oz][(l * 16 + g) * 64 + q];
        for (int tau = 0; tau <= 16; ++tau) { const float er = expf(lr * dt * tau); float sn, cs; sincosf(li * dt * tau, &sn, &cs); apr[tau * 64 + q] = er * cs; api[tau * 64 + q] = er * sn; }
        const float ar = apr[64 + q], ai = api[64 + q]; const float nr = ar - 1.f, ni = ai, den = lr * lr + li * li; const float fr = (nr * lr + ni * li) / den, fi = (ni * lr - nr * li) / den;
        for (int c = 0; c < 16; ++c) { const float br = p.in[I_BRE + oz][((l * 16 + g) * 64 + q) * 16 + c], bi = p.in[I_BIM + oz][((l * 16 + g) * 64 + q) * 16 + c]; bbr[q * 16 + c] = fr * br - fi * bi; bbi[q * 16 + c] = fr * bi + fi * br;
            ccr[c * 64 + q] = p.in[I_CRE + oz][((l * 16 + g) * 16 + c) * 64 + q]; cci[c * 64 + q] = p.in[I_CIM + oz][((l * 16 + g) * 16 + c) * 64 + q]; }
        float* al = (float*)(ws + WS_S5AL) + ((l * 16 + g) * 64 + q) * 2; al[0] = apr[16 * 64 + q]; al[1] = api[16 * 64 + q];
    }
    __syncthreads();
    for (int idx = tid; idx < 4096; idx += NTHR) { const int tau = idx >> 8, c = (idx >> 4) & 15, c2 = idx & 15; float acc = 0.f;
        for (int q = 0; q < 64; ++q) { const float mr = ccr[c * 64 + q] * apr[tau * 64 + q] - cci[c * 64 + q] * api[tau * 64 + q], mi = ccr[c * 64 + q] * api[tau * 64 + q] + cci[c * 64 + q] * apr[tau * 64 + q];
            acc += mr * bbr[q * 16 + c2] - mi * bbi[q * 16 + c2]; }
        if (tau == 0 && c == c2) acc += p.in[I_S5D + oz][(l * 16 + g) * 16 + c];
        Kt[idx] = acc; }
    __syncthreads();
    bf16* WO = (bf16*)(ws + WS_S5WO) + (size_t)(l * 16 + g) * 256 * 384; bf16* WL = (bf16*)(ws + WS_S5WL) + (size_t)(l * 16 + g) * 256 * 256;
    for (int ch = tid; ch < 256 * 48; ch += NTHR) { const int n = ch / 48, k0 = (ch % 48) * 8, j = n >> 4, c = n & 15; float v[8];
#pragma unroll
        for (int e = 0; e < 8; ++e) { const int k = k0 + e; float val;
            if (k < 256) { const int i = k >> 4, c2 = k & 15; val = (j >= i) ? Kt[((j - i) << 8) + (c << 4) + c2] : 0.f; }
            else { const int q = (k - 256) & 63; const float pr = apr[(j + 1) * 64 + q], pi = api[(j + 1) * 64 + q], cr = ccr[c * 64 + q], ci = cci[c * 64 + q];
                val = (k - 256 < 64) ? (cr * pr - ci * pi) : -(cr * pi + ci * pr); }
            v[e] = val; }
        v4u o; o.x = pk2(v[0], v[1]); o.y = pk2(v[2], v[3]); o.z = pk2(v[4], v[5]); o.w = pk2(v[6], v[7]);
        *(GAS v4u*)(WO + (size_t)n * 384 + k0) = o; }
    for (int ch = tid; ch < 256 * 32; ch += NTHR) { const int n = ch / 32, k0 = (ch % 32) * 8; float v[8];
#pragma unroll
        for (int e = 0; e < 8; ++e) { const int k = k0 + e, i = k >> 4, c2 = k & 15; float val = 0.f;
            if (n < 128) { const int q = n & 63; const float pr = apr[(15 - i) * 64 + q], pi = api[(15 - i) * 64 + q], br = bbr[q * 16 + c2], bi = bbi[q * 16 + c2]; val = (n < 64) ? (pr * br - pi * bi) : (pr * bi + pi * br); }
            v[e] = val; }
        v4u o; o.x = pk2(v[0], v[1]); o.y = pk2(v[2], v[3]); o.z = pk2(v[4], v[5]); o.w = pk2(v[6], v[7]);
        *(GAS v4u*)(WL + (size_t)n * 256 + k0) = o; }
    __syncthreads();
}
__device__ __forceinline__ void row_load(const float* X, int m, int lane, f32x4 (&v)[4]) { const GAS f32x4* xr = (const GAS f32x4*)(X + (size_t)m * 1024) + lane;
#pragma unroll
    for (int j = 0; j < 4; ++j) v[j] = xr[64 * j]; }
__device__ __forceinline__ void row_load_bf(const bf16* X, int m, int lane, f32x4 (&v)[4]) { const GAS v2u* xr = (const GAS v2u*)(X + (size_t)m * 1024) + lane;
#pragma unroll
    for (int j = 0; j < 4; ++j) { const v2u w = xr[64 * j]; v[j] = (f32x4){bflo(w.x), bfhi(w.x), bflo(w.y), bfhi(w.y)}; } }
__device__ __forceinline__ void adaln_factors(const float* w, const float* sh, const float* sc, int lane, f32x4 (&A)[4], f32x4 (&B)[4]) {
#pragma unroll
    for (int j = 0; j < 4; ++j) { const f32x4 ww = ((const GAS f32x4*)w)[lane + 64 * j], a = ((const GAS f32x4*)sc)[lane + 64 * j]; A[j] = ww * (a + 1.f); B[j] = ((const GAS f32x4*)sh)[lane + 64 * j]; } }
__device__ __forceinline__ void norm_row_to_bf16(f32x4 (&v)[4], const f32x4 (&A)[4], const f32x4 (&B)[4], bf16* orow, int lane) {
    float s = 0.f;
#pragma unroll
    for (int j = 0; j < 4; ++j) s += (v[j].x * v[j].x + v[j].y * v[j].y) + (v[j].z * v[j].z + v[j].w * v[j].w);
    const float rstd = __builtin_amdgcn_rsqf(wave_sum(s, lane) * (1.f / 1024.f) + 1e-6f);
    GAS unsigned long long* o8 = (GAS unsigned long long*)orow + lane;
#pragma unroll
    for (int j = 0; j < 4; ++j) { const f32x4 h = (v[j] * rstd) * A[j] + B[j]; v[j] = h;
        o8[64 * j] = (unsigned long long)pk2(h.x, h.y) | ((unsigned long long)pk2(h.z, h.w) << 32); }
}
}
namespace fx {
#define XB_TMO      128
#define XB_XCNT(j)  (256  + 64 * (j))
#define XB_XSUB(j)  (1280 + 64 * (j))
#define XB_XGEN(j)  (2304 + 64 * (j))
#define XB_TOP      3328
#define XB_TOPGEN   3392
#define XCD_BAR_WORDS 3456
#define XB_SPIN_CAP (1u << 18)

__device__ __forceinline__ unsigned xb_ld(unsigned* p)              { return __hip_atomic_load(p, __ATOMIC_RELAXED, __HIP_MEMORY_SCOPE_AGENT); }
__device__ __forceinline__ unsigned xb_add(unsigned* p, unsigned v) { return __hip_atomic_fetch_add(p, v, __ATOMIC_RELAXED, __HIP_MEMORY_SCOPE_AGENT); }
__device__ __forceinline__ unsigned xb_xcc_id() { return (unsigned)__builtin_amdgcn_s_getreg((3 << 11) | 20) & 0xFu; }
#define XB_SPIN(cond, bar) do { unsigned _sp = 0; while (cond) { __builtin_amdgcn_s_sleep(1); \
    if ((++_sp & 255u) == 0u) { if (xb_ld(&(bar)[XB_TMO])) break; if (_sp > XB_SPIN_CAP) { atomicAdd(&(bar)[XB_TMO], 1u); break; } } } } while (0)

struct XcdBarrier {
    unsigned* bar; unsigned x;
    volatile LAS unsigned* st;
};

__device__ __forceinline__ XcdBarrier xcd_barrier_post(unsigned* bar, volatile LAS unsigned* st, bool leader) {
    XcdBarrier b; b.bar = bar; b.x = xb_xcc_id(); b.st = st;
    if (leader) (void)xb_add(&bar[XB_XCNT(b.x)], 1u);
    return b;
}
__device__ __forceinline__ void xcd_barrier_complete(unsigned* bar, unsigned x, unsigned& nloc, unsigned& nx) {
    const unsigned G = gridDim.x * gridDim.y * gridDim.z;
    asm volatile("" : "+s"(x));
    unsigned sum, cnt, mine, sp = 0u;
    for (;;) {
        sum = 0u; cnt = 0u; mine = 0u;
#pragma unroll
        for (unsigned j = 0; j < 16; ++j) { const unsigned c = xb_ld(&bar[XB_XCNT(j)]); sum += c; cnt += (c > 0u) ? 1u : 0u; mine = (j == x) ? c : mine; }
        if (sum == G) break;
        __builtin_amdgcn_s_sleep(1);
        if ((++sp & 255u) == 0u) { if (xb_ld(&bar[XB_TMO])) break; if (sp > XB_SPIN_CAP) { atomicAdd(&bar[XB_TMO], 1u); break; } }
    }
    nloc = mine > 0u ? mine : 1u; nx = cnt > 0u ? cnt : 1u;
}

__device__ __forceinline__ void xcd_barrier(const XcdBarrier& b, bool leader) {
    asm volatile("s_waitcnt vmcnt(0)" ::: "memory");
    __syncthreads();
    if (leader) {
        unsigned* bar = b.bar;
        __builtin_amdgcn_s_waitcnt(0);
        unsigned nloc = b.st[0], nx = b.st[1];
        if (nloc == 0u) { xcd_barrier_complete(bar, b.x, nloc, nx); b.st[0] = nloc; b.st[1] = nx; }
        const unsigned old = xb_add(&bar[XB_XSUB(b.x)], 1u);
        const unsigned gen = old / nloc;
        if (old + 1u == (gen + 1u) * nloc) {
            __builtin_amdgcn_fence(__ATOMIC_RELEASE, "agent");
            asm volatile("s_waitcnt vmcnt(0)" ::: "memory");
            const unsigned og = xb_add(&bar[XB_TOP], 1u);
            const unsigned tg = og / nx;
            if (og + 1u == (tg + 1u) * nx) xb_add(&bar[XB_TOPGEN], 1u);
            else XB_SPIN(xb_ld(&bar[XB_TOPGEN]) == tg, bar);
            __builtin_amdgcn_fence(__ATOMIC_ACQUIRE, "agent");
            xb_add(&bar[XB_XGEN(b.x)], 1u);
            asm volatile("s_waitcnt vmcnt(0)" ::: "memory");
        } else {
            XB_SPIN(xb_ld(&bar[XB_XGEN(b.x)]) == gen, bar);
            __builtin_amdgcn_fence(__ATOMIC_ACQUIRE, "agent");
            asm volatile("s_waitcnt vmcnt(0)" ::: "memory");
        }
    }
    __syncthreads();
}

}
namespace pg8 {
#define PG8_LAS __attribute__((address_space(3)))
typedef unsigned short bf16_t;
typedef short bf16x8 __attribute__((ext_vector_type(8)));
typedef float f32x4 __attribute__((ext_vector_type(4)));
typedef unsigned u32x4 __attribute__((ext_vector_type(4)));
constexpr int BM = 256, BK = 64, HALF = 128, HTB = HALF * BK * 2  , STAGE_BYTES = 8 * HTB, NXCD = 8, WGM = 8;

__host__ __device__ __forceinline__ int lds_byte(int r, int c) { const int st = (r >> 4) * 2 + (c >> 5), rr = r & 15, cc = c & 31, ob = rr * 64 + cc * 2; return st * 1024 + (ob ^ (((ob >> 9) & 1) << 5)); }
__host__ __device__ __forceinline__ void stage_rc(int b, int& R, int& C) { const int st = b / 1024, sb = b % 1024, swz = sb ^ (((sb >> 9) & 1) << 5); R = (st >> 1) * 16 + swz / 64; C = (st & 1) * 32 + (swz % 64) / 2; }
__host__ __device__ __forceinline__ int perm32(int rho) { const int n = rho >> 4, i = rho & 15; return 8 * (i >> 2) + 4 * n + (i & 3); }

struct Unit { int pm, pn; int k0, k1; };
struct Gemm { const bf16_t* A; const bf16_t* Bt; int M, N, K, lda, ldb; };

struct StaticOrder {
    int nM, nN, nwg, G, c;
    __host__ __device__ void init(int M, int N, int G_, int c_) { nM = M / BM; nN = N / BM; nwg = nM * nN; G = G_; c = c_; }
    __host__ __device__ bool next(int i, Unit& u) const {
        const long L = (long)i * G + c; if (L >= nwg) return false;
        int wgid = (int)L; { const int q = nwg / NXCD, r = nwg % NXCD, xcd = wgid % NXCD, off = wgid / NXCD; wgid = (xcd < r ? xcd * (q + 1) : r * (q + 1) + (xcd - r) * q) + off; }
        const int nig = WGM * nN, gid = wgid / nig, fm = gid * WGM, gsz = (nM - fm) < WGM ? (nM - fm) : WGM;
        u.pm = fm + ((wgid % nig) % gsz); u.pn = (wgid % nig) / gsz; return true;
    }
    __device__ __forceinline__ void a_ready(const Unit&) const {}
    __device__ __forceinline__ void done(const Unit&) const {}
};

__device__ __forceinline__ unsigned cvt_pk_bf16(float lo, float hi) { unsigned r; asm volatile("v_cvt_pk_bf16_f32 %0, %1, %2" : "=v"(r) : "v"(lo), "v"(hi)); return r; }
typedef float f32x2 __attribute__((ext_vector_type(2)));
__device__ __forceinline__ f32x2 gelu_pk(f32x2 v) {
    const f32x2 av = __builtin_elementwise_abs(v), d = av * 0.2316418882f + 1.0f;
    f32x2 t; t.x = __builtin_amdgcn_rcpf(d.x); t.y = __builtin_amdgcn_rcpf(d.y);
    f32x2 q = t * 0.5307027145f + (-0.7265760135f); q = q * t + 0.7107068705f; q = q * t + (-0.142248368f); q = q * t + 0.127414796f; q = q * t;
    const f32x2 s = (v * v) * (-0.72134752044f);
    f32x2 e; e.x = __builtin_amdgcn_exp2f(s.x); e.y = __builtin_amdgcn_exp2f(s.y);
    const f32x2 m = v * (q * e), r = v - m;
    f32x2 o; o.x = v.x < 0.f ? m.x : r.x; o.y = v.y < 0.f ? m.y : r.y; return o;
}

template <int ACT  > struct EpiBf16 {
    static constexpr bool PERM = true, AFTER_DRAIN = false; static_assert(ACT == 0 || ACT == 1, "EpiBf16: ACT is 0 (none) or 1 (gelu_pk)");
    bf16_t* O; int ldc; const float* bias; int split_cols; size_t split_stride; float scale0;
    __device__ __forceinline__ void operator()(const f32x4 (&acc)[2][2][4][2], const Unit& u, int wr, int wc, int fr, int fq) const {
        const int row0 = u.pm * BM + wr * 64 + fr; int colt = u.pn * BM; bf16_t* base = O;
        float sc = 1.f; if (split_cols) { const int t = colt / split_cols; base += (size_t)t * split_stride; colt -= t * split_cols; if (t == 0) sc = scale0; }
        const int col0 = colt + wc * 32 + 8 * fq, bcol0 = u.pn * BM + wc * 32 + 8 * fq;
        f32x4 bv[2][2];
#pragma unroll
        for (int bj = 0; bj < 2; ++bj)
#pragma unroll
            for (int n = 0; n < 2; ++n) bv[bj][n] = bias ? *(const f32x4*)(bias + bcol0 + bj * HALF + 4 * n) : (f32x4){0.f, 0.f, 0.f, 0.f};
#pragma unroll
        for (int ai = 0; ai < 2; ++ai)
#pragma unroll
            for (int m = 0; m < 4; ++m) { bf16_t* rowp = base + (size_t)(row0 + ai * HALF + m * 16) * ldc + col0;
#pragma unroll
                for (int bj = 0; bj < 2; ++bj) { f32x4 v0 = acc[ai][bj][m][0] + bv[bj][0], v1 = acc[ai][bj][m][1] + bv[bj][1];
                    if (ACT == 1) { f32x2 a = gelu_pk((f32x2){v0[0], v0[1]}), b = gelu_pk((f32x2){v0[2], v0[3]}), c = gelu_pk((f32x2){v1[0], v1[1]}), d = gelu_pk((f32x2){v1[2], v1[3]});
                        v0 = (f32x4){a.x, a.y, b.x, b.y}; v1 = (f32x4){c.x, c.y, d.x, d.y}; }
                    v0 = v0 * sc; v1 = v1 * sc; u32x4 w; w.x = cvt_pk_bf16(v0[0], v0[1]); w.y = cvt_pk_bf16(v0[2], v0[3]); w.z = cvt_pk_bf16(v1[0], v1[1]); w.w = cvt_pk_bf16(v1[2], v1[3]);
                    *(u32x4*)(rowp + bj * HALF) = w; } }
    }
};

struct PanelStats {
    unsigned* xbuf;
    unsigned* cnt;
    unsigned* tmo;
    int ntn; float eps;
    unsigned code;
    __device__ __forceinline__ bool run(const f32x4 (&v)[2][2][4][2], const Unit& u, int wr, int wc, int fr, int fq, PG8_LAS unsigned char* lds, int wid, int lane) const {
        typedef float f32x2v __attribute__((ext_vector_type(2)));
        PG8_LAS f32x2v* P = (PG8_LAS f32x2v*)lds;
        PG8_LAS f32x2v* S = (PG8_LAS f32x2v*)(lds + 8192);
        PG8_LAS unsigned* flag = (PG8_LAS unsigned*)(lds + 8192 + 2048);
#pragma unroll
        for (int ai = 0; ai < 2; ++ai)
#pragma unroll
            for (int m = 0; m < 4; ++m) {
                float s = 0.f;
#pragma unroll
                for (int bj = 0; bj < 2; ++bj)
#pragma unroll
                    for (int n = 0; n < 2; ++n) { const f32x4 x = v[ai][bj][m][n]; s += (x[0] + x[1]) + (x[2] + x[3]); }
                s += __shfl_xor(s, 16); s += __shfl_xor(s, 32);
                const float mw = s * (1.0f / 64.0f); float q = 0.f;
#pragma unroll
                for (int bj = 0; bj < 2; ++bj)
#pragma unroll
                    for (int n = 0; n < 2; ++n) { const f32x4 d = v[ai][bj][m][n] - mw; q += (d[0] * d[0] + d[1] * d[1]) + (d[2] * d[2] + d[3] * d[3]); }
                q += __shfl_xor(q, 16); q += __shfl_xor(q, 32);
                if (fq == 0) P[(ai * HALF + wr * 64 + m * 16 + fr) * 4 + wc] = (f32x2v){mw, q};
            }
        asm volatile("s_waitcnt lgkmcnt(0)" ::: "memory"); __builtin_amdgcn_s_barrier(); asm volatile("" ::: "memory");
#if defined(BROKEN_EXCHANGE_NO_WAIT)
#warning BROKEN CONTROL BUILD: the row-statistics exchange does not wait; results are wrong by design
        if (blockIdx.x >= 64) { const long long t0_ = clock64(); while (clock64() - t0_ < 60000) __builtin_amdgcn_s_sleep(8); }
#endif
        const int row = wid * 32 + (lane & 31);
        if (lane < 32) {
            const f32x2v a = P[row * 4 + 0], b = P[row * 4 + 1], c = P[row * 4 + 2], d = P[row * 4 + 3];
            const float mt = (a.x + b.x + c.x + d.x) * 0.25f;
            const float da = a.x - mt, db = b.x - mt, dc = c.x - mt, dd = d.x - mt;
            const float m2 = (a.y + b.y) + (c.y + d.y) + 64.0f * ((da * da + db * db) + (dc * dc + dd * dd));
            unsigned long long* slot = (unsigned long long*)xbuf + ((size_t)(u.pm * BM + row) * 4 + u.pn);
            __hip_atomic_store(slot, ((unsigned long long)__float_as_uint(m2) << 32) | __float_as_uint(mt), __ATOMIC_RELAXED, __HIP_MEMORY_SCOPE_AGENT);
        }
        asm volatile("s_waitcnt vmcnt(0)" ::: "memory");
        if (lane == 0) __hip_atomic_fetch_add(cnt + 64 * u.pm, 1u, __ATOMIC_RELAXED, __HIP_MEMORY_SCOPE_AGENT);
        if (wid == 0) {
            bool dead = false; const unsigned long long t0 = __builtin_amdgcn_s_memrealtime(); const unsigned want = 8u * (unsigned)ntn;
            for (;;) {
#if defined(BROKEN_EXCHANGE_NO_WAIT)
                break;
#endif
                if ((unsigned)__builtin_amdgcn_readfirstlane(__hip_atomic_load(cnt + 64 * u.pm, __ATOMIC_RELAXED, __HIP_MEMORY_SCOPE_AGENT)) >= want) break;
                if (__builtin_amdgcn_s_memrealtime() - t0 > 2000000ull) {
                    if (lane == 0) { unsigned expect = 0u; __hip_atomic_compare_exchange_strong(tmo + 1, &expect, code | (unsigned)(u.pm & 0xff), __ATOMIC_RELAXED, __ATOMIC_RELAXED, __HIP_MEMORY_SCOPE_AGENT);
                                     __hip_atomic_store(tmo, 1u, __ATOMIC_RELAXED, __HIP_MEMORY_SCOPE_AGENT); }
                    dead = true; break; }
                __builtin_amdgcn_s_sleep(2);
            }
            __builtin_amdgcn_fence(__ATOMIC_ACQUIRE, "agent");
            if (lane == 0) flag[0] = dead ? 1u : 0u;
        }
        asm volatile("s_waitcnt vmcnt(0) lgkmcnt(0)" ::: "memory"); __builtin_amdgcn_s_barrier(); asm volatile("" ::: "memory");
        const bool bad = flag[0] != 0u;
        if (lane < 32) {
            const unsigned long long* slot = (const unsigned long long*)xbuf + (size_t)(u.pm * BM + row) * 4; float mt[4], m2[4]; float ms = 0.f;
#pragma unroll
            for (int t = 0; t < 4; ++t) { if (t < ntn) { const unsigned long long w = __hip_atomic_load(slot + t, __ATOMIC_RELAXED, __HIP_MEMORY_SCOPE_AGENT); mt[t] = __uint_as_float((unsigned)w); m2[t] = __uint_as_float((unsigned)(w >> 32)); } else { mt[t] = 0.f; m2[t] = 0.f; } ms += mt[t]; }
            const float mean = ms / (float)ntn; float q = 0.f;
#pragma unroll
            for (int t = 0; t < 4; ++t) if (t < ntn) { const float dm = mt[t] - mean; q += m2[t] + 256.0f * dm * dm; }
            S[row] = (f32x2v){mean, 1.0f / sqrtf(q / (256.0f * (float)ntn) + eps)};
        }
        asm volatile("s_waitcnt lgkmcnt(0)" ::: "memory"); __builtin_amdgcn_s_barrier(); asm volatile("" ::: "memory");
        return bad;
    }
};
struct EpiLnRes {
    static constexpr bool PERM = false, AFTER_DRAIN = true;
    const float* base; float* out; int ldc; const float* bias; PanelStats st; unsigned poison;
    __device__ __forceinline__ void fused(f32x4 (&acc)[2][2][4][2], const Unit& u, int wr, int wc, int fr, int fq, PG8_LAS unsigned char* lds, int wid, int lane) const {
        typedef float f32x2v __attribute__((ext_vector_type(2)));
        const PG8_LAS f32x2v* S = (const PG8_LAS f32x2v*)(lds + 8192);
        const int col0 = u.pn * BM + wc * 32 + 4 * fq;
#pragma unroll
        for (int bj = 0; bj < 2; ++bj)
#pragma unroll
            for (int n = 0; n < 2; ++n) { const f32x4 bv = bias ? *(const f32x4*)(bias + col0 + bj * HALF + n * 16) : (f32x4){0.f, 0.f, 0.f, 0.f};
#pragma unroll
                for (int ai = 0; ai < 2; ++ai)
#pragma unroll
                    for (int m = 0; m < 4; ++m) acc[ai][bj][m][n] += bv; }
        f32x4 pre[4][2][2];
#pragma unroll
        for (int m = 0; m < 4; ++m) { const size_t off = (size_t)(u.pm * BM + wr * 64 + m * 16 + fr) * ldc + col0;
#pragma unroll
            for (int bj = 0; bj < 2; ++bj)
#pragma unroll
                for (int n = 0; n < 2; ++n) pre[m][bj][n] = *(const f32x4*)(base + off + bj * HALF + n * 16); }
        const bool bad = st.run(acc, u, wr, wc, fr, fq, lds, wid, lane) || poison != 0u;
        const float qnan = __builtin_nanf("");
#pragma unroll
        for (int ai = 0; ai < 2; ++ai)
#pragma unroll
            for (int m = 0; m < 4; ++m) { const int r = ai * HALF + wr * 64 + m * 16 + fr; const f32x2v sr = S[r]; const size_t off = (size_t)(u.pm * BM + r) * ldc + col0;
#pragma unroll
                for (int bj = 0; bj < 2; ++bj)
#pragma unroll
                    for (int n = 0; n < 2; ++n) { const f32x4 bs = ai == 0 ? pre[m][bj][n] : *(const f32x4*)(base + off + bj * HALF + n * 16); f32x4 o = bs + (acc[ai][bj][m][n] - sr.x) * sr.y;
                        if (bad) o = (f32x4){qnan, qnan, qnan, qnan}; *(f32x4*)(out + off + bj * HALF + n * 16) = o; }
                if (m & 1) asm volatile("" ::: "memory"); }
    }
};
struct EpiLnResLn {
    static constexpr bool PERM = false, AFTER_DRAIN = true;
    const float* base; float* out; bf16_t* xn; int ldc; const float* bias; PanelStats st1, st2; unsigned poison;
    __device__ __forceinline__ void fused(f32x4 (&acc)[2][2][4][2], const Unit& u, int wr, int wc, int fr, int fq, PG8_LAS unsigned char* lds, int wid, int lane) const {
        typedef float f32x2v __attribute__((ext_vector_type(2))); typedef unsigned u32x2v __attribute__((ext_vector_type(2)));
        const PG8_LAS f32x2v* S = (const PG8_LAS f32x2v*)(lds + 8192);
        const int col0 = u.pn * BM + wc * 32 + 4 * fq;
#pragma unroll
        for (int bj = 0; bj < 2; ++bj)
#pragma unroll
            for (int n = 0; n < 2; ++n) { const f32x4 bv = bias ? *(const f32x4*)(bias + col0 + bj * HALF + n * 16) : (f32x4){0.f, 0.f, 0.f, 0.f};
#pragma unroll
                for (int ai = 0; ai < 2; ++ai)
#pragma unroll
                    for (int m = 0; m < 4; ++m) acc[ai][bj][m][n] += bv; }
        bool bad = st1.run(acc, u, wr, wc, fr, fq, lds, wid, lane) || poison != 0u;
        const float qnan = __builtin_nanf("");
#pragma unroll
        for (int ai = 0; ai < 2; ++ai)
#pragma unroll
            for (int m = 0; m < 4; ++m) { const int r = ai * HALF + wr * 64 + m * 16 + fr; const f32x2v sr = S[r]; const size_t off = (size_t)(u.pm * BM + r) * ldc + col0;
#pragma unroll
                for (int bj = 0; bj < 2; ++bj)
#pragma unroll
                    for (int n = 0; n < 2; ++n) { const f32x4 bs = *(const f32x4*)(base + off + bj * HALF + n * 16); acc[ai][bj][m][n] = bs + (acc[ai][bj][m][n] - sr.x) * sr.y; }
                asm volatile("" : "+v"(acc[ai][0][m][0]), "+v"(acc[ai][0][m][1]), "+v"(acc[ai][1][m][0]), "+v"(acc[ai][1][m][1]));
                if (m & 1) asm volatile("" ::: "memory"); }
        const bool bad1 = bad;
        bad = st2.run(acc, u, wr, wc, fr, fq, lds, wid, lane) || bad;
#pragma unroll
        for (int ai = 0; ai < 2; ++ai)
#pragma unroll
            for (int m = 0; m < 4; ++m) { const int r = ai * HALF + wr * 64 + m * 16 + fr; const f32x2v sr = S[r]; const size_t off = (size_t)(u.pm * BM + r) * ldc + col0;
#pragma unroll
                for (int bj = 0; bj < 2; ++bj)
#pragma unroll
                    for (int n = 0; n < 2; ++n) { const f32x4 x1 = acc[ai][bj][m][n]; *(f32x4*)(out + off + bj * HALF + n * 16) = bad1 ? (f32x4){qnan, qnan, qnan, qnan} : x1;
                        const f32x4 o = (x1 - sr.x) * sr.y; u32x2v w; w.x = cvt_pk_bf16(o[0], o[1]); w.y = cvt_pk_bf16(o[2], o[3]);
                        if (bad) { w.x = 0x7fc07fc0u; w.y = 0x7fc07fc0u; } *(u32x2v*)(xn + off + bj * HALF + n * 16) = w; }
                asm volatile("" ::: "memory"); }
    }
};

template <class Epi, class Sched, bool ALIGN_EPI = false, bool SP2 = false, bool KSPLIT = false>
__device__ __forceinline__ void gemm_phase(PG8_LAS unsigned char* lds, const Gemm g, const Sched& S, const Epi& E, const int wave0) {
    int wv0_ = wave0; asm volatile("" : "+s"(wv0_));
    int z0_ = 0; asm volatile("" : "+v"(z0_)); const int tid_ = wv0_ * 64 + (int)__builtin_amdgcn_mbcnt_hi(~0u, __builtin_amdgcn_mbcnt_lo(~0u, (unsigned)z0_));
    const int tid = tid_, wid = __builtin_amdgcn_readfirstlane(tid >> 6), lane = tid & 63, wr = wid >> 2, wc = wid & 3, fr = lane & 15, fq = lane >> 4;
    const int K = g.K, nt = K / BK;
    unsigned voffA[2], voffB[2];
#pragma unroll
    for (int i = 0; i < 2; ++i) { int R, C; stage_rc(tid * 16 + i * 8192, R, C); const int Rb = Epi::PERM ? ((R & ~31) + perm32(R & 31)) : R;
        voffA[i] = (unsigned)(R * g.lda + C) * 2u; voffB[i] = (unsigned)(Rb * g.ldb + C) * 2u; }
    const unsigned kstep = (unsigned)(BK * 2);
    const unsigned hstepA = (unsigned)HALF * g.lda * 2, hstepB = (unsigned)HALF * g.ldb * 2;
    const unsigned tstepA = 2 * hstepA, tstepB = 2 * hstepB;
    const char* const baseA = (const char*)g.A; const char* const baseB = (const char*)g.Bt;
    const unsigned ldsw = (unsigned)wid * 1024u;
    const int aoff = lds_byte(wr * 64 + fr, fq * 8), boff = lds_byte(wc * 32 + fr, fq * 8);
#define PG8_SA(b, h) (((b) * 2 + (h)) * HTB)
#define PG8_SB(b, h) ((4 + (b) * 2 + (h)) * HTB)
#define PG8_STAGE_X(bufoff, base, soff, voff) do { _Pragma("unroll") for (int _i = 0; _i < 2; ++_i) \
        __builtin_amdgcn_global_load_lds((const unsigned*)((base) + (unsigned)((soff) + (voff)[_i])), (PG8_LAS unsigned*)(lds + (bufoff) + ldsw + _i * 8192), 16, 0, 0); } while (0)
#define PG8_LDA(dst, b, h) do { _Pragma("unroll") for (int m = 0; m < 4; ++m) _Pragma("unroll") for (int k = 0; k < 2; ++k) dst[m][k] = *(const PG8_LAS bf16x8*)(lds + PG8_SA(b, h) + aoff + m * 2048 + k * 1024); } while (0)
#define PG8_LDB(dst, b, h) do { _Pragma("unroll") for (int n = 0; n < 2; ++n) _Pragma("unroll") for (int k = 0; k < 2; ++k) dst[n][k] = *(const PG8_LAS bf16x8*)(lds + PG8_SB(b, h) + boff + n * 2048 + k * 1024); } while (0)
#define PG8_MMA(ai, bj, At, Bt) do { __builtin_amdgcn_s_setprio(1); _Pragma("unroll") for (int m = 0; m < 4; ++m) _Pragma("unroll") for (int n = 0; n < 2; ++n) _Pragma("unroll") for (int k = 0; k < 2; ++k) \
        acc[ai][bj][m][n] = __builtin_amdgcn_mfma_f32_16x16x32_bf16(Bt[n][k], At[m][k], acc[ai][bj][m][n], 0, 0, 0); __builtin_amdgcn_s_setprio(0); } while (0)
#define PG8_WAIT_V(n) asm volatile("s_waitcnt vmcnt(" #n ")" ::: "memory")
#define PG8_WAIT_L(n) asm volatile("s_waitcnt lgkmcnt(" #n ")" ::: "memory")
#define PG8_BAR __builtin_amdgcn_s_barrier()
#define PG8_SCHED __builtin_amdgcn_sched_barrier(0)
    Unit cur, nxt; int ui = 0;
    if (!S.next(0, cur)) return;
    f32x4 acc[2][2][4][2];
#pragma unroll
    for (int a = 0; a < 2; ++a)
#pragma unroll
        for (int b = 0; b < 2; ++b)
#pragma unroll
            for (int m = 0; m < 4; ++m)
#pragma unroll
                for (int n = 0; n < 2; ++n) acc[a][b][m][n] = (f32x4){0.f, 0.f, 0.f, 0.f};
    bf16x8 At[4][2], B0[2][2], B1[2][2];
    unsigned cA = (unsigned)cur.pm * tstepA; unsigned cB = (unsigned)cur.pn * tstepB + (KSPLIT ? (unsigned)cur.k0 * 2u : 0u);
    unsigned sB = KSPLIT ? (unsigned)cur.pn * tstepB + (unsigned)cur.k1 * 2u - (unsigned)(nt / 2) * kstep : cB;
    S.a_ready(cur);
    if constexpr (SP2) {
        PG8_STAGE_X(PG8_SB(0, 0), baseB, cB, voffB); PG8_STAGE_X(PG8_SB(0, 1), baseB, cB + hstepB, voffB); PG8_STAGE_X(PG8_SA(0, 0), baseA, cA, voffA); PG8_STAGE_X(PG8_SA(0, 1), baseA, cA + hstepA, voffA);
        if (wr == 1) PG8_BAR;
        PG8_WAIT_V(2); PG8_BAR;
        PG8_STAGE_X(PG8_SB(1, 0), baseB, cB + kstep, voffB); PG8_STAGE_X(PG8_SA(1, 0), baseA, cA + kstep, voffA); PG8_STAGE_X(PG8_SB(1, 1), baseB, cB + hstepB + kstep, voffB);
        PG8_WAIT_V(6); PG8_BAR;
    } else {
        PG8_STAGE_X(PG8_SB(0, 0), baseB, cB, voffB); PG8_STAGE_X(PG8_SA(0, 0), baseA, cA, voffA); PG8_STAGE_X(PG8_SB(0, 1), baseB, cB + hstepB, voffB); PG8_STAGE_X(PG8_SA(0, 1), baseA, cA + hstepA, voffA);
        if (wr == 1) PG8_BAR;
        PG8_WAIT_V(4); PG8_BAR;
        PG8_STAGE_X(PG8_SB(1, 0), baseB, cB + kstep, voffB); PG8_STAGE_X(PG8_SA(1, 0), baseA, cA + kstep, voffA); PG8_STAGE_X(PG8_SB(1, 1), baseB, cB + hstepB + kstep, voffB);
        PG8_WAIT_V(6); PG8_BAR;
    }
    for (;;) {
        const bool has_next = S.next(ui + 1, nxt);
        const unsigned nA = has_next ? (unsigned)nxt.pm * tstepA : cA; const unsigned nB = has_next ? (unsigned)nxt.pn * tstepB + (KSPLIT ? (unsigned)nxt.k0 * 2u : 0u) : cB;
        const unsigned nsB = (KSPLIT && has_next) ? (unsigned)nxt.pn * tstepB + (unsigned)nxt.k1 * 2u - (unsigned)(nt / 2) * kstep : sB;
        for (int t = 0; t < nt; t += 2) {
            const bool last = (t == nt - 2);
            const unsigned a1 = cA + (unsigned)(t + 1) * kstep;
            const unsigned a2 = last ? nA : cA + (unsigned)(t + 2) * kstep; const unsigned b2 = last ? nB : ((KSPLIT && (t + 2) >= nt / 2) ? sB : cB) + (unsigned)(t + 2) * kstep;
            const unsigned a3 = a2 + kstep; const unsigned b3 = b2 + kstep;
            if (last && has_next) S.a_ready(nxt);
            if constexpr (SP2) {
            PG8_LDB(B0, 0, 0); PG8_LDB(B1, 0, 1); PG8_SCHED; PG8_LDA(At, 0, 0); PG8_STAGE_X(PG8_SA(1, 1), baseA, a1 + hstepA, voffA);
            PG8_WAIT_V(8); PG8_WAIT_L(0); PG8_BAR; PG8_MMA(0, 0, At, B0); PG8_MMA(0, 1, At, B1); PG8_BAR; PG8_SCHED;
            PG8_LDA(At, 0, 1); PG8_STAGE_X(PG8_SB(0, 0), baseB, b2, voffB); PG8_STAGE_X(PG8_SB(0, 1), baseB, b2 + hstepB, voffB); PG8_STAGE_X(PG8_SA(0, 0), baseA, a2, voffA);
            PG8_WAIT_V(8); PG8_WAIT_L(0); PG8_BAR; PG8_MMA(1, 0, At, B0); PG8_MMA(1, 1, At, B1); PG8_BAR; PG8_SCHED;
            PG8_LDB(B0, 1, 0); PG8_LDB(B1, 1, 1); PG8_SCHED; PG8_LDA(At, 1, 0); PG8_STAGE_X(PG8_SA(0, 1), baseA, a2 + hstepA, voffA);
            PG8_WAIT_V(8); PG8_WAIT_L(0); PG8_BAR; PG8_MMA(0, 0, At, B0); PG8_MMA(0, 1, At, B1); PG8_BAR; PG8_SCHED;
            PG8_LDA(At, 1, 1); PG8_STAGE_X(PG8_SB(1, 0), baseB, b3, voffB); PG8_STAGE_X(PG8_SB(1, 1), baseB, b3 + hstepB, voffB); PG8_STAGE_X(PG8_SA(1, 0), baseA, a3, voffA);
            PG8_WAIT_V(8); PG8_WAIT_L(0); PG8_BAR; PG8_MMA(1, 0, At, B0); PG8_MMA(1, 1, At, B1); PG8_BAR; PG8_SCHED;
            } else {
            PG8_LDB(B0, 0, 0); PG8_SCHED; PG8_LDA(At, 0, 0); PG8_STAGE_X(PG8_SA(1, 1), baseA, a1 + hstepA, voffA);
            PG8_WAIT_L(8); PG8_BAR; PG8_WAIT_L(0); PG8_MMA(0, 0, At, B0); PG8_BAR; PG8_SCHED;
            PG8_LDB(B1, 0, 1); PG8_STAGE_X(PG8_SB(0, 0), baseB, b2, voffB);
            PG8_BAR; PG8_WAIT_L(0); PG8_MMA(0, 1, At, B1); PG8_BAR;
            PG8_LDA(At, 0, 1); PG8_STAGE_X(PG8_SA(0, 0), baseA, a2, voffA);
            PG8_BAR; PG8_WAIT_L(0); PG8_MMA(1, 0, At, B0); PG8_BAR; PG8_SCHED;
            PG8_STAGE_X(PG8_SB(0, 1), baseB, b2 + hstepB, voffB);
            PG8_WAIT_V(6); PG8_BAR; PG8_MMA(1, 1, At, B1); PG8_BAR;
            PG8_LDB(B0, 1, 0); PG8_SCHED; PG8_LDA(At, 1, 0); PG8_STAGE_X(PG8_SA(0, 1), baseA, a2 + hstepA, voffA);
            PG8_WAIT_L(8); PG8_BAR; PG8_WAIT_L(0); PG8_MMA(0, 0, At, B0); PG8_BAR; PG8_SCHED;
            PG8_LDB(B1, 1, 1); PG8_STAGE_X(PG8_SB(1, 0), baseB, b3, voffB);
            PG8_BAR; PG8_WAIT_L(0); PG8_MMA(0, 1, At, B1); PG8_BAR;
            PG8_LDA(At, 1, 1); PG8_STAGE_X(PG8_SA(1, 0), baseA, a3, voffA);
            PG8_BAR; PG8_WAIT_L(0); PG8_MMA(1, 0, At, B0); PG8_BAR; PG8_SCHED;
            PG8_STAGE_X(PG8_SB(1, 1), baseB, b3 + hstepB, voffB);
            PG8_WAIT_V(6); PG8_BAR; PG8_MMA(1, 1, At, B1); PG8_BAR;
            }
        }
        if constexpr (ALIGN_EPI) { if (wr == 0) PG8_BAR; }
        if constexpr (!Epi::AFTER_DRAIN) { E(acc, cur, wr, wc, fr, fq); S.done(cur); }
        if (!has_next) break;
#pragma unroll
        for (int a = 0; a < 2; ++a)
#pragma unroll
            for (int b = 0; b < 2; ++b)
#pragma unroll
                for (int m = 0; m < 4; ++m)
#pragma unroll
                    for (int n = 0; n < 2; ++n) acc[a][b][m][n] = (f32x4){0.f, 0.f, 0.f, 0.f};
        cur = nxt; cA = nA; cB = nB; sB = nsB; ++ui;
        if constexpr (ALIGN_EPI) { if (wr == 1) PG8_BAR; }
    }
    PG8_WAIT_V(0);
    if constexpr (!ALIGN_EPI) { if (wr == 0) PG8_BAR; }
    PG8_BAR;
    if constexpr (Epi::AFTER_DRAIN) { E.fused(acc, cur, wr, wc, fr, fq, lds, wid, lane); S.done(cur); }
#undef PG8_SA
#undef PG8_SB
#undef PG8_STAGE_X
#undef PG8_LDA
#undef PG8_LDB
#undef PG8_MMA
#undef PG8_WAIT_V
#undef PG8_WAIT_L
#undef PG8_BAR
#undef PG8_SCHED
}
}
namespace attn_body {
using bf16=__hip_bfloat16;
using bf16x8=__attribute__((ext_vector_type(8)))short;
using s16x4=__attribute__((ext_vector_type(4)))short;
using f32x16=__attribute__((ext_vector_type(16)))float;
using u32x4=__attribute__((ext_vector_type(4)))unsigned;
constexpr int BATCH=8,NHEAD=6,SEQ=4096,D=64,DM=3072;
constexpr int NW=8,QBLK=32,QB=QBLK*NW,KVBLK=64,NQB=SEQ/QB;
constexpr int ATTN_PITCH=DM, ATTN_UNIT_ROWS=QB;
__device__ __forceinline__ int crow(int r,int hi){return (r&3)+8*(r>>2)+4*hi;}
#define SBAR() __builtin_amdgcn_sched_barrier(0)
__device__ __forceinline__ void cmask(f32x16&p0,f32x16&p1,int jb,int qrel,int hi){
  const float NEG=-INFINITY; int kb=64*jb+4*hi;
  #pragma unroll
  for(int r=0;r<16;++r){int kv=kb+(r&3)+8*(r>>2); if(kv>qrel)p0[r]=NEG; if(kv+32>qrel)p1[r]=NEG;}
}

constexpr int NSLOT=3, SLOTB=8192;
constexpr int LDS_K=0, LDS_V=NSLOT*SLOTB, LDS_WS=2*NSLOT*SLOTB, LDS_OST=LDS_WS+NW*64*4, LDS_G=LDS_OST+NW*4096, LDS_BYTES=LDS_G+SEQ*4;
constexpr float C2=0.125f*1.4426950408889634f;
__device__ __forceinline__ void glds16(const void*gsrc,unsigned lds_dst){unsigned keep;
  asm volatile("s_mov_b32 %0, m0\n\ts_mov_b32 m0, %2\n\ts_nop 0\n\tglobal_load_lds_dwordx4 %1, off\n\ts_mov_b32 m0, %0":"=&s"(keep):"v"(gsrc),"s"(lds_dst):"memory");}
__device__ __forceinline__ float max3f(float a,float b,float c){float r;asm("v_max3_f32 %0, %1, %2, %3":"=v"(r):"v"(a),"v"(b),"v"(c));return r;}
__device__ __forceinline__ float max2f(float a,float b){float r;asm("v_max_f32_e32 %0, %1, %2":"=v"(r):"v"(a),"v"(b));return r;}
__device__ __forceinline__ float fadd_s(float a,float b){float r;asm("v_add_f32_e32 %0, %1, %2":"=v"(r):"v"(a),"v"(b));return r;}
__device__ __forceinline__ float fsub_s(float a,float b){float r;asm("v_sub_f32_e32 %0, %1, %2":"=v"(r):"v"(a),"v"(b));return r;}
typedef float f32x2_t __attribute__((ext_vector_type(2))); typedef __bf16 bf16x2_t __attribute__((ext_vector_type(2)));
__device__ __forceinline__ unsigned cvtpk_s(float lo,float hi){f32x2_t v={lo,hi};bf16x2_t b=__builtin_convertvector(v,bf16x2_t);return __builtin_bit_cast(unsigned,b);}
#define WAIT_BAR(N) asm volatile("s_waitcnt vmcnt(" #N ") lgkmcnt(0)\n\ts_barrier":::"memory")

__device__ __forceinline__ void qkt(f32x16&p0,f32x16&p1,const char*Kslot,const bf16x8*qr,const f32x16&negm,int r32,int hi){
  const char*kb=Kslot+hi*1024+r32*16;
  #pragma unroll
  for(int d0=0;d0<4;++d0){
    const bf16x8 b0=*reinterpret_cast<const bf16x8*>(kb+d0*2048);
    const bf16x8 b1=*reinterpret_cast<const bf16x8*>(kb+d0*2048+512);
    if(d0==0){p0=__builtin_amdgcn_mfma_f32_32x32x16_bf16(b0,qr[0],negm,0,0,0);p1=__builtin_amdgcn_mfma_f32_32x32x16_bf16(b1,qr[0],negm,0,0,0);}
    else{p0=__builtin_amdgcn_mfma_f32_32x32x16_bf16(b0,qr[d0],p0,0,0,0);p1=__builtin_amdgcn_mfma_f32_32x32x16_bf16(b1,qr[d0],p1,0,0,0);}}
}
typedef __attribute__((address_space(3))) const char* lds_cptr;
typedef short v4i16_t __attribute__((ext_vector_type(4)));
__device__ __forceinline__ void kload8(bf16x8*kf,lds_cptr kp){
  kf[0]=*(const __attribute__((address_space(3))) bf16x8*)(kp);      kf[1]=*(const __attribute__((address_space(3))) bf16x8*)(kp+512);
  kf[2]=*(const __attribute__((address_space(3))) bf16x8*)(kp+2048); kf[3]=*(const __attribute__((address_space(3))) bf16x8*)(kp+2560);
  kf[4]=*(const __attribute__((address_space(3))) bf16x8*)(kp+4096); kf[5]=*(const __attribute__((address_space(3))) bf16x8*)(kp+4608);
  kf[6]=*(const __attribute__((address_space(3))) bf16x8*)(kp+6144); kf[7]=*(const __attribute__((address_space(3))) bf16x8*)(kp+6656);
}
__device__ __forceinline__ void kload2(bf16x8*kf,lds_cptr kp,int j){ kf[2*j]=*(const __attribute__((address_space(3))) bf16x8*)(kp+j*2048); kf[2*j+1]=*(const __attribute__((address_space(3))) bf16x8*)(kp+j*2048+512); }
__device__ __forceinline__ s16x4 vtr(lds_cptr p){ return __builtin_bit_cast(s16x4,__builtin_amdgcn_ds_read_tr16_b64_v4i16((__attribute__((address_space(3))) v4i16_t*)p)); }
__device__ __forceinline__ float rowmax(const f32x16&p0,const f32x16&p1){
  float a=max3f(p0[0],p0[1],p1[0]),b=max3f(p0[2],p0[3],p1[1]);a=max3f(a,p1[2],p1[3]);
  #pragma unroll
  for(int r=4;r<16;r+=4){a=max3f(a,p0[r],p0[r+1]);b=max3f(b,p0[r+2],p0[r+3]);a=max3f(a,p1[r],p1[r+1]);b=max3f(b,p1[r+2],p1[r+3]);}
  const float m=max2f(a,b);
  auto rr=__builtin_amdgcn_permlane32_swap(__float_as_uint(m),__float_as_uint(m),false,false);
  return max2f(__uint_as_float(rr[0]),__uint_as_float(rr[1]));
}
__device__ __forceinline__ void pv(f32x16*o,int vb,bf16x8 pa0,bf16x8 pa1,bf16x8 pa2,bf16x8 pa3){
  #pragma unroll
  for(int d0=0;d0<2;++d0){s16x4 lo[4],hi[4];
    #pragma unroll
    for(int ks=0;ks<4;++ks){
      asm volatile("ds_read_b64_tr_b16 %0,%1 offset:%c2":"=&v"(lo[ks]):"v"(vb),"i"(d0*4096+ks*1024):"memory");
      asm volatile("ds_read_b64_tr_b16 %0,%1 offset:%c2":"=&v"(hi[ks]):"v"(vb),"i"(d0*4096+ks*1024+512):"memory");}
    asm volatile("s_waitcnt lgkmcnt(0)":::"memory");SBAR();
    #define PK(k) (bf16x8){lo[k][0],lo[k][1],lo[k][2],lo[k][3],hi[k][0],hi[k][1],hi[k][2],hi[k][3]}
    o[d0]=__builtin_amdgcn_mfma_f32_32x32x16_bf16(pa0,PK(0),o[d0],0,0,0);
    o[d0]=__builtin_amdgcn_mfma_f32_32x32x16_bf16(pa1,PK(1),o[d0],0,0,0);
    o[d0]=__builtin_amdgcn_mfma_f32_32x32x16_bf16(pa2,PK(2),o[d0],0,0,0);
    o[d0]=__builtin_amdgcn_mfma_f32_32x32x16_bf16(pa3,PK(3),o[d0],0,0,0);
    #undef PK
  }
}

#ifndef ATTN_STORE16
#define ATTN_STORE16(p,v) (*(u32x4*)(p)=(v))
#endif
template<int THRL> __device__ __forceinline__ void attn_unit(int b,int h,int qb,const bf16*Q,const bf16*__restrict__ K,const bf16*__restrict__ V,bf16*O,const float*Gbh,char*shm,const int wave0,const int ts){
  int wv0_=wave0; asm volatile("":"+s"(wv0_)); int z0_=0; asm volatile("":"+v"(z0_)); const int tid=wv0_*64+(int)__builtin_amdgcn_mbcnt_hi(~0u,__builtin_amdgcn_mbcnt_lo(~0u,(unsigned)z0_)),lane=tid&63,r32=lane&31,hi=lane>>5; const int wid=__builtin_amdgcn_readfirstlane(tid>>6);
  const long rowbase=(long)b*SEQ; const int q0=qb*QB;
  const bf16*Qw=Q+(rowbase+q0+wid*QBLK)*DM+h*D;
  const bf16*Kh=K+(rowbase+(long)ts*KVBLK)*DM+h*D,*Vh=V+(rowbase+(long)ts*KVBLK)*DM+h*D;
  const int q0r=q0-ts*KVBLK; Gbh+=ts*KVBLK;
  const unsigned lds0=(unsigned)(uintptr_t)shm;
  float*wsf=(float*)(shm+LDS_WS)+wid*64;
  const bf16*ksrc=Kh+(long)lane*DM+wid*8;
  const bf16*vsrc=Vh+(long)(16*(wid&3)+(lane>>2))*DM+(wid>>2)*32+(lane&3)*8;
  const unsigned kdst=lds0+LDS_K+wid*1024, vdst=lds0+LDS_V+wid*1024;
  #define DMA_K(t,slot) glds16(ksrc+(long)(t)*KVBLK*DM,(unsigned)__builtin_amdgcn_readfirstlane(kdst+(slot)))
  #define DMA_V(t,slot) glds16(vsrc+(long)(t)*KVBLK*DM,(unsigned)__builtin_amdgcn_readfirstlane(vdst+(slot)))
  const int vb0=(int)(lds0+LDS_V)+((lane>>4)&1)*32+(lane&3)*8+(4*hi+((lane&15)>>2))*64;
  const char*Kbase=shm+LDS_K; bf16x8 kf[8];
  const lds_cptr shm3=(lds_cptr)shm; const lds_cptr kp0=shm3+LDS_K+hi*1024+r32*16; const lds_cptr vp0=shm3+LDS_V+((lane>>4)&1)*32+(lane&3)*8+(4*hi+((lane&15)>>2))*64;
  const int NT=(q0r+QB)/KVBLK;
  typedef float f32x4v __attribute__((ext_vector_type(4)));
  { float*gl=(float*)(shm+LDS_G); const int ng4=(q0r+QB)>>2; for(int i=tid;i<ng4;i+=NW*64){ *(f32x4v*)(gl+4*i)=*(const f32x4v*)(Gbh+4*i); } }
  DMA_K(0,0);DMA_V(0,0);DMA_K(1,SLOTB);
  bf16x8 qr[4];
  #pragma unroll
  for(int d0=0;d0<4;++d0)qr[d0]=*reinterpret_cast<const bf16x8*>(&Qw[(long)r32*DM+d0*16+hi*8]);
  float mhat=0.f,l_reg=0.f;f32x16 o[2];o[0]=f32x16{};o[1]=f32x16{};f32x16 negm=f32x16{};asm volatile("":"+v"(negm));
  const int qrel=wid*QBLK+r32;
  #define CMASK(P0,P1,t) do{int jb_=(t)-(NT-4); if(jb_>=0)cmask(P0,P1,jb_,qrel,hi);}while(0)
  #define KBIAS(P0,P1,t) do{ const float*gp_=(const float*)(shm+LDS_G)+64*(t)+4*hi; \
    _Pragma("unroll") for(int j_=0;j_<4;++j_){ { const f32x4v a_=*(const f32x4v*)(gp_+8*j_); P0[4*j_]+=a_.x; P0[4*j_+1]+=a_.y; P0[4*j_+2]+=a_.z; P0[4*j_+3]+=a_.w; } SBAR(); \
      { const f32x4v c_=*(const f32x4v*)(gp_+32+8*j_); P1[4*j_]+=c_.x; P1[4*j_+1]+=c_.y; P1[4*j_+2]+=c_.z; P1[4*j_+3]+=c_.w; } SBAR(); } }while(0)
  bool resc=false;
  #define START(P0,P1) do{ const float rm=rowmax(P0,P1); resc=false; \
    { const float dl=__builtin_fmaxf(rm,0.f); mhat=fadd_s(mhat,dl); \
      _Pragma("unroll") for(int r=0;r<16;++r){P0[r]=fsub_s(P0[r],dl);P1[r]=fsub_s(P1[r],dl);} \
      _Pragma("unroll") for(int r=0;r<16;++r)negm[r]=-mhat; asm volatile("":"+v"(negm)); } \
    _Pragma("unroll") for(int r=0;r<16;++r)P0[r]=__builtin_amdgcn_exp2f(P0[r]); }while(0)
  #define RESC() do{ if(resc){ asm volatile("s_waitcnt lgkmcnt(0)":::"memory"); \
      _Pragma("unroll") for(int d_=0;d_<2;++d_) _Pragma("unroll") for(int r=0;r<16;++r)o[d_][r]*=wsf[crow(r,hi)]; } }while(0)
  f32x16 pA0,pA1,pB0,pB1;
  int sl_prev=0,sl_cur=0,sl_next=SLOTB;
  #define ROT() do{sl_prev=sl_cur;sl_cur=sl_next;sl_next=(sl_next==(NSLOT-1)*SLOTB)?0:sl_next+SLOTB;}while(0)
  DMA_K(2,2*SLOTB);
  WAIT_BAR(3);
  { const float*gl=(const float*)(shm+LDS_G); mhat=gl[q0r+qrel]; _Pragma("unroll") for(int r=0;r<16;++r)negm[r]=-mhat; asm volatile("":"+v"(negm)); }
  qkt(pA0,pA1,Kbase,qr,negm,r32,hi);asm volatile("s_nop 15\n\ts_nop 7":"+v"(pA0),"+v"(pA1));KBIAS(pA0,pA1,0);CMASK(pA0,pA1,0);
  START(pA0,pA1);
  _Pragma("unroll") for(int r=0;r<16;++r)pA1[r]=__builtin_amdgcn_exp2f(pA1[r]);
  WAIT_BAR(0);
  DMA_K(3,0);DMA_V(1,SLOTB);
  ROT();
  kload8(kf,kp0+sl_cur);
  WAIT_BAR(2);
  s16x4 vlo[8],vhi[8]; u32x4 pw0,pw1,pw2,pw3;
  #define PKW(P,B) cvtpk_s(P[B],P[B+1])
  #define PAF(k) __builtin_bit_cast(bf16x8,pw##k)
  #define VFR(i) (bf16x8){vlo[i][0],vlo[i][1],vlo[i][2],vlo[i][3],vhi[i][0],vhi[i][1],vhi[i][2],vhi[i][3]}
  #define PIN(x) asm volatile("":"+v"(x))
  #define MX3(a,b,c) __builtin_fmaxf(__builtin_fmaxf((a),(b)),(c))
  #define GAPA(MF,A0,A1,A2,A3,W0,W1,PW) do{ MF; sacc+=A0; sacc+=A1; sacc+=A2; sacc+=A3; PIN(sacc); W0; W1; PIN(PW); SBAR(); }while(0)
  #define EX(v) __builtin_amdgcn_exp2f(v)
  #define GAPB(MF,X,B) do{ MF; X[B]=EX(X[B]); X[B+1]=EX(X[B+1]); X[B+2]=EX(X[B+2]); X[B+3]=EX(X[B+3]); PIN(X); SBAR(); }while(0)
  #define VRD(i) do{ vlo[i]=vtr(vp_+(((i)>>2)*4096+((i)&3)*1024)); vhi[i]=vtr(vp_+(((i)>>2)*4096+((i)&3)*1024+512)); }while(0)
  #define KRD(G,j) do{ if(G){ kload2(kf,kp0+sl_next,j); SBAR(); } }while(0)
  #define STEP(C0,C1,P0,P1,t,GK,GV,GL) do{ SBAR(); \
    const lds_cptr vp_=vp0+sl_prev; \
    VRD(0); SBAR(); float sacc=(P0[0]+P0[1]); \
    GAPA(C0=__builtin_amdgcn_mfma_f32_32x32x16_bf16(kf[0],qr[0],negm,0,0,0), P0[2],P0[3],P0[4],P0[5],     pw0[0]=PKW(P0,0), pw0[1]=PKW(P0,2), pw0); \
    VRD(4); SBAR(); GAPA(C1=__builtin_amdgcn_mfma_f32_32x32x16_bf16(kf[1],qr[0],negm,0,0,0), P0[6],P0[7],P0[8],P0[9],     pw0[2]=PKW(P0,4), pw0[3]=PKW(P0,6), pw0); \
    VRD(1); SBAR(); GAPA(C0=__builtin_amdgcn_mfma_f32_32x32x16_bf16(kf[2],qr[1],C0,0,0,0),   P0[10],P0[11],P0[12],P0[13], pw1[0]=PKW(P0,8), pw1[1]=PKW(P0,10), pw1); \
    VRD(5); SBAR(); GAPA(C1=__builtin_amdgcn_mfma_f32_32x32x16_bf16(kf[3],qr[1],C1,0,0,0),   P0[14],P0[15],P1[0],P1[1],   pw1[2]=PKW(P0,12),pw1[3]=PKW(P0,14), pw1); \
    VRD(2); SBAR(); GAPA(C0=__builtin_amdgcn_mfma_f32_32x32x16_bf16(kf[4],qr[2],C0,0,0,0),   P1[2],P1[3],P1[4],P1[5],     pw2[0]=PKW(P1,0), pw2[1]=PKW(P1,2), pw2); \
    VRD(6); SBAR(); GAPA(C1=__builtin_amdgcn_mfma_f32_32x32x16_bf16(kf[5],qr[2],C1,0,0,0),   P1[6],P1[7],P1[8],P1[9],     pw2[2]=PKW(P1,4), pw2[3]=PKW(P1,6), pw2); \
    VRD(3); SBAR(); GAPA(C0=__builtin_amdgcn_mfma_f32_32x32x16_bf16(kf[6],qr[3],C0,0,0,0),   P1[10],P1[11],P1[12],P1[13], pw3[0]=PKW(P1,8), pw3[1]=PKW(P1,10), pw3); \
    VRD(7); SBAR(); GAPA(C1=__builtin_amdgcn_mfma_f32_32x32x16_bf16(kf[7],qr[3],C1,0,0,0),   P1[14],P1[15],0.f,0.f,       pw3[2]=PKW(P1,12),pw3[3]=PKW(P1,14), pw3); \
    l_reg+=sacc; \
    if(GK){DMA_K((t)+3,sl_cur);} if(GV){DMA_V((t)+1,sl_next);} \
    KBIAS(C0,C1,t); CMASK(C0,C1,t); \
    { float a=MX3(C0[0],C0[1],C1[0]),b=MX3(C0[2],C0[3],C1[1]); a=MX3(a,C1[2],C1[3]); \
      _Pragma("unroll") for(int r=4;r<16;r+=4){a=MX3(a,C0[r],C0[r+1]);b=MX3(b,C0[r+2],C0[r+3]);a=MX3(a,C1[r],C1[r+1]);b=MX3(b,C1[r+2],C1[r+3]);} \
      float rm=__builtin_fmaxf(a,b); { auto rr=__builtin_amdgcn_permlane32_swap(__float_as_uint(rm),__float_as_uint(rm),false,false); rm=__builtin_fmaxf(__uint_as_float(rr[0]),__uint_as_float(rr[1])); } \
      resc=false; \
      if(__builtin_expect(__any(rm>(float)THRL),0)){ const float dl=__builtin_fmaxf(rm,0.f); mhat+=dl; \
        _Pragma("unroll") for(int r=0;r<16;++r){C0[r]-=dl;C1[r]-=dl;} \
        _Pragma("unroll") for(int r=0;r<16;++r)negm[r]=-mhat; asm volatile("":"+v"(negm)); \
        const float f=__builtin_amdgcn_exp2f(-dl); l_reg*=f; if(hi==0)wsf[r32]=f; resc=true; } } \
    SBAR(); \
    GAPB(o[0]=__builtin_amdgcn_mfma_f32_32x32x16_bf16(PAF(0),VFR(0),o[0],0,0,0), C0,0); \
    GAPB(o[1]=__builtin_amdgcn_mfma_f32_32x32x16_bf16(PAF(0),VFR(4),o[1],0,0,0), C0,4); \
    KRD(GL,0); GAPB(o[0]=__builtin_amdgcn_mfma_f32_32x32x16_bf16(PAF(1),VFR(1),o[0],0,0,0), C0,8); \
    KRD(GL,1); GAPB(o[1]=__builtin_amdgcn_mfma_f32_32x32x16_bf16(PAF(1),VFR(5),o[1],0,0,0), C0,12); \
    KRD(GL,2); GAPB(o[0]=__builtin_amdgcn_mfma_f32_32x32x16_bf16(PAF(2),VFR(2),o[0],0,0,0), C1,0); \
    KRD(GL,3); GAPB(o[1]=__builtin_amdgcn_mfma_f32_32x32x16_bf16(PAF(2),VFR(6),o[1],0,0,0), C1,4); \
    GAPB(o[0]=__builtin_amdgcn_mfma_f32_32x32x16_bf16(PAF(3),VFR(3),o[0],0,0,0), C1,8); \
    GAPB(o[1]=__builtin_amdgcn_mfma_f32_32x32x16_bf16(PAF(3),VFR(7),o[1],0,0,0), C1,12); \
    }while(0)
  int t=1;
  #undef CMASK
  #define CMASK(P0,P1,t) do{}while(0)
  for(;t+5<NT;t+=2){
    STEP(pB0,pB1,pA0,pA1,t,true,true,true);     WAIT_BAR(2); RESC(); ROT();
    STEP(pA0,pA1,pB0,pB1,t+1,true,true,true);   WAIT_BAR(2); RESC(); ROT();
  }
  #undef CMASK
  #define CMASK(P0,P1,t) do{int jb_=(t)-(NT-4); if(jb_>=0)cmask(P0,P1,jb_,qrel,hi);}while(0)
  #define ENDW(tt) do{ if((tt)+3<NT){WAIT_BAR(2);} else if((tt)+2<NT){WAIT_BAR(1);} else {WAIT_BAR(0);} }while(0)
  for(;t+1<NT;t+=2){
    STEP(pB0,pB1,pA0,pA1,t,(t+3<NT),(t+1<NT),(t+1<NT));       ENDW(t);   RESC(); ROT();
    STEP(pA0,pA1,pB0,pB1,t+1,(t+4<NT),(t+2<NT),(t+2<NT));     ENDW(t+1); RESC(); ROT();
  }
  STEP(pB0,pB1,pA0,pA1,NT-1,false,false,false); RESC();
  { float sacc=pB0[0]+pB0[1]; _Pragma("unroll") for(int r=2;r<16;++r)sacc+=pB0[r]; _Pragma("unroll") for(int r=0;r<16;++r)sacc+=pB1[r]; l_reg+=sacc;
    pw0=(u32x4){PKW(pB0,0),PKW(pB0,2),PKW(pB0,4),PKW(pB0,6)};pw1=(u32x4){PKW(pB0,8),PKW(pB0,10),PKW(pB0,12),PKW(pB0,14)};pw2=(u32x4){PKW(pB1,0),PKW(pB1,2),PKW(pB1,4),PKW(pB1,6)};pw3=(u32x4){PKW(pB1,8),PKW(pB1,10),PKW(pB1,12),PKW(pB1,14)};
    SBAR(); pv(o,vb0+sl_cur,PAF(0),PAF(1),PAF(2),PAF(3)); }
  #undef PKW
  #undef PAF
  #undef VFR
  #undef PIN
  #undef MX3
  #undef GAPA
  #undef GAPB
  #undef EX
  #undef VRD
  #undef KRD
  #undef STEP
  #undef ENDW
  {auto rr=__builtin_amdgcn_permlane32_swap(__float_as_uint(l_reg),__float_as_uint(l_reg),false,false);l_reg=__uint_as_float(rr[0])+__uint_as_float(rr[1]);}
  if(hi==0)wsf[32+r32]=l_reg;asm volatile("s_waitcnt lgkmcnt(0)":::"memory");
  float rli[16];
  #pragma unroll
  for(int r=0;r<16;++r)rli[r]=__builtin_amdgcn_rcpf(wsf[32+crow(r,hi)]);
  bf16*Ow=O+(rowbase+q0+wid*QBLK)*DM+h*D;
  { bf16*stg=(bf16*)(shm+LDS_OST)+wid*2048;
    #pragma unroll
    for(int r=0;r<16;++r){const int orow=crow(r,hi);
      #pragma unroll
      for(int d0=0;d0<2;++d0)stg[orow*64+d0*32+r32]=__float2bfloat16(o[d0][r]*rli[r]);}
    asm volatile("s_waitcnt lgkmcnt(0)":::"memory");
    #pragma unroll
    for(int i=0;i<4;++i){const int row=i*8+(lane>>3),ch=lane&7; const u32x4 v=*(const u32x4*)(stg+row*64+ch*8); ATTN_STORE16(Ow+(long)row*DM+ch*8,v);} }
  asm volatile("s_waitcnt lgkmcnt(0)\n\ts_barrier":::"memory");
  #undef DMA_K
  #undef DMA_V
  #undef CMASK
  #undef KBIAS
  #undef START
  #undef RESC
  #undef ROT
}
constexpr int ATTN_LDS_BYTES=LDS_BYTES;
struct AttnTensors { const bf16* Q; const bf16* K; const bf16* V; bf16* O; const float* G; };
struct AttnUnit { int bh; int qb; };
struct StaticOrder {
  int vcu;
  __device__ __forceinline__ explicit StaticOrder(int grid,int block):vcu((block%8)*(grid/8)+block/8){}
  __device__ __forceinline__ bool next(int i,AttnUnit&u)const{ if(i>=4)return false; const int s=vcu&7; u.bh=vcu>>3; u.qb=(i==0)?s:(i==1)?15-s:(i==2)?16+s:31-s; return true; }
  __device__ __forceinline__ void a_ready(const AttnUnit&)const{}
  __device__ __forceinline__ void done(const AttnUnit&)const{}
};
template<class Sched,int THRL=8> __device__ __forceinline__ void attn_phase(char*lds,const AttnTensors&T,const Sched&S){
  AttnUnit u;
  for(int i=0;S.next(i,u);++i){ S.a_ready(u); attn_unit<THRL>(u.bh/NHEAD,u.bh%NHEAD,u.qb,T.Q,T.K,T.V,T.O,T.G+(long)u.bh*SEQ,lds); S.done(u); }
}
#undef SBAR
#undef WAIT_BAR
}
namespace fx {
struct EpiZ {
    static constexpr bool PERM = true, AFTER_DRAIN = false;
    bf16* Z; bf16* UP; float* NLF; const float* fbias;
    __device__ __forceinline__ void operator()(const pg8::f32x4 (&acc)[2][2][4][2], const pg8::Unit& u, int wr, int wc, int fr_, int fq_) const {
        int z_ = 0; asm volatile("" : "+v"(z_)); const int ln_ = __builtin_amdgcn_mbcnt_hi(~0u, __builtin_amdgcn_mbcnt_lo(~0u, z_)); const int fr = ln_ & 15, fq = ln_ >> 4; (void)fr_; (void)fq_;
        const int row0 = u.pm * 256 + wr * 64 + fr, col0 = wc * 32 + 8 * fq;
#pragma unroll
        for (int bj = 0; bj < 2; ++bj) {
            const int hb = u.pn * 2 + bj;
            const float sc = (hb < 3) ? C2 : 1.f;
            bf16* base = Z + ((size_t)row0 * NZ + hb * 128 + col0); size_t stride = (size_t)16 * NZ;
            if (hb == 9 || hb == 10) { const int sidx = (hb - 9) * 128 + col0, g = sidx >> 4, ch0 = sidx & 15;
                base = UP + ((size_t)(g * 2048 + (row0 >> 4)) * 384 + (row0 & 15) * 16 + ch0); stride = 384; }
#pragma unroll
            for (int ai = 0; ai < 2; ++ai)
#pragma unroll
                for (int m = 0; m < 4; ++m) { const pg8::f32x4 v0 = acc[ai][bj][m][0] * sc, v1 = acc[ai][bj][m][1] * sc;
                    v4u w; w.x = pk2(v0[0], v0[1]); w.y = pk2(v0[2], v0[3]); w.z = pk2(v1[0], v1[1]); w.w = pk2(v1[2], v1[3]);
                    *(GAS v4u*)(base + (size_t)(ai * 8 + m) * stride) = w; }
        }
        if (u.pn == 11 && col0 == 0) {
#pragma unroll
            for (int ai = 0; ai < 2; ++ai)
#pragma unroll
                for (int m = 0; m < 4; ++m) { const int r = row0 + ai * 128 + m * 16, b = r >> 12, t = r & 4095; float* o = NLF + (size_t)(b * 6) * 4096 + t;
                    o[0 * 4096] = nlf1(acc[ai][1][m][0][0] + fbias[0]); o[1 * 4096] = nlf1(acc[ai][1][m][0][1] + fbias[1]); o[2 * 4096] = nlf1(acc[ai][1][m][0][2] + fbias[2]);
                    o[3 * 4096] = nlf1(acc[ai][1][m][0][3] + fbias[3]); o[4 * 4096] = nlf1(acc[ai][1][m][1][0] + fbias[4]); o[5 * 4096] = nlf1(acc[ai][1][m][1][1] + fbias[5]); }
        }
    }
    static __device__ __forceinline__ float nlf1(float x) { return -LOG2E * (fminf(x, 0.f) - __logf(1.f + __expf(-fabsf(x)))); }
};
template <bool XF32> struct EpiRes {
    static constexpr bool PERM = false, AFTER_DRAIN = false;
    const void* X; bf16* out; const float* gate;
    __device__ __forceinline__ void operator()(const pg8::f32x4 (&acc)[2][2][4][2], const pg8::Unit& u, int wr, int wc, int fr_, int fq_) const {
        int z_ = 0; asm volatile("" : "+v"(z_)); const int ln_ = __builtin_amdgcn_mbcnt_hi(~0u, __builtin_amdgcn_mbcnt_lo(~0u, z_)); const int fr = ln_ & 15, fq = ln_ >> 4; (void)fr_; (void)fq_;
        const int row0 = u.pm * 256 + wr * 64 + fr, col0 = u.pn * 256 + wc * 32 + 4 * fq;
        const float* gb = gate + (size_t)(row0 >> 12) * 6144;
#pragma unroll
        for (int bj = 0; bj < 2; ++bj)
#pragma unroll
            for (int n = 0; n < 2; ++n) { const int c = col0 + bj * 128 + n * 16; const pg8::f32x4 gv = *(const GAS pg8::f32x4*)(gb + c);
#pragma unroll
                for (int ai = 0; ai < 2; ++ai)
#pragma unroll
                    for (int m = 0; m < 4; ++m) { const size_t off = (size_t)(row0 + ai * 128 + m * 16) * 1024 + c; pg8::f32x4 xv;
                        if (XF32) xv = *(const GAS pg8::f32x4*)((const float*)X + off); else { const v2u w = *(const GAS v2u*)((const bf16*)X + off); xv = (pg8::f32x4){bflo(w.x), bfhi(w.x), bflo(w.y), bfhi(w.y)}; }
                        const pg8::f32x4 o = xv + gv * acc[ai][bj][m][n]; v2u ow; ow.x = pk2(o[0], o[1]); ow.y = pk2(o[2], o[3]); *(GAS v2u*)(out + off) = ow; } }
    }
};
}
namespace fx {
constexpr int MOE_ROWS = 40960, MOE_TILES = MOE_ROWS / 256, NCLS = 24;
constexpr size_t WS_TOKINFO = WS_HLOC + 8 * MiB;
constexpr size_t WS_CNT = WS_TOKINFO + (size_t)M * 16;
constexpr size_t WS_ROWTOK = WS_CNT + 256 * 32 * 4;
constexpr size_t WS_ROWW = WS_ROWTOK + (size_t)MOE_ROWS * 4;
constexpr size_t WS_TILECLS = WS_ROWW + (size_t)MOE_ROWS * 8;
constexpr size_t WS_H2S = WS_Z;
constexpr size_t WS_HID = WS_Z + (size_t)MOE_ROWS * 1024 * 2;
static_assert(WS_TILECLS + (MOE_TILES + 1) * 4 <= WS_END, "moe scratch fits");
static_assert(WS_HID + (size_t)MOE_ROWS * 512 * 2 <= WS_UP, "H2S + HID fit in the Z region");

__device__ __forceinline__ void cls_experts(int cls, int& e_lo, int& e_hi) {
    const int g = cls / 6, pr = cls % 6; const int lo = (pr < 3) ? 0 : (pr < 5 ? 1 : 2); const int hi = (pr < 3) ? pr + 1 : (pr < 5 ? pr - 1 : 3);
    e_lo = g * 4 + lo; e_hi = g * 4 + hi;
}
__device__ __forceinline__ void moe_route(const Params& p, int oz, int l, LAS unsigned char* lds, int tid, int lane, int wave, int bx, int G) {
    unsigned char* ws = p.ws + oz; LAS float* rws = (LAS float*)lds; LAS int* hist = (LAS int*)(lds + 70656);
    const float* rw = p.in[I_RW + oz];
    for (int i = tid; i < 4096; i += NTHR) { const int c = i >> 2; ((LAS f32x4*)rws)[i + (c >> 2)] = ((const GAS f32x4*)rw)[i]; }
    if (tid < 32) hist[tid] = 0;
    __syncthreads();
    const int tpw = M / G, t0 = bx * tpw; const float* mod = (const float*)(ws + WS_MOD) + l * 8 * 6144; const float* nw = p.in[I_NFW + oz] + l * 1024; const float* rb = p.in[I_RB + oz];
    const bf16* X1 = (const bf16*)(ws + WS_XB); bf16* H = (bf16*)(ws + WS_H);
    f32x4 A[4], B[4]; adaln_factors(nw, mod + (t0 >> 12) * 6144 + 3072, mod + (t0 >> 12) * 6144 + 4096, lane, A, B);
    f32x4 v[4] = {}; if (wave < tpw) row_load_bf(X1, t0 + wave, lane, v);
    for (int r = wave; r < tpw; r += NWAVES) {
        const int row = t0 + r;
        f32x4 nxt[4] = {}; if (r + NWAVES < tpw) row_load_bf(X1, row + NWAVES, lane, nxt);
        norm_row_to_bf16(v, A, B, H + (size_t)row * 1024, lane);
        float lg[16];
#pragma unroll
        for (int e = 0; e < 16; ++e) lg[e] = 0.f;
#pragma unroll
        for (int j = 0; j < 4; ++j) { const LAS f32x4* wr4 = (const LAS f32x4*)rws + (4 * lane + 256 * j) * 4 + (lane + 64 * j);
#pragma unroll
            for (int cc = 0; cc < 4; ++cc) { const float hv = v[j][cc];
#pragma unroll
                for (int q = 0; q < 4; ++q) { const f32x4 w4 = wr4[cc * 4 + q]; lg[4 * q] += hv * w4.x; lg[4 * q + 1] += hv * w4.y; lg[4 * q + 2] += hv * w4.z; lg[4 * q + 3] += hv * w4.w; }
                __builtin_amdgcn_sched_barrier(0); } }
#pragma unroll
        for (int e = 0; e < 16; ++e) lg[e] = wave_sum(lg[e], lane) + rb[e];
        float mx = lg[0];
#pragma unroll
        for (int e = 1; e < 16; ++e) mx = fmaxf(mx, lg[e]);
        float sum = 0.f;
#pragma unroll
        for (int e = 0; e < 16; ++e) { lg[e] = __expf(lg[e] - mx); sum += lg[e]; }
        const float inv = 1.f / sum;
#pragma unroll
        for (int e = 0; e < 16; ++e) lg[e] *= inv;
        int best = 0, bi1 = 0, bi2 = 1; float bs = -1.f, bv1 = 0.f, bv2 = 0.f;
#pragma unroll
        for (int g = 0; g < 4; ++g) {
            int i1 = 0; float v1 = lg[g * 4];
#pragma unroll
            for (int i = 1; i < 4; ++i) if (lg[g * 4 + i] > v1) { v1 = lg[g * 4 + i]; i1 = i; }
            int i2 = -1; float v2 = -1.f;
#pragma unroll
            for (int i = 0; i < 4; ++i) if (i != i1 && lg[g * 4 + i] > v2) { v2 = lg[g * 4 + i]; i2 = i; }
            const float sc = v1 + v2; if (sc > bs) { bs = sc; best = g; bi1 = i1; bi2 = i2; bv1 = v1; bv2 = v2; }
        }
        if (lane == 0) {
            const int lo = bi1 < bi2 ? bi1 : bi2, hi = bi1 < bi2 ? bi2 : bi1; const float w1 = bv1 / (bv1 + bv2), w2 = bv2 / (bv1 + bv2);
            const int cls = best * 6 + (lo * (7 - lo)) / 2 + (hi - lo - 1);
            const int rank = __hip_atomic_fetch_add(hist + cls, 1, __ATOMIC_RELAXED, __HIP_MEMORY_SCOPE_WORKGROUP);
            GAS f32x4* ti = (GAS f32x4*)(ws + WS_TOKINFO) + row;
            *ti = (f32x4){__builtin_bit_cast(float, cls | (rank << 8)), bi1 < bi2 ? w1 : w2, bi1 < bi2 ? w2 : w1, 0.f};
        }
#pragma unroll
        for (int j = 0; j < 4; ++j) v[j] = nxt[j];
    }
    __syncthreads();
    if (tid < 32) ((int*)(ws + WS_CNT))[bx * 32 + tid] = (tid < NCLS) ? hist[tid] : 0;
}
__device__ __forceinline__ void moe_gather(const Params& p, int oz, LAS unsigned char* lds, int tid, int lane, int wave, int bx, int G) {
    unsigned char* ws = p.ws + oz; LAS int* cl = (LAS int*)lds; LAS int* base = (LAS int*)(lds + 32768); LAS int* off = base + 32; LAS int* tot = off + 32;
    const int* cnt = (const int*)(ws + WS_CNT);
    for (int i = tid; i < G * 32; i += NTHR) cl[i] = cnt[i];
    __syncthreads();
    { LAS int* ps = tot + 32; const int c = tid & 31, part = tid >> 5; int s = 0, mine = 0; for (int w = part * (G / 16); w < (part + 1) * (G / 16); ++w) { if (w < bx) mine += cl[w * 32 + c]; s += cl[w * 32 + c]; } ps[part * 32 + c] = s; ps[512 + part * 32 + c] = mine; }
    __syncthreads();
    if (tid < NCLS) { LAS int* ps = tot + 32; int s = 0, mine = 0; for (int q = 0; q < 16; ++q) { s += ps[q * 32 + tid]; mine += ps[512 + q * 32 + tid]; } tot[tid] = s; off[tid] = mine; }
    __syncthreads();
    if (tid == 0) { int b = 0; for (int c = 0; c < NCLS; ++c) { base[c] = b; b += (tot[c] + 255) & ~255; } base[NCLS] = b; }
    __syncthreads();
    int* rowtok = (int*)(ws + WS_ROWTOK); float* roww = (float*)(ws + WS_ROWW);
    if (bx < NCLS) { const int c = bx, b0 = base[c], n = tot[c], b1 = base[c + 1];
        for (int r = b0 + n + tid; r < b1; r += NTHR) { rowtok[r] = -1; roww[2 * r] = (float)oz; roww[2 * r + 1] = (float)oz; }
        int* tc = (int*)(ws + WS_TILECLS); for (int t = b0 / 256 + tid; t < b1 / 256; t += NTHR) tc[t] = c;
        if (c == NCLS - 1 && tid == 0) tc[MOE_TILES] = b1 / 256; }
    const int tpw = M / G, t0 = bx * tpw; const bf16* H = (const bf16*)(ws + WS_H); bf16* H2S = (bf16*)(ws + WS_H2S);
    for (int r = wave; r < tpw; r += NWAVES) { const int row = t0 + r; const f32x4 ti = ((const GAS f32x4*)(ws + WS_TOKINFO))[row]; const int cr = __builtin_bit_cast(int, ti.x), cls = cr & 255, rank = cr >> 8;
        const int pos = base[cls] + off[cls] + rank;
        const GAS v4u* src = (const GAS v4u*)(H + (size_t)row * 1024) + lane; GAS v4u* dst = (GAS v4u*)(H2S + (size_t)pos * 1024) + lane;
        const v4u a = src[0], b = src[64]; dst[0] = a; dst[64] = b;
        if (lane == 0) { rowtok[pos] = row; roww[2 * pos] = ti.y; roww[2 * pos + 1] = ti.z; } }
}
struct ListOrder {
    const LAS int* list; int n;
    __device__ __forceinline__ bool next(int i, pg8::Unit& u) const { if (i >= n) return false; typedef int v4i_ __attribute__((ext_vector_type(4))); const v4i_ q = *(const LAS v4i_*)(list + 4 * i);
        u.pm = __builtin_amdgcn_readfirstlane(q.x); u.pn = __builtin_amdgcn_readfirstlane(q.y); u.k0 = __builtin_amdgcn_readfirstlane(q.z); u.k1 = __builtin_amdgcn_readfirstlane(q.w); return true; }
    __device__ __forceinline__ void a_ready(const pg8::Unit&) const {}
    __device__ __forceinline__ void done(const pg8::Unit&) const {}
};
template <bool DOWN>
__device__ __forceinline__ int moe_build_list(unsigned char* ws, LAS int* list, int tid, int bx, int G) {
    const int* tc = (const int*)(ws + WS_TILECLS);
    const int ntiles = __builtin_amdgcn_readfirstlane(((const GAS int*)tc)[MOE_TILES]); const int nunits = ntiles * 4; int n = 0;
    for (int L = bx; L < nunits; L += G) ++n;
    if (tid < n) { const int L = bx + tid * G, tile = L >> 2, j = L & 3; const int cls = ((const GAS int*)tc)[tile]; int e_lo, e_hi; cls_experts(cls, e_lo, e_hi);
        if (DOWN) { list[4 * tid] = tile; list[4 * tid + 1] = j; list[4 * tid + 2] = e_lo * 256; list[4 * tid + 3] = e_hi * 256; }
        else { list[4 * tid] = tile; list[4 * tid + 1] = (j < 2 ? e_lo : e_hi) * 2 + (j & 1); list[4 * tid + 2] = j; list[4 * tid + 3] = 0; } }
    __syncthreads();
    return n;
}
struct EpiHid {
    static constexpr bool PERM = true, AFTER_DRAIN = false;
    bf16* HID; const float* roww;
    __device__ __forceinline__ void operator()(const pg8::f32x4 (&acc)[2][2][4][2], const pg8::Unit& u, int wr, int wc, int fr_, int fq_) const {
        int z_ = 0; asm volatile("" : "+v"(z_)); const int ln_ = __builtin_amdgcn_mbcnt_hi(~0u, __builtin_amdgcn_mbcnt_lo(~0u, z_)); const int fr = ln_ & 15, fq = ln_ >> 4; (void)fr_; (void)fq_;
        const int row0 = u.pm * 256 + wr * 64 + fr, j = u.k0, col0 = j * 128 + wc * 32 + 8 * fq;
#pragma unroll
        for (int ai = 0; ai < 2; ++ai)
#pragma unroll
            for (int m = 0; m < 4; ++m) { const int pos = row0 + ai * 128 + m * 16; const float w = ((const GAS float*)roww)[2 * pos + (j >> 1)];
                float h[8];
#pragma unroll
                for (int n = 0; n < 2; ++n)
#pragma unroll
                    for (int e = 0; e < 4; ++e) { const float gt = acc[ai][0][m][n][e], up = acc[ai][1][m][n][e]; h[4 * n + e] = gt * fsigmoid(gt) * up * w; }
                v4u o; o.x = pk2(h[0], h[1]); o.y = pk2(h[2], h[3]); o.z = pk2(h[4], h[5]); o.w = pk2(h[6], h[7]);
                *(GAS v4u*)(HID + (size_t)pos * 512 + col0) = o; }
    }
};
struct EpiMoeOut {
    static constexpr bool PERM = false, AFTER_DRAIN = false;
    bf16* out; const float* gate; const int* rowtok;
    __device__ __forceinline__ void operator()(const pg8::f32x4 (&acc)[2][2][4][2], const pg8::Unit& u, int wr, int wc, int fr_, int fq_) const {
        int z_ = 0; asm volatile("" : "+v"(z_)); const int ln_ = __builtin_amdgcn_mbcnt_hi(~0u, __builtin_amdgcn_mbcnt_lo(~0u, z_)); const int fr = ln_ & 15, fq = ln_ >> 4; (void)fr_; (void)fq_;
        const int row0 = u.pm * 256 + wr * 64 + fr, col0 = u.pn * 256 + wc * 32 + 4 * fq;
#pragma unroll
        for (int ai = 0; ai < 2; ++ai)
#pragma unroll
            for (int m = 0; m < 4; ++m) { const int tok = ((const GAS int*)rowtok)[row0 + ai * 128 + m * 16];
                if (tok >= 0) { const float* gb = gate + (size_t)(tok >> 12) * 6144; bf16* orow = out + (size_t)tok * 1024;
#pragma unroll
                    for (int bj = 0; bj < 2; ++bj)
#pragma unroll
                        for (int n = 0; n < 2; ++n) { const int c = col0 + bj * 128 + n * 16; const pg8::f32x4 gv = *(const GAS pg8::f32x4*)(gb + c); const v2u w = *(const GAS v2u*)(orow + c);
                            const pg8::f32x4 o = (pg8::f32x4){bflo(w.x), bfhi(w.x), bflo(w.y), bfhi(w.y)} + gv * acc[ai][bj][m][n]; v2u ow; ow.x = pk2(o[0], o[1]); ow.y = pk2(o[2], o[3]); *(GAS v2u*)(orow + c) = ow; } } }
    }
};
}
namespace fx {
struct EpiS5Loc {
    static constexpr bool PERM = false, AFTER_DRAIN = false;
    float* LOC;
    __device__ __forceinline__ void operator()(const pg8::f32x4 (&acc)[2][2][4][2], const pg8::Unit& u, int wr, int wc, int fr_, int fq_) const {
        int z_ = 0; asm volatile("" : "+v"(z_)); const int ln_ = __builtin_amdgcn_mbcnt_hi(~0u, __builtin_amdgcn_mbcnt_lo(~0u, z_)); const int fr = ln_ & 15, fq = ln_ >> 4; (void)fr_; (void)fq_;
        const int row0 = u.pm * 256 + wr * 64 + fr, col0 = wc * 32 + 4 * fq;
#pragma unroll
        for (int n = 0; n < 2; ++n)
#pragma unroll
            for (int ai = 0; ai < 2; ++ai)
#pragma unroll
                for (int m = 0; m < 4; ++m) *(GAS pg8::f32x4*)(LOC + (size_t)(row0 + ai * 128 + m * 16) * 128 + col0 + n * 16) = acc[ai][0][m][n];
    }
};
__device__ __forceinline__ float gelu_tanh_f(float x) { const float u = 0.7978845608028654f * (x + 0.044715f * x * x * x); const float e = __builtin_amdgcn_exp2f(-2.f * LOG2E * u); return x * __builtin_amdgcn_rcpf(1.f + e); }
struct EpiS5Y {
    static constexpr bool PERM = true, AFTER_DRAIN = false;
    bf16* Y;
    __device__ __forceinline__ void operator()(const pg8::f32x4 (&acc)[2][2][4][2], const pg8::Unit& u, int wr, int wc, int fr_, int fq_) const {
        int z_ = 0; asm volatile("" : "+v"(z_)); const int ln_ = __builtin_amdgcn_mbcnt_hi(~0u, __builtin_amdgcn_mbcnt_lo(~0u, z_)); const int fr = ln_ & 15, fq = ln_ >> 4; (void)fr_; (void)fq_;
        const int g = u.pn, b = u.pm & 7, c0 = wr * 64 + fr;
#pragma unroll
        for (int bj = 0; bj < 2; ++bj) { const int n0 = bj * 128 + wc * 32 + 8 * fq, j = n0 >> 4, ch0 = n0 & 15;
#pragma unroll
            for (int ai = 0; ai < 2; ++ai)
#pragma unroll
                for (int m = 0; m < 4; ++m) { const int c = c0 + ai * 128 + m * 16; const pg8::f32x4 v0 = acc[ai][bj][m][0], v1 = acc[ai][bj][m][1];
                    v4u w; w.x = pk2(gelu_tanh_f(v0[0]), gelu_tanh_f(v0[1])); w.y = pk2(gelu_tanh_f(v0[2]), gelu_tanh_f(v0[3])); w.z = pk2(gelu_tanh_f(v1[0]), gelu_tanh_f(v1[1])); w.w = pk2(gelu_tanh_f(v1[2]), gelu_tanh_f(v1[3]));
                    *(GAS v4u*)(Y + ((size_t)(b * 4096 + c * 16 + j) * 256 + g * 16 + ch0)) = w; } }
    }
};
struct OneUnit { int pm, pn;
    __device__ __forceinline__ bool next(int i, pg8::Unit& u) const { if (i >= 1) return false; u.pm = pm; u.pn = pn; u.k0 = 0; u.k1 = 0; return true; }
    __device__ __forceinline__ void a_ready(const pg8::Unit&) const {}
    __device__ __forceinline__ void done(const pg8::Unit&) const {} };
__device__ __forceinline__ void s5_scan(unsigned char* ws, int l, int g, int b, int tid) {
    if (tid < 64) { const int q = tid; const float* al = (const float*)(ws + WS_S5AL) + ((l * 16 + g) * 64 + q) * 2; const float ar = al[0], ai = al[1];
        const float* loc = (const float*)(ws + WS_LOC) + (size_t)(g * 2048 + b * 256) * 128; bf16* up = (bf16*)(ws + WS_UP) + (size_t)(g * 2048 + b * 256) * 384 + 256;
        float sr = 0.f, si = 0.f;
        for (int c0 = 0; c0 < 256; c0 += 8) { float lr[8], li[8];
#pragma unroll
            for (int k = 0; k < 8; ++k) { lr[k] = loc[(size_t)(c0 + k) * 128 + q]; li[k] = loc[(size_t)(c0 + k) * 128 + 64 + q]; }
#pragma unroll
            for (int k = 0; k < 8; ++k) { up[(size_t)(c0 + k) * 384 + q] = (bf16)f2bf(sr); up[(size_t)(c0 + k) * 384 + 64 + q] = (bf16)f2bf(si);
                const float nr = ar * sr - ai * si + lr[k], ni = ar * si + ai * sr + li[k]; sr = nr; si = ni; } }
    }
    asm volatile("s_waitcnt vmcnt(0)" ::: "memory");
    __syncthreads();
}
struct EpiGlu {
    static constexpr bool PERM = false, AFTER_DRAIN = true;
    const bf16* Y; const float* gb; const float* bnw; bf16* MIX;
    __device__ __forceinline__ void fused(pg8::f32x4 (&acc)[2][2][4][2], const pg8::Unit& u, int wr, int wc, int fr_, int fq_, PG8_LAS unsigned char* lds, int wid, int lane_) const {
        int z_ = 0; asm volatile("" : "+v"(z_)); const int ln_ = __builtin_amdgcn_mbcnt_hi(~0u, __builtin_amdgcn_mbcnt_lo(~0u, z_)); const int fr = ln_ & 15, fq = ln_ >> 4; (void)fr_; (void)fq_; (void)wid; (void)lane_;
        PG8_LAS float* P = (PG8_LAS float*)lds;
        const int row0 = u.pm * 256 + wr * 64 + fr, col0 = wc * 32 + 4 * fq;
#pragma unroll
        for (int ai = 0; ai < 2; ++ai)
#pragma unroll
            for (int m = 0; m < 4; ++m) { const int r = row0 + ai * 128 + m * 16; float s = 0.f;
#pragma unroll
                for (int bj = 0; bj < 2; ++bj)
#pragma unroll
                    for (int n = 0; n < 2; ++n) { const int c = col0 + bj * 128 + n * 16; const pg8::f32x4 bv = *(const GAS pg8::f32x4*)(gb + c); const v2u yw = *(const GAS v2u*)(Y + (size_t)r * 256 + c);
                        pg8::f32x4 a = acc[ai][bj][m][n] + bv; const float y0 = bflo(yw.x), y1 = bfhi(yw.x), y2 = bflo(yw.y), y3 = bfhi(yw.y);
                        a[0] = y0 * fsigmoid(a[0]); a[1] = y1 * fsigmoid(a[1]); a[2] = y2 * fsigmoid(a[2]); a[3] = y3 * fsigmoid(a[3]); acc[ai][bj][m][n] = a;
                        s += (a[0] * a[0] + a[1] * a[1]) + (a[2] * a[2] + a[3] * a[3]); }
                s += lane_get(s, ln_ ^ 16); s += lane_get(s, ln_ ^ 32);
                if (fq == 0) P[(wr * 64 + ai * 128 + m * 16 + fr) * 4 + wc] = s; }
        asm volatile("s_waitcnt lgkmcnt(0)" ::: "memory"); __builtin_amdgcn_s_barrier(); asm volatile("" ::: "memory");
#pragma unroll
        for (int ai = 0; ai < 2; ++ai)
#pragma unroll
            for (int m = 0; m < 4; ++m) { const int rl = wr * 64 + ai * 128 + m * 16 + fr, r = u.pm * 256 + rl; const PG8_LAS pg8::f32x4* pp = (const PG8_LAS pg8::f32x4*)(P + rl * 4); const pg8::f32x4 ps = *pp;
                const float rstd = __builtin_amdgcn_rsqf(((ps[0] + ps[1]) + (ps[2] + ps[3])) * (1.f / 256.f) + 1e-6f);
#pragma unroll
                for (int bj = 0; bj < 2; ++bj)
#pragma unroll
                    for (int n = 0; n < 2; ++n) { const int c = col0 + bj * 128 + n * 16; const pg8::f32x4 wv = *(const GAS pg8::f32x4*)(bnw + c); const pg8::f32x4 o = acc[ai][bj][m][n] * rstd * wv;
                        v2u w; w.x = pk2(o[0], o[1]); w.y = pk2(o[2], o[3]); *(GAS v2u*)(MIX + (size_t)r * 1024 + 384 + c) = w; } }
    }
};
}
namespace fx {
constexpr int HG_NSEG = 8, HG_SEGTOK = SEQ / HG_NSEG, HG_CT = 32, HG_NCH = HG_SEGTOK / HG_CT;
constexpr size_t WS_HD = WS_HLOC + 7 * MiB;
typedef short hbf16x8 __attribute__((ext_vector_type(8)));
typedef float hf32x16 __attribute__((ext_vector_type(16)));
constexpr int HL_QT = 0, HL_KT = 4608, HL_KH = 9216, HL_VT = 14336, HL_PP = 19456, HL_ST = 22016, HL_DD = 31232, HL_TOT = 31488, HL_OO = 32512, HL_END = 41216;
constexpr int HP_QK = 72, HP_T = 40, HP_OO = 68;
__device__ __forceinline__ int hcrow(int r, int hi) { return (r & 3) + 8 * (r >> 2) + 4 * hi; }

template <bool FULL>
__device__ __forceinline__ void hgrn_pair(unsigned char* ws, const float* nw_l, int l, int u0, LAS unsigned char* lds_wg, const int wave00) {
    int wave0 = wave00; asm volatile("" : "+s"(wave0));
    const int lane = lane_now(), r32 = lane & 31, hi = lane >> 5, half = wave0 >> 2, hw = wave0 & 3, htid = hw * 64 + lane;
    constexpr int NS = FULL ? HG_NSEG : HG_NSEG - 1;
    const int unit = u0 + half, bh = unit / NS, seg = unit % NS, b = bh / 6, h = bh % 6; const int d = lane, sg = hw;
    LAS unsigned char* lds = lds_wg + half * HL_END;
    const bf16* Zb = (const bf16*)(ws + WS_Z) + (size_t)(b * SEQ + seg * HG_SEGTOK) * NZ + h * 64;
    const float lbv = ((const float*)(ws + WS_LB))[l * 384 + h * 64 + d], oml = 1.f - lbv;
    LAS unsigned short* QT = (LAS unsigned short*)(lds + HL_QT); LAS unsigned short* KT = (LAS unsigned short*)(lds + HL_KT);
    LAS unsigned short* KH = (LAS unsigned short*)(lds + HL_KH); LAS unsigned short* VT = (LAS unsigned short*)(lds + HL_VT);
    LAS unsigned short* PP = (LAS unsigned short*)(lds + HL_PP); LAS unsigned short* ST = (LAS unsigned short*)(lds + HL_ST);
    LAS float* DD = (LAS float*)(lds + HL_DD); LAS float* TOT = (LAS float*)(lds + HL_TOT); LAS float* OO = (LAS float*)(lds + HL_OO);
    const int dt = hw >> 1, vt = hw & 1;
    hf32x16 S;
#pragma unroll
    for (int r = 0; r < 16; ++r) S[r] = 0.f;
    if (FULL) {
        for (int j = 0; j < seg; ++j) { const float* loc = (const float*)(ws + WS_HLOC) + (size_t)(bh * HG_NSEG + j) * 4096; const float* hd = (const float*)(ws + WS_HD) + (bh * HG_NSEG + j) * 64;
#pragma unroll
            for (int r = 0; r < 16; ++r) { const int dd = 32 * dt + hcrow(r, hi); S[r] = S[r] * hd[dd] + loc[dd * 64 + 32 * vt + r32]; } }
#pragma unroll
        for (int j = 0; j < 4; ++j) { v2u w; w.x = pk2(S[4 * j], S[4 * j + 1]); w.y = pk2(S[4 * j + 2], S[4 * j + 3]); *(LAS v2u*)(ST + (32 * vt + r32) * HP_QK + 32 * dt + 8 * j + 4 * hi) = w; }
    }
    float lsum = 0.f;
    unsigned short rf[8] = {}, rv[8] = {}, rq[8] = {}; v4u rg = {};
    { const bf16* zr = Zb + (size_t)(8 * sg) * NZ;
#pragma unroll
        for (int i = 0; i < 8; ++i) { rf[i] = zr[(size_t)i * NZ + ZC_HF + d]; rv[i] = zr[(size_t)i * NZ + ZC_HI + d]; if (FULL) rq[i] = zr[(size_t)i * NZ + ZC_HQ + d]; }
        if (FULL) rg = *(const GAS v4u*)(Zb + (size_t)(htid >> 3) * NZ + ZC_HG + 8 * (htid & 7)); }
    for (int ch = 0; ch < HG_NCH; ++ch) {
        float lf[8], kk[8], qq[8], vv[8];
#pragma unroll
        for (int i = 0; i < 8; ++i) { const float z = bf2f(rf[i]); const float s1 = fsigmoid(z); lf[i] = __logf(lbv + oml * s1); kk[i] = oml * (1.f - s1);
            vv[i] = bf2f(rv[i]); if (FULL) qq[i] = fsilu(bf2f(rq[i])); }
        const v4u gw_ = rg;
        if (ch + 1 < HG_NCH) { const bf16* zr = Zb + (size_t)((ch + 1) * HG_CT + 8 * sg) * NZ;
#pragma unroll
            for (int i = 0; i < 8; ++i) { rf[i] = zr[(size_t)i * NZ + ZC_HF + d]; rv[i] = zr[(size_t)i * NZ + ZC_HI + d]; if (FULL) rq[i] = zr[(size_t)i * NZ + ZC_HQ + d]; }
            if (FULL) rg = *(const GAS v4u*)(Zb + (size_t)((ch + 1) * HG_CT + (htid >> 3)) * NZ + ZC_HG + 8 * (htid & 7)); }
#pragma unroll
        for (int i = 1; i < 8; ++i) lf[i] += lf[i - 1];
        TOT[sg * 64 + d] = lf[7];
        __syncthreads();
        float base = 0.f, blast = 0.f;
#pragma unroll
        for (int s2 = 0; s2 < 4; ++s2) { const float tv = TOT[s2 * 64 + d]; blast += tv; if (s2 < sg) base += tv; }
        lsum += blast;
        { float kh[8];
#pragma unroll
            for (int i = 0; i < 8; ++i) { const float bi = base + lf[i]; kh[i] = kk[i] * __expf(blast - bi); }
            if (FULL) {
#pragma unroll
                for (int i = 0; i < 8; i += 2) { const float e0 = __expf(base + lf[i]), e1 = __expf(base + lf[i + 1]); const float n0 = __builtin_amdgcn_rcpf(e0), n1 = __builtin_amdgcn_rcpf(e1);
                    const unsigned qw = pk2(qq[i] * e0, qq[i + 1] * e1), kw = pk2(kk[i] * n0, kk[i + 1] * n1); const int t = 8 * sg + i;
                    QT[t * HP_QK + d] = (unsigned short)qw; QT[(t + 1) * HP_QK + d] = (unsigned short)(qw >> 16); KT[t * HP_QK + d] = (unsigned short)kw; KT[(t + 1) * HP_QK + d] = (unsigned short)(kw >> 16); } }
            v4u w; w.x = pk2(kh[0], kh[1]); w.y = pk2(kh[2], kh[3]); w.z = pk2(kh[4], kh[5]); w.w = pk2(kh[6], kh[7]); *(LAS v4u*)(KH + d * HP_T + 8 * sg) = w;
            v4u wv; wv.x = pk2(vv[0], vv[1]); wv.y = pk2(vv[2], vv[3]); wv.z = pk2(vv[4], vv[5]); wv.w = pk2(vv[6], vv[7]); *(LAS v4u*)(VT + d * HP_T + 8 * sg) = wv;
            if (sg == 0) DD[d] = __expf(blast); }
        __syncthreads();
        if (FULL && hw == 0) { hf32x16 c;
#pragma unroll
            for (int r = 0; r < 16; ++r) c[r] = 0.f;
#pragma unroll
            for (int ks = 0; ks < 4; ++ks) { const hbf16x8 a = *(const LAS hbf16x8*)(QT + r32 * HP_QK + 16 * ks + 8 * hi), bb = *(const LAS hbf16x8*)(KT + r32 * HP_QK + 16 * ks + 8 * hi); c = __builtin_amdgcn_mfma_f32_32x32x16_bf16(a, bb, c, 0, 0, 0); }
#pragma unroll
            for (int r = 0; r < 16; ++r) { const int t = hcrow(r, hi); PP[t * HP_T + r32] = (unsigned short)f2bf(r32 <= t ? c[r] : 0.f); } }
        {
#pragma unroll
            for (int r = 0; r < 16; ++r) S[r] *= DD[32 * dt + hcrow(r, hi)];
#pragma unroll
            for (int ks = 0; ks < 2; ++ks) { const hbf16x8 a = *(const LAS hbf16x8*)(KH + (32 * dt + r32) * HP_T + 16 * ks + 8 * hi), bb = *(const LAS hbf16x8*)(VT + (32 * vt + r32) * HP_T + 16 * ks + 8 * hi); S = __builtin_amdgcn_mfma_f32_32x32x16_bf16(a, bb, S, 0, 0, 0); } }
        if (FULL) {
            __syncthreads();
            if (hw == 1 || hw == 2) { const int ov = hw - 1; hf32x16 c;
#pragma unroll
                for (int r = 0; r < 16; ++r) c[r] = 0.f;
#pragma unroll
                for (int ks = 0; ks < 2; ++ks) { const hbf16x8 a = *(const LAS hbf16x8*)(PP + r32 * HP_T + 16 * ks + 8 * hi), bb = *(const LAS hbf16x8*)(VT + (32 * ov + r32) * HP_T + 16 * ks + 8 * hi); c = __builtin_amdgcn_mfma_f32_32x32x16_bf16(a, bb, c, 0, 0, 0); }
#pragma unroll
                for (int ks = 0; ks < 4; ++ks) { const hbf16x8 a = *(const LAS hbf16x8*)(QT + r32 * HP_QK + 16 * ks + 8 * hi), bb = *(const LAS hbf16x8*)(ST + (32 * ov + r32) * HP_QK + 16 * ks + 8 * hi); c = __builtin_amdgcn_mfma_f32_32x32x16_bf16(a, bb, c, 0, 0, 0); }
#pragma unroll
                for (int r = 0; r < 16; ++r) OO[hcrow(r, hi) * HP_OO + 32 * ov + r32] = c[r]; }
            __syncthreads();
#pragma unroll
            for (int j = 0; j < 4; ++j) { v2u w; w.x = pk2(S[4 * j], S[4 * j + 1]); w.y = pk2(S[4 * j + 2], S[4 * j + 3]); *(LAS v2u*)(ST + (32 * vt + r32) * HP_QK + 32 * dt + 8 * j + 4 * hi) = w; }
            { const int t = htid >> 3, vg = htid & 7; const f32x4 o0 = *(const LAS f32x4*)(OO + t * HP_OO + 8 * vg), o1 = *(const LAS f32x4*)(OO + t * HP_OO + 8 * vg + 4);
                float s = ((o0.x * o0.x + o0.y * o0.y) + (o0.z * o0.z + o0.w * o0.w)) + ((o1.x * o1.x + o1.y * o1.y) + (o1.z * o1.z + o1.w * o1.w));
                s += lane_get(s, lane ^ 1); s += lane_get(s, lane ^ 2); s += lane_get(s, lane ^ 4);
                const float rstd = __builtin_amdgcn_rsqf(s * (1.f / 64.f) + 1e-6f); const size_t row = (size_t)(b * SEQ + seg * HG_SEGTOK + ch * HG_CT + t);
                const f32x4 w0 = *(const GAS f32x4*)(nw_l + 8 * vg), w1 = *(const GAS f32x4*)(nw_l + 8 * vg + 4);
                v4u w; w.x = pk2(o0.x * rstd * w0.x * fsilu(bflo(gw_.x)), o0.y * rstd * w0.y * fsilu(bfhi(gw_.x))); w.y = pk2(o0.z * rstd * w0.z * fsilu(bflo(gw_.y)), o0.w * rstd * w0.w * fsilu(bfhi(gw_.y)));
                w.z = pk2(o1.x * rstd * w1.x * fsilu(bflo(gw_.z)), o1.y * rstd * w1.y * fsilu(bfhi(gw_.z))); w.w = pk2(o1.z * rstd * w1.z * fsilu(bflo(gw_.w)), o1.w * rstd * w1.w * fsilu(bfhi(gw_.w)));
                *(GAS v4u*)((bf16*)(ws + WS_H) + row * 1024 + 640 + h * 64 + 8 * vg) = w; }
        }
    }
    if (!FULL) {
        { float* loc = (float*)(ws + WS_HLOC) + (size_t)(bh * HG_NSEG + seg) * 4096;
#pragma unroll
            for (int r = 0; r < 16; ++r) loc[(32 * dt + hcrow(r, hi)) * 64 + 32 * vt + r32] = S[r]; }
        if (sg == 0) ((float*)(ws + WS_HD))[(bh * HG_NSEG + seg) * 64 + d] = __expf(lsum);
    }
    __syncthreads();
}
}
namespace fx {
constexpr int LDS_BYTES = 147456;
constexpr int RING_BYTES = 131072, LDSCTL_OFF = RING_BYTES, MISC_OFF = LDSCTL_OFF + 320;
constexpr int PH_PRO = 0, PH_FINAL = 21, NPH = 22;

struct QueueOrder {
    unsigned* ctr; LAS unsigned* slot;
    __device__ __forceinline__ bool next(int, attn_body::AttnUnit& u) const {
        if (threadIdx.x == 0) *slot = __hip_atomic_fetch_add(ctr, 1u, __ATOMIC_RELAXED, __HIP_MEMORY_SCOPE_AGENT);
        __syncthreads(); const unsigned v = *slot; __syncthreads();
        if (v >= 768u) return false; u.bh = (int)(v >> 4); u.qb = 15 - (int)(v & 15u); return true; }
    __device__ __forceinline__ void a_ready(const attn_body::AttnUnit&) const {}
    __device__ __forceinline__ void done(const attn_body::AttnUnit&) const {}
};

__global__ void __launch_bounds__(NTHR, 2) mk_fwd(Params p) {
    extern __shared__ __attribute__((aligned(16))) unsigned char lds_raw[];
    LAS unsigned char* lds = (LAS unsigned char*)lds_raw;
    const int wave0 = __builtin_amdgcn_readfirstlane(threadIdx.x >> 6);
    for (int u = threadIdx.x; u < (LDS_BYTES - LDSCTL_OFF) / 4; u += NTHR) ((LAS unsigned*)(lds + LDSCTL_OFF))[u] = 0u;
    __syncthreads();
    const XcdBarrier bar = xcd_barrier_post((unsigned*)(p.ws + WS_CTL) + 8192 + p.li * 4096, (volatile LAS unsigned*)(lds + MISC_OFF) + 8, threadIdx.x == 0);
#ifdef EXTRA_BARS
    for (int eb = 0; eb < EXTRA_BARS; ++eb) xcd_barrier(bar, wave0 == 0 && lane_now() == 0);
#endif
    for (int ph = p.ph_lo; ph < p.ph_hi; ++ph) {
#ifdef DUP_MASK
      for (int rep = (((DUP_MASK) >> ph) & 1u) ? 0 : 1; rep < 2; ++rep) {
#else
      { const int rep = 1;
#endif
#ifdef PROBE_MASK
        if (blockIdx.x == 0 && wave0 == 0 && lane_now() == 0) __hip_atomic_store((unsigned long long*)(p.ws + WS_CTL + 512 * 1024) + ph, __builtin_amdgcn_s_memrealtime(), __ATOMIC_RELAXED, __HIP_MEMORY_SCOPE_AGENT);
#endif
        int oz = 0; asm volatile("" : "+s"(oz));
        const int G = gridDim.x, bx = blockIdx.x + oz;
#define PHASE_IDS int wv_ = wave0; asm volatile("" : "+s"(wv_)); const int lane = lane_now(), wave = wv_, tid = wv_ * 64 + lane; \
        const int vcu = (G % 8 == 0) ? (bx % 8) * (G / 8) + bx / 8 : bx; const int gw = vcu * NWAVES + wave, ngw = G * NWAVES; (void)tid; (void)lane; (void)gw; (void)ngw;
        unsigned char* ws = p.ws + oz;
#define PIN(i) (p.in[(i) + oz])
        const int l = (ph - 1) / 10, sub = (ph - 1) % 10;
#ifndef EXP_NO_PRO
        if (ph == PH_PRO) { PHASE_IDS
            { LAS float* cact = (LAS float*)lds; const float* c = PIN(I_C); for (int i = tid; i < 8192; i += NTHR) { const float cv = c[i]; cact[i] = cv * fsigmoid(cv); } __syncthreads();
              for (int it = bx; it < 192; it += G) prologue_mod_item(p, oz, it, (LAS float*)lds, tid, lane, wave); }
            __syncthreads();
            for (int it = (G >= 224 ? bx - 192 : bx); it >= 0 && it < 32; it += G) prologue_s5_item(p, oz, it / 16, it % 16, (LAS float*)lds, tid);
            __syncthreads();
            prologue_wave_items(p, oz, (LAS float*)(lds + wave * 16384), gw, ngw, lane);
        } else
#endif
        if (ph == PH_FINAL) { PHASE_IDS
            float* X = p.out + oz; const bf16* XBp = (const bf16*)(ws + WS_XB); const float* w = PIN(I_FINW);
#ifdef PROBE_MASK
            float pscale = 1.f; { unsigned long long* tsb = (unsigned long long*)(ws + WS_CTL + 512 * 1024); unsigned long long t0 = __hip_atomic_load(tsb, __ATOMIC_RELAXED, __HIP_MEMORY_SCOPE_AGENT), tl = __hip_atomic_load(tsb + PH_FINAL, __ATOMIC_RELAXED, __HIP_MEMORY_SCOPE_AGENT); unsigned long long acc = 0;
#pragma unroll 1
                for (int k = 0; k < PH_FINAL; ++k) if ((PROBE_MASK >> k) & 1u) acc += __hip_atomic_load(tsb + k + 1, __ATOMIC_RELAXED, __HIP_MEMORY_SCOPE_AGENT) - __hip_atomic_load(tsb + k, __ATOMIC_RELAXED, __HIP_MEMORY_SCOPE_AGENT);
                pscale = 1.f + (float)acc / (float)(tl - t0); }
#endif
            f32x4 W4[4];
#pragma unroll
            for (int j = 0; j < 4; ++j) W4[j] = ((const GAS f32x4*)w)[lane + 64 * j];
            f32x4 v[4] = {}; if (gw < M) row_load_bf(XBp, gw, lane, v);
            for (int m = gw; m < M; m += ngw) { GAS f32x4* xr = (GAS f32x4*)(X + (size_t)m * 1024) + lane; f32x4 nxt[4] = {}; const int mn = m + ngw; if (mn < M) row_load_bf(XBp, mn, lane, nxt); float s = 0.f;
#pragma unroll
                for (int j = 0; j < 4; ++j) s += (v[j].x * v[j].x + v[j].y * v[j].y) + (v[j].z * v[j].z + v[j].w * v[j].w);
                const float rstd = __builtin_amdgcn_rsqf(wave_sum(s, lane) * (1.f / 1024.f) + 1e-6f);
#pragma unroll
                for (int j = 0; j < 4; ++j) { f32x4 o = (v[j] * rstd) * W4[j];
#ifdef PROBE_MASK
                    o = o * pscale;
#endif
                    xr[64 * j] = o; }
#pragma unroll
                for (int j = 0; j < 4; ++j) v[j] = nxt[j]; }
        }
#ifndef EXP_NO_ROW
        else if (sub == 0) { PHASE_IDS
            const float* X = PIN(I_X); const float* mod = (const float*)(ws + WS_MOD) + l * 8 * 6144;
            const int tpw = M / G, t0 = bx * tpw, b = t0 >> 12; f32x4 A[4], B[4]; adaln_factors(PIN(I_NMW) + l * 1024, mod + b * 6144, mod + b * 6144 + 1024, lane, A, B);
            const bf16* XBp = (const bf16*)(ws + WS_XB);
            f32x4 cur[4] = {}; if (wave < tpw) { if (l == 0) row_load(X, t0 + wave, lane, cur); else row_load_bf(XBp, t0 + wave, lane, cur); }
            for (int r = wave; r < tpw; r += NWAVES) { f32x4 nxt[4] = {}; if (r + NWAVES < tpw) { if (l == 0) row_load(X, t0 + r + NWAVES, lane, nxt); else row_load_bf(XBp, t0 + r + NWAVES, lane, nxt); }
                norm_row_to_bf16(cur, A, B, (bf16*)(ws + WS_H) + (size_t)(t0 + r) * 1024, lane);
#pragma unroll
                for (int j = 0; j < 4; ++j) cur[j] = nxt[j]; }
        }
#endif
        else if (sub == 1) {
            pg8::Gemm g{(const pg8::bf16_t*)(ws + WS_H), (const pg8::bf16_t*)(ws + WS_WIN) + (size_t)l * 3072 * 1024, M, NZ, 1024, 1024, 1024};
            pg8::StaticOrder S; S.init(M, NZ, G, bx);
            EpiZ E{(bf16*)(ws + WS_Z), (bf16*)(ws + WS_UP), (float*)(ws + WS_NLF), PIN(I_FOXB) + l * 6};
#ifdef EXP_EPI_BF16
            pg8::EpiBf16<0> E2{(bf16*)(ws + WS_Z), NZ, nullptr, 0, 0, 1.f};
            pg8::gemm_phase<pg8::EpiBf16<0>, pg8::StaticOrder, true, true>(lds, g, S, E2);
#else
            pg8::gemm_phase<EpiZ, pg8::StaticOrder, true, true>(lds, g, S, E, wave0);
#endif
        }
        else if (sub == 2) {
            unsigned* qctr = (unsigned*)(ws + WS_CTL) + 1024 + ph * 64 + rep * 32; LAS unsigned* qslot = (LAS unsigned*)(lds + MISC_OFF);
            constexpr unsigned NHL = 48u * (HG_NSEG - 1) / 2u;
            for (;;) {
                int ozq = 0; asm volatile("" : "+s"(ozq)); unsigned char* wsq = p.ws + ozq;
                if (wave0 == 0 && lane_now() == 0) *qslot = __hip_atomic_fetch_add(qctr, 1u, __ATOMIC_RELAXED, __HIP_MEMORY_SCOPE_AGENT);
                __syncthreads(); const unsigned v = __builtin_amdgcn_readfirstlane(*qslot); __syncthreads();
                if (v >= NHL + 128u + 48u + 768u) break;
                if (v < NHL) { hgrn_pair<false>(wsq, p.in[I_HNW + ozq] + l * 64, l, (int)(2u * v), lds, wave0); }
                else if (v < NHL + 128u) { const int u5 = (int)(v - NHL); const OneUnit S5{u5, u5 >> 3};
                    pg8::Gemm g5{(const pg8::bf16_t*)(wsq + WS_UP), (const pg8::bf16_t*)(wsq + WS_S5WL) + (size_t)l * 16 * 256 * 256, 16 * 2048, 16 * 256, 256, 384, 256}; EpiS5Loc E5{(float*)(wsq + WS_LOC)}; pg8::gemm_phase<EpiS5Loc, OneUnit, false, true>(lds, g5, S5, E5, wave0); __syncthreads(); }
                else if (v >= NHL + 128u + 48u) {
                    const int u = (int)(v - NHL - 128u - 48u), bh = u >> 4, qb = u & 15, b = bh / 6, h = bh % 6; int wv_ = wave0; asm volatile("" : "+s"(wv_)); const int lane = lane_now();
                    const bf16* Zr = (const bf16*)(wsq + WS_Z) + (size_t)(b * SEQ + qb * 256 + wv_ * 32) * NZ + h * 64; float kmax = 0.f, qmax = 0.f;
#pragma unroll
                    for (int i = 0; i < 8; ++i) { const bf16* rp = Zr + (size_t)(4 * i + (lane >> 4)) * NZ + 4 * (lane & 15); const v2u kw = *(const GAS v2u*)(rp + ZC_FK), qw = *(const GAS v2u*)(rp + ZC_FQ);
                        float ks = (bflo(kw.x) * bflo(kw.x) + bfhi(kw.x) * bfhi(kw.x)) + (bflo(kw.y) * bflo(kw.y) + bfhi(kw.y) * bfhi(kw.y)), qs = (bflo(qw.x) * bflo(qw.x) + bfhi(qw.x) * bfhi(qw.x)) + (bflo(qw.y) * bflo(qw.y) + bfhi(qw.y) * bfhi(qw.y));
                        ks += lane_get(ks, lane ^ 1); qs += lane_get(qs, lane ^ 1); ks += lane_get(ks, lane ^ 2); qs += lane_get(qs, lane ^ 2); ks += lane_get(ks, lane ^ 4); qs += lane_get(qs, lane ^ 4); ks += lane_get(ks, lane ^ 8); qs += lane_get(qs, lane ^ 8);
                        kmax = fmaxf(kmax, ks); qmax = fmaxf(qmax, qs); }
                    kmax = fmaxf(kmax, lane_get(kmax, lane ^ 16)); qmax = fmaxf(qmax, lane_get(qmax, lane ^ 16)); kmax = fmaxf(kmax, lane_get(kmax, lane ^ 32)); qmax = fmaxf(qmax, lane_get(qmax, lane ^ 32));
                    LAS float* red = (LAS float*)lds; if (lane == 0) { red[wv_] = kmax; red[8 + wv_] = qmax; }
                    __syncthreads();
                    if (wv_ == 0 && lane < 4) ((float*)(wsq + WS_KN))[bh * 64 + qb * 4 + lane] = fmaxf(red[2 * lane], red[2 * lane + 1]) * 1.02f;
                    if (wv_ == 0 && lane == 4) { float m = red[8]; for (int w = 1; w < 8; ++w) m = fmaxf(m, red[8 + w]); ((float*)(wsq + WS_QN))[bh * 16 + qb] = m * 1.02f; }
                    __syncthreads(); }
                else { const int bh = (int)(v - NHL - 128u); int wv_ = wave0; asm volatile("" : "+s"(wv_)); const int lane = lane_now(), wave = wv_, tid = wv_ * 64 + lane; LAS float* wsum = (LAS float*)lds;
                    const float* src = (const float*)(wsq + WS_NLF) + (size_t)bh * SEQ + tid * 8; float v8[8]; float s = 0.f;
                    const f32x4 a = *(const GAS f32x4*)src, b4 = *(const GAS f32x4*)(src + 4);
                    v8[0] = a.x; v8[1] = a.y; v8[2] = a.z; v8[3] = a.w; v8[4] = b4.x; v8[5] = b4.y; v8[6] = b4.z; v8[7] = b4.w;
#pragma unroll
                    for (int i = 0; i < 8; ++i) { s += v8[i]; v8[i] = s; }
                    float incl = s;
#pragma unroll
                    for (int o = 1; o < 64; o <<= 1) { const float n = lane_get(incl, lane - o); if (lane >= o) incl += n; }
                    if (lane == 63) wsum[wave] = incl;
                    __syncthreads();
                    float base = incl - s;
                    for (int w = 0; w < wave; ++w) base += wsum[w];
                    float* dst = (float*)(wsq + WS_G) + (size_t)bh * SEQ + tid * 8;
                    *(GAS f32x4*)dst = (f32x4){v8[0] + base, v8[1] + base, v8[2] + base, v8[3] + base}; *(GAS f32x4*)(dst + 4) = (f32x4){v8[4] + base, v8[5] + base, v8[6] + base, v8[7] + base};
                    __syncthreads(); }
            }
        }
        else if (sub == 3) {
            unsigned* qctr = (unsigned*)(ws + WS_CTL) + 1024 + ph * 64 + rep * 32; LAS unsigned* qslot = (LAS unsigned*)(lds + MISC_OFF);
            for (;;) {
                int ozq = 0; asm volatile("" : "+s"(ozq)); unsigned char* wsq = p.ws + ozq;
                if (wave0 == 0 && lane_now() == 0) *qslot = __hip_atomic_fetch_add(qctr, 1u, __ATOMIC_RELAXED, __HIP_MEMORY_SCOPE_AGENT);
                __syncthreads(); const unsigned v = __builtin_amdgcn_readfirstlane(*qslot); __syncthreads();
                constexpr unsigned NHF = 48u * HG_NSEG / 2u;
                if (v >= NHF + 128u + 768u) break;
#ifdef DUP_MASK
                if (rep == 0 && v >= NHF + 128u) break;
#endif
                if (v < NHF) { hgrn_pair<true>(wsq, p.in[I_HNW + ozq] + l * 64, l, (int)(2u * v), lds, wave0); }
                else if (v < NHF + 128u) { const unsigned v5 = v - NHF;
                    s5_scan(wsq, l, (int)(v5 >> 3), (int)(v5 & 7u), wave0 * 64 + lane_now());
                    pg8::Gemm g5{(const pg8::bf16_t*)(wsq + WS_UP), (const pg8::bf16_t*)(wsq + WS_S5WO) + (size_t)l * 16 * 256 * 384, 16 * 2048, 16 * 256, 384, 384, 384}; EpiS5Y E5{(bf16*)(wsq + WS_Y)};
                    const OneUnit S5{(int)v5, (int)(v5 >> 3)}; pg8::gemm_phase<EpiS5Y, OneUnit, false, false>(lds, g5, S5, E5, wave0); __syncthreads(); }
                else { const unsigned a = v - NHF - 128u; const int bh = (int)(a >> 4), qb = 15 - (int)(a & 15u);
                    const attn_body::bf16* Zq = (const attn_body::bf16*)(wsq + WS_Z);
                    int ts; { const int ln = lane_now(); const float* Gb = (const float*)(wsq + WS_G) + (size_t)bh * SEQ; const float* KN = (const float*)(wsq + WS_KN) + bh * 64; const float qn = ((const float*)(wsq + WS_QN))[bh * 16 + qb];
                        const float kd = fmaxf(fmaxf(KN[4 * qb], KN[4 * qb + 1]), fmaxf(KN[4 * qb + 2], KN[4 * qb + 3])); const float ub = __builtin_sqrtf(qn * KN[ln]) + Gb[64 * ln + 63] - Gb[256 * qb] + __builtin_sqrtf(qn * kd);
                        const unsigned long long need = __ballot((ln < 4 * qb) && !(ub < -36.f)); const int first = need ? (int)__builtin_ctzll(need) : 4 * qb; ts = __builtin_amdgcn_readfirstlane(first & ~1); }
                    attn_body::attn_unit<8>(bh / 6, bh % 6, qb, Zq + ZC_FQ, Zq + ZC_FK, Zq + ZC_FV, (attn_body::bf16*)(wsq + WS_Z) + ZC_FQ, (const float*)(wsq + WS_G) + (long)bh * SEQ, (char*)lds_raw, wave0, ts); }
            }
        }
        else if (sub == 4) { PHASE_IDS
            if (bx < 128) {
                pg8::Gemm gg{(const pg8::bf16_t*)(ws + WS_Y), (const pg8::bf16_t*)(ws + WS_GLU) + (size_t)l * 256 * 256, M, 256, 256, 256, 256};
                const OneUnit SG{bx, 0}; EpiGlu EG{(const bf16*)(ws + WS_Y), PIN(I_GLUB) + l * 256, PIN(I_BNS) + l * 256, (bf16*)(ws + WS_H)};
                pg8::gemm_phase<EpiGlu, OneUnit, false, true>(lds, gg, SG, EG, wave0);
            } else {
            const int gw2 = (bx - 128) * NWAVES + wave, ngw2 = (G - 128) * NWAVES;
            const bf16* Zb = (const bf16*)(ws + WS_Z); bf16* MIX = (bf16*)(ws + WS_H); const float* w = PIN(I_BNF) + l * 384;
            float wl[6];
#pragma unroll
            for (int i = 0; i < 6; ++i) wl[i] = w[lane * 6 + i];
            for (int m = gw2; m < M; m += ngw2) {
                const GAS unsigned* src = (const GAS unsigned*)(Zb + (size_t)m * NZ) + lane * 3; const unsigned a = src[0], b2 = src[1], c = src[2];
                float v[6] = {bflo(a), bfhi(a), bflo(b2), bfhi(b2), bflo(c), bfhi(c)}; float s = 0.f;
#pragma unroll
                for (int i = 0; i < 6; ++i) s += v[i] * v[i];
                const float rstd = __builtin_amdgcn_rsqf(wave_sum(s, lane) * (1.f / 384.f) + 1e-6f);
                GAS unsigned* dst = (GAS unsigned*)(MIX + (size_t)m * 1024) + lane * 3;
                dst[0] = pk2(v[0] * rstd * wl[0], v[1] * rstd * wl[1]); dst[1] = pk2(v[2] * rstd * wl[2], v[3] * rstd * wl[3]); dst[2] = pk2(v[4] * rstd * wl[4], v[5] * rstd * wl[5]);
            }
            }
        }
        else if (sub == 5) {
            pg8::Gemm g{(const pg8::bf16_t*)(ws + WS_H), (const pg8::bf16_t*)(ws + WS_WOUT) + (size_t)l * 1024 * 1024, M, 1024, 1024, 1024, 1024};
            pg8::StaticOrder S; S.init(M, 1024, G, bx);
            const float* gm = (const float*)(ws + WS_MOD) + l * 8 * 6144 + 2048;
            if (l == 0) { EpiRes<true> E{PIN(I_X), (bf16*)(ws + WS_XB), gm}; pg8::gemm_phase<EpiRes<true>, pg8::StaticOrder, true, true>(lds, g, S, E, wave0); }
            else { EpiRes<false> E{ws + WS_XB, (bf16*)(ws + WS_XB), gm}; pg8::gemm_phase<EpiRes<false>, pg8::StaticOrder, true, true>(lds, g, S, E, wave0); }
        }
        else if (sub == 6) { PHASE_IDS moe_route(p, oz, l, lds, tid, lane, wave, bx, G);
        }
        else if (sub == 7) { PHASE_IDS moe_gather(p, oz, lds, tid, lane, wave, bx, G);
        }
        else if (sub == 8) { PHASE_IDS
            LAS int* list = (LAS int*)(lds + RING_BYTES + 1024); const int n = moe_build_list<false>(ws, list, tid, bx, G);
            pg8::Gemm g{(const pg8::bf16_t*)(ws + WS_H2S), (const pg8::bf16_t*)(ws + WS_W1) + (size_t)l * 8192 * 1024, MOE_ROWS, 8192, 1024, 1024, 1024};
            ListOrder S{list, n}; EpiHid E{(bf16*)(ws + WS_HID), (const float*)(ws + WS_ROWW)};
            pg8::gemm_phase<EpiHid, ListOrder, true, true>(lds, g, S, E, wave0);
        }
        else if (sub == 9) { PHASE_IDS
            LAS int* list = (LAS int*)(lds + RING_BYTES + 1024); const int n = moe_build_list<true>(ws, list, tid, bx, G);
            pg8::Gemm g{(const pg8::bf16_t*)(ws + WS_HID), (const pg8::bf16_t*)(ws + WS_W2) + (size_t)l * 1024 * 4096, MOE_ROWS, 1024, 512, 512, 4096};
            ListOrder S{list, n}; EpiMoeOut E{(bf16*)(ws + WS_XB), (const float*)(ws + WS_MOD) + l * 8 * 6144 + 5 * 1024, (const int*)(ws + WS_ROWTOK)};
            pg8::gemm_phase<EpiMoeOut, ListOrder, false, true, true>(lds, g, S, E, wave0);
        }
        if (ph + 1 < p.ph_hi || rep == 0) xcd_barrier(bar, wave0 == 0 && lane_now() == 0); else __syncthreads();
      }
    }
}

static int g_grid = 0;
inline bool mk_setup() {
    if (g_grid) return g_grid > 0;
    int dev = 0, cus = 0;
    if (hipGetDevice(&dev) != hipSuccess || hipDeviceGetAttribute(&cus, hipDeviceAttributeMultiprocessorCount, dev) != hipSuccess) { g_grid = -1; return false; }
    if (hipFuncSetAttribute((const void*)mk_fwd, hipFuncAttributeMaxDynamicSharedMemorySize, LDS_BYTES) != hipSuccess) { fprintf(stderr, "hipFuncSetAttribute failed\n"); g_grid = -1; return false; }
    g_grid = cus; return true;
}
inline void mk_zero_ctl(void* d_ws, hipStream_t st) { (void)hipMemsetAsync((char*)d_ws + WS_CTL, 0, CTL_ZERO_BYTES, st); }
inline void mk_launch(void* const* d_in, void* d_out, void* d_ws, hipStream_t st, int lo, int hi, int li = 0) {
    if (!mk_setup()) return;
    Params p{}; for (int i = 0; i < 29; ++i) p.in[i] = (const float*)d_in[i]; p.out = (float*)d_out; p.ws = (unsigned char*)d_ws; p.ph_lo = lo; p.ph_hi = hi; p.li = li;
    hipLaunchKernelGGL(mk_fwd, dim3(g_grid), dim3(NTHR), LDS_BYTES, st, p);
}
}
extern "C" void kernel_launch(void* const* d_in, const int* in_sizes, int n_in, void* d_out, int out_size, void* d_ws, size_t ws_size, hipStream_t stream) {
    fx::mk_zero_ctl(d_ws, stream);
    fx::mk_launch(d_in, d_out, d_ws, stream, 0, 22, 0);
}
```

```cpp
#include <hip/hip_runtime.h>
#include <hip/hip_bf16.h>
#include <cstdio>
#include <cstdint>
#include <cmath>
namespace fx {
constexpr int BATCH = 8, SEQ = 4096, DM = 1024, M = BATCH * SEQ, NZ = 3072, NIN = 2950;
constexpr int NWAVES = 8, NTHR = 512;
constexpr float LOG2E = 1.4426950408889634f;
constexpr float C2 = 0.125f * LOG2E;
constexpr int ZC_FQ = 0, ZC_FK = 384, ZC_FV = 768, ZC_SU = 1152, ZC_HQ = 1408, ZC_HF = 1792, ZC_HI = 2176, ZC_HG = 2560, ZC_FF = 2944;
constexpr size_t MiB = 1u << 20;
constexpr size_t WS_CTL = 0, CTL_ZERO_BYTES = 1 * MiB;
constexpr size_t WS_MOD = 1 * MiB;
constexpr size_t WS_LB = WS_MOD + 512 * 1024;
constexpr size_t WS_S5AL = WS_LB + 4096;
constexpr size_t WS_NLF = 2 * MiB;
constexpr size_t WS_G = WS_NLF + 48 * 4096 * 4;
constexpr size_t WS_KN = WS_G + 48 * 4096 * 4;
constexpr size_t WS_QN = WS_KN + 48 * 64 * 4;
constexpr size_t WS_WIN = 4 * MiB;
constexpr size_t WS_WOUT = WS_WIN + 2ull * 3072 * 1024 * 2;
constexpr size_t WS_W1 = WS_WOUT + 2ull * 1024 * 1024 * 2;
constexpr size_t WS_W2 = WS_W1 + 2ull * 8192 * 1024 * 2;
constexpr size_t WS_GLU = WS_W2 + 2ull * 1024 * 4096 * 2;
constexpr size_t WS_S5WO = WS_GLU + 2ull * 256 * 256 * 2;
constexpr size_t WS_S5WL = WS_S5WO + 2ull * 16 * 256 * 384 * 2;
constexpr size_t WS_H = 80 * MiB;
constexpr size_t WS_Z = WS_H + (size_t)M * 1024 * 2;
constexpr size_t WS_UP = WS_Z + (size_t)M * NZ * 2;
constexpr size_t WS_LOC = WS_UP + 16ull * 2048 * 384 * 2;
constexpr size_t WS_Y = WS_LOC + 16ull * 2048 * 128 * 4;
constexpr size_t WS_HLOC = WS_Y + (size_t)M * 256 * 2;
constexpr size_t WS_XB = WS_HLOC + 16 * MiB;
constexpr size_t WS_END = WS_XB + (size_t)M * 1024 * 2;
static_assert(WS_S5WL + 2ull * 16 * 256 * 256 * 2 <= WS_H, "weights fit below H");
static_assert(WS_QN + 48 * 16 * 4 <= WS_WIN, "norm tables fit below the weights");
static_assert(WS_END <= 512 * MiB, "workspace fits 512 MiB");

#define GAS __attribute__((address_space(1)))
#define LAS __attribute__((address_space(3)))
typedef unsigned short bf16;
typedef unsigned v4u __attribute__((ext_vector_type(4)));
typedef unsigned v2u __attribute__((ext_vector_type(2)));
typedef float f32x4 __attribute__((ext_vector_type(4)));
typedef GAS unsigned gu32;
#define RLX_AGENT __ATOMIC_RELAXED, __HIP_MEMORY_SCOPE_AGENT
#define LDS_WAIT() asm volatile("s_waitcnt lgkmcnt(0)" ::: "memory")
#define VM_WAIT() asm volatile("s_waitcnt vmcnt(0)" ::: "memory")
__device__ __forceinline__ unsigned f2bf(float f) { unsigned u = __builtin_bit_cast(unsigned, f); return (u + 0x7fffu + ((u >> 16) & 1u)) >> 16; }
__device__ __forceinline__ unsigned pk2(float lo, float hi) { return f2bf(lo) | (f2bf(hi) << 16); }
__device__ __forceinline__ float bf2f(unsigned short h) { return __builtin_bit_cast(float, (unsigned)h << 16); }
__device__ __forceinline__ float bflo(unsigned w) { return __builtin_bit_cast(float, w << 16); }
__device__ __forceinline__ float bfhi(unsigned w) { return __builtin_bit_cast(float, w & 0xffff0000u); }
__device__ __forceinline__ float fsigmoid(float x) { return __builtin_amdgcn_rcpf(1.f + __builtin_amdgcn_exp2f(-LOG2E * x)); }
__device__ __forceinline__ float fsilu(float x) { return x * fsigmoid(x); }
__device__ __forceinline__ float lane_get(float v, int src_lane) { return __builtin_bit_cast(float, __builtin_amdgcn_ds_bpermute(src_lane << 2, __builtin_bit_cast(int, v))); }
__device__ __forceinline__ float wave_sum(float v, int  ) {
    v += __builtin_bit_cast(float, __builtin_amdgcn_update_dpp(0, __builtin_bit_cast(int, v), 0xB1, 0xF, 0xF, false));
    v += __builtin_bit_cast(float, __builtin_amdgcn_update_dpp(0, __builtin_bit_cast(int, v), 0x4E, 0xF, 0xF, false));
    v += __builtin_bit_cast(float, __builtin_amdgcn_update_dpp(0, __builtin_bit_cast(int, v), 0x141, 0xF, 0xF, false));
    v += __builtin_bit_cast(float, __builtin_amdgcn_update_dpp(0, __builtin_bit_cast(int, v), 0x140, 0xF, 0xF, false));
    v += __builtin_bit_cast(float, __builtin_amdgcn_update_dpp(0, __builtin_bit_cast(int, v), 0x142, 0xA, 0xF, false));
    v += __builtin_bit_cast(float, __builtin_amdgcn_update_dpp(0, __builtin_bit_cast(int, v), 0x143, 0xC, 0xF, false));
    return __builtin_bit_cast(float, __builtin_amdgcn_readlane(__builtin_bit_cast(int, v), 63));
}

__device__ __forceinline__ int lane_now() { int z = 0; asm volatile("" : "+v"(z)); return (int)__builtin_amdgcn_mbcnt_hi(~0u, __builtin_amdgcn_mbcnt_lo(~0u, (unsigned)z)); }

struct Params {
    const float* in[29]; float* out; unsigned char* ws; int ph_lo, ph_hi, li, pad;
};
enum { I_X = 0, I_C, I_ADAW, I_ADAB, I_NMW, I_NFW, I_WIN, I_FOXB, I_ARE, I_AIM, I_BRE, I_BIM, I_CRE, I_CIM, I_S5D, I_LOGDT, I_GLUW, I_GLUB, I_LBL, I_HNW, I_BNF, I_BNS, I_WOUT, I_RW, I_RB, I_WG, I_WU, I_WD, I_FINW };

__device__ __forceinline__ void transpose_item(const float* src, int ld_src, int c0, int nvalid, bf16* dst, int ldd, int k0, LAS float* scr, int lane) {
#pragma unroll 8
    for (int i = 0; i < 32; ++i) { const int kk = 2 * i + (lane >> 5), n = lane & 31; scr[kk * 33 + n] = (n < nvalid) ? src[(size_t)(k0 + kk) * ld_src + c0 + n] : 0.f; }
    LDS_WAIT(); asm volatile("" ::: "memory");
    const int c = lane & 7;
#pragma unroll
    for (int j = 0; j < 4; ++j) { const int n = (lane >> 3) + 8 * j; const LAS float* s = scr + (8 * c) * 33 + n;
        v4u o; o.x = pk2(s[0 * 33], s[1 * 33]); o.y = pk2(s[2 * 33], s[3 * 33]); o.z = pk2(s[4 * 33], s[5 * 33]); o.w = pk2(s[6 * 33], s[7 * 33]);
        *(GAS v4u*)(dst + (size_t)n * ldd + k0 + 8 * c) = o; }
    LDS_WAIT(); asm volatile("" ::: "memory");
}
__device__ __forceinline__ int win_src_col(int n) {
    if (n < 1152) return n;
    if (n < 1408) return 1158 + (n - 1152);
    if (n < 2944) return 1414 + (n - 1408);
    if (n < 2950) return 1152 + (n - 2944);
    return -1;
}
__device__ __forceinline__ void prologue_wave_items(const Params& p, int oz, LAS float* scr, int gw, int ngw, int lane) {
    unsigned char* ws = p.ws + oz;
    constexpr int IT_WIN = 2 * 16 * 96, IT_WOUT = 2 * 16 * 32, IT_W1 = 2 * 16 * 256, IT_W2 = 2 * 64 * 32, IT_GLU = 2 * 4 * 8;
    constexpr int NITEMS = IT_WIN + IT_WOUT + IT_W1 + IT_W2 + IT_GLU;
    for (int it = gw; it < NITEMS; it += ngw) {
        int r = it;
        if (r < IT_WIN) { const int l = r / (16 * 96), q = r % (16 * 96), kb = q / 96, nb = q % 96, n0 = nb * 32; const int sc = win_src_col(n0);
            int nvalid = 32; if (sc < 0) nvalid = 0; else if (n0 == 2944) nvalid = 6;
            transpose_item(p.in[I_WIN + oz] + (size_t)l * 1024 * NIN, NIN, sc < 0 ? 0 : sc, nvalid, (bf16*)(ws + WS_WIN) + ((size_t)l * 3072 + n0) * 1024, 1024, kb * 64, scr, lane); continue; }
        r -= IT_WIN;
        if (r < IT_WOUT) { const int l = r / (16 * 32), q = r % (16 * 32), kb = q / 32, nb = q % 32;
            transpose_item(p.in[I_WOUT + oz] + (size_t)l * 1024 * 1024, 1024, nb * 32, 32, (bf16*)(ws + WS_WOUT) + ((size_t)l * 1024 + nb * 32) * 1024, 1024, kb * 64, scr, lane); continue; }
        r -= IT_WOUT;
        if (r < IT_W1) {
            const int l = r / (16 * 256), q = r % (16 * 256), kb = q / 256, nb = q % 256, n0 = nb * 32; const int e = n0 / 512, j = (n0 % 512) / 256, w = n0 % 256; const bool up = w >= 128; const int f0 = j * 128 + (w % 128);
            const float* src = (up ? p.in[I_WU + oz] : p.in[I_WG + oz]) + ((size_t)l * 16 + e) * 1024 * 256;
            transpose_item(src, 256, f0, 32, (bf16*)(ws + WS_W1) + ((size_t)l * 8192 + n0) * 1024, 1024, kb * 64, scr, lane); continue; }
        r -= IT_W1;
        if (r < IT_W2) { const int l = r / (64 * 32), q = r % (64 * 32), kb = q / 32, nb = q % 32;
            transpose_item(p.in[I_WD + oz] + (size_t)l * 4096 * 1024, 1024, nb * 32, 32, (bf16*)(ws + WS_W2) + ((size_t)l * 1024 + nb * 32) * 4096, 4096, kb * 64, scr, lane); continue; }
        r -= IT_W2;
        { const int l = r / 32, q = r % 32, kb = q / 8, nb = q % 8;
            transpose_item(p.in[I_GLUW + oz] + (size_t)l * 65536, 256, nb * 32, 32, (bf16*)(ws + WS_GLU) + ((size_t)l * 256 + nb * 32) * 256, 256, kb * 64, scr, lane); }
    }
    if (gw == 0) { float* lb = (float*)(ws + WS_LB); for (int j = lane; j < 384; j += 64) { const float a = p.in[I_LBL + oz][j], b = p.in[I_LBL + oz][384 + j], m = fmaxf(a, b), ea = __expf(a - m), eb = __expf(b - m); lb[j] = 0.f; lb[384 + j] = eb / (ea + eb); } }
}
__device__ __forceinline__ void prologue_mod_item(const Params& p, int oz, int item, LAS float* lds, int tid, int lane, int wave) {
    LAS float* cact = lds; LAS float* part = lds + 8192;
    const int l = item / 96, nb = item % 96, n = nb * 64 + lane; const float* W = p.in[I_ADAW + oz] + ((size_t)l * 1024 + wave * 128) * 6144 + n;
    float acc[8];
#pragma unroll
    for (int b = 0; b < 8; ++b) acc[b] = 0.f;
    for (int k0 = 0; k0 < 128; k0 += 16) { float w[16];
#pragma unroll
        for (int u = 0; u < 16; ++u) w[u] = W[(size_t)(k0 + u) * 6144];
#pragma unroll
        for (int u = 0; u < 16; ++u)
#pragma unroll
            for (int b = 0; b < 8; ++b) acc[b] += cact[b * 1024 + wave * 128 + k0 + u] * w[u]; }
#pragma unroll
    for (int b = 0; b < 8; ++b) part[(wave * 8 + b) * 64 + lane] = acc[b];
    __syncthreads();
    { const int b = tid >> 6; float s = 0.f;
#pragma unroll
        for (int w = 0; w < 8; ++w) s += part[(w * 8 + b) * 64 + lane];
        ((float*)(p.ws + oz + WS_MOD))[(l * 8 + b) * 6144 + n] = s + p.in[I_ADAB + oz][l * 6144 + n]; }
    __syncthreads();
}
__device__ __forceinline__ void prologue_s5_item(const Params& p, int oz, int l, int g, LAS float* lds, int tid) {
    LAS float* apr = lds;
    LAS float* api = lds + 17 * 64;
    LAS float* bbr = lds + 34 * 64;
    LAS float* bbi = bbr + 1024;
    LAS float* ccr = bbi + 1024;
    LAS float* cci = ccr + 1024;
    LAS float* Kt = cci + 1024;
    unsigned char* ws = p.ws + oz;
    if (tid < 64) { const int q = tid; const float dt = __expf(p.in[I_LOGDT + oz][l * 16 + g]); const float lr = p.in[I_ARE + oz][(l * 16 + g) * 64 + q], li = p.in[I_AIM + oz][(l * 16 + g) * 64 + q];
        for (int tau = 0; tau <= 16; ++tau) { const float er = expf(lr * dt * tau); float sn, cs; sincosf(li * dt * tau, &sn, &cs); apr[tau * 64 + q] = er * cs; api[tau * 64 + q] = er * sn; }
        const float ar = apr[64 + q], ai = api[64 + q]; const float nr = ar - 1.f, ni = ai, den = lr * lr + li * li; const float fr = (nr * lr + ni * li) / den, fi = (ni * lr - nr * li) / den;
        for (int c = 0; c < 16; ++c) { const float br = p.in[I_BRE + oz][((l * 16 + g) * 64 + q) * 16 + c], bi = p.in[I_BIM + oz][((l * 16 + g) * 64 + q) * 16 + c]; bbr[q * 16 + c] = fr * br - fi * bi; bbi[q * 16 + c] = fr * bi + fi * br;
            ccr[c * 64 + q] = p.in[I_CRE + oz][((l * 16 + g) * 16 + c) * 64 + q]; cci[c * 64 + q] = p.in[I_CIM + oz][((l * 16 + g) * 16 + c) * 64 + q]; }
        float* al = (float*)(ws + WS_S5AL) + ((l * 16 + g) * 64 + q) * 2; al[0] = apr[16 * 64 + q]; al[1] = api[16 * 64 + q];
    }
    __syncthreads();
    for (int idx = tid; idx < 4096; idx += NTHR) { const int tau = idx >> 8, c = (idx >> 4) & 15, c2 = idx & 15; float acc = 0.f;
        for (int q = 0; q < 64; ++q) { const float mr = ccr[c * 64 + q] * apr[tau * 64 + q] - cci[c * 64 + q] * api[tau * 64 + q], mi = ccr[c * 64 + q] * api[tau * 64 + q] + cci[c * 64 + q] * apr[tau * 64 + q];
            acc += mr * bbr[q * 16 + c2] - mi * bbi[q * 16 + c2]; }
        if (tau == 0 && c == c2) acc += p.in[I_S5D + oz][(l * 16 + g) * 16 + c];
        Kt[idx] = acc; }
    __syncthreads();
    bf16* WO = (bf16*)(ws + WS_S5WO) + (size_t)(l * 16 + g) * 256 * 384; bf16* WL = (bf16*)(ws + WS_S5WL) + (size_t)(l * 16 + g) * 256 * 256;
    for (int ch = tid; ch < 256 * 48; ch += NTHR) { const int n = ch / 48, k0 = (ch % 48) * 8, j = n >> 4, c = n & 15; float v[8];
#pragma unroll
        for (int e = 0; e < 8; ++e) { const int k = k0 + e; float val;
            if (k < 256) { const int i = k >> 4, c2 = k & 15; val = (j >= i) ? Kt[((j - i) << 8) + (c << 4) + c2] : 0.f; }
            else { const int q = (k - 256) & 63; const float pr = apr[(j + 1) * 64 + q], pi = api[(j + 1) * 64 + q], cr = ccr[c * 64 + q], ci = cci[c * 64 + q];
                val = (k - 256 < 64) ? (cr * pr - ci * pi) : -(cr * pi + ci * pr); }
            v[e] = val; }
        v4u o; o.x = pk2(v[0], v[1]); o.y = pk2(v[2], v[3]); o.z = pk2(v[4], v[5]); o.w = pk2(v[6], v[7]);
        *(GAS v4u*)(WO + (size_t)n * 384 + k0) = o; }
    for (int ch = tid; ch < 256 * 32; ch += NTHR) { const int n = ch / 32, k0 = (ch % 32) * 8; float v[8];
#pragma unroll
        for (int e = 0; e < 8; ++e) { const int k = k0 + e, i = k >> 4, c2 = k & 15; float val = 0.f;
            if (n < 128) { const int q = n & 63; const float pr = apr[(15 - i) * 64 + q], pi = api[(15 - i) * 64 + q], br = bbr[q * 16 + c2], bi = bbi[q * 16 + c2]; val = (n < 64) ? (pr * br - pi * bi) : (pr * bi + pi * br); }
            v[e] = val; }
        v4u o; o.x = pk2(v[0], v[1]); o.y = pk2(v[2], v[3]); o.z = pk2(v[4], v[5]); o.w = pk2(v[6], v[7]);
        *(GAS v4u*)(WL + (size_t)n * 256 + k0) = o; }
    __syncthreads();
}
__device__ __forceinline__ void row_load(const float* X, int m, int lane, f32x4 (&v)[4]) { const GAS f32x4* xr = (const GAS f32x4*)(X + (size_t)m * 1024) + lane;
#pragma unroll
    for (int j = 0; j < 4; ++j) v[j] = xr[64 * j]; }
__device__ __forceinline__ void row_load_bf(const bf16* X, int m, int lane, f32x4 (&v)[4]) { const GAS v2u* xr = (const GAS v2u*)(X + (size_t)m * 1024) + lane;
#pragma unroll
    for (int j = 0; j < 4; ++j) { const v2u w = xr[64 * j]; v[j] = (f32x4){bflo(w.x), bfhi(w.x), bflo(w.y), bfhi(w.y)}; } }
__device__ __forceinline__ void adaln_factors(const float* w, const float* sh, const float* sc, int lane, f32x4 (&A)[4], f32x4 (&B)[4]) {
#pragma unroll
    for (int j = 0; j < 4; ++j) { const f32x4 ww = ((const GAS f32x4*)w)[lane + 64 * j], a = ((const GAS f32x4*)sc)[lane + 64 * j]; A[j] = ww * (a + 1.f); B[j] = ((const GAS f32x4*)sh)[lane + 64 * j]; } }
__device__ __forceinline__ void norm_row_to_bf16(f32x4 (&v)[4], const f32x4 (&A)[4], const f32x4 (&B)[4], bf16* orow, int lane) {
    float s = 0.f;
#pragma unroll
    for (int j = 0; j < 4; ++j) s += (v[j].x * v[j].x + v[j].y * v[j].y) + (v[j].z * v[j].z + v[j].w * v[j].w);
    const float rstd = __builtin_amdgcn_rsqf(wave_sum(s, lane) * (1.f / 1024.f) + 1e-6f);
    GAS unsigned long long* o8 = (GAS unsigned long long*)orow + lane;
#pragma unroll
    for (int j = 0; j < 4; ++j) { const f32x4 h = (v[j] * rstd) * A[j] + B[j]; v[j] = h;
        o8[64 * j] = (unsigned long long)pk2(h.x, h.y) | ((unsigned long long)pk2(h.z, h.w) << 32); }
}
}
namespace fx {
#define XB_TMO      128
#define XB_XCNT(j)  (256  + 64 * (j))
#define XB_XSUB(j)  (1280 + 64 * (j))
#define XB_XGEN(j)  (2304 + 64 * (j))
#define XB_TOP      3328
#define XB_TOPGEN   3392
#define XCD_BAR_WORDS 3456
#define XB_SPIN_CAP (1u << 18)

__device__ __forceinline__ unsigned xb_ld(unsigned* p)              { return __hip_atomic_load(p, __ATOMIC_RELAXED, __HIP_MEMORY_SCOPE_AGENT); }
__device__ __forceinline__ unsigned xb_add(unsigned* p, unsigned v) { return __hip_atomic_fetch_add(p, v, __ATOMIC_RELAXED, __HIP_MEMORY_SCOPE_AGENT); }
__device__ __forceinline__ unsigned xb_xcc_id() { return (unsigned)__builtin_amdgcn_s_getreg((3 << 11) | 20) & 0xFu; }
#define XB_SPIN(cond, bar) do { unsigned _sp = 0; while (cond) { __builtin_amdgcn_s_sleep(1); \
    if ((++_sp & 255u) == 0u) { if (xb_ld(&(bar)[XB_TMO])) break; if (_sp > XB_SPIN_CAP) { atomicAdd(&(bar)[XB_TMO], 1u); break; } } } } while (0)

struct XcdBarrier {
    unsigned* bar; unsigned x;
    volatile LAS unsigned* st;
};

__device__ __forceinline__ XcdBarrier xcd_barrier_post(unsigned* bar, volatile LAS unsigned* st, bool leader) {
    XcdBarrier b; b.bar = bar; b.x = xb_xcc_id(); b.st = st;
    if (leader) (void)xb_add(&bar[XB_XCNT(b.x)], 1u);
    return b;
}
__device__ __forceinline__ void xcd_barrier_complete(unsigned* bar, unsigned x, unsigned& nloc, unsigned& nx) {
    const unsigned G = gridDim.x * gridDim.y * gridDim.z;
    asm volatile("" : "+s"(x));
    unsigned sum, cnt, mine, sp = 0u;
    for (;;) {
        sum = 0u; cnt = 0u; mine = 0u;
#pragma unroll
        for (unsigned j = 0; j < 16; ++j) { const unsigned c = xb_ld(&bar[XB_XCNT(j)]); sum += c; cnt += (c > 0u) ? 1u : 0u; mine = (j == x) ? c : mine; }
        if (sum == G) break;
        __builtin_amdgcn_s_sleep(1);
        if ((++sp & 255u) == 0u) { if (xb_ld(&bar[XB_TMO])) break; if (sp > XB_SPIN_CAP) { atomicAdd(&bar[XB_TMO], 1u); break; } }
    }
    nloc = mine > 0u ? mine : 1u; nx = cnt > 0u ? cnt : 1u;
}

__device__ __forceinline__ void xcd_barrier(const XcdBarrier& b, bool leader) {
    asm volatile("s_waitcnt vmcnt(0)" ::: "memory");
    __syncthreads();
    if (leader) {
        unsigned* bar = b.bar;
        __builtin_amdgcn_s_waitcnt(0);
        unsigned nloc = b.st[0], nx = b.st[1];
        if (nloc == 0u) { xcd_barrier_complete(bar, b.x, nloc, nx); b.st[0] = nloc; b.st[1] = nx; }
        const unsigned old = xb_add(&bar[XB_XSUB(b.x)], 1u);
        const unsigned gen = old / nloc;
        if (old + 1u == (gen + 1u) * nloc) {
            __builtin_amdgcn_fence(__ATOMIC_RELEASE, "agent");
            asm volatile("s_waitcnt vmcnt(0)" ::: "memory");
            const unsigned og = xb_add(&bar[XB_TOP], 1u);
            const unsigned tg = og / nx;
            if (og + 1u == (tg + 1u) * nx) xb_add(&bar[XB_TOPGEN], 1u);
            else XB_SPIN(xb_ld(&bar[XB_TOPGEN]) == tg, bar);
            __builtin_amdgcn_fence(__ATOMIC_ACQUIRE, "agent");
            xb_add(&bar[XB_XGEN(b.x)], 1u);
            asm volatile("s_waitcnt vmcnt(0)" ::: "memory");
        } else {
            XB_SPIN(xb_ld(&bar[XB_XGEN(b.x)]) == gen, bar);
            __builtin_amdgcn_fence(__ATOMIC_ACQUIRE, "agent");
            asm volatile("s_waitcnt vmcnt(0)" ::: "memory");
        }
    }
    __syncthreads();
}

}
namespace pg8 {
#define PG8_LAS __attribute__((address_space(3)))
typedef unsigned short bf16_t;
typedef short bf16x8 __attribute__((ext_vector_type(8)));
typedef float f32x4 __attribute__((ext_vector_type(4)));
typedef unsigned u32x4 __attribute__((ext_vector_type(4)));
constexpr int BM = 256, BK = 64, HALF = 128, HTB = HALF * BK * 2  , STAGE_BYTES = 8 * HTB, NXCD = 8, WGM = 8;

__host__ __device__ __forceinline__ int lds_byte(int r, int c) { const int st = (r >> 4) * 2 + (c >> 5), rr = r & 15, cc = c & 31, ob = rr * 64 + cc * 2; return st * 1024 + (ob ^ (((ob >> 9) & 1) << 5)); }
__host__ __device__ __forceinline__ void stage_rc(int b, int& R, int& C) { const int st = b / 1024, sb = b % 1024, swz = sb ^ (((sb >> 9) & 1) << 5); R = (st >> 1) * 16 + swz / 64; C = (st & 1) * 32 + (swz % 64) / 2; }
__host__ __device__ __forceinline__ int perm32(int rho) { const int n = rho >> 4, i = rho & 15; return 8 * (i >> 2) + 4 * n + (i & 3); }

struct Unit { int pm, pn; int k0, k1; };
struct Gemm { const bf16_t* A; const bf16_t* Bt; int M, N, K, lda, ldb; };

struct StaticOrder {
    int nM, nN, nwg, G, c;
    __host__ __device__ void init(int M, int N, int G_, int c_) { nM = M / BM; nN = N / BM; nwg = nM * nN; G = G_; c = c_; }
    __host__ __device__ bool next(int i, Unit& u) const {
        const long L = (long)i * G + c; if (L >= nwg) return false;
        int wgid = (int)L; { const int q = nwg / NXCD, r = nwg % NXCD, xcd = wgid % NXCD, off = wgid / NXCD; wgid = (xcd < r ? xcd * (q + 1) : r * (q + 1) + (xcd - r) * q) + off; }
        const int nig = WGM * nN, gid = wgid / nig, fm = gid * WGM, gsz = (nM - fm) < WGM ? (nM - fm) : WGM;
        u.pm = fm + ((wgid % nig) % gsz); u.pn = (wgid % nig) / gsz; return true;
    }
    __device__ __forceinline__ void a_ready(const Unit&) const {}
    __device__ __forceinline__ void done(const Unit&) const {}
};

__device__ __forceinline__ unsigned cvt_pk_bf16(float lo, float hi) { unsigned r; asm volatile("v_cvt_pk_bf16_f32 %0, %1, %2" : "=v"(r) : "v"(lo), "v"(hi)); return r; }
typedef float f32x2 __attribute__((ext_vector_type(2)));
__device__ __forceinline__ f32x2 gelu_pk(f32x2 v) {
    const f32x2 av = __builtin_elementwise_abs(v), d = av * 0.2316418882f + 1.0f;
    f32x2 t; t.x = __builtin_amdgcn_rcpf(d.x); t.y = __builtin_amdgcn_rcpf(d.y);
    f32x2 q = t * 0.5307027145f + (-0.7265760135f); q = q * t + 0.7107068705f; q = q * t + (-0.142248368f); q = q * t + 0.127414796f; q = q * t;
    const f32x2 s = (v * v) * (-0.72134752044f);
    f32x2 e; e.x = __builtin_amdgcn_exp2f(s.x); e.y = __builtin_amdgcn_exp2f(s.y);
    const f32x2 m = v * (q * e), r = v - m;
    f32x2 o; o.x = v.x < 0.f ? m.x : r.x; o.y = v.y < 0.f ? m.y : r.y; return o;
}

template <int ACT  > struct EpiBf16 {
    static constexpr bool PERM = true, AFTER_DRAIN = false; static_assert(ACT == 0 || ACT == 1, "EpiBf16: ACT is 0 (none) or 1 (gelu_pk)");
    bf16_t* O; int ldc; const float* bias; int split_cols; size_t split_stride; float scale0;
    __device__ __forceinline__ void operator()(const f32x4 (&acc)[2][2][4][2], const Unit& u, int wr, int wc, int fr, int fq) const {
        const int row0 = u.pm * BM + wr * 64 + fr; int colt = u.pn * BM; bf16_t* base = O;
        float sc = 1.f; if (split_cols) { const int t = colt / split_cols; base += (size_t)t * split_stride; colt -= t * split_cols; if (t == 0) sc = scale0; }
        const int col0 = colt + wc * 32 + 8 * fq, bcol0 = u.pn * BM + wc * 32 + 8 * fq;
        f32x4 bv[2][2];
#pragma unroll
        for (int bj = 0; bj < 2; ++bj)
#pragma unroll
            for (int n = 0; n < 2; ++n) bv[bj][n] = bias ? *(const f32x4*)(bias + bcol0 + bj * HALF + 4 * n) : (f32x4){0.f, 0.f, 0.f, 0.f};
#pragma unroll
        for (int ai = 0; ai < 2; ++ai)
#pragma unroll
            for (int m = 0; m < 4; ++m) { bf16_t* rowp = base + (size_t)(row0 + ai * HALF + m * 16) * ldc + col0;
#pragma unroll
                for (int bj = 0; bj < 2; ++bj) { f32x4 v0 = acc[ai][bj][m][0] + bv[bj][0], v1 = acc[ai][bj][m][1] + bv[bj][1];
                    if (ACT == 1) { f32x2 a = gelu_pk((f32x2){v0[0], v0[1]}), b = gelu_pk((f32x2){v0[2], v0[3]}), c = gelu_pk((f32x2){v1[0], v1[1]}), d = gelu_pk((f32x2){v1[2], v1[3]});
                        v0 = (f32x4){a.x, a.y, b.x, b.y}; v1 = (f32x4){c.x, c.y, d.x, d.y}; }
                    v0 = v0 * sc; v1 = v1 * sc; u32x4 w; w.x = cvt_pk_bf16(v0[0], v0[1]); w.y = cvt_pk_bf16(v0[2], v0[3]); w.z = cvt_pk_bf16(v1[0], v1[1]); w.w = cvt_pk_bf16(v1[2], v1[3]);
                    *(u32x4*)(rowp + bj * HALF) = w; } }
    }
};

struct PanelStats {
    unsigned* xbuf;
    unsigned* cnt;
    unsigned* tmo;
    int ntn; float eps;
    unsigned code;
    __device__ __forceinline__ bool run(const f32x4 (&v)[2][2][4][2], const Unit& u, int wr, int wc, int fr, int fq, PG8_LAS unsigned char* lds, int wid, int lane) const {
        typedef float f32x2v __attribute__((ext_vector_type(2)));
        PG8_LAS f32x2v* P = (PG8_LAS f32x2v*)lds;
        PG8_LAS f32x2v* S = (PG8_LAS f32x2v*)(lds + 8192);
        PG8_LAS unsigned* flag = (PG8_LAS unsigned*)(lds + 8192 + 2048);
#pragma unroll
        for (int ai = 0; ai < 2; ++ai)
#pragma unroll
            for (int m = 0; m < 4; ++m) {
                float s = 0.f;
#pragma unroll
                for (int bj = 0; bj < 2; ++bj)
#pragma unroll
                    for (int n = 0; n < 2; ++n) { const f32x4 x = v[ai][bj][m][n]; s += (x[0] + x[1]) + (x[2] + x[3]); }
                s += __shfl_xor(s, 16); s += __shfl_xor(s, 32);
                const float mw = s * (1.0f / 64.0f); float q = 0.f;
#pragma unroll
                for (int bj = 0; bj < 2; ++bj)
#pragma unroll
                    for (int n = 0; n < 2; ++n) { const f32x4 d = v[ai][bj][m][n] - mw; q += (d[0] * d[0] + d[1] * d[1]) + (d[2] * d[2] + d[3] * d[3]); }
                q += __shfl_xor(q, 16); q += __shfl_xor(q, 32);
                if (fq == 0) P[(ai * HALF + wr * 64 + m * 16 + fr) * 4 + wc] = (f32x2v){mw, q};
            }
        asm volatile("s_waitcnt lgkmcnt(0)" ::: "memory"); __builtin_amdgcn_s_barrier(); asm volatile("" ::: "memory");
#if defined(BROKEN_EXCHANGE_NO_WAIT)
#warning BROKEN CONTROL BUILD: the row-statistics exchange does not wait; results are wrong by design
        if (blockIdx.x >= 64) { const long long t0_ = clock64(); while (clock64() - t0_ < 60000) __builtin_amdgcn_s_sleep(8); }
#endif
        const int row = wid * 32 + (lane & 31);
        if (lane < 32) {
            const f32x2v a = P[row * 4 + 0], b = P[row * 4 + 1], c = P[row * 4 + 2], d = P[row * 4 + 3];
            const float mt = (a.x + b.x + c.x + d.x) * 0.25f;
            const float da = a.x - mt, db = b.x - mt, dc = c.x - mt, dd = d.x - mt;
            const float m2 = (a.y + b.y) + (c.y + d.y) + 64.0f * ((da * da + db * db) + (dc * dc + dd * dd));
            unsigned long long* slot = (unsigned long long*)xbuf + ((size_t)(u.pm * BM + row) * 4 + u.pn);
            __hip_atomic_store(slot, ((unsigned long long)__float_as_uint(m2) << 32) | __float_as_uint(mt), __ATOMIC_RELAXED, __HIP_MEMORY_SCOPE_AGENT);
        }
        asm volatile("s_waitcnt vmcnt(0)" ::: "memory");
        if (lane == 0) __hip_atomic_fetch_add(cnt + 64 * u.pm, 1u, __ATOMIC_RELAXED, __HIP_MEMORY_SCOPE_AGENT);
        if (wid == 0) {
            bool dead = false; const unsigned long long t0 = __builtin_amdgcn_s_memrealtime(); const unsigned want = 8u * (unsigned)ntn;
            for (;;) {
#if defined(BROKEN_EXCHANGE_NO_WAIT)
                break;
#endif
                if ((unsigned)__builtin_amdgcn_readfirstlane(__hip_atomic_load(cnt + 64 * u.pm, __ATOMIC_RELAXED, __HIP_MEMORY_SCOPE_AGENT)) >= want) break;
                if (__builtin_amdgcn_s_memrealtime() - t0 > 2000000ull) {
                    if (lane == 0) { unsigned expect = 0u; __hip_atomic_compare_exchange_strong(tmo + 1, &expect, code | (unsigned)(u.pm & 0xff), __ATOMIC_RELAXED, __ATOMIC_RELAXED, __HIP_MEMORY_SCOPE_AGENT);
                                     __hip_atomic_store(tmo, 1u, __ATOMIC_RELAXED, __HIP_MEMORY_SCOPE_AGENT); }
                    dead = true; break; }
                __builtin_amdgcn_s_sleep(2);
            }
            __builtin_amdgcn_fence(__ATOMIC_ACQUIRE, "agent");
            if (lane == 0) flag[0] = dead ? 1u : 0u;
        }
        asm volatile("s_waitcnt vmcnt(0) lgkmcnt(0)" ::: "memory"); __builtin_amdgcn_s_barrier(); asm volatile("" ::: "memory");
        const bool bad = flag[0] != 0u;
        if (lane < 32) {
            const unsigned long long* slot = (const unsigned long long*)xbuf + (size_t)(u.pm * BM + row) * 4; float mt[4], m2[4]; float ms = 0.f;
#pragma unroll
            for (int t = 0; t < 4; ++t) { if (t < ntn) { const unsigned long long w = __hip_atomic_load(slot + t, __ATOMIC_RELAXED, __HIP_MEMORY_SCOPE_AGENT); mt[t] = __uint_as_float((unsigned)w); m2[t] = __uint_as_float((unsigned)(w >> 32)); } else { mt[t] = 0.f; m2[t] = 0.f; } ms += mt[t]; }
            const float mean = ms / (float)ntn; float q = 0.f;
#pragma unroll
            for (int t = 0; t < 4; ++t) if (t < ntn) { const float dm = mt[t] - mean; q += m2[t] + 256.0f * dm * dm; }
            S[row] = (f32x2v){mean, 1.0f / sqrtf(q / (256.0f * (float)ntn) + eps)};
        }
        asm volatile("s_waitcnt lgkmcnt(0)" ::: "memory"); __builtin_amdgcn_s_barrier(); asm volatile("" ::: "memory");
        return bad;
    }
};
struct EpiLnRes {
    static constexpr bool PERM = false, AFTER_DRAIN = true;
    const float* base; float* out; int ldc; const float* bias; PanelStats st; unsigned poison;
    __device__ __forceinline__ void fused(f32x4 (&acc)[2][2][4][2], const Unit& u, int wr, int wc, int fr, int fq, PG8_LAS unsigned char* lds, int wid, int lane) const {
        typedef float f32x2v __attribute__((ext_vector_type(2)));
        const PG8_LAS f32x2v* S = (const PG8_LAS f32x2v*)(lds + 8192);
        const int col0 = u.pn * BM + wc * 32 + 4 * fq;
#pragma unroll
        for (int bj = 0; bj < 2; ++bj)
#pragma unroll
            for (int n = 0; n < 2; ++n) { const f32x4 bv = bias ? *(const f32x4*)(bias + col0 + bj * HALF + n * 16) : (f32x4){0.f, 0.f, 0.f, 0.f};
#pragma unroll
                for (int ai = 0; ai < 2; ++ai)
#pragma unroll
                    for (int m = 0; m < 4; ++m) acc[ai][bj][m][n] += bv; }
        f32x4 pre[4][2][2];
#pragma unroll
        for (int m = 0; m < 4; ++m) { const size_t off = (size_t)(u.pm * BM + wr * 64 + m * 16 + fr) * ldc + col0;
#pragma unroll
            for (int bj = 0; bj < 2; ++bj)
#pragma unroll
                for (int n = 0; n < 2; ++n) pre[m][bj][n] = *(const f32x4*)(base + off + bj * HALF + n * 16); }
        const bool bad = st.run(acc, u, wr, wc, fr, fq, lds, wid, lane) || poison != 0u;
        const float qnan = __builtin_nanf("");
#pragma unroll
        for (int ai = 0; ai < 2; ++ai)
#pragma unroll
            for (int m = 0; m < 4; ++m) { const int r = ai * HALF + wr * 64 + m * 16 + fr; const f32x2v sr = S[r]; const size_t off = (size_t)(u.pm * BM + r) * ldc + col0;
#pragma unroll
                for (int bj = 0; bj < 2; ++bj)
#pragma unroll
                    for (int n = 0; n < 2; ++n) { const f32x4 bs = ai == 0 ? pre[m][bj][n] : *(const f32x4*)(base + off + bj * HALF + n * 16); f32x4 o = bs + (acc[ai][bj][m][n] - sr.x) * sr.y;
                        if (bad) o = (f32x4){qnan, qnan, qnan, qnan}; *(f32x4*)(out + off + bj * HALF + n * 16) = o; }
                if (m & 1) asm volatile("" ::: "memory"); }
    }
};
struct EpiLnResLn {
    static constexpr bool PERM = false, AFTER_DRAIN = true;
    const float* base; float* out; bf16_t* xn; int ldc; const float* bias; PanelStats st1, st2; unsigned poison;
    __device__ __forceinline__ void fused(f32x4 (&acc)[2][2][4][2], const Unit& u, int wr, int wc, int fr, int fq, PG8_LAS unsigned char* lds, int wid, int lane) const {
        typedef float f32x2v __attribute__((ext_vector_type(2))); typedef unsigned u32x2v __attribute__((ext_vector_type(2)));
        const PG8_LAS f32x2v* S = (const PG8_LAS f32x2v*)(lds + 8192);
        const int col0 = u.pn * BM + wc * 32 + 4 * fq;
#pragma unroll
        for (int bj = 0; bj < 2; ++bj)
#pragma unroll
            for (int n = 0; n < 2; ++n) { const f32x4 bv = bias ? *(const f32x4*)(bias + col0 + bj * HALF + n * 16) : (f32x4){0.f, 0.f, 0.f, 0.f};
#pragma unroll
                for (int ai = 0; ai < 2; ++ai)
#pragma unroll
                    for (int m = 0; m < 4; ++m) acc[ai][bj][m][n] += bv; }
        bool bad = st1.run(acc, u, wr, wc, fr, fq, lds, wid, lane) || poison != 0u;
        const float qnan = __builtin_nanf("");
#pragma unroll
        for (int ai = 0; ai < 2; ++ai)
#pragma unroll
            for (int m = 0; m < 4; ++m) { const int r = ai * HALF + wr * 64 + m * 16 + fr; const f32x2v sr = S[r]; const size_t off = (size_t)(u.pm * BM + r) * ldc + col0;
#pragma unroll
                for (int bj = 0; bj < 2; ++bj)
#pragma unroll
                    for (int n = 0; n < 2; ++n) { const f32x4 bs = *(const f32x4*)(base + off + bj * HALF + n * 16); acc[ai][bj][m][n] = bs + (acc[ai][bj][m][n] - sr.x) * sr.y; }
                asm volatile("" : "+v"(acc[ai][0][m][0]), "+v"(acc[ai][0][m][1]), "+v"(acc[ai][1][m][0]), "+v"(acc[ai][1][m][1]));
                if (m & 1) asm volatile("" ::: "memory"); }
        const bool bad1 = bad;
        bad = st2.run(acc, u, wr, wc, fr, fq, lds, wid, lane) || bad;
#pragma unroll
        for (int ai = 0; ai < 2; ++ai)
#pragma unroll
            for (int m = 0; m < 4; ++m) { const int r = ai * HALF + wr * 64 + m * 16 + fr; const f32x2v sr = S[r]; const size_t off = (size_t)(u.pm * BM + r) * ldc + col0;
#pragma unroll
                for (int bj = 0; bj < 2; ++bj)
#pragma unroll
                    for (int n = 0; n < 2; ++n) { const f32x4 x1 = acc[ai][bj][m][n]; *(f32x4*)(out + off + bj * HALF + n * 16) = bad1 ? (f32x4){qnan, qnan, qnan, qnan} : x1;
                        const f32x4 o = (x1 - sr.x) * sr.y; u32x2v w; w.x = cvt_pk_bf16(o[0], o[1]); w.y = cvt_pk_bf16(o[2], o[3]);
                        if (bad) { w.x = 0x7fc07fc0u; w.y = 0x7fc07fc0u; } *(u32x2v*)(xn + off + bj * HALF + n * 16) = w; }
                asm volatile("" ::: "memory"); }
    }
};

template <class Epi, class Sched, bool ALIGN_EPI = false, bool SP2 = false, bool KSPLIT = false>
__device__ __forceinline__ void gemm_phase(PG8_LAS unsigned char* lds, const Gemm g, const Sched& S, const Epi& E, const int wave0) {
    int wv0_ = wave0; asm volatile("" : "+s"(wv0_));
    int z0_ = 0; asm volatile("" : "+v"(z0_)); const int tid_ = wv0_ * 64 + (int)__builtin_amdgcn_mbcnt_hi(~0u, __builtin_amdgcn_mbcnt_lo(~0u, (unsigned)z0_));
    const int tid = tid_, wid = __builtin_amdgcn_readfirstlane(tid >> 6), lane = tid & 63, wr = wid >> 2, wc = wid & 3, fr = lane & 15, fq = lane >> 4;
    const int K = g.K, nt = K / BK;
    unsigned voffA[2], voffB[2];
#pragma unroll
    for (int i = 0; i < 2; ++i) { int R, C; stage_rc(tid * 16 + i * 8192, R, C); const int Rb = Epi::PERM ? ((R & ~31) + perm32(R & 31)) : R;
        voffA[i] = (unsigned)(R * g.lda + C) * 2u; voffB[i] = (unsigned)(Rb * g.ldb + C) * 2u; }
    const unsigned kstep = (unsigned)(BK * 2);
    const unsigned hstepA = (unsigned)HALF * g.lda * 2, hstepB = (unsigned)HALF * g.ldb * 2;
    const unsigned tstepA = 2 * hstepA, tstepB = 2 * hstepB;
    const char* const baseA = (const char*)g.A; const char* const baseB = (const char*)g.Bt;
    const unsigned ldsw = (unsigned)wid * 1024u;
    const int aoff = lds_byte(wr * 64 + fr, fq * 8), boff = lds_byte(wc * 32 + fr, fq * 8);
#define PG8_SA(b, h) (((b) * 2 + (h)) * HTB)
#define PG8_SB(b, h) ((4 + (b) * 2 + (h)) * HTB)
#define PG8_STAGE_X(bufoff, base, soff, voff) do { _Pragma("unroll") for (int _i = 0; _i < 2; ++_i) \
        __builtin_amdgcn_global_load_lds((const unsigned*)((base) + (unsigned)((soff) + (voff)[_i])), (PG8_LAS unsigned*)(lds + (bufoff) + ldsw + _i * 8192), 16, 0, 0); } while (0)
#define PG8_LDA(dst, b, h) do { _Pragma("unroll") for (int m = 0; m < 4; ++m) _Pragma("unroll") for (int k = 0; k < 2; ++k) dst[m][k] = *(const PG8_LAS bf16x8*)(lds + PG8_SA(b, h) + aoff + m * 2048 + k * 1024); } while (0)
#define PG8_LDB(dst, b, h) do { _Pragma("unroll") for (int n = 0; n < 2; ++n) _Pragma("unroll") for (int k = 0; k < 2; ++k) dst[n][k] = *(const PG8_LAS bf16x8*)(lds + PG8_SB(b, h) + boff + n * 2048 + k * 1024); } while (0)
#define PG8_MMA(ai, bj, At, Bt) do { __builtin_amdgcn_s_setprio(1); _Pragma("unroll") for (int m = 0; m < 4; ++m) _Pragma("unroll") for (int n = 0; n < 2; ++n) _Pragma("unroll") for (int k = 0; k < 2; ++k) \
        acc[ai][bj][m][n] = __builtin_amdgcn_mfma_f32_16x16x32_bf16(Bt[n][k], At[m][k], acc[ai][bj][m][n], 0, 0, 0); __builtin_amdgcn_s_setprio(0); } while (0)
#define PG8_WAIT_V(n) asm volatile("s_waitcnt vmcnt(" #n ")" ::: "memory")
#define PG8_WAIT_L(n) asm volatile("s_waitcnt lgkmcnt(" #n ")" ::: "memory")
#define PG8_BAR __builtin_amdgcn_s_barrier()
#define PG8_SCHED __builtin_amdgcn_sched_barrier(0)
    Unit cur, nxt; int ui = 0;
    if (!S.next(0, cur)) return;
    f32x4 acc[2][2][4][2];
#pragma unroll
    for (int a = 0; a < 2; ++a)
#pragma unroll
        for (int b = 0; b < 2; ++b)
#pragma unroll
            for (int m = 0; m < 4; ++m)
#pragma unroll
                for (int n = 0; n < 2; ++n) acc[a][b][m][n] = (f32x4){0.f, 0.f, 0.f, 0.f};
    bf16x8 At[4][2], B0[2][2], B1[2][2];
    unsigned cA = (unsigned)cur.pm * tstepA; unsigned cB = (unsigned)cur.pn * tstepB + (KSPLIT ? (unsigned)cur.k0 * 2u : 0u);
    unsigned sB = KSPLIT ? (unsigned)cur.pn * tstepB + (unsigned)cur.k1 * 2u - (unsigned)(nt / 2) * kstep : cB;
    S.a_ready(cur);
    if constexpr (SP2) {
        PG8_STAGE_X(PG8_SB(0, 0), baseB, cB, voffB); PG8_STAGE_X(PG8_SB(0, 1), baseB, cB + hstepB, voffB); PG8_STAGE_X(PG8_SA(0, 0), baseA, cA, voffA); PG8_STAGE_X(PG8_SA(0, 1), baseA, cA + hstepA, voffA);
        if (wr == 1) PG8_BAR;
        PG8_WAIT_V(2); PG8_BAR;
        PG8_STAGE_X(PG8_SB(1, 0), baseB, cB + kstep, voffB); PG8_STAGE_X(PG8_SA(1, 0), baseA, cA + kstep, voffA); PG8_STAGE_X(PG8_SB(1, 1), baseB, cB + hstepB + kstep, voffB);
        PG8_WAIT_V(6); PG8_BAR;
    } else {
        PG8_STAGE_X(PG8_SB(0, 0), baseB, cB, voffB); PG8_STAGE_X(PG8_SA(0, 0), baseA, cA, voffA); PG8_STAGE_X(PG8_SB(0, 1), baseB, cB + hstepB, voffB); PG8_STAGE_X(PG8_SA(0, 1), baseA, cA + hstepA, voffA);
        if (wr == 1) PG8_BAR;
        PG8_WAIT_V(4); PG8_BAR;
        PG8_STAGE_X(PG8_SB(1, 0), baseB, cB + kstep, voffB); PG8_STAGE_X(PG8_SA(1, 0), baseA, cA + kstep, voffA); PG8_STAGE_X(PG8_SB(1, 1), baseB, cB + hstepB + kstep, voffB);
        PG8_WAIT_V(6); PG8_BAR;
    }
    for (;;) {
        const bool has_next = S.next(ui + 1, nxt);
        const unsigned nA = has_next ? (unsigned)nxt.pm * tstepA : cA; const unsigned nB = has_next ? (unsigned)nxt.pn * tstepB + (KSPLIT ? (unsigned)nxt.k0 * 2u : 0u) : cB;
        const unsigned nsB = (KSPLIT && has_next) ? (unsigned)nxt.pn * tstepB + (unsigned)nxt.k1 * 2u - (unsigned)(nt / 2) * kstep : sB;
        for (int t = 0; t < nt; t += 2) {
            const bool last = (t == nt - 2);
            const unsigned a1 = cA + (unsigned)(t + 1) * kstep;
            const unsigned a2 = last ? nA : cA + (unsigned)(t + 2) * kstep; const unsigned b2 = last ? nB : ((KSPLIT && (t + 2) >= nt / 2) ? sB : cB) + (unsigned)(t + 2) * kstep;
            const unsigned a3 = a2 + kstep; const unsigned b3 = b2 + kstep;
            if (last && has_next) S.a_ready(nxt);
            if constexpr (SP2) {
            PG8_LDB(B0, 0, 0); PG8_LDB(B1, 0, 1); PG8_SCHED; PG8_LDA(At, 0, 0); PG8_STAGE_X(PG8_SA(1, 1), baseA, a1 + hstepA, voffA);
            PG8_WAIT_V(8); PG8_WAIT_L(0); PG8_BAR; PG8_MMA(0, 0, At, B0); PG8_MMA(0, 1, At, B1); PG8_BAR; PG8_SCHED;
            PG8_LDA(At, 0, 1); PG8_STAGE_X(PG8_SB(0, 0), baseB, b2, voffB); PG8_STAGE_X(PG8_SB(0, 1), baseB, b2 + hstepB, voffB); PG8_STAGE_X(PG8_SA(0, 0), baseA, a2, voffA);
            PG8_WAIT_V(8); PG8_WAIT_L(0); PG8_BAR; PG8_MMA(1, 0, At, B0); PG8_MMA(1, 1, At, B1); PG8_BAR; PG8_SCHED;
            PG8_LDB(B0, 1, 0); PG8_LDB(B1, 1, 1); PG8_SCHED; PG8_LDA(At, 1, 0); PG8_STAGE_X(PG8_SA(0, 1), baseA, a2 + hstepA, voffA);
            PG8_WAIT_V(8); PG8_WAIT_L(0); PG8_BAR; PG8_MMA(0, 0, At, B0); PG8_MMA(0, 1, At, B1); PG8_BAR; PG8_SCHED;
            PG8_LDA(At, 1, 1); PG8_STAGE_X(PG8_SB(1, 0), baseB, b3, voffB); PG8_STAGE_X(PG8_SB(1, 1), baseB, b3 + hstepB, voffB); PG8_STAGE_X(PG8_SA(1, 0), baseA, a3, voffA);
            PG8_WAIT_V(8); PG8_WAIT_L(0); PG8_BAR; PG8_MMA(1, 0, At, B0); PG8_MMA(1, 1, At, B1); PG8_BAR; PG8_SCHED;
            } else {
            PG8_LDB(B0, 0, 0); PG8_SCHED; PG8_LDA(At, 0, 0); PG8_STAGE_X(PG8_SA(1, 1), baseA, a1 + hstepA, voffA);
            PG8_WAIT_L(8); PG8_BAR; PG8_WAIT_L(0); PG8_MMA(0, 0, At, B0); PG8_BAR; PG8_SCHED;
            PG8_LDB(B1, 0, 1); PG8_STAGE_X(PG8_SB(0, 0), baseB, b2, voffB);
            PG8_BAR; PG8_WAIT_L(0); PG8_MMA(0, 1, At, B1); PG8_BAR;
            PG8_LDA(At, 0, 1); PG8_STAGE_X(PG8_SA(0, 0), baseA, a2, voffA);
            PG8_BAR; PG8_WAIT_L(0); PG8_MMA(1, 0, At, B0); PG8_BAR; PG8_SCHED;
            PG8_STAGE_X(PG8_SB(0, 1), baseB, b2 + hstepB, voffB);
            PG8_WAIT_V(6); PG8_BAR; PG8_MMA(1, 1, At, B1); PG8_BAR;
            PG8_LDB(B0, 1, 0); PG8_SCHED; PG8_LDA(At, 1, 0); PG8_STAGE_X(PG8_SA(0, 1), baseA, a2 + hstepA, voffA);
            PG8_WAIT_L(8); PG8_BAR; PG8_WAIT_L(0); PG8_MMA(0, 0, At, B0); PG8_BAR; PG8_SCHED;
            PG8_LDB(B1, 1, 1); PG8_STAGE_X(PG8_SB(1, 0), baseB, b3, voffB);
            PG8_BAR; PG8_WAIT_L(0); PG8_MMA(0, 1, At, B1); PG8_BAR;
            PG8_LDA(At, 1, 1); PG8_STAGE_X(PG8_SA(1, 0), baseA, a3, voffA);
            PG8_BAR; PG8_WAIT_L(0); PG8_MMA(1, 0, At, B0); PG8_BAR; PG8_SCHED;
            PG8_STAGE_X(PG8_SB(1, 1), baseB, b3 + hstepB, voffB);
            PG8_WAIT_V(6); PG8_BAR; PG8_MMA(1, 1, At, B1); PG8_BAR;
            }
        }
        if constexpr (ALIGN_EPI) { if (wr == 0) PG8_BAR; }
        if constexpr (!Epi::AFTER_DRAIN) { E(acc, cur, wr, wc, fr, fq); S.done(cur); }
        if (!has_next) break;
#pragma unroll
        for (int a = 0; a < 2; ++a)
#pragma unroll
            for (int b = 0; b < 2; ++b)
#pragma unroll
                for (int m = 0; m < 4; ++m)
#pragma unroll
                    for (int n = 0; n < 2; ++n) acc[a][b][m][n] = (f32x4){0.f, 0.f, 0.f, 0.f};
        cur = nxt; cA = nA; cB = nB; sB = nsB; ++ui;
        if constexpr (ALIGN_EPI) { if (wr == 1) PG8_BAR; }
    }
    PG8_WAIT_V(0);
    if constexpr (!ALIGN_EPI) { if (wr == 0) PG8_BAR; }
    PG8_BAR;
    if constexpr (Epi::AFTER_DRAIN) { E.fused(acc, cur, wr, wc, fr, fq, lds, wid, lane); S.done(cur); }
#undef PG8_SA
#undef PG8_SB
#undef PG8_STAGE_X
#undef PG8_LDA
#undef PG8_LDB
#undef PG8_MMA
#undef PG8_WAIT_V
#undef PG8_WAIT_L
#undef PG8_BAR
#undef PG8_SCHED
}
}
namespace attn_body {
using bf16=__hip_bfloat16;
using bf16x8=__attribute__((ext_vector_type(8)))short;
using s16x4=__attribute__((ext_vector_type(4)))short;
using f32x16=__attribute__((ext_vector_type(16)))float;
using u32x4=__attribute__((ext_vector_type(4)))unsigned;
constexpr int BATCH=8,NHEAD=6,SEQ=4096,D=64,DM=3072;
constexpr int NW=8,QBLK=32,QB=QBLK*NW,KVBLK=64,NQB=SEQ/QB;
constexpr int ATTN_PITCH=DM, ATTN_UNIT_ROWS=QB;
__device__ __forceinline__ int crow(int r,int hi){return (r&3)+8*(r>>2)+4*hi;}
#define SBAR() __builtin_amdgcn_sched_barrier(0)
__device__ __forceinline__ void cmask(f32x16&p0,f32x16&p1,int jb,int qrel,int hi){
  const float NEG=-INFINITY; int kb=64*jb+4*hi;
  #pragma unroll
  for(int r=0;r<16;++r){int kv=kb+(r&3)+8*(r>>2); if(kv>qrel)p0[r]=NEG; if(kv+32>qrel)p1[r]=NEG;}
}

constexpr int NSLOT=3, SLOTB=8192;
constexpr int LDS_K=0, LDS_V=NSLOT*SLOTB, LDS_WS=2*NSLOT*SLOTB, LDS_OST=LDS_WS+NW*64*4, LDS_G=LDS_OST+NW*4096, LDS_BYTES=LDS_G+SEQ*4;
constexpr float C2=0.125f*1.4426950408889634f;
__device__ __forceinline__ void glds16(const void*gsrc,unsigned lds_dst){unsigned keep;
  asm volatile("s_mov_b32 %0, m0\n\ts_mov_b32 m0, %2\n\ts_nop 0\n\tglobal_load_lds_dwordx4 %1, off\n\ts_mov_b32 m0, %0":"=&s"(keep):"v"(gsrc),"s"(lds_dst):"memory");}
__device__ __forceinline__ float max3f(float a,float b,float c){float r;asm("v_max3_f32 %0, %1, %2, %3":"=v"(r):"v"(a),"v"(b),"v"(c));return r;}
__device__ __forceinline__ float max2f(float a,float b){float r;asm("v_max_f32_e32 %0, %1, %2":"=v"(r):"v"(a),"v"(b));return r;}
__device__ __forceinline__ float fadd_s(float a,float b){float r;asm("v_add_f32_e32 %0, %1, %2":"=v"(r):"v"(a),"v"(b));return r;}
__device__ __forceinline__ float fsub_s(float a,float b){float r;asm("v_sub_f32_e32 %0, %1, %2":"=v"(r):"v"(a),"v"(b));return r;}
typedef float f32x2_t __attribute__((ext_vector_type(2))); typedef __bf16 bf16x2_t __attribute__((ext_vector_type(2)));
__device__ __forceinline__ unsigned cvtpk_s(float lo,float hi){f32x2_t v={lo,hi};bf16x2_t b=__builtin_convertvector(v,bf16x2_t);return __builtin_bit_cast(unsigned,b);}
#define WAIT_BAR(N) asm volatile("s_waitcnt vmcnt(" #N ") lgkmcnt(0)\n\ts_barrier":::"memory")

__device__ __forceinline__ void qkt(f32x16&p0,f32x16&p1,const char*Kslot,const bf16x8*qr,const f32x16&negm,int r32,int hi){
  const char*kb=Kslot+hi*1024+r32*16;
  #pragma unroll
  for(int d0=0;d0<4;++d0){
    const bf16x8 b0=*reinterpret_cast<const bf16x8*>(kb+d0*2048);
    const bf16x8 b1=*reinterpret_cast<const bf16x8*>(kb+d0*2048+512);
    if(d0==0){p0=__builtin_amdgcn_mfma_f32_32x32x16_bf16(b0,qr[0],negm,0,0,0);p1=__builtin_amdgcn_mfma_f32_32x32x16_bf16(b1,qr[0],negm,0,0,0);}
    else{p0=__builtin_amdgcn_mfma_f32_32x32x16_bf16(b0,qr[d0],p0,0,0,0);p1=__builtin_amdgcn_mfma_f32_32x32x16_bf16(b1,qr[d0],p1,0,0,0);}}
}
typedef __attribute__((address_space(3))) const char* lds_cptr;
typedef short v4i16_t __attribute__((ext_vector_type(4)));
__device__ __forceinline__ void kload8(bf16x8*kf,lds_cptr kp){
  kf[0]=*(const __attribute__((address_space(3))) bf16x8*)(kp);      kf[1]=*(const __attribute__((address_space(3))) bf16x8*)(kp+512);
  kf[2]=*(const __attribute__((address_space(3))) bf16x8*)(kp+2048); kf[3]=*(const __attribute__((address_space(3))) bf16x8*)(kp+2560);
  kf[4]=*(const __attribute__((address_space(3))) bf16x8*)(kp+4096); kf[5]=*(const __attribute__((address_space(3))) bf16x8*)(kp+4608);
  kf[6]=*(const __attribute__((address_space(3))) bf16x8*)(kp+6144); kf[7]=*(const __attribute__((address_space(3))) bf16x8*)(kp+6656);
}
__device__ __forceinline__ void kload2(bf16x8*kf,lds_cptr kp,int j){ kf[2*j]=*(const __attribute__((address_space(3))) bf16x8*)(kp+j*2048); kf[2*j+1]=*(const __attribute__((address_space(3))) bf16x8*)(kp+j*2048+512); }
__device__ __forceinline__ s16x4 vtr(lds_cptr p){ return __builtin_bit_cast(s16x4,__builtin_amdgcn_ds_read_tr16_b64_v4i16((__attribute__((address_space(3))) v4i16_t*)p)); }
__device__ __forceinline__ float rowmax(const f32x16&p0,const f32x16&p1){
  float a=max3f(p0[0],p0[1],p1[0]),b=max3f(p0[2],p0[3],p1[1]);a=max3f(a,p1[2],p1[3]);
  #pragma unroll
  for(int r=4;r<16;r+=4){a=max3f(a,p0[r],p0[r+1]);b=max3f(b,p0[r+2],p0[r+3]);a=max3f(a,p1[r],p1[r+1]);b=max3f(b,p1[r+2],p1[r+3]);}
  const float m=max2f(a,b);
  auto rr=__builtin_amdgcn_permlane32_swap(__float_as_uint(m),__float_as_uint(m),false,false);
  return max2f(__uint_as_float(rr[0]),__uint_as_float(rr[1]));
}
__device__ __forceinline__ void pv(f32x16*o,int vb,bf16x8 pa0,bf16x8 pa1,bf16x8 pa2,bf16x8 pa3){
  #pragma unroll
  for(int d0=0;d0<2;++d0){s16x4 lo[4],hi[4];
    #pragma unroll
    for(int ks=0;ks<4;++ks){
      asm volatile("ds_read_b64_tr_b16 %0,%1 offset:%c2":"=&v"(lo[ks]):"v"(vb),"i"(d0*4096+ks*1024):"memory");
      asm volatile("ds_read_b64_tr_b16 %0,%1 offset:%c2":"=&v"(hi[ks]):"v"(vb),"i"(d0*4096+ks*1024+512):"memory");}
    asm volatile("s_waitcnt lgkmcnt(0)":::"memory");SBAR();
    #define PK(k) (bf16x8){lo[k][0],lo[k][1],lo[k][2],lo[k][3],hi[k][0],hi[k][1],hi[k][2],hi[k][3]}
    o[d0]=__builtin_amdgcn_mfma_f32_32x32x16_bf16(pa0,PK(0),o[d0],0,0,0);
    o[d0]=__builtin_amdgcn_mfma_f32_32x32x16_bf16(pa1,PK(1),o[d0],0,0,0);
    o[d0]=__builtin_amdgcn_mfma_f32_32x32x16_bf16(pa2,PK(2),o[d0],0,0,0);
    o[d0]=__builtin_amdgcn_mfma_f32_32x32x16_bf16(pa3,PK(3),o[d0],0,0,0);
    #undef PK
  }
}

#ifndef ATTN_STORE16
#define ATTN_STORE16(p,v) (*(u32x4*)(p)=(v))
#endif
template<int THRL> __device__ __forceinline__ void attn_unit(int b,int h,int qb,const bf16*Q,const bf16*__restrict__ K,const bf16*__restrict__ V,bf16*O,const float*Gbh,char*shm,const int wave0,const int ts,const bool do_store=true){
  int wv0_=wave0; asm volatile("":"+s"(wv0_)); int z0_=0; asm volatile("":"+v"(z0_)); const int tid=wv0_*64+(int)__builtin_amdgcn_mbcnt_hi(~0u,__builtin_amdgcn_mbcnt_lo(~0u,(unsigned)z0_)),lane=tid&63,r32=lane&31,hi=lane>>5; const int wid=__builtin_amdgcn_readfirstlane(tid>>6);
  const long rowbase=(long)b*SEQ; const int q0=qb*QB;
  const bf16*Qw=Q+(rowbase+q0+wid*QBLK)*DM+h*D;
  const bf16*Kh=K+(rowbase+(long)ts*KVBLK)*DM+h*D,*Vh=V+(rowbase+(long)ts*KVBLK)*DM+h*D;
  const int q0r=q0-ts*KVBLK; Gbh+=ts*KVBLK;
  const unsigned lds0=(unsigned)(uintptr_t)shm;
  float*wsf=(float*)(shm+LDS_WS)+wid*64;
  const bf16*ksrc=Kh+(long)lane*DM+wid*8;
  const bf16*vsrc=Vh+(long)(16*(wid&3)+(lane>>2))*DM+(wid>>2)*32+(lane&3)*8;
  const unsigned kdst=lds0+LDS_K+wid*1024, vdst=lds0+LDS_V+wid*1024;
  #define DMA_K(t,slot) glds16(ksrc+(long)(t)*KVBLK*DM,(unsigned)__builtin_amdgcn_readfirstlane(kdst+(slot)))
  #define DMA_V(t,slot) glds16(vsrc+(long)(t)*KVBLK*DM,(unsigned)__builtin_amdgcn_readfirstlane(vdst+(slot)))
  const int vb0=(int)(lds0+LDS_V)+((lane>>4)&1)*32+(lane&3)*8+(4*hi+((lane&15)>>2))*64;
  const char*Kbase=shm+LDS_K; bf16x8 kf[8];
  const lds_cptr shm3=(lds_cptr)shm; const lds_cptr kp0=shm3+LDS_K+hi*1024+r32*16; const lds_cptr vp0=shm3+LDS_V+((lane>>4)&1)*32+(lane&3)*8+(4*hi+((lane&15)>>2))*64;
  const int NT=(q0r+QB)/KVBLK;
  typedef float f32x4v __attribute__((ext_vector_type(4)));
  { float*gl=(float*)(shm+LDS_G); const int ng4=(q0r+QB)>>2; for(int i=tid;i<ng4;i+=NW*64){ *(f32x4v*)(gl+4*i)=*(const f32x4v*)(Gbh+4*i); } }
  DMA_K(0,0);DMA_V(0,0);DMA_K(1,SLOTB);
  bf16x8 qr[4];
  #pragma unroll
  for(int d0=0;d0<4;++d0)qr[d0]=*reinterpret_cast<const bf16x8*>(&Qw[(long)r32*DM+d0*16+hi*8]);
  float mhat=0.f,l_reg=0.f;f32x16 o[2];o[0]=f32x16{};o[1]=f32x16{};f32x16 negm=f32x16{};asm volatile("":"+v"(negm));
  const int qrel=wid*QBLK+r32;
  #define CMASK(P0,P1,t) do{int jb_=(t)-(NT-4); if(jb_>=0)cmask(P0,P1,jb_,qrel,hi);}while(0)
  #define KBIAS(P0,P1,t) do{ const float*gp_=(const float*)(shm+LDS_G)+64*(t)+4*hi; \
    _Pragma("unroll") for(int j_=0;j_<4;++j_){ { const f32x4v a_=*(const f32x4v*)(gp_+8*j_); P0[4*j_]+=a_.x; P0[4*j_+1]+=a_.y; P0[4*j_+2]+=a_.z; P0[4*j_+3]+=a_.w; } SBAR(); \
      { const f32x4v c_=*(const f32x4v*)(gp_+32+8*j_); P1[4*j_]+=c_.x; P1[4*j_+1]+=c_.y; P1[4*j_+2]+=c_.z; P1[4*j_+3]+=c_.w; } SBAR(); } }while(0)
  bool resc=false;
  #define START(P0,P1) do{ const float rm=rowmax(P0,P1); resc=false; \
    { const float dl=__builtin_fmaxf(rm,0.f); mhat=fadd_s(mhat,dl); \
      _Pragma("unroll") for(int r=0;r<16;++r){P0[r]=fsub_s(P0[r],dl);P1[r]=fsub_s(P1[r],dl);} \
      _Pragma("unroll") for(int r=0;r<16;++r)negm[r]=-mhat; asm volatile("":"+v"(negm)); } \
    _Pragma("unroll") for(int r=0;r<16;++r)P0[r]=__builtin_amdgcn_exp2f(P0[r]); }while(0)
  #define RESC() do{ if(resc){ asm volatile("s_waitcnt lgkmcnt(0)":::"memory"); \
      _Pragma("unroll") for(int d_=0;d_<2;++d_) _Pragma("unroll") for(int r=0;r<16;++r)o[d_][r]*=wsf[crow(r,hi)]; } }while(0)
  f32x16 pA0,pA1,pB0,pB1;
  int sl_prev=0,sl_cur=0,sl_next=SLOTB;
  #define ROT() do{sl_prev=sl_cur;sl_cur=sl_next;sl_next=(sl_next==(NSLOT-1)*SLOTB)?0:sl_next+SLOTB;}while(0)
  DMA_K(2,2*SLOTB);
  WAIT_BAR(3);
  { const float*gl=(const float*)(shm+LDS_G); mhat=gl[q0r+qrel]; _Pragma("unroll") for(int r=0;r<16;++r)negm[r]=-mhat; asm volatile("":"+v"(negm)); }
  qkt(pA0,pA1,Kbase,qr,negm,r32,hi);asm volatile("s_nop 15\n\ts_nop 7":"+v"(pA0),"+v"(pA1));KBIAS(pA0,pA1,0);CMASK(pA0,pA1,0);
  START(pA0,pA1);
  _Pragma("unroll") for(int r=0;r<16;++r)pA1[r]=__builtin_amdgcn_exp2f(pA1[r]);
  WAIT_BAR(0);
  DMA_K(3,0);DMA_V(1,SLOTB);
  ROT();
  kload8(kf,kp0+sl_cur);
  WAIT_BAR(2);
  s16x4 vlo[8],vhi[8]; u32x4 pw0,pw1,pw2,pw3;
  #define PKW(P,B) cvtpk_s(P[B],P[B+1])
  #define PAF(k) __builtin_bit_cast(bf16x8,pw##k)
  #define VFR(i) (bf16x8){vlo[i][0],vlo[i][1],vlo[i][2],vlo[i][3],vhi[i][0],vhi[i][1],vhi[i][2],vhi[i][3]}
  #define PIN(x) asm volatile("":"+v"(x))
  #define MX3(a,b,c) __builtin_fmaxf(__builtin_fmaxf((a),(b)),(c))
  #define GAPA(MF,A0,A1,A2,A3,W0,W1,PW) do{ MF; sacc+=A0; sacc+=A1; sacc+=A2; sacc+=A3; PIN(sacc); W0; W1; PIN(PW); SBAR(); }while(0)
  #define EX(v) __builtin_amdgcn_exp2f(v)
  #define GAPB(MF,X,B) do{ MF; X[B]=EX(X[B]); X[B+1]=EX(X[B+1]); X[B+2]=EX(X[B+2]); X[B+3]=EX(X[B+3]); PIN(X); SBAR(); }while(0)
  #define VRD(i) do{ vlo[i]=vtr(vp_+(((i)>>2)*4096+((i)&3)*1024)); vhi[i]=vtr(vp_+(((i)>>2)*4096+((i)&3)*1024+512)); }while(0)
  #define KRD(G,j) do{ if(G){ kload2(kf,kp0+sl_next,j); SBAR(); } }while(0)
  #define STEP(C0,C1,P0,P1,t,GK,GV,GL) do{ SBAR(); \
    const lds_cptr vp_=vp0+sl_prev; \
    VRD(0); SBAR(); float sacc=(P0[0]+P0[1]); \
    GAPA(C0=__builtin_amdgcn_mfma_f32_32x32x16_bf16(kf[0],qr[0],negm,0,0,0), P0[2],P0[3],P0[4],P0[5],     pw0[0]=PKW(P0,0), pw0[1]=PKW(P0,2), pw0); \
    VRD(4); SBAR(); GAPA(C1=__builtin_amdgcn_mfma_f32_32x32x16_bf16(kf[1],qr[0],negm,0,0,0), P0[6],P0[7],P0[8],P0[9],     pw0[2]=PKW(P0,4), pw0[3]=PKW(P0,6), pw0); \
    VRD(1); SBAR(); GAPA(C0=__builtin_amdgcn_mfma_f32_32x32x16_bf16(kf[2],qr[1],C0,0,0,0),   P0[10],P0[11],P0[12],P0[13], pw1[0]=PKW(P0,8), pw1[1]=PKW(P0,10), pw1); \
    VRD(5); SBAR(); GAPA(C1=__builtin_amdgcn_mfma_f32_32x32x16_bf16(kf[3],qr[1],C1,0,0,0),   P0[14],P0[15],P1[0],P1[1],   pw1[2]=PKW(P0,12),pw1[3]=PKW(P0,14), pw1); \
    VRD(2); SBAR(); GAPA(C0=__builtin_amdgcn_mfma_f32_32x32x16_bf16(kf[4],qr[2],C0,0,0,0),   P1[2],P1[3],P1[4],P1[5],     pw2[0]=PKW(P1,0), pw2[1]=PKW(P1,2), pw2); \
    VRD(6); SBAR(); GAPA(C1=__builtin_amdgcn_mfma_f32_32x32x16_bf16(kf[5],qr[2],C1,0,0,0),   P1[6],P1[7],P1[8],P1[9],     pw2[2]=PKW(P1,4), pw2[3]=PKW(P1,6), pw2); \
    VRD(3); SBAR(); GAPA(C0=__builtin_amdgcn_mfma_f32_32x32x16_bf16(kf[6],qr[3],C0,0,0,0),   P1[10],P1[11],P1[12],P1[13], pw3[0]=PKW(P1,8), pw3[1]=PKW(P1,10), pw3); \
    VRD(7); SBAR(); GAPA(C1=__builtin_amdgcn_mfma_f32_32x32x16_bf16(kf[7],qr[3],C1,0,0,0),   P1[14],P1[15],0.f,0.f,       pw3[2]=PKW(P1,12),pw3[3]=PKW(P1,14), pw3); \
    l_reg+=sacc; \
    if(GK){DMA_K((t)+3,sl_cur);} if(GV){DMA_V((t)+1,sl_next);} \
    KBIAS(C0,C1,t); CMASK(C0,C1,t); \
    { float a=MX3(C0[0],C0[1],C1[0]),b=MX3(C0[2],C0[3],C1[1]); a=MX3(a,C1[2],C1[3]); \
      _Pragma("unroll") for(int r=4;r<16;r+=4){a=MX3(a,C0[r],C0[r+1]);b=MX3(b,C0[r+2],C0[r+3]);a=MX3(a,C1[r],C1[r+1]);b=MX3(b,C1[r+2],C1[r+3]);} \
      float rm=__builtin_fmaxf(a,b); { auto rr=__builtin_amdgcn_permlane32_swap(__float_as_uint(rm),__float_as_uint(rm),false,false); rm=__builtin_fmaxf(__uint_as_float(rr[0]),__uint_as_float(rr[1])); } \
      resc=false; \
      if(__builtin_expect(__any(rm>(float)THRL),0)){ const float dl=__builtin_fmaxf(rm,0.f); mhat+=dl; \
        _Pragma("unroll") for(int r=0;r<16;++r){C0[r]-=dl;C1[r]-=dl;} \
        _Pragma("unroll") for(int r=0;r<16;++r)negm[r]=-mhat; asm volatile("":"+v"(negm)); \
        const float f=__builtin_amdgcn_exp2f(-dl); l_reg*=f; if(hi==0)wsf[r32]=f; resc=true; } } \
    SBAR(); \
    GAPB(o[0]=__builtin_amdgcn_mfma_f32_32x32x16_bf16(PAF(0),VFR(0),o[0],0,0,0), C0,0); \
    GAPB(o[1]=__builtin_amdgcn_mfma_f32_32x32x16_bf16(PAF(0),VFR(4),o[1],0,0,0), C0,4); \
    KRD(GL,0); GAPB(o[0]=__builtin_amdgcn_mfma_f32_32x32x16_bf16(PAF(1),VFR(1),o[0],0,0,0), C0,8); \
    KRD(GL,1); GAPB(o[1]=__builtin_amdgcn_mfma_f32_32x32x16_bf16(PAF(1),VFR(5),o[1],0,0,0), C0,12); \
    KRD(GL,2); GAPB(o[0]=__builtin_amdgcn_mfma_f32_32x32x16_bf16(PAF(2),VFR(2),o[0],0,0,0), C1,0); \
    KRD(GL,3); GAPB(o[1]=__builtin_amdgcn_mfma_f32_32x32x16_bf16(PAF(2),VFR(6),o[1],0,0,0), C1,4); \
    GAPB(o[0]=__builtin_amdgcn_mfma_f32_32x32x16_bf16(PAF(3),VFR(3),o[0],0,0,0), C1,8); \
    GAPB(o[1]=__builtin_amdgcn_mfma_f32_32x32x16_bf16(PAF(3),VFR(7),o[1],0,0,0), C1,12); \
    }while(0)
  int t=1;
  #undef CMASK
  #define CMASK(P0,P1,t) do{}while(0)
  for(;t+5<NT;t+=2){
    STEP(pB0,pB1,pA0,pA1,t,true,true,true);     WAIT_BAR(2); RESC(); ROT();
    STEP(pA0,pA1,pB0,pB1,t+1,true,true,true);   WAIT_BAR(2); RESC(); ROT();
  }
  #undef CMASK
  #define CMASK(P0,P1,t) do{int jb_=(t)-(NT-4); if(jb_>=0)cmask(P0,P1,jb_,qrel,hi);}while(0)
  #define ENDW(tt) do{ if((tt)+3<NT){WAIT_BAR(2);} else if((tt)+2<NT){WAIT_BAR(1);} else {WAIT_BAR(0);} }while(0)
  for(;t+1<NT;t+=2){
    STEP(pB0,pB1,pA0,pA1,t,(t+3<NT),(t+1<NT),(t+1<NT));       ENDW(t);   RESC(); ROT();
    STEP(pA0,pA1,pB0,pB1,t+1,(t+4<NT),(t+2<NT),(t+2<NT));     ENDW(t+1); RESC(); ROT();
  }
  STEP(pB0,pB1,pA0,pA1,NT-1,false,false,false); RESC();
  { float sacc=pB0[0]+pB0[1]; _Pragma("unroll") for(int r=2;r<16;++r)sacc+=pB0[r]; _Pragma("unroll") for(int r=0;r<16;++r)sacc+=pB1[r]; l_reg+=sacc;
    pw0=(u32x4){PKW(pB0,0),PKW(pB0,2),PKW(pB0,4),PKW(pB0,6)};pw1=(u32x4){PKW(pB0,8),PKW(pB0,10),PKW(pB0,12),PKW(pB0,14)};pw2=(u32x4){PKW(pB1,0),PKW(pB1,2),PKW(pB1,4),PKW(pB1,6)};pw3=(u32x4){PKW(pB1,8),PKW(pB1,10),PKW(pB1,12),PKW(pB1,14)};
    SBAR(); pv(o,vb0+sl_cur,PAF(0),PAF(1),PAF(2),PAF(3)); }
  #undef PKW
  #undef PAF
  #undef VFR
  #undef PIN
  #undef MX3
  #undef GAPA
  #undef GAPB
  #undef EX
  #undef VRD
  #undef KRD
  #undef STEP
  #undef ENDW
  {auto rr=__builtin_amdgcn_permlane32_swap(__float_as_uint(l_reg),__float_as_uint(l_reg),false,false);l_reg=__uint_as_float(rr[0])+__uint_as_float(rr[1]);}
  if(hi==0)wsf[32+r32]=l_reg;asm volatile("s_waitcnt lgkmcnt(0)":::"memory");
  float rli[16];
  #pragma unroll
  for(int r=0;r<16;++r)rli[r]=__builtin_amdgcn_rcpf(wsf[32+crow(r,hi)]);
  bf16*Ow=O+(rowbase+q0+wid*QBLK)*DM+h*D;
  { bf16*stg=(bf16*)(shm+LDS_OST)+wid*2048;
    #pragma unroll
    for(int r=0;r<16;++r){const int orow=crow(r,hi);
      #pragma unroll
      for(int d0=0;d0<2;++d0)stg[orow*64+d0*32+r32]=__float2bfloat16(o[d0][r]*rli[r]);}
    asm volatile("s_waitcnt lgkmcnt(0)":::"memory");
    #pragma unroll
    for(int i=0;i<4;++i){const int row=i*8+(lane>>3),ch=lane&7; const u32x4 v=*(const u32x4*)(stg+row*64+ch*8); if(do_store)ATTN_STORE16(Ow+(long)row*DM+ch*8,v);} }
  asm volatile("s_waitcnt lgkmcnt(0)\n\ts_barrier":::"memory");
  #undef DMA_K
  #undef DMA_V
  #undef CMASK
  #undef KBIAS
  #undef START
  #undef RESC
  #undef ROT
}
constexpr int ATTN_LDS_BYTES=LDS_BYTES;
struct AttnTensors { const bf16* Q; const bf16* K; const bf16* V; bf16* O; const float* G; };
struct AttnUnit { int bh; int qb; };
struct StaticOrder {
  int vcu;
  __device__ __forceinline__ explicit StaticOrder(int grid,int block):vcu((block%8)*(grid/8)+block/8){}
  __device__ __forceinline__ bool next(int i,AttnUnit&u)const{ if(i>=4)return false; const int s=vcu&7; u.bh=vcu>>3; u.qb=(i==0)?s:(i==1)?15-s:(i==2)?16+s:31-s; return true; }
  __device__ __forceinline__ void a_ready(const AttnUnit&)const{}
  __device__ __forceinline__ void done(const AttnUnit&)const{}
};
template<class Sched,int THRL=8> __device__ __forceinline__ void attn_phase(char*lds,const AttnTensors&T,const Sched&S){
  AttnUnit u;
  for(int i=0;S.next(i,u);++i){ S.a_ready(u); attn_unit<THRL>(u.bh/NHEAD,u.bh%NHEAD,u.qb,T.Q,T.K,T.V,T.O,T.G+(long)u.bh*SEQ,lds); S.done(u); }
}
#undef SBAR
#undef WAIT_BAR
}
namespace fx {
struct EpiZ {
    static constexpr bool PERM = true, AFTER_DRAIN = false;
    bf16* Z; bf16* UP; float* NLF; const float* fbias;
    __device__ __forceinline__ void operator()(const pg8::f32x4 (&acc)[2][2][4][2], const pg8::Unit& u, int wr, int wc, int fr_, int fq_) const {
        int z_ = 0; asm volatile("" : "+v"(z_)); const int ln_ = __builtin_amdgcn_mbcnt_hi(~0u, __builtin_amdgcn_mbcnt_lo(~0u, z_)); const int fr = ln_ & 15, fq = ln_ >> 4; (void)fr_; (void)fq_;
        const int row0 = u.pm * 256 + wr * 64 + fr, col0 = wc * 32 + 8 * fq;
#pragma unroll
        for (int bj = 0; bj < 2; ++bj) {
            const int hb = u.pn * 2 + bj;
            const float sc = (hb < 3) ? C2 : 1.f;
            bf16* base = Z + ((size_t)row0 * NZ + hb * 128 + col0); size_t stride = (size_t)16 * NZ;
            if (hb == 9 || hb == 10) { const int sidx = (hb - 9) * 128 + col0, g = sidx >> 4, ch0 = sidx & 15;
                base = UP + ((size_t)(g * 2048 + (row0 >> 4)) * 384 + (row0 & 15) * 16 + ch0); stride = 384; }
#pragma unroll
            for (int ai = 0; ai < 2; ++ai)
#pragma unroll
                for (int m = 0; m < 4; ++m) { const pg8::f32x4 v0 = acc[ai][bj][m][0] * sc, v1 = acc[ai][bj][m][1] * sc;
                    v4u w; w.x = pk2(v0[0], v0[1]); w.y = pk2(v0[2], v0[3]); w.z = pk2(v1[0], v1[1]); w.w = pk2(v1[2], v1[3]);
                    *(GAS v4u*)(base + (size_t)(ai * 8 + m) * stride) = w; }
        }
        if (u.pn == 11 && col0 == 0) {
#pragma unroll
            for (int ai = 0; ai < 2; ++ai)
#pragma unroll
                for (int m = 0; m < 4; ++m) { const int r = row0 + ai * 128 + m * 16, b = r >> 12, t = r & 4095; float* o = NLF + (size_t)(b * 6) * 4096 + t;
                    o[0 * 4096] = nlf1(acc[ai][1][m][0][0] + fbias[0]); o[1 * 4096] = nlf1(acc[ai][1][m][0][1] + fbias[1]); o[2 * 4096] = nlf1(acc[ai][1][m][0][2] + fbias[2]);
                    o[3 * 4096] = nlf1(acc[ai][1][m][0][3] + fbias[3]); o[4 * 4096] = nlf1(acc[ai][1][m][1][0] + fbias[4]); o[5 * 4096] = nlf1(acc[ai][1][m][1][1] + fbias[5]); }
        }
    }
    static __device__ __forceinline__ float nlf1(float x) { return -LOG2E * (fminf(x, 0.f) - __logf(1.f + __expf(-fabsf(x)))); }
};
template <bool XF32> struct EpiRes {
    static constexpr bool PERM = false, AFTER_DRAIN = false;
    const void* X; bf16* out; const float* gate;
    __device__ __forceinline__ void operator()(const pg8::f32x4 (&acc)[2][2][4][2], const pg8::Unit& u, int wr, int wc, int fr_, int fq_) const {
        int z_ = 0; asm volatile("" : "+v"(z_)); const int ln_ = __builtin_amdgcn_mbcnt_hi(~0u, __builtin_amdgcn_mbcnt_lo(~0u, z_)); const int fr = ln_ & 15, fq = ln_ >> 4; (void)fr_; (void)fq_;
        const int row0 = u.pm * 256 + wr * 64 + fr, col0 = u.pn * 256 + wc * 32 + 4 * fq;
        const float* gb = gate + (size_t)(row0 >> 12) * 6144;
#pragma unroll
        for (int bj = 0; bj < 2; ++bj)
#pragma unroll
            for (int n = 0; n < 2; ++n) { const int c = col0 + bj * 128 + n * 16; const pg8::f32x4 gv = *(const GAS pg8::f32x4*)(gb + c);
#pragma unroll
                for (int ai = 0; ai < 2; ++ai)
#pragma unroll
                    for (int m = 0; m < 4; ++m) { const size_t off = (size_t)(row0 + ai * 128 + m * 16) * 1024 + c; pg8::f32x4 xv;
                        if (XF32) xv = *(const GAS pg8::f32x4*)((const float*)X + off); else { const v2u w = *(const GAS v2u*)((const bf16*)X + off); xv = (pg8::f32x4){bflo(w.x), bfhi(w.x), bflo(w.y), bfhi(w.y)}; }
                        const pg8::f32x4 o = xv + gv * acc[ai][bj][m][n]; v2u ow; ow.x = pk2(o[0], o[1]); ow.y = pk2(o[2], o[3]); *(GAS v2u*)(out + off) = ow; } }
    }
};
}
namespace fx {
constexpr int MOE_ROWS = 40960, MOE_TILES = MOE_ROWS / 256, NCLS = 24;
constexpr size_t WS_TOKINFO = WS_HLOC + 8 * MiB;
constexpr size_t WS_CNT = WS_TOKINFO + (size_t)M * 16;
constexpr size_t WS_ROWTOK = WS_CNT + 256 * 32 * 4;
constexpr size_t WS_ROWW = WS_ROWTOK + (size_t)MOE_ROWS * 4;
constexpr size_t WS_TILECLS = WS_ROWW + (size_t)MOE_ROWS * 8;
constexpr size_t WS_H2S = WS_Z;
constexpr size_t WS_HID = WS_Z + (size_t)MOE_ROWS * 1024 * 2;
static_assert(WS_TILECLS + (MOE_TILES + 1) * 4 <= WS_END, "moe scratch fits");
static_assert(WS_HID + (size_t)MOE_ROWS * 512 * 2 <= WS_UP, "H2S + HID fit in the Z region");

__device__ __forceinline__ void cls_experts(int cls, int& e_lo, int& e_hi) {
    const int g = cls / 6, pr = cls % 6; const int lo = (pr < 3) ? 0 : (pr < 5 ? 1 : 2); const int hi = (pr < 3) ? pr + 1 : (pr < 5 ? pr - 1 : 3);
    e_lo = g * 4 + lo; e_hi = g * 4 + hi;
}
__device__ __forceinline__ void moe_route(const Params& p, int oz, int l, LAS unsigned char* lds, int tid, int lane, int wave, int bx, int G) {
    unsigned char* ws = p.ws + oz; constexpr int WP = 1032;
    LAS unsigned short* Whi = (LAS unsigned short*)lds; LAS unsigned short* Wlo = (LAS unsigned short*)(lds + 33024); LAS float* rstds = (LAS float*)(lds + 66048); LAS float* SR = (LAS float*)(lds + 66560); LAS int* hist = (LAS int*)(lds + 66624);
    const int tpw = M / G, t0 = bx * tpw, b = t0 >> 12; const float* mod = (const float*)(ws + WS_MOD) + l * 8 * 6144 + b * 6144; const float* nw = p.in[I_NFW + oz] + l * 1024; const float* rw = p.in[I_RW + oz]; const float* rb = p.in[I_RB + oz];
    for (int k = tid; k < 1024; k += NTHR) { const float a = nw[k] * (1.f + mod[4096 + k]);
#pragma unroll
        for (int q = 0; q < 4; ++q) { const f32x4 w4 = ((const GAS f32x4*)rw)[k * 4 + q];
#pragma unroll
            for (int e = 0; e < 4; ++e) { const float v = a * w4[e]; const unsigned hi = f2bf(v); const float r = v - __builtin_bit_cast(float, hi << 16); Whi[(4 * q + e) * WP + k] = (unsigned short)hi; Wlo[(4 * q + e) * WP + k] = (unsigned short)f2bf(r); } } }
    if (tid < 32) hist[tid] = 0;
    { float s0 = 0.f, s1 = 0.f;
        for (int k = lane; k < 1024; k += 64) { const float bv = mod[3072 + k]; s0 += bv * rw[k * 16 + 2 * wave]; s1 += bv * rw[k * 16 + 2 * wave + 1]; }
        s0 = wave_sum(s0, lane); s1 = wave_sum(s1, lane); if (lane == 0) { SR[2 * wave] = s0 + rb[2 * wave]; SR[2 * wave + 1] = s1 + rb[2 * wave + 1]; } }
    const bf16* X1 = (const bf16*)(ws + WS_XB); bf16* H = (bf16*)(ws + WS_H);
    f32x4 A[4], B[4]; adaln_factors(nw, mod + 3072, mod + 4096, lane, A, B);
    f32x4 v[4] = {}; if (wave < tpw) row_load_bf(X1, t0 + wave, lane, v);
    for (int r = wave; r < tpw; r += NWAVES) {
        const int row = t0 + r;
        f32x4 nxt[4] = {}; if (r + NWAVES < tpw) row_load_bf(X1, row + NWAVES, lane, nxt);
        float s = 0.f;
#pragma unroll
        for (int j = 0; j < 4; ++j) s += (v[j].x * v[j].x + v[j].y * v[j].y) + (v[j].z * v[j].z + v[j].w * v[j].w);
        const float rstd = __builtin_amdgcn_rsqf(wave_sum(s, lane) * (1.f / 1024.f) + 1e-6f); if (lane == 0) rstds[r] = rstd;
        GAS unsigned long long* o8 = (GAS unsigned long long*)(H + (size_t)row * 1024) + lane;
#pragma unroll
        for (int j = 0; j < 4; ++j) { const f32x4 h = (v[j] * rstd) * A[j] + B[j]; o8[64 * j] = (unsigned long long)pk2(h.x, h.y) | ((unsigned long long)pk2(h.z, h.w) << 32); }
#pragma unroll
        for (int j = 0; j < 4; ++j) v[j] = nxt[j];
    }
    __syncthreads();
    typedef short rbf16x8 __attribute__((ext_vector_type(8)));
    const int n = lane & 15, q = lane >> 4, tok = t0 + 16 * wave + n;
    f32x4 acc = {0.f, 0.f, 0.f, 0.f};
    const GAS rbf16x8* xrow = (const GAS rbf16x8*)(X1 + (size_t)tok * 1024 + 8 * q);
    const LAS unsigned short* ahi = Whi + n * WP + 8 * q; const LAS unsigned short* alo = Wlo + n * WP + 8 * q;
#pragma unroll 1
    for (int k0 = 0; k0 < 32; k0 += 8) { rbf16x8 xb[8];
#pragma unroll
        for (int u = 0; u < 8; ++u) xb[u] = xrow[(k0 + u) * 4];
#pragma unroll
        for (int u = 0; u < 8; ++u) { const rbf16x8 a1 = *(const LAS rbf16x8*)(ahi + (k0 + u) * 32), a2 = *(const LAS rbf16x8*)(alo + (k0 + u) * 32);
            acc = __builtin_amdgcn_mfma_f32_16x16x32_bf16(a1, xb[u], acc, 0, 0, 0); acc = __builtin_amdgcn_mfma_f32_16x16x32_bf16(a2, xb[u], acc, 0, 0, 0); } }
    const float rs = rstds[16 * wave + n]; float lg[4];
#pragma unroll
    for (int e = 0; e < 4; ++e) lg[e] = acc[e] * rs + SR[4 * q + e];
    float mx = fmaxf(fmaxf(lg[0], lg[1]), fmaxf(lg[2], lg[3])); mx = fmaxf(mx, lane_get(mx, lane ^ 16)); mx = fmaxf(mx, lane_get(mx, lane ^ 32));
    float sum = 0.f;
#pragma unroll
    for (int e = 0; e < 4; ++e) { lg[e] = __expf(lg[e] - mx); sum += lg[e]; }
    sum += lane_get(sum, lane ^ 16); sum += lane_get(sum, lane ^ 32); const float inv = 1.f / sum;
#pragma unroll
    for (int e = 0; e < 4; ++e) lg[e] *= inv;
    int i1 = 0; float v1 = lg[0];
#pragma unroll
    for (int i = 1; i < 4; ++i) if (lg[i] > v1) { v1 = lg[i]; i1 = i; }
    int i2 = -1; float v2 = -1.f;
#pragma unroll
    for (int i = 0; i < 4; ++i) if (i != i1 && lg[i] > v2) { v2 = lg[i]; i2 = i; }
    const float sc = v1 + v2;
    float bs = sc; int bq = q;
    { const float os = lane_get(bs, lane ^ 16); const int oq = __builtin_amdgcn_ds_bpermute((lane ^ 16) << 2, bq); if (os > bs || (os == bs && oq < bq)) { bs = os; bq = oq; } }
    { const float os = lane_get(bs, lane ^ 32); const int oq = __builtin_amdgcn_ds_bpermute((lane ^ 32) << 2, bq); if (os > bs || (os == bs && oq < bq)) { bs = os; bq = oq; } }
    if (bq == q) {
        const int lo = i1 < i2 ? i1 : i2, hi = i1 < i2 ? i2 : i1; const float w1 = v1 / (v1 + v2), w2 = v2 / (v1 + v2);
        const int cls = q * 6 + (lo * (7 - lo)) / 2 + (hi - lo - 1);
        const int rank = __hip_atomic_fetch_add(hist + cls, 1, __ATOMIC_RELAXED, __HIP_MEMORY_SCOPE_WORKGROUP);
        GAS f32x4* ti = (GAS f32x4*)(ws + WS_TOKINFO) + tok;
        *ti = (f32x4){__builtin_bit_cast(float, cls | (rank << 8)), i1 < i2 ? w1 : w2, i1 < i2 ? w2 : w1, 0.f};
    }
    __syncthreads();
    if (tid < 32) ((int*)(ws + WS_CNT))[bx * 32 + tid] = (tid < NCLS) ? hist[tid] : 0;
}
__device__ __forceinline__ void moe_gather(const Params& p, int oz, LAS unsigned char* lds, int tid, int lane, int wave, int bx, int G) {
    unsigned char* ws = p.ws + oz; LAS int* cl = (LAS int*)lds; LAS int* base = (LAS int*)(lds + 32768); LAS int* off = base + 32; LAS int* tot = off + 32;
    const int* cnt = (const int*)(ws + WS_CNT);
    for (int i = tid; i < G * 32; i += NTHR) cl[i] = cnt[i];
    __syncthreads();
    { LAS int* ps = tot + 32; const int c = tid & 31, part = tid >> 5; int s = 0, mine = 0; for (int w = part * (G / 16); w < (part + 1) * (G / 16); ++w) { if (w < bx) mine += cl[w * 32 + c]; s += cl[w * 32 + c]; } ps[part * 32 + c] = s; ps[512 + part * 32 + c] = mine; }
    __syncthreads();
    if (tid < NCLS) { LAS int* ps = tot + 32; int s = 0, mine = 0; for (int q = 0; q < 16; ++q) { s += ps[q * 32 + tid]; mine += ps[512 + q * 32 + tid]; } tot[tid] = s; off[tid] = mine; }
    __syncthreads();
    if (tid == 0) { int b = 0; for (int c = 0; c < NCLS; ++c) { base[c] = b; b += (tot[c] + 255) & ~255; } base[NCLS] = b; }
    __syncthreads();
    int* rowtok = (int*)(ws + WS_ROWTOK); float* roww = (float*)(ws + WS_ROWW);
    if (bx < NCLS) { const int c = bx, b0 = base[c], n = tot[c], b1 = base[c + 1];
        for (int r = b0 + n + tid; r < b1; r += NTHR) { rowtok[r] = -1; roww[2 * r] = (float)oz; roww[2 * r + 1] = (float)oz; }
        int* tc = (int*)(ws + WS_TILECLS); for (int t = b0 / 256 + tid; t < b1 / 256; t += NTHR) tc[t] = c;
        if (c == NCLS - 1 && tid == 0) tc[MOE_TILES] = b1 / 256; }
    const int tpw = M / G, t0 = bx * tpw; const bf16* H = (const bf16*)(ws + WS_H); bf16* H2S = (bf16*)(ws + WS_H2S);
    for (int r = wave; r < tpw; r += NWAVES) { const int row = t0 + r; const f32x4 ti = ((const GAS f32x4*)(ws + WS_TOKINFO))[row]; const int cr = __builtin_bit_cast(int, ti.x), cls = cr & 255, rank = cr >> 8;
        const int pos = base[cls] + off[cls] + rank;
        const GAS v4u* src = (const GAS v4u*)(H + (size_t)row * 1024) + lane; GAS v4u* dst = (GAS v4u*)(H2S + (size_t)pos * 1024) + lane;
        const v4u a = src[0], b = src[64]; dst[0] = a; dst[64] = b;
        if (lane == 0) { rowtok[pos] = row; roww[2 * pos] = ti.y; roww[2 * pos + 1] = ti.z; } }
}
struct ListOrder {
    const LAS int* list; int n;
    __device__ __forceinline__ bool next(int i, pg8::Unit& u) const { if (i >= n) return false; typedef int v4i_ __attribute__((ext_vector_type(4))); const v4i_ q = *(const LAS v4i_*)(list + 4 * i);
        u.pm = __builtin_amdgcn_readfirstlane(q.x); u.pn = __builtin_amdgcn_readfirstlane(q.y); u.k0 = __builtin_amdgcn_readfirstlane(q.z); u.k1 = __builtin_amdgcn_readfirstlane(q.w); return true; }
    __device__ __forceinline__ void a_ready(const pg8::Unit&) const {}
    __device__ __forceinline__ void done(const pg8::Unit&) const {}
};
template <bool DOWN>
__device__ __forceinline__ int moe_build_list(unsigned char* ws, LAS int* list, int tid, int bx, int G) {
    const int* tc = (const int*)(ws + WS_TILECLS);
    const int ntiles = __builtin_amdgcn_readfirstlane(((const GAS int*)tc)[MOE_TILES]); const int nunits = ntiles * 4; int n = 0;
    for (int L = bx; L < nunits; L += G) ++n;
    if (tid < n) { const int L = bx + tid * G, tile = L >> 2, j = L & 3; const int cls = ((const GAS int*)tc)[tile]; int e_lo, e_hi; cls_experts(cls, e_lo, e_hi);
        if (DOWN) { list[4 * tid] = tile; list[4 * tid + 1] = j; list[4 * tid + 2] = e_lo * 256; list[4 * tid + 3] = e_hi * 256; }
        else { list[4 * tid] = tile; list[4 * tid + 1] = (j < 2 ? e_lo : e_hi) * 2 + (j & 1); list[4 * tid + 2] = j; list[4 * tid + 3] = 0; } }
    __syncthreads();
    return n;
}
struct EpiHid {
    static constexpr bool PERM = true, AFTER_DRAIN = false;
    bf16* HID; const float* roww;
    __device__ __forceinline__ void operator()(const pg8::f32x4 (&acc)[2][2][4][2], const pg8::Unit& u, int wr, int wc, int fr_, int fq_) const {
        int z_ = 0; asm volatile("" : "+v"(z_)); const int ln_ = __builtin_amdgcn_mbcnt_hi(~0u, __builtin_amdgcn_mbcnt_lo(~0u, z_)); const int fr = ln_ & 15, fq = ln_ >> 4; (void)fr_; (void)fq_;
        const int row0 = u.pm * 256 + wr * 64 + fr, j = u.k0, col0 = j * 128 + wc * 32 + 8 * fq;
#pragma unroll
        for (int ai = 0; ai < 2; ++ai)
#pragma unroll
            for (int m = 0; m < 4; ++m) { const int pos = row0 + ai * 128 + m * 16; const float w = ((const GAS float*)roww)[2 * pos + (j >> 1)];
                float h[8];
#pragma unroll
                for (int n = 0; n < 2; ++n)
#pragma unroll
                    for (int e = 0; e < 4; ++e) { const float gt = acc[ai][0][m][n][e], up = acc[ai][1][m][n][e]; h[4 * n + e] = gt * fsigmoid(gt) * up * w; }
                v4u o; o.x = pk2(h[0], h[1]); o.y = pk2(h[2], h[3]); o.z = pk2(h[4], h[5]); o.w = pk2(h[6], h[7]);
                *(GAS v4u*)(HID + (size_t)pos * 512 + col0) = o; }
    }
};
struct EpiMoeOut {
    static constexpr bool PERM = false, AFTER_DRAIN = false;
    bf16* out; const float* gate; const int* rowtok;
    __device__ __forceinline__ void operator()(const pg8::f32x4 (&acc)[2][2][4][2], const pg8::Unit& u, int wr, int wc, int fr_, int fq_) const {
        int z_ = 0; asm volatile("" : "+v"(z_)); const int ln_ = __builtin_amdgcn_mbcnt_hi(~0u, __builtin_amdgcn_mbcnt_lo(~0u, z_)); const int fr = ln_ & 15, fq = ln_ >> 4; (void)fr_; (void)fq_;
        const int row0 = u.pm * 256 + wr * 64 + fr, col0 = u.pn * 256 + wc * 32 + 4 * fq;
#pragma unroll
        for (int ai = 0; ai < 2; ++ai)
#pragma unroll
            for (int m = 0; m < 4; ++m) { const int tok = ((const GAS int*)rowtok)[row0 + ai * 128 + m * 16];
                if (tok >= 0) { const float* gb = gate + (size_t)(tok >> 12) * 6144; bf16* orow = out + (size_t)tok * 1024;
#pragma unroll
                    for (int bj = 0; bj < 2; ++bj)
#pragma unroll
                        for (int n = 0; n < 2; ++n) { const int c = col0 + bj * 128 + n * 16; const pg8::f32x4 gv = *(const GAS pg8::f32x4*)(gb + c); const v2u w = *(const GAS v2u*)(orow + c);
                            const pg8::f32x4 o = (pg8::f32x4){bflo(w.x), bfhi(w.x), bflo(w.y), bfhi(w.y)} + gv * acc[ai][bj][m][n]; v2u ow; ow.x = pk2(o[0], o[1]); ow.y = pk2(o[2], o[3]); *(GAS v2u*)(orow + c) = ow; } } }
    }
};
}
namespace fx {
struct EpiS5Loc {
    static constexpr bool PERM = false, AFTER_DRAIN = false;
    float* LOC;
    __device__ __forceinline__ void operator()(const pg8::f32x4 (&acc)[2][2][4][2], const pg8::Unit& u, int wr, int wc, int fr_, int fq_) const {
        int z_ = 0; asm volatile("" : "+v"(z_)); const int ln_ = __builtin_amdgcn_mbcnt_hi(~0u, __builtin_amdgcn_mbcnt_lo(~0u, z_)); const int fr = ln_ & 15, fq = ln_ >> 4; (void)fr_; (void)fq_;
        const int row0 = u.pm * 256 + wr * 64 + fr, col0 = wc * 32 + 4 * fq;
#pragma unroll
        for (int n = 0; n < 2; ++n)
#pragma unroll
            for (int ai = 0; ai < 2; ++ai)
#pragma unroll
                for (int m = 0; m < 4; ++m) *(GAS pg8::f32x4*)(LOC + (size_t)(row0 + ai * 128 + m * 16) * 128 + col0 + n * 16) = acc[ai][0][m][n];
    }
};
__device__ __forceinline__ float gelu_tanh_f(float x) { const float u = 0.7978845608028654f * (x + 0.044715f * x * x * x); const float e = __builtin_amdgcn_exp2f(-2.f * LOG2E * u); return x * __builtin_amdgcn_rcpf(1.f + e); }
struct EpiS5Y {
    static constexpr bool PERM = true, AFTER_DRAIN = false;
    bf16* Y;
    __device__ __forceinline__ void operator()(const pg8::f32x4 (&acc)[2][2][4][2], const pg8::Unit& u, int wr, int wc, int fr_, int fq_) const {
        int z_ = 0; asm volatile("" : "+v"(z_)); const int ln_ = __builtin_amdgcn_mbcnt_hi(~0u, __builtin_amdgcn_mbcnt_lo(~0u, z_)); const int fr = ln_ & 15, fq = ln_ >> 4; (void)fr_; (void)fq_;
        const int g = u.pn, b = u.pm & 7, c0 = wr * 64 + fr;
#pragma unroll
        for (int bj = 0; bj < 2; ++bj) { const int n0 = bj * 128 + wc * 32 + 8 * fq, j = n0 >> 4, ch0 = n0 & 15;
#pragma unroll
            for (int ai = 0; ai < 2; ++ai)
#pragma unroll
                for (int m = 0; m < 4; ++m) { const int c = c0 + ai * 128 + m * 16; const pg8::f32x4 v0 = acc[ai][bj][m][0], v1 = acc[ai][bj][m][1];
                    v4u w; w.x = pk2(gelu_tanh_f(v0[0]), gelu_tanh_f(v0[1])); w.y = pk2(gelu_tanh_f(v0[2]), gelu_tanh_f(v0[3])); w.z = pk2(gelu_tanh_f(v1[0]), gelu_tanh_f(v1[1])); w.w = pk2(gelu_tanh_f(v1[2]), gelu_tanh_f(v1[3]));
                    *(GAS v4u*)(Y + ((size_t)(b * 4096 + c * 16 + j) * 256 + g * 16 + ch0)) = w; } }
    }
};
struct OneUnit { int pm, pn;
    __device__ __forceinline__ bool next(int i, pg8::Unit& u) const { if (i >= 1) return false; u.pm = pm; u.pn = pn; u.k0 = 0; u.k1 = 0; return true; }
    __device__ __forceinline__ void a_ready(const pg8::Unit&) const {}
    __device__ __forceinline__ void done(const pg8::Unit&) const {} };
__device__ __forceinline__ void s5_scan(unsigned char* ws, int l, int g, int b, int tid) {
    if (tid < 64) { const int q = tid; const float* al = (const float*)(ws + WS_S5AL) + ((l * 16 + g) * 64 + q) * 2; const float ar = al[0], ai = al[1];
        const float* loc = (const float*)(ws + WS_LOC) + (size_t)(g * 2048 + b * 256) * 128; bf16* up = (bf16*)(ws + WS_UP) + (size_t)(g * 2048 + b * 256) * 384 + 256;
        float sr = 0.f, si = 0.f;
        for (int c0 = 0; c0 < 256; c0 += 8) { float lr[8], li[8];
#pragma unroll
            for (int k = 0; k < 8; ++k) { lr[k] = loc[(size_t)(c0 + k) * 128 + q]; li[k] = loc[(size_t)(c0 + k) * 128 + 64 + q]; }
#pragma unroll
            for (int k = 0; k < 8; ++k) { up[(size_t)(c0 + k) * 384 + q] = (bf16)f2bf(sr); up[(size_t)(c0 + k) * 384 + 64 + q] = (bf16)f2bf(si);
                const float nr = ar * sr - ai * si + lr[k], ni = ar * si + ai * sr + li[k]; sr = nr; si = ni; } }
    }
    asm volatile("s_waitcnt vmcnt(0)" ::: "memory");
    __syncthreads();
}
struct EpiGlu {
    static constexpr bool PERM = false, AFTER_DRAIN = true;
    const bf16* Y; const float* gb; const float* bnw; bf16* MIX;
    __device__ __forceinline__ void fused(pg8::f32x4 (&acc)[2][2][4][2], const pg8::Unit& u, int wr, int wc, int fr_, int fq_, PG8_LAS unsigned char* lds, int wid, int lane_) const {
        int z_ = 0; asm volatile("" : "+v"(z_)); const int ln_ = __builtin_amdgcn_mbcnt_hi(~0u, __builtin_amdgcn_mbcnt_lo(~0u, z_)); const int fr = ln_ & 15, fq = ln_ >> 4; (void)fr_; (void)fq_; (void)wid; (void)lane_;
        PG8_LAS float* P = (PG8_LAS float*)lds;
        const int row0 = u.pm * 256 + wr * 64 + fr, col0 = wc * 32 + 4 * fq;
#pragma unroll
        for (int ai = 0; ai < 2; ++ai)
#pragma unroll
            for (int m = 0; m < 4; ++m) { const int r = row0 + ai * 128 + m * 16; float s = 0.f;
#pragma unroll
                for (int bj = 0; bj < 2; ++bj)
#pragma unroll
                    for (int n = 0; n < 2; ++n) { const int c = col0 + bj * 128 + n * 16; const pg8::f32x4 bv = *(const GAS pg8::f32x4*)(gb + c); const v2u yw = *(const GAS v2u*)(Y + (size_t)r * 256 + c);
                        pg8::f32x4 a = acc[ai][bj][m][n] + bv; const float y0 = bflo(yw.x), y1 = bfhi(yw.x), y2 = bflo(yw.y), y3 = bfhi(yw.y);
                        a[0] = y0 * fsigmoid(a[0]); a[1] = y1 * fsigmoid(a[1]); a[2] = y2 * fsigmoid(a[2]); a[3] = y3 * fsigmoid(a[3]); acc[ai][bj][m][n] = a;
                        s += (a[0] * a[0] + a[1] * a[1]) + (a[2] * a[2] + a[3] * a[3]); }
                s += lane_get(s, ln_ ^ 16); s += lane_get(s, ln_ ^ 32);
                if (fq == 0) P[(wr * 64 + ai * 128 + m * 16 + fr) * 4 + wc] = s; }
        asm volatile("s_waitcnt lgkmcnt(0)" ::: "memory"); __builtin_amdgcn_s_barrier(); asm volatile("" ::: "memory");
#pragma unroll
        for (int ai = 0; ai < 2; ++ai)
#pragma unroll
            for (int m = 0; m < 4; ++m) { const int rl = wr * 64 + ai * 128 + m * 16 + fr, r = u.pm * 256 + rl; const PG8_LAS pg8::f32x4* pp = (const PG8_LAS pg8::f32x4*)(P + rl * 4); const pg8::f32x4 ps = *pp;
                const float rstd = __builtin_amdgcn_rsqf(((ps[0] + ps[1]) + (ps[2] + ps[3])) * (1.f / 256.f) + 1e-6f);
#pragma unroll
                for (int bj = 0; bj < 2; ++bj)
#pragma unroll
                    for (int n = 0; n < 2; ++n) { const int c = col0 + bj * 128 + n * 16; const pg8::f32x4 wv = *(const GAS pg8::f32x4*)(bnw + c); const pg8::f32x4 o = acc[ai][bj][m][n] * rstd * wv;
                        v2u w; w.x = pk2(o[0], o[1]); w.y = pk2(o[2], o[3]); *(GAS v2u*)(MIX + (size_t)r * 1024 + 384 + c) = w; } }
    }
};
}
namespace fx {
constexpr int HG_NSEG = 8, HG_SEGTOK = SEQ / HG_NSEG, HG_CT = 32, HG_NCH = HG_SEGTOK / HG_CT;
constexpr size_t WS_HD = WS_HLOC + 7 * MiB;
typedef short hbf16x8 __attribute__((ext_vector_type(8)));
typedef float hf32x16 __attribute__((ext_vector_type(16)));
constexpr int HL_QT = 0, HL_KT = 4608, HL_KH = 9216, HL_VT = 14336, HL_PP = 19456, HL_ST = 22016, HL_DD = 31232, HL_TOT = 31488, HL_OO = 32512, HL_END = 41216;
constexpr int HP_QK = 72, HP_T = 40, HP_OO = 68;
__device__ __forceinline__ int hcrow(int r, int hi) { return (r & 3) + 8 * (r >> 2) + 4 * hi; }

template <bool FULL>
__device__ __forceinline__ void hgrn_pair(unsigned char* ws, const float* nw_l, int l, int u0, LAS unsigned char* lds_wg, const int wave00) {
    int wave0 = wave00; asm volatile("" : "+s"(wave0));
    const int lane = lane_now(), r32 = lane & 31, hi = lane >> 5, half = wave0 >> 2, hw = wave0 & 3, htid = hw * 64 + lane;
    constexpr int NS = FULL ? HG_NSEG : HG_NSEG - 1;
    const int unit = u0 + half, bh = unit / NS, seg = unit % NS, b = bh / 6, h = bh % 6; const int d = lane, sg = hw;
    LAS unsigned char* lds = lds_wg + half * HL_END;
    const bf16* Zb = (const bf16*)(ws + WS_Z) + (size_t)(b * SEQ + seg * HG_SEGTOK) * NZ + h * 64;
    const float lbv = ((const float*)(ws + WS_LB))[l * 384 + h * 64 + d], oml = 1.f - lbv;
    LAS unsigned short* QT = (LAS unsigned short*)(lds + HL_QT); LAS unsigned short* KT = (LAS unsigned short*)(lds + HL_KT);
    LAS unsigned short* KH = (LAS unsigned short*)(lds + HL_KH); LAS unsigned short* VT = (LAS unsigned short*)(lds + HL_VT);
    LAS unsigned short* PP = (LAS unsigned short*)(lds + HL_PP); LAS unsigned short* ST = (LAS unsigned short*)(lds + HL_ST);
    LAS float* DD = (LAS float*)(lds + HL_DD); LAS float* TOT = (LAS float*)(lds + HL_TOT); LAS float* OO = (LAS float*)(lds + HL_OO);
    const int dt = hw >> 1, vt = hw & 1;
    hf32x16 S;
#pragma unroll
    for (int r = 0; r < 16; ++r) S[r] = 0.f;
    if (FULL) {
        for (int j = 0; j < seg; ++j) { const float* loc = (const float*)(ws + WS_HLOC) + (size_t)(bh * HG_NSEG + j) * 4096; const float* hd = (const float*)(ws + WS_HD) + (bh * HG_NSEG + j) * 64;
#pragma unroll
            for (int r = 0; r < 16; ++r) { const int dd = 32 * dt + hcrow(r, hi); S[r] = S[r] * hd[dd] + loc[dd * 64 + 32 * vt + r32]; } }
#pragma unroll
        for (int j = 0; j < 4; ++j) { v2u w; w.x = pk2(S[4 * j], S[4 * j + 1]); w.y = pk2(S[4 * j + 2], S[4 * j + 3]); *(LAS v2u*)(ST + (32 * vt + r32) * HP_QK + 32 * dt + 8 * j + 4 * hi) = w; }
    }
    float lsum = 0.f;
    unsigned short rf[8] = {}, rv[8] = {}, rq[8] = {}; v4u rg = {};
    { const bf16* zr = Zb + (size_t)(8 * sg) * NZ;
#pragma unroll
        for (int i = 0; i < 8; ++i) { rf[i] = zr[(size_t)i * NZ + ZC_HF + d]; rv[i] = zr[(size_t)i * NZ + ZC_HI + d]; if (FULL) rq[i] = zr[(size_t)i * NZ + ZC_HQ + d]; }
        if (FULL) rg = *(const GAS v4u*)(Zb + (size_t)(htid >> 3) * NZ + ZC_HG + 8 * (htid & 7)); }
    for (int ch = 0; ch < HG_NCH; ++ch) {
        float lf[8], kk[8], qq[8], vv[8];
#pragma unroll
        for (int i = 0; i < 8; ++i) { const float z = bf2f(rf[i]); const float s1 = fsigmoid(z); lf[i] = __logf(lbv + oml * s1); kk[i] = oml * (1.f - s1);
            vv[i] = bf2f(rv[i]); if (FULL) qq[i] = fsilu(bf2f(rq[i])); }
        const v4u gw_ = rg;
        if (ch + 1 < HG_NCH) { const bf16* zr = Zb + (size_t)((ch + 1) * HG_CT + 8 * sg) * NZ;
#pragma unroll
            for (int i = 0; i < 8; ++i) { rf[i] = zr[(size_t)i * NZ + ZC_HF + d]; rv[i] = zr[(size_t)i * NZ + ZC_HI + d]; if (FULL) rq[i] = zr[(size_t)i * NZ + ZC_HQ + d]; }
            if (FULL) rg = *(const GAS v4u*)(Zb + (size_t)((ch + 1) * HG_CT + (htid >> 3)) * NZ + ZC_HG + 8 * (htid & 7)); }
#pragma unroll
        for (int i = 1; i < 8; ++i) lf[i] += lf[i - 1];
        TOT[sg * 64 + d] = lf[7];
        __syncthreads();
        float base = 0.f, blast = 0.f;
#pragma unroll
        for (int s2 = 0; s2 < 4; ++s2) { const float tv = TOT[s2 * 64 + d]; blast += tv; if (s2 < sg) base += tv; }
        lsum += blast;
        { float kh[8];
#pragma unroll
            for (int i = 0; i < 8; ++i) { const float bi = base + lf[i]; kh[i] = kk[i] * __expf(blast - bi);
                if (FULL) { const int t = 8 * sg + i; QT[t * HP_QK + d] = (unsigned short)f2bf(qq[i] * __expf(bi)); KT[t * HP_QK + d] = (unsigned short)f2bf(kk[i] * __expf(-bi)); } }
            v4u w; w.x = pk2(kh[0], kh[1]); w.y = pk2(kh[2], kh[3]); w.z = pk2(kh[4], kh[5]); w.w = pk2(kh[6], kh[7]); *(LAS v4u*)(KH + d * HP_T + 8 * sg) = w;
            v4u wv; wv.x = pk2(vv[0], vv[1]); wv.y = pk2(vv[2], vv[3]); wv.z = pk2(vv[4], vv[5]); wv.w = pk2(vv[6], vv[7]); *(LAS v4u*)(VT + d * HP_T + 8 * sg) = wv;
            if (sg == 0) DD[d] = __expf(blast); }
        __syncthreads();
        if (FULL && hw == 0) { hf32x16 c;
#pragma unroll
            for (int r = 0; r < 16; ++r) c[r] = 0.f;
#pragma unroll
            for (int ks = 0; ks < 4; ++ks) { const hbf16x8 a = *(const LAS hbf16x8*)(QT + r32 * HP_QK + 16 * ks + 8 * hi), bb = *(const LAS hbf16x8*)(KT + r32 * HP_QK + 16 * ks + 8 * hi); c = __builtin_amdgcn_mfma_f32_32x32x16_bf16(a, bb, c, 0, 0, 0); }
#pragma unroll
            for (int r = 0; r < 16; ++r) { const int t = hcrow(r, hi); PP[t * HP_T + r32] = (unsigned short)f2bf(r32 <= t ? c[r] : 0.f); } }
        {
#pragma unroll
            for (int r = 0; r < 16; ++r) S[r] *= DD[32 * dt + hcrow(r, hi)];
#pragma unroll
            for (int ks = 0; ks < 2; ++ks) { const hbf16x8 a = *(const LAS hbf16x8*)(KH + (32 * dt + r32) * HP_T + 16 * ks + 8 * hi), bb = *(const LAS hbf16x8*)(VT + (32 * vt + r32) * HP_T + 16 * ks + 8 * hi); S = __builtin_amdgcn_mfma_f32_32x32x16_bf16(a, bb, S, 0, 0, 0); } }
        if (FULL) {
            __syncthreads();
            if (hw == 1 || hw == 2) { const int ov = hw - 1; hf32x16 c;
#pragma unroll
                for (int r = 0; r < 16; ++r) c[r] = 0.f;
#pragma unroll
                for (int ks = 0; ks < 2; ++ks) { const hbf16x8 a = *(const LAS hbf16x8*)(PP + r32 * HP_T + 16 * ks + 8 * hi), bb = *(const LAS hbf16x8*)(VT + (32 * ov + r32) * HP_T + 16 * ks + 8 * hi); c = __builtin_amdgcn_mfma_f32_32x32x16_bf16(a, bb, c, 0, 0, 0); }
#pragma unroll
                for (int ks = 0; ks < 4; ++ks) { const hbf16x8 a = *(const LAS hbf16x8*)(QT + r32 * HP_QK + 16 * ks + 8 * hi), bb = *(const LAS hbf16x8*)(ST + (32 * ov + r32) * HP_QK + 16 * ks + 8 * hi); c = __builtin_amdgcn_mfma_f32_32x32x16_bf16(a, bb, c, 0, 0, 0); }
#pragma unroll
                for (int r = 0; r < 16; ++r) OO[hcrow(r, hi) * HP_OO + 32 * ov + r32] = c[r]; }
            __syncthreads();
#pragma unroll
            for (int j = 0; j < 4; ++j) { v2u w; w.x = pk2(S[4 * j], S[4 * j + 1]); w.y = pk2(S[4 * j + 2], S[4 * j + 3]); *(LAS v2u*)(ST + (32 * vt + r32) * HP_QK + 32 * dt + 8 * j + 4 * hi) = w; }
            { const int t = htid >> 3, vg = htid & 7; const f32x4 o0 = *(const LAS f32x4*)(OO + t * HP_OO + 8 * vg), o1 = *(const LAS f32x4*)(OO + t * HP_OO + 8 * vg + 4);
                float s = ((o0.x * o0.x + o0.y * o0.y) + (o0.z * o0.z + o0.w * o0.w)) + ((o1.x * o1.x + o1.y * o1.y) + (o1.z * o1.z + o1.w * o1.w));
                s += lane_get(s, lane ^ 1); s += lane_get(s, lane ^ 2); s += lane_get(s, lane ^ 4);
                const float rstd = __builtin_amdgcn_rsqf(s * (1.f / 64.f) + 1e-6f); const size_t row = (size_t)(b * SEQ + seg * HG_SEGTOK + ch * HG_CT + t);
                const f32x4 w0 = *(const GAS f32x4*)(nw_l + 8 * vg), w1 = *(const GAS f32x4*)(nw_l + 8 * vg + 4);
                v4u w; w.x = pk2(o0.x * rstd * w0.x * fsilu(bflo(gw_.x)), o0.y * rstd * w0.y * fsilu(bfhi(gw_.x))); w.y = pk2(o0.z * rstd * w0.z * fsilu(bflo(gw_.y)), o0.w * rstd * w0.w * fsilu(bfhi(gw_.y)));
                w.z = pk2(o1.x * rstd * w1.x * fsilu(bflo(gw_.z)), o1.y * rstd * w1.y * fsilu(bfhi(gw_.z))); w.w = pk2(o1.z * rstd * w1.z * fsilu(bflo(gw_.w)), o1.w * rstd * w1.w * fsilu(bfhi(gw_.w)));
                *(GAS v4u*)((bf16*)(ws + WS_H) + row * 1024 + 640 + h * 64 + 8 * vg) = w; }
        }
    }
    if (!FULL) {
        { float* loc = (float*)(ws + WS_HLOC) + (size_t)(bh * HG_NSEG + seg) * 4096;
#pragma unroll
            for (int r = 0; r < 16; ++r) loc[(32 * dt + hcrow(r, hi)) * 64 + 32 * vt + r32] = S[r]; }
        if (sg == 0) ((float*)(ws + WS_HD))[(bh * HG_NSEG + seg) * 64 + d] = __expf(lsum);
    }
    __syncthreads();
}
}
namespace fx {
constexpr int LDS_BYTES = 147456;
constexpr int RING_BYTES = 131072, LDSCTL_OFF = RING_BYTES, MISC_OFF = LDSCTL_OFF + 320;
constexpr int PH_PRO = 0, PH_FINAL = 21, NPH = 22;

struct QueueOrder {
    unsigned* ctr; LAS unsigned* slot;
    __device__ __forceinline__ bool next(int, attn_body::AttnUnit& u) const {
        if (threadIdx.x == 0) *slot = __hip_atomic_fetch_add(ctr, 1u, __ATOMIC_RELAXED, __HIP_MEMORY_SCOPE_AGENT);
        __syncthreads(); const unsigned v = *slot; __syncthreads();
        if (v >= 768u) return false; u.bh = (int)(v >> 4); u.qb = 15 - (int)(v & 15u); return true; }
    __device__ __forceinline__ void a_ready(const attn_body::AttnUnit&) const {}
    __device__ __forceinline__ void done(const attn_body::AttnUnit&) const {}
};

__global__ void __launch_bounds__(NTHR, 2) mk_fwd(Params p) {
    extern __shared__ __attribute__((aligned(16))) unsigned char lds_raw[];
    LAS unsigned char* lds = (LAS unsigned char*)lds_raw;
    const int wave0 = __builtin_amdgcn_readfirstlane(threadIdx.x >> 6);
    for (int u = threadIdx.x; u < (LDS_BYTES - LDSCTL_OFF) / 4; u += NTHR) ((LAS unsigned*)(lds + LDSCTL_OFF))[u] = 0u;
    __syncthreads();
    const XcdBarrier bar = xcd_barrier_post((unsigned*)(p.ws + WS_CTL) + 8192 + p.li * 4096, (volatile LAS unsigned*)(lds + MISC_OFF) + 8, threadIdx.x == 0);
#ifdef EXTRA_BARS
    for (int eb = 0; eb < EXTRA_BARS; ++eb) xcd_barrier(bar, wave0 == 0 && lane_now() == 0);
#endif
    for (int ph = p.ph_lo; ph < p.ph_hi; ++ph) {
#ifdef DUP_MASK
      for (int rep = (((DUP_MASK) >> ph) & 1u) ? 0 : 1; rep < 2; ++rep) {
#else
      { const int rep = 1;
#endif
#ifdef PROBE_MASK
        if (blockIdx.x == 0 && wave0 == 0 && lane_now() == 0) __hip_atomic_store((unsigned long long*)(p.ws + WS_CTL + 512 * 1024) + ph, __builtin_amdgcn_s_memrealtime(), __ATOMIC_RELAXED, __HIP_MEMORY_SCOPE_AGENT);
#endif
        int oz = 0; asm volatile("" : "+s"(oz));
        const int G = gridDim.x, bx = blockIdx.x + oz;
#define PHASE_IDS int wv_ = wave0; asm volatile("" : "+s"(wv_)); const int lane = lane_now(), wave = wv_, tid = wv_ * 64 + lane; \
        const int vcu = (G % 8 == 0) ? (bx % 8) * (G / 8) + bx / 8 : bx; const int gw = vcu * NWAVES + wave, ngw = G * NWAVES; (void)tid; (void)lane; (void)gw; (void)ngw;
        unsigned char* ws = p.ws + oz;
#define PIN(i) (p.in[(i) + oz])
        const int l = (ph - 1) / 10, sub = (ph - 1) % 10;
#ifndef EXP_NO_PRO
        if (ph == PH_PRO) { PHASE_IDS
            { LAS float* cact = (LAS float*)lds; const float* c = PIN(I_C); for (int i = tid; i < 8192; i += NTHR) { const float cv = c[i]; cact[i] = cv * fsigmoid(cv); } __syncthreads();
              for (int it = bx; it < 192; it += G) prologue_mod_item(p, oz, it, (LAS float*)lds, tid, lane, wave); }
            __syncthreads();
            for (int it = (G >= 224 ? bx - 192 : bx); it >= 0 && it < 32; it += G) prologue_s5_item(p, oz, it / 16, it % 16, (LAS float*)lds, tid);
            __syncthreads();
            prologue_wave_items(p, oz, (LAS float*)(lds + wave * 16384), gw, ngw, lane);
        } else
#endif
        if (ph == PH_FINAL) { PHASE_IDS
            float* X = p.out + oz; const bf16* XBp = (const bf16*)(ws + WS_XB); const float* w = PIN(I_FINW);
#ifdef PROBE_MASK
            float pscale = 1.f; { unsigned long long* tsb = (unsigned long long*)(ws + WS_CTL + 512 * 1024); unsigned long long t0 = __hip_atomic_load(tsb, __ATOMIC_RELAXED, __HIP_MEMORY_SCOPE_AGENT), tl = __hip_atomic_load(tsb + PH_FINAL, __ATOMIC_RELAXED, __HIP_MEMORY_SCOPE_AGENT); unsigned long long acc = 0;
#pragma unroll 1
                for (int k = 0; k < PH_FINAL; ++k) if ((PROBE_MASK >> k) & 1u) acc += __hip_atomic_load(tsb + k + 1, __ATOMIC_RELAXED, __HIP_MEMORY_SCOPE_AGENT) - __hip_atomic_load(tsb + k, __ATOMIC_RELAXED, __HIP_MEMORY_SCOPE_AGENT);
                pscale = 1.f + (float)acc / (float)(tl - t0); }
#endif
            f32x4 W4[4];
#pragma unroll
            for (int j = 0; j < 4; ++j) W4[j] = ((const GAS f32x4*)w)[lane + 64 * j];
            f32x4 v[4] = {}; if (gw < M) row_load_bf(XBp, gw, lane, v);
            for (int m = gw; m < M; m += ngw) { GAS f32x4* xr = (GAS f32x4*)(X + (size_t)m * 1024) + lane; f32x4 nxt[4] = {}; const int mn = m + ngw; if (mn < M) row_load_bf(XBp, mn, lane, nxt); float s = 0.f;
#pragma unroll
                for (int j = 0; j < 4; ++j) s += (v[j].x * v[j].x + v[j].y * v[j].y) + (v[j].z * v[j].z + v[j].w * v[j].w);
                const float rstd = __builtin_amdgcn_rsqf(wave_sum(s, lane) * (1.f / 1024.f) + 1e-6f);
#pragma unroll
                for (int j = 0; j < 4; ++j) { f32x4 o = (v[j] * rstd) * W4[j];
#ifdef PROBE_MASK
                    o = o * pscale;
#endif
                    xr[64 * j] = o; }
#pragma unroll
                for (int j = 0; j < 4; ++j) v[j] = nxt[j]; }
        }
#ifndef EXP_NO_ROW
        else if (sub == 0) { PHASE_IDS
            const float* X = PIN(I_X); const float* mod = (const float*)(ws + WS_MOD) + l * 8 * 6144;
            const int tpw = M / G, t0 = bx * tpw, b = t0 >> 12; f32x4 A[4], B[4]; adaln_factors(PIN(I_NMW) + l * 1024, mod + b * 6144, mod + b * 6144 + 1024, lane, A, B);
            const bf16* XBp = (const bf16*)(ws + WS_XB);
            f32x4 cur[4] = {}; if (wave < tpw) { if (l == 0) row_load(X, t0 + wave, lane, cur); else row_load_bf(XBp, t0 + wave, lane, cur); }
            for (int r = wave; r < tpw; r += NWAVES) { f32x4 nxt[4] = {}; if (r + NWAVES < tpw) { if (l == 0) row_load(X, t0 + r + NWAVES, lane, nxt); else row_load_bf(XBp, t0 + r + NWAVES, lane, nxt); }
                norm_row_to_bf16(cur, A, B, (bf16*)(ws + WS_H) + (size_t)(t0 + r) * 1024, lane);
#pragma unroll
                for (int j = 0; j < 4; ++j) cur[j] = nxt[j]; }
        }
#endif
        else if (sub == 1) {
            pg8::Gemm g{(const pg8::bf16_t*)(ws + WS_H), (const pg8::bf16_t*)(ws + WS_WIN) + (size_t)l * 3072 * 1024, M, NZ, 1024, 1024, 1024};
            pg8::StaticOrder S; S.init(M, NZ, G, bx);
            EpiZ E{(bf16*)(ws + WS_Z), (bf16*)(ws + WS_UP), (float*)(ws + WS_NLF), PIN(I_FOXB) + l * 6};
#ifdef EXP_EPI_BF16
            pg8::EpiBf16<0> E2{(bf16*)(ws + WS_Z), NZ, nullptr, 0, 0, 1.f};
            pg8::gemm_phase<pg8::EpiBf16<0>, pg8::StaticOrder, true, true>(lds, g, S, E2);
#else
            pg8::gemm_phase<EpiZ, pg8::StaticOrder, true, true>(lds, g, S, E, wave0);
#endif
        }
        else if (sub == 2) {
            unsigned* qctr = (unsigned*)(ws + WS_CTL) + 1024 + ph * 64 + rep * 32; LAS unsigned* qslot = (LAS unsigned*)(lds + MISC_OFF);
            constexpr unsigned NHL = 48u * (HG_NSEG - 1) / 2u;
            for (;;) {
                int ozq = 0; asm volatile("" : "+s"(ozq)); unsigned char* wsq = p.ws + ozq;
                if (wave0 == 0 && lane_now() == 0) *qslot = __hip_atomic_fetch_add(qctr, 1u, __ATOMIC_RELAXED, __HIP_MEMORY_SCOPE_AGENT);
                __syncthreads(); const unsigned v = __builtin_amdgcn_readfirstlane(*qslot); __syncthreads();
                if (v >= NHL + 128u + 48u + 768u) break;
                if (v < NHL) { hgrn_pair<false>(wsq, p.in[I_HNW + ozq] + l * 64, l, (int)(2u * v), lds, wave0); }
                else if (v < NHL + 128u) { const int u5 = (int)(v - NHL); const OneUnit S5{u5, u5 >> 3};
                    pg8::Gemm g5{(const pg8::bf16_t*)(wsq + WS_UP), (const pg8::bf16_t*)(wsq + WS_S5WL) + (size_t)l * 16 * 256 * 256, 16 * 2048, 16 * 256, 256, 384, 256}; EpiS5Loc E5{(float*)(wsq + WS_LOC)}; pg8::gemm_phase<EpiS5Loc, OneUnit, false, true>(lds, g5, S5, E5, wave0); __syncthreads(); }
                else if (v >= NHL + 128u + 48u) {
                    const int u = (int)(v - NHL - 128u - 48u), bh = u >> 4, qb = u & 15, b = bh / 6, h = bh % 6; int wv_ = wave0; asm volatile("" : "+s"(wv_)); const int lane = lane_now();
                    const bf16* Zr = (const bf16*)(wsq + WS_Z) + (size_t)(b * SEQ + qb * 256 + wv_ * 32) * NZ + h * 64; float kmax = 0.f, qmax = 0.f;
#pragma unroll
                    for (int i = 0; i < 8; ++i) { const bf16* rp = Zr + (size_t)(4 * i + (lane >> 4)) * NZ + 4 * (lane & 15); const v2u kw = *(const GAS v2u*)(rp + ZC_FK), qw = *(const GAS v2u*)(rp + ZC_FQ);
                        float ks = (bflo(kw.x) * bflo(kw.x) + bfhi(kw.x) * bfhi(kw.x)) + (bflo(kw.y) * bflo(kw.y) + bfhi(kw.y) * bfhi(kw.y)), qs = (bflo(qw.x) * bflo(qw.x) + bfhi(qw.x) * bfhi(qw.x)) + (bflo(qw.y) * bflo(qw.y) + bfhi(qw.y) * bfhi(qw.y));
                        ks += lane_get(ks, lane ^ 1); qs += lane_get(qs, lane ^ 1); ks += lane_get(ks, lane ^ 2); qs += lane_get(qs, lane ^ 2); ks += lane_get(ks, lane ^ 4); qs += lane_get(qs, lane ^ 4); ks += lane_get(ks, lane ^ 8); qs += lane_get(qs, lane ^ 8);
                        kmax = fmaxf(kmax, ks); qmax = fmaxf(qmax, qs); }
                    kmax = fmaxf(kmax, lane_get(kmax, lane ^ 16)); qmax = fmaxf(qmax, lane_get(qmax, lane ^ 16)); kmax = fmaxf(kmax, lane_get(kmax, lane ^ 32)); qmax = fmaxf(qmax, lane_get(qmax, lane ^ 32));
                    LAS float* red = (LAS float*)lds; if (lane == 0) { red[wv_] = kmax; red[8 + wv_] = qmax; }
                    __syncthreads();
                    if (wv_ == 0 && lane < 4) ((float*)(wsq + WS_KN))[bh * 64 + qb * 4 + lane] = fmaxf(red[2 * lane], red[2 * lane + 1]) * 1.02f;
                    if (wv_ == 0 && lane == 4) { float m = red[8]; for (int w = 1; w < 8; ++w) m = fmaxf(m, red[8 + w]); ((float*)(wsq + WS_QN))[bh * 16 + qb] = m * 1.02f; }
                    __syncthreads(); }
                else { const int bh = (int)(v - NHL - 128u); int wv_ = wave0; asm volatile("" : "+s"(wv_)); const int lane = lane_now(), wave = wv_, tid = wv_ * 64 + lane; LAS float* wsum = (LAS float*)lds;
                    const float* src = (const float*)(wsq + WS_NLF) + (size_t)bh * SEQ + tid * 8; float v8[8]; float s = 0.f;
                    const f32x4 a = *(const GAS f32x4*)src, b4 = *(const GAS f32x4*)(src + 4);
                    v8[0] = a.x; v8[1] = a.y; v8[2] = a.z; v8[3] = a.w; v8[4] = b4.x; v8[5] = b4.y; v8[6] = b4.z; v8[7] = b4.w;
#pragma unroll
                    for (int i = 0; i < 8; ++i) { s += v8[i]; v8[i] = s; }
                    float incl = s;
#pragma unroll
                    for (int o = 1; o < 64; o <<= 1) { const float n = lane_get(incl, lane - o); if (lane >= o) incl += n; }
                    if (lane == 63) wsum[wave] = incl;
                    __syncthreads();
                    float base = incl - s;
                    for (int w = 0; w < wave; ++w) base += wsum[w];
                    float* dst = (float*)(wsq + WS_G) + (size_t)bh * SEQ + tid * 8;
                    *(GAS f32x4*)dst = (f32x4){v8[0] + base, v8[1] + base, v8[2] + base, v8[3] + base}; *(GAS f32x4*)(dst + 4) = (f32x4){v8[4] + base, v8[5] + base, v8[6] + base, v8[7] + base};
                    __syncthreads(); }
            }
        }
        else if (sub == 3) {
            unsigned* qctr = (unsigned*)(ws + WS_CTL) + 1024 + ph * 64 + rep * 32; LAS unsigned* qslot = (LAS unsigned*)(lds + MISC_OFF);
            for (;;) {
                int ozq = 0; asm volatile("" : "+s"(ozq)); unsigned char* wsq = p.ws + ozq;
                if (wave0 == 0 && lane_now() == 0) *qslot = __hip_atomic_fetch_add(qctr, 1u, __ATOMIC_RELAXED, __HIP_MEMORY_SCOPE_AGENT);
                __syncthreads(); const unsigned v = __builtin_amdgcn_readfirstlane(*qslot); __syncthreads();
                constexpr unsigned NHF = 48u * HG_NSEG / 2u;
                if (v >= NHF + 128u + 768u) break;
#ifdef DUP_MASK
#ifndef DUP_CSEL
                if (rep == 0 && v >= NHF + 128u) break;
#else
                if (rep == 0 && DUP_CSEL != 3 && v >= NHF + 128u) break;
#endif
#ifdef DUP_CSEL
                if (rep == 0 && DUP_CSEL == 1 && v >= NHF) break;
                if (rep == 0 && DUP_CSEL == 2 && v < NHF) continue;
                if (rep == 0 && DUP_CSEL == 3 && v < NHF + 128u) continue;
#endif
#endif
                if (v < NHF) { hgrn_pair<true>(wsq, p.in[I_HNW + ozq] + l * 64, l, (int)(2u * v), lds, wave0); }
                else if (v < NHF + 128u) { const unsigned v5 = v - NHF;
                    s5_scan(wsq, l, (int)(v5 >> 3), (int)(v5 & 7u), wave0 * 64 + lane_now());
                    pg8::Gemm g5{(const pg8::bf16_t*)(wsq + WS_UP), (const pg8::bf16_t*)(wsq + WS_S5WO) + (size_t)l * 16 * 256 * 384, 16 * 2048, 16 * 256, 384, 384, 384}; EpiS5Y E5{(bf16*)(wsq + WS_Y)};
                    const OneUnit S5{(int)v5, (int)(v5 >> 3)}; pg8::gemm_phase<EpiS5Y, OneUnit, false, false>(lds, g5, S5, E5, wave0); __syncthreads(); }
                else { const unsigned a = v - NHF - 128u; const int bh = (int)(a >> 4), qb = 15 - (int)(a & 15u);
                    const attn_body::bf16* Zq = (const attn_body::bf16*)(wsq + WS_Z);
                    int ts; { const int ln = lane_now(); const float* Gb = (const float*)(wsq + WS_G) + (size_t)bh * SEQ; const float* KN = (const float*)(wsq + WS_KN) + bh * 64; const float qn = ((const float*)(wsq + WS_QN))[bh * 16 + qb];
                        const float kd = fmaxf(fmaxf(KN[4 * qb], KN[4 * qb + 1]), fmaxf(KN[4 * qb + 2], KN[4 * qb + 3])); const float ub = __builtin_sqrtf(qn * KN[ln]) + Gb[64 * ln + 63] - Gb[256 * qb] + __builtin_sqrtf(qn * kd);
                        const unsigned long long need = __ballot((ln < 4 * qb) && !(ub < -36.f)); const int first = need ? (int)__builtin_ctzll(need) : 4 * qb; ts = __builtin_amdgcn_readfirstlane(first & ~1); }
                    attn_body::attn_unit<8>(bh / 6, bh % 6, qb, Zq + ZC_FQ, Zq + ZC_FK, Zq + ZC_FV, (attn_body::bf16*)(wsq + WS_Z) + ZC_FQ, (const float*)(wsq + WS_G) + (long)bh * SEQ, (char*)lds_raw, wave0, ts, rep != 0); }
            }
        }
        else if (sub == 4) { PHASE_IDS
            if (bx < 128) {
                pg8::Gemm gg{(const pg8::bf16_t*)(ws + WS_Y), (const pg8::bf16_t*)(ws + WS_GLU) + (size_t)l * 256 * 256, M, 256, 256, 256, 256};
                const OneUnit SG{bx, 0}; EpiGlu EG{(const bf16*)(ws + WS_Y), PIN(I_GLUB) + l * 256, PIN(I_BNS) + l * 256, (bf16*)(ws + WS_H)};
                pg8::gemm_phase<EpiGlu, OneUnit, false, true>(lds, gg, SG, EG, wave0);
            } else {
            const int gw2 = (bx - 128) * NWAVES + wave, ngw2 = (G - 128) * NWAVES;
            const bf16* Zb = (const bf16*)(ws + WS_Z); bf16* MIX = (bf16*)(ws + WS_H); const float* w = PIN(I_BNF) + l * 384;
            float wl[6];
#pragma unroll
            for (int i = 0; i < 6; ++i) wl[i] = w[lane * 6 + i];
            for (int m = gw2; m < M; m += ngw2) {
                const GAS unsigned* src = (const GAS unsigned*)(Zb + (size_t)m * NZ) + lane * 3; const unsigned a = src[0], b2 = src[1], c = src[2];
                float v[6] = {bflo(a), bfhi(a), bflo(b2), bfhi(b2), bflo(c), bfhi(c)}; float s = 0.f;
#pragma unroll
                for (int i = 0; i < 6; ++i) s += v[i] * v[i];
                const float rstd = __builtin_amdgcn_rsqf(wave_sum(s, lane) * (1.f / 384.f) + 1e-6f);
                GAS unsigned* dst = (GAS unsigned*)(MIX + (size_t)m * 1024) + lane * 3;
                dst[0] = pk2(v[0] * rstd * wl[0], v[1] * rstd * wl[1]); dst[1] = pk2(v[2] * rstd * wl[2], v[3] * rstd * wl[3]); dst[2] = pk2(v[4] * rstd * wl[4], v[5] * rstd * wl[5]);
            }
            }
        }
        else if (sub == 5) {
            pg8::Gemm g{(const pg8::bf16_t*)(ws + WS_H), (const pg8::bf16_t*)(ws + WS_WOUT) + (size_t)l * 1024 * 1024, M, 1024, 1024, 1024, 1024};
            pg8::StaticOrder S; S.init(M, 1024, G, bx);
            const float* gm = (const float*)(ws + WS_MOD) + l * 8 * 6144 + 2048;
            if (l == 0) { EpiRes<true> E{PIN(I_X), (bf16*)(ws + WS_XB), gm}; pg8::gemm_phase<EpiRes<true>, pg8::StaticOrder, true, true>(lds, g, S, E, wave0); }
            else { EpiRes<false> E{ws + WS_XB, (bf16*)(ws + WS_XB), gm}; pg8::gemm_phase<EpiRes<false>, pg8::StaticOrder, true, true>(lds, g, S, E, wave0); }
        }
        else if (sub == 6) { PHASE_IDS moe_route(p, oz, l, lds, tid, lane, wave, bx, G);
        }
        else if (sub == 7) { PHASE_IDS moe_gather(p, oz, lds, tid, lane, wave, bx, G);
        }
        else if (sub == 8) { PHASE_IDS
            LAS int* list = (LAS int*)(lds + RING_BYTES + 1024); const int n = moe_build_list<false>(ws, list, tid, bx, G);
            pg8::Gemm g{(const pg8::bf16_t*)(ws + WS_H2S), (const pg8::bf16_t*)(ws + WS_W1) + (size_t)l * 8192 * 1024, MOE_ROWS, 8192, 1024, 1024, 1024};
            ListOrder S{list, n}; EpiHid E{(bf16*)(ws + WS_HID), (const float*)(ws + WS_ROWW)};
            pg8::gemm_phase<EpiHid, ListOrder, true, true>(lds, g, S, E, wave0);
        }
        else if (sub == 9) { PHASE_IDS
            LAS int* list = (LAS int*)(lds + RING_BYTES + 1024); const int n = moe_build_list<true>(ws, list, tid, bx, G);
            pg8::Gemm g{(const pg8::bf16_t*)(ws + WS_HID), (const pg8::bf16_t*)(ws + WS_W2) + (size_t)l * 1024 * 4096, MOE_ROWS, 1024, 512, 512, 4096};
            ListOrder S{list, n}; EpiMoeOut E{(bf16*)(ws + WS_XB), (const float*)(ws + WS_MOD) + l * 8 * 6144 + 5 * 1024, (const int*)(ws + WS_ROWTOK)};
            pg8::gemm_phase<EpiMoeOut, ListOrder, false, true, true>(lds, g, S, E, wave0);
        }
        if (ph + 1 < p.ph_hi || rep == 0) xcd_barrier(bar, wave0 == 0 && lane_now() == 0); else __syncthreads();
      }
    }
}

static int g_grid = 0;
inline bool mk_setup() {
    if (g_grid) return g_grid > 0;
    int dev = 0, cus = 0;
    if (hipGetDevice(&dev) != hipSuccess || hipDeviceGetAttribute(&cus, hipDeviceAttributeMultiprocessorCount, dev) != hipSuccess) { g_grid = -1; return false; }
    if (hipFuncSetAttribute((const void*)mk_fwd, hipFuncAttributeMaxDynamicSharedMemorySize, LDS_BYTES) != hipSuccess) { fprintf(stderr, "hipFuncSetAttribute failed\n"); g_grid = -1; return false; }
    g_grid = cus; return true;
}
inline void mk_zero_ctl(void* d_ws, hipStream_t st) { (void)hipMemsetAsync((char*)d_ws + WS_CTL, 0, CTL_ZERO_BYTES, st); }
inline void mk_launch(void* const* d_in, void* d_out, void* d_ws, hipStream_t st, int lo, int hi, int li = 0) {
    if (!mk_setup()) return;
    Params p{}; for (int i = 0; i < 29; ++i) p.in[i] = (const float*)d_in[i]; p.out = (float*)d_out; p.ws = (unsigned char*)d_ws; p.ph_lo = lo; p.ph_hi = hi; p.li = li;
    hipLaunchKernelGGL(mk_fwd, dim3(g_grid), dim3(NTHR), LDS_BYTES, st, p);
}
}
extern "C" void kernel_launch(void* const* d_in, const int* in_sizes, int n_in, void* d_out, int out_size, void* d_ws, size_t ws_size, hipStream_t stream) {
    fx::mk_zero_ctl(d_ws, stream);
    fx::mk_launch(d_in, d_out, d_ws, stream, 0, 22, 0);
}
```

```cpp
#include <hip/hip_runtime.h>
#include <hip/hip_bf16.h>
#include <cstdio>
#include <cstdint>
#include <cmath>
namespace fx {
constexpr int BATCH = 8, SEQ = 4096, DM = 1024, M = BATCH * SEQ, NZ = 3072, NIN = 2950;
constexpr int NWAVES = 8, NTHR = 512;
constexpr float LOG2E = 1.4426950408889634f;
constexpr float C2 = 0.125f * LOG2E;
constexpr int ZC_FQ = 0, ZC_FK = 384, ZC_FV = 768, ZC_SU = 1152, ZC_HQ = 1408, ZC_HF = 1792, ZC_HI = 2176, ZC_HG = 2560, ZC_FF = 2944;
constexpr size_t MiB = 1u << 20;
constexpr size_t WS_CTL = 0, CTL_ZERO_BYTES = 1 * MiB;
constexpr size_t WS_MOD = 1 * MiB;
constexpr size_t WS_LB = WS_MOD + 512 * 1024;
constexpr size_t WS_S5AL = WS_LB + 4096;
constexpr size_t WS_NLF = 2 * MiB;
constexpr size_t WS_G = WS_NLF + 48 * 4096 * 4;
constexpr size_t WS_KN = WS_G + 48 * 4096 * 4;
constexpr size_t WS_QN = WS_KN + 48 * 64 * 4;
constexpr size_t WS_WIN = 4 * MiB;
constexpr size_t WS_WOUT = WS_WIN + 2ull * 3072 * 1024 * 2;
constexpr size_t WS_W1 = WS_WOUT + 2ull * 1024 * 1024 * 2;
constexpr size_t WS_W2 = WS_W1 + 2ull * 8192 * 1024 * 2;
constexpr size_t WS_GLU = WS_W2 + 2ull * 1024 * 4096 * 2;
constexpr size_t WS_S5WO = WS_GLU + 2ull * 256 * 256 * 2;
constexpr size_t WS_S5WL = WS_S5WO + 2ull * 16 * 256 * 384 * 2;
constexpr size_t WS_H = 80 * MiB;
constexpr size_t WS_Z = WS_H + (size_t)M * 1024 * 2;
constexpr size_t WS_UP = WS_Z + (size_t)M * NZ * 2;
constexpr size_t WS_LOC = WS_UP + 16ull * 2048 * 384 * 2;
constexpr size_t WS_Y = WS_LOC + 16ull * 2048 * 128 * 4;
constexpr size_t WS_HLOC = WS_Y + (size_t)M * 256 * 2;
constexpr size_t WS_XB = WS_HLOC + 16 * MiB;
constexpr size_t WS_END = WS_XB + (size_t)M * 1024 * 2;
static_assert(WS_S5WL + 2ull * 16 * 256 * 256 * 2 <= WS_H, "weights fit below H");
static_assert(WS_QN + 48 * 16 * 4 <= WS_WIN, "norm tables fit below the weights");
static_assert(WS_END <= 512 * MiB, "workspace fits 512 MiB");

#define GAS __attribute__((address_space(1)))
#define LAS __attribute__((address_space(3)))
typedef unsigned short bf16;
typedef unsigned v4u __attribute__((ext_vector_type(4)));
typedef unsigned v2u __attribute__((ext_vector_type(2)));
typedef float f32x4 __attribute__((ext_vector_type(4)));
typedef GAS unsigned gu32;
#define RLX_AGENT __ATOMIC_RELAXED, __HIP_MEMORY_SCOPE_AGENT
#define LDS_WAIT() asm volatile("s_waitcnt lgkmcnt(0)" ::: "memory")
#define VM_WAIT() asm volatile("s_waitcnt vmcnt(0)" ::: "memory")
__device__ __forceinline__ unsigned f2bf(float f) { unsigned u = __builtin_bit_cast(unsigned, f); return (u + 0x7fffu + ((u >> 16) & 1u)) >> 16; }
__device__ __forceinline__ unsigned pk2(float lo, float hi) { return f2bf(lo) | (f2bf(hi) << 16); }
__device__ __forceinline__ float bf2f(unsigned short h) { return __builtin_bit_cast(float, (unsigned)h << 16); }
__device__ __forceinline__ float bflo(unsigned w) { return __builtin_bit_cast(float, w << 16); }
__device__ __forceinline__ float bfhi(unsigned w) { return __builtin_bit_cast(float, w & 0xffff0000u); }
__device__ __forceinline__ float fsigmoid(float x) { return __builtin_amdgcn_rcpf(1.f + __builtin_amdgcn_exp2f(-LOG2E * x)); }
__device__ __forceinline__ float fsilu(float x) { return x * fsigmoid(x); }
__device__ __forceinline__ float lane_get(float v, int src_lane) { return __builtin_bit_cast(float, __builtin_amdgcn_ds_bpermute(src_lane << 2, __builtin_bit_cast(int, v))); }
__device__ __forceinline__ float wave_sum(float v, int  ) {
    v += __builtin_bit_cast(float, __builtin_amdgcn_update_dpp(0, __builtin_bit_cast(int, v), 0xB1, 0xF, 0xF, false));
    v += __builtin_bit_cast(float, __builtin_amdgcn_update_dpp(0, __builtin_bit_cast(int, v), 0x4E, 0xF, 0xF, false));
    v += __builtin_bit_cast(float, __builtin_amdgcn_update_dpp(0, __builtin_bit_cast(int, v), 0x141, 0xF, 0xF, false));
    v += __builtin_bit_cast(float, __builtin_amdgcn_update_dpp(0, __builtin_bit_cast(int, v), 0x140, 0xF, 0xF, false));
    v += __builtin_bit_cast(float, __builtin_amdgcn_update_dpp(0, __builtin_bit_cast(int, v), 0x142, 0xA, 0xF, false));
    v += __builtin_bit_cast(float, __builtin_amdgcn_update_dpp(0, __builtin_bit_cast(int, v), 0x143, 0xC, 0xF, false));
    return __builtin_bit_cast(float, __builtin_amdgcn_readlane(__builtin_bit_cast(int, v), 63));
}

__device__ __forceinline__ int lane_now() { int z = 0; asm volatile("" : "+v"(z)); return (int)__builtin_amdgcn_mbcnt_hi(~0u, __builtin_amdgcn_mbcnt_lo(~0u, (unsigned)z)); }

struct Params {
    const float* in[29]; float* out; unsigned char* ws; int ph_lo, ph_hi, li, pad;
};
enum { I_X = 0, I_C, I_ADAW, I_ADAB, I_NMW, I_NFW, I_WIN, I_FOXB, I_ARE, I_AIM, I_BRE, I_BIM, I_CRE, I_CIM, I_S5D, I_LOGDT, I_GLUW, I_GLUB, I_LBL, I_HNW, I_BNF, I_BNS, I_WOUT, I_RW, I_RB, I_WG, I_WU, I_WD, I_FINW };

__device__ __forceinline__ void transpose_item(const float* src, int ld_src, int c0, int nvalid, bf16* dst, int ldd, int k0, LAS float* scr, int lane) {
#pragma unroll 8
    for (int i = 0; i < 32; ++i) { const int kk = 2 * i + (lane >> 5), n = lane & 31; scr[kk * 33 + n] = (n < nvalid) ? src[(size_t)(k0 + kk) * ld_src + c0 + n] : 0.f; }
    LDS_WAIT(); asm volatile("" ::: "memory");
    const int c = lane & 7;
#pragma unroll
    for (int j = 0; j < 4; ++j) { const int n = (lane >> 3) + 8 * j; const LAS float* s = scr + (8 * c) * 33 + n;
        v4u o; o.x = pk2(s[0 * 33], s[1 * 33]); o.y = pk2(s[2 * 33], s[3 * 33]); o.z = pk2(s[4 * 33], s[5 * 33]); o.w = pk2(s[6 * 33], s[7 * 33]);
        *(GAS v4u*)(dst + (size_t)n * ldd + k0 + 8 * c) = o; }
    LDS_WAIT(); asm volatile("" ::: "memory");
}
__device__ __forceinline__ int win_src_col(int n) {
    if (n < 1152) return n;
    if (n < 1408) return 1158 + (n - 1152);
    if (n < 2944) return 1414 + (n - 1408);
    if (n < 2950) return 1152 + (n - 2944);
    return -1;
}
__device__ __forceinline__ void prologue_wave_items(const Params& p, int oz, LAS float* scr, int gw, int ngw, int lane) {
    unsigned char* ws = p.ws + oz;
    constexpr int IT_WIN = 2 * 16 * 96, IT_WOUT = 2 * 16 * 32, IT_W1 = 2 * 16 * 256, IT_W2 = 2 * 64 * 32, IT_GLU = 2 * 4 * 8;
    constexpr int NITEMS = IT_WIN + IT_WOUT + IT_W1 + IT_W2 + IT_GLU;
    for (int it = gw; it < NITEMS; it += ngw) {
        int r = it;
        if (r < IT_WIN) { const int l = r / (16 * 96), q = r % (16 * 96), kb = q / 96, nb = q % 96, n0 = nb * 32; const int sc = win_src_col(n0);
            int nvalid = 32; if (sc < 0) nvalid = 0; else if (n0 == 2944) nvalid = 6;
            transpose_item(p.in[I_WIN + oz] + (size_t)l * 1024 * NIN, NIN, sc < 0 ? 0 : sc, nvalid, (bf16*)(ws + WS_WIN) + ((size_t)l * 3072 + n0) * 1024, 1024, kb * 64, scr, lane); continue; }
        r -= IT_WIN;
        if (r < IT_WOUT) { const int l = r / (16 * 32), q = r % (16 * 32), kb = q / 32, nb = q % 32;
            transpose_item(p.in[I_WOUT + oz] + (size_t)l * 1024 * 1024, 1024, nb * 32, 32, (bf16*)(ws + WS_WOUT) + ((size_t)l * 1024 + nb * 32) * 1024, 1024, kb * 64, scr, lane); continue; }
        r -= IT_WOUT;
        if (r < IT_W1) {
            const int l = r / (16 * 256), q = r % (16 * 256), kb = q / 256, nb = q % 256, n0 = nb * 32; const int e = n0 / 512, j = (n0 % 512) / 256, w = n0 % 256; const bool up = w >= 128; const int f0 = j * 128 + (w % 128);
            const float* src = (up ? p.in[I_WU + oz] : p.in[I_WG + oz]) + ((size_t)l * 16 + e) * 1024 * 256;
            transpose_item(src, 256, f0, 32, (bf16*)(ws + WS_W1) + ((size_t)l * 8192 + n0) * 1024, 1024, kb * 64, scr, lane); continue; }
        r -= IT_W1;
        if (r < IT_W2) { const int l = r / (64 * 32), q = r % (64 * 32), kb = q / 32, nb = q % 32;
            transpose_item(p.in[I_WD + oz] + (size_t)l * 4096 * 1024, 1024, nb * 32, 32, (bf16*)(ws + WS_W2) + ((size_t)l * 1024 + nb * 32) * 4096, 4096, kb * 64, scr, lane); continue; }
        r -= IT_W2;
        { const int l = r / 32, q = r % 32, kb = q / 8, nb = q % 8;
            transpose_item(p.in[I_GLUW + oz] + (size_t)l * 65536, 256, nb * 32, 32, (bf16*)(ws + WS_GLU) + ((size_t)l * 256 + nb * 32) * 256, 256, kb * 64, scr, lane); }
    }
    if (gw == 0) { float* lb = (float*)(ws + WS_LB); for (int j = lane; j < 384; j += 64) { const float a = p.in[I_LBL + oz][j], b = p.in[I_LBL + oz][384 + j], m = fmaxf(a, b), ea = __expf(a - m), eb = __expf(b - m); lb[j] = 0.f; lb[384 + j] = eb / (ea + eb); } }
}
__device__ __forceinline__ void prologue_mod_item(const Params& p, int oz, int item, LAS float* lds, int tid, int lane, int wave) {
    LAS float* cact = lds; LAS float* part = lds + 8192;
    const int l = item / 96, nb = item % 96, n = nb * 64 + lane; const float* W = p.in[I_ADAW + oz] + ((size_t)l * 1024 + wave * 128) * 6144 + n;
    float acc[8];
#pragma unroll
    for (int b = 0; b < 8; ++b) acc[b] = 0.f;
    for (int k0 = 0; k0 < 128; k0 += 16) { float w[16];
#pragma unroll
        for (int u = 0; u < 16; ++u) w[u] = W[(size_t)(k0 + u) * 6144];
#pragma unroll
        for (int u = 0; u < 16; ++u)
#pragma unroll
            for (int b = 0; b < 8; ++b) acc[b] += cact[b * 1024 + wave * 128 + k0 + u] * w[u]; }
#pragma unroll
    for (int b = 0; b < 8; ++b) part[(wave * 8 + b) * 64 + lane] = acc[b];
    __syncthreads();
    { const int b = tid >> 6; float s = 0.f;
#pragma unroll
        for (int w = 0; w < 8; ++w) s += part[(w * 8 + b) * 64 + lane];
        ((float*)(p.ws + oz + WS_MOD))[(l * 8 + b) * 6144 + n] = s + p.in[I_ADAB + oz][l * 6144 + n]; }
    __syncthreads();
}
__device__ __forceinline__ void prologue_s5_item(const Params& p, int oz, int l, int g, LAS float* lds, int tid) {
    LAS float* apr = lds;
    LAS float* api = lds + 17 * 64;
    LAS float* bbr = lds + 34 * 64;
    LAS float* bbi = bbr + 1024;
    LAS float* ccr = bbi + 1024;
    LAS float* cci = ccr + 1024;
    LAS float* Kt = cci + 1024;
    unsigned char* ws = p.ws + oz;
    if (tid < 64) { const int q = tid; const float dt = __expf(p.in[I_LOGDT + oz][l * 16 + g]); const float lr = p.in[I_ARE + oz][(l * 16 + g) * 64 + q], li = p.in[I_AIM + oz][(l * 16 + g) * 64 + q];
        for (int tau = 0; tau <= 16; ++tau) { const float er = expf(lr * dt * tau); float sn, cs; sincosf(li * dt * tau, &sn, &cs); apr[tau * 64 + q] = er * cs; api[tau * 64 + q] = er * sn; }
        const float ar = apr[64 + q], ai = api[64 + q]; const float nr = ar - 1.f, ni = ai, den = lr * lr + li * li; const float fr = (nr * lr + ni * li) / den, fi = (ni * lr - nr * li) / den;
        for (int c = 0; c < 16; ++c) { const float br = p.in[I_BRE + oz][((l * 16 + g) * 64 + q) * 16 + c], bi = p.in[I_BIM + oz][((l * 16 + g) * 64 + q) * 16 + c]; bbr[q * 16 + c] = fr * br - fi * bi; bbi[q * 16 + c] = fr * bi + fi * br;
            ccr[c * 64 + q] = p.in[I_CRE + oz][((l * 16 + g) * 16 + c) * 64 + q]; cci[c * 64 + q] = p.in[I_CIM + oz][((l * 16 + g) * 16 + c) * 64 + q]; }
        float* al = (float*)(ws + WS_S5AL) + ((l * 16 + g) * 64 + q) * 2; al[0] = apr[16 * 64 + q]; al[1] = api[16 * 64 + q];
    }
    __syncthreads();
    for (int idx = tid; idx < 4096; idx += NTHR) { const int tau = idx >> 8, c = (idx >> 4) & 15, c2 = idx & 15; float acc = 0.f;
        for (int q = 0; q < 64; ++q) { const float mr = ccr[c * 64 + q] * apr[tau * 64 + q] - cci[c * 64 + q] * api[tau * 64 + q], mi = ccr[c * 64 + q] * api[tau * 64 + q] + cci[c * 64 + q] * apr[tau * 64 + q];
            acc += mr * bbr[q * 16 + c2] - mi * bbi[q * 16 + c2]; }
        if (tau == 0 && c == c2) acc += p.in[I_S5D + oz][(l * 16 + g) * 16 + c];
        Kt[idx] = acc; }
    __syncthreads();
    bf16* WO = (bf16*)(ws + WS_S5WO) + (size_t)(l * 16 + g) * 256 * 384; bf16* WL = (bf16*)(ws + WS_S5WL) + (size_t)(l * 16 + g) * 256 * 256;
    for (int ch = tid; ch < 256 * 48; ch += NTHR) { const int n = ch / 48, k0 = (ch % 48) * 8, j = n >> 4, c = n & 15; float v[8];
#pragma unroll
        for (int e = 0; e < 8; ++e) { const int k = k0 + e; float val;
            if (k < 256) { const int i = k >> 4, c2 = k & 15; val = (j >= i) ? Kt[((j - i) << 8) + (c << 4) + c2] : 0.f; }
            else { const int q = (k - 256) & 63; const float pr = apr[(j + 1) * 64 + q], pi = api[(j + 1) * 64 + q], cr = ccr[c * 64 + q], ci = cci[c * 64 + q];
                val = (k - 256 < 64) ? (cr * pr - ci * pi) : -(cr * pi + ci * pr); }
            v[e] = val; }
        v4u o; o.x = pk2(v[0], v[1]); o.y = pk2(v[2], v[3]); o.z = pk2(v[4], v[5]); o.w = pk2(v[6], v[7]);
        *(GAS v4u*)(WO + (size_t)n * 384 + k0) = o; }
    for (int ch = tid; ch < 256 * 32; ch += NTHR) { const int n = ch / 32, k0 = (ch % 32) * 8; float v[8];
#pragma unroll
        for (int e = 0; e < 8; ++e) { const int k = k0 + e, i = k >> 4, c2 = k & 15; float val = 0.f;
            if (n < 128) { const int q = n & 63; const float pr = apr[(15 - i) * 64 + q], pi = api[(15 - i) * 64 + q], br = bbr[q * 16 + c2], bi = bbi[q * 16 + c2]; val = (n < 64) ? (pr * br - pi * bi) : (pr * bi + pi * br); }
            v[e] = val; }
        v4u o; o.x = pk2(v[0], v[1]); o.y = pk2(v[2], v[3]); o.z = pk2(v[4], v[5]); o.w = pk2(v[6], v[7]);
        *(GAS v4u*)(WL + (size_t)n * 256 + k0) = o; }
    __syncthreads();
}
__device__ __forceinline__ void row_load(const float* X, int m, int lane, f32x4 (&v)[4]) { const GAS f32x4* xr = (const GAS f32x4*)(X + (size_t)m * 1024) + lane;
#pragma unroll
    for (int j = 0; j < 4; ++j) v[j] = xr[64 * j]; }
__device__ __forceinline__ void row_load_bf(const bf16* X, int m, int lane, f32x4 (&v)[4]) { const GAS v2u* xr = (const GAS v2u*)(X + (size_t)m * 1024) + lane;
#pragma unroll
    for (int j = 0; j < 4; ++j) { const v2u w = xr[64 * j]; v[j] = (f32x4){bflo(w.x), bfhi(w.x), bflo(w.y), bfhi(w.y)}; } }
__device__ __forceinline__ void adaln_factors(const float* w, const float* sh, const float* sc, int lane, f32x4 (&A)[4], f32x4 (&B)[4]) {
#pragma unroll
    for (int j = 0; j < 4; ++j) { const f32x4 ww = ((const GAS f32x4*)w)[lane + 64 * j], a = ((const GAS f32x4*)sc)[lane + 64 * j]; A[j] = ww * (a + 1.f); B[j] = ((const GAS f32x4*)sh)[lane + 64 * j]; } }
__device__ __forceinline__ void norm_row_to_bf16(f32x4 (&v)[4], const f32x4 (&A)[4], const f32x4 (&B)[4], bf16* orow, int lane) {
    float s = 0.f;
#pragma unroll
    for (int j = 0; j < 4; ++j) s += (v[j].x * v[j].x + v[j].y * v[j].y) + (v[j].z * v[j].z + v[j].w * v[j].w);
    const float rstd = __builtin_amdgcn_rsqf(wave_sum(s, lane) * (1.f / 1024.f) + 1e-6f);
    GAS unsigned long long* o8 = (GAS unsigned long long*)orow + lane;
#pragma unroll
    for (int j = 0; j < 4; ++j) { const f32x4 h = (v[j] * rstd) * A[j] + B[j]; v[j] = h;
        o8[64 * j] = (unsigned long long)pk2(h.x, h.y) | ((unsigned long long)pk2(h.z, h.w) << 32); }
}
}
namespace fx {
#define XB_TMO      128
#define XB_XCNT(j)  (256  + 64 * (j))
#define XB_XSUB(j)  (1280 + 64 * (j))
#define XB_XGEN(j)  (2304 + 64 * (j))
#define XB_TOP      3328
#define XB_TOPGEN   3392
#define XCD_BAR_WORDS 3456
#define XB_SPIN_CAP (1u << 18)

__device__ __forceinline__ unsigned xb_ld(unsigned* p)              { return __hip_atomic_load(p, __ATOMIC_RELAXED, __HIP_MEMORY_SCOPE_AGENT); }
__device__ __forceinline__ unsigned xb_add(unsigned* p, unsigned v) { return __hip_atomic_fetch_add(p, v, __ATOMIC_RELAXED, __HIP_MEMORY_SCOPE_AGENT); }
__device__ __forceinline__ unsigned xb_xcc_id() { return (unsigned)__builtin_amdgcn_s_getreg((3 << 11) | 20) & 0xFu; }
#define XB_SPIN(cond, bar) do { unsigned _sp = 0; while (cond) { __builtin_amdgcn_s_sleep(1); \
    if ((++_sp & 255u) == 0u) { if (xb_ld(&(bar)[XB_TMO])) break; if (_sp > XB_SPIN_CAP) { atomicAdd(&(bar)[XB_TMO], 1u); break; } } } } while (0)

struct XcdBarrier {
    unsigned* bar; unsigned x;
    volatile LAS unsigned* st;
};

__device__ __forceinline__ XcdBarrier xcd_barrier_post(unsigned* bar, volatile LAS unsigned* st, bool leader) {
    XcdBarrier b; b.bar = bar; b.x = xb_xcc_id(); b.st = st;
    if (leader) (void)xb_add(&bar[XB_XCNT(b.x)], 1u);
    return b;
}
__device__ __forceinline__ void xcd_barrier_complete(unsigned* bar, unsigned x, unsigned& nloc, unsigned& nx) {
    const unsigned G = gridDim.x * gridDim.y * gridDim.z;
    asm volatile("" : "+s"(x));
    unsigned sum, cnt, mine, sp = 0u;
    for (;;) {
        sum = 0u; cnt = 0u; mine = 0u;
#pragma unroll
        for (unsigned j = 0; j < 16; ++j) { const unsigned c = xb_ld(&bar[XB_XCNT(j)]); sum += c; cnt += (c > 0u) ? 1u : 0u; mine = (j == x) ? c : mine; }
        if (sum == G) break;
        __builtin_amdgcn_s_sleep(1);
        if ((++sp & 255u) == 0u) { if (xb_ld(&bar[XB_TMO])) break; if (sp > XB_SPIN_CAP) { atomicAdd(&bar[XB_TMO], 1u); break; } }
    }
    nloc = mine > 0u ? mine : 1u; nx = cnt > 0u ? cnt : 1u;
}

__device__ __forceinline__ void xcd_barrier(const XcdBarrier& b, bool leader) {
    asm volatile("s_waitcnt vmcnt(0)" ::: "memory");
    __syncthreads();
    if (leader) {
        unsigned* bar = b.bar;
        __builtin_amdgcn_s_waitcnt(0);
        unsigned nloc = b.st[0], nx = b.st[1];
        if (nloc == 0u) { xcd_barrier_complete(bar, b.x, nloc, nx); b.st[0] = nloc; b.st[1] = nx; }
        const unsigned old = xb_add(&bar[XB_XSUB(b.x)], 1u);
        const unsigned gen = old / nloc;
        if (old + 1u == (gen + 1u) * nloc) {
            __builtin_amdgcn_fence(__ATOMIC_RELEASE, "agent");
            asm volatile("s_waitcnt vmcnt(0)" ::: "memory");
            const unsigned og = xb_add(&bar[XB_TOP], 1u);
            const unsigned tg = og / nx;
            if (og + 1u == (tg + 1u) * nx) xb_add(&bar[XB_TOPGEN], 1u);
            else XB_SPIN(xb_ld(&bar[XB_TOPGEN]) == tg, bar);
            __builtin_amdgcn_fence(__ATOMIC_ACQUIRE, "agent");
            xb_add(&bar[XB_XGEN(b.x)], 1u);
            asm volatile("s_waitcnt vmcnt(0)" ::: "memory");
        } else {
            XB_SPIN(xb_ld(&bar[XB_XGEN(b.x)]) == gen, bar);
            __builtin_amdgcn_fence(__ATOMIC_ACQUIRE, "agent");
            asm volatile("s_waitcnt vmcnt(0)" ::: "memory");
        }
    }
    __syncthreads();
}

}
namespace pg8 {
#define PG8_LAS __attribute__((address_space(3)))
typedef unsigned short bf16_t;
typedef short bf16x8 __attribute__((ext_vector_type(8)));
typedef float f32x4 __attribute__((ext_vector_type(4)));
typedef unsigned u32x4 __attribute__((ext_vector_type(4)));
constexpr int BM = 256, BK = 64, HALF = 128, HTB = HALF * BK * 2  , STAGE_BYTES = 8 * HTB, NXCD = 8, WGM = 8;

__host__ __device__ __forceinline__ int lds_byte(int r, int c) { const int st = (r >> 4) * 2 + (c >> 5), rr = r & 15, cc = c & 31, ob = rr * 64 + cc * 2; return st * 1024 + (ob ^ (((ob >> 9) & 1) << 5)); }
__host__ __device__ __forceinline__ void stage_rc(int b, int& R, int& C) { const int st = b / 1024, sb = b % 1024, swz = sb ^ (((sb >> 9) & 1) << 5); R = (st >> 1) * 16 + swz / 64; C = (st & 1) * 32 + (swz % 64) / 2; }
__host__ __device__ __forceinline__ int perm32(int rho) { const int n = rho >> 4, i = rho & 15; return 8 * (i >> 2) + 4 * n + (i & 3); }

struct Unit { int pm, pn; int k0, k1; };
struct Gemm { const bf16_t* A; const bf16_t* Bt; int M, N, K, lda, ldb; };

struct StaticOrder {
    int nM, nN, nwg, G, c;
    __host__ __device__ void init(int M, int N, int G_, int c_) { nM = M / BM; nN = N / BM; nwg = nM * nN; G = G_; c = c_; }
    __host__ __device__ bool next(int i, Unit& u) const {
        const long L = (long)i * G + c; if (L >= nwg) return false;
        int wgid = (int)L; { const int q = nwg / NXCD, r = nwg % NXCD, xcd = wgid % NXCD, off = wgid / NXCD; wgid = (xcd < r ? xcd * (q + 1) : r * (q + 1) + (xcd - r) * q) + off; }
        const int nig = WGM * nN, gid = wgid / nig, fm = gid * WGM, gsz = (nM - fm) < WGM ? (nM - fm) : WGM;
        u.pm = fm + ((wgid % nig) % gsz); u.pn = (wgid % nig) / gsz; return true;
    }
    __device__ __forceinline__ void a_ready(const Unit&) const {}
    __device__ __forceinline__ void done(const Unit&) const {}
};

__device__ __forceinline__ unsigned cvt_pk_bf16(float lo, float hi) { unsigned r; asm volatile("v_cvt_pk_bf16_f32 %0, %1, %2" : "=v"(r) : "v"(lo), "v"(hi)); return r; }
typedef float f32x2 __attribute__((ext_vector_type(2)));
__device__ __forceinline__ f32x2 gelu_pk(f32x2 v) {
    const f32x2 av = __builtin_elementwise_abs(v), d = av * 0.2316418882f + 1.0f;
    f32x2 t; t.x = __builtin_amdgcn_rcpf(d.x); t.y = __builtin_amdgcn_rcpf(d.y);
    f32x2 q = t * 0.5307027145f + (-0.7265760135f); q = q * t + 0.7107068705f; q = q * t + (-0.142248368f); q = q * t + 0.127414796f; q = q * t;
    const f32x2 s = (v * v) * (-0.72134752044f);
    f32x2 e; e.x = __builtin_amdgcn_exp2f(s.x); e.y = __builtin_amdgcn_exp2f(s.y);
    const f32x2 m = v * (q * e), r = v - m;
    f32x2 o; o.x = v.x < 0.f ? m.x : r.x; o.y = v.y < 0.f ? m.y : r.y; return o;
}

template <int ACT  > struct EpiBf16 {
    static constexpr bool PERM = true, AFTER_DRAIN = false; static_assert(ACT == 0 || ACT == 1, "EpiBf16: ACT is 0 (none) or 1 (gelu_pk)");
    bf16_t* O; int ldc; const float* bias; int split_cols; size_t split_stride; float scale0;
    __device__ __forceinline__ void operator()(const f32x4 (&acc)[2][2][4][2], const Unit& u, int wr, int wc, int fr, int fq) const {
        const int row0 = u.pm * BM + wr * 64 + fr; int colt = u.pn * BM; bf16_t* base = O;
        float sc = 1.f; if (split_cols) { const int t = colt / split_cols; base += (size_t)t * split_stride; colt -= t * split_cols; if (t == 0) sc = scale0; }
        const int col0 = colt + wc * 32 + 8 * fq, bcol0 = u.pn * BM + wc * 32 + 8 * fq;
        f32x4 bv[2][2];
#pragma unroll
        for (int bj = 0; bj < 2; ++bj)
#pragma unroll
            for (int n = 0; n < 2; ++n) bv[bj][n] = bias ? *(const f32x4*)(bias + bcol0 + bj * HALF + 4 * n) : (f32x4){0.f, 0.f, 0.f, 0.f};
#pragma unroll
        for (int ai = 0; ai < 2; ++ai)
#pragma unroll
            for (int m = 0; m < 4; ++m) { bf16_t* rowp = base + (size_t)(row0 + ai * HALF + m * 16) * ldc + col0;
#pragma unroll
                for (int bj = 0; bj < 2; ++bj) { f32x4 v0 = acc[ai][bj][m][0] + bv[bj][0], v1 = acc[ai][bj][m][1] + bv[bj][1];
                    if (ACT == 1) { f32x2 a = gelu_pk((f32x2){v0[0], v0[1]}), b = gelu_pk((f32x2){v0[2], v0[3]}), c = gelu_pk((f32x2){v1[0], v1[1]}), d = gelu_pk((f32x2){v1[2], v1[3]});
                        v0 = (f32x4){a.x, a.y, b.x, b.y}; v1 = (f32x4){c.x, c.y, d.x, d.y}; }
                    v0 = v0 * sc; v1 = v1 * sc; u32x4 w; w.x = cvt_pk_bf16(v0[0], v0[1]); w.y = cvt_pk_bf16(v0[2], v0[3]); w.z = cvt_pk_bf16(v1[0], v1[1]); w.w = cvt_pk_bf16(v1[2], v1[3]);
                    *(u32x4*)(rowp + bj * HALF) = w; } }
    }
};

struct PanelStats {
    unsigned* xbuf;
    unsigned* cnt;
    unsigned* tmo;
    int ntn; float eps;
    unsigned code;
    __device__ __forceinline__ bool run(const f32x4 (&v)[2][2][4][2], const Unit& u, int wr, int wc, int fr, int fq, PG8_LAS unsigned char* lds, int wid, int lane) const {
        typedef float f32x2v __attribute__((ext_vector_type(2)));
        PG8_LAS f32x2v* P = (PG8_LAS f32x2v*)lds;
        PG8_LAS f32x2v* S = (PG8_LAS f32x2v*)(lds + 8192);
        PG8_LAS unsigned* flag = (PG8_LAS unsigned*)(lds + 8192 + 2048);
#pragma unroll
        for (int ai = 0; ai < 2; ++ai)
#pragma unroll
            for (int m = 0; m < 4; ++m) {
                float s = 0.f;
#pragma unroll
                for (int bj = 0; bj < 2; ++bj)
#pragma unroll
                    for (int n = 0; n < 2; ++n) { const f32x4 x = v[ai][bj][m][n]; s += (x[0] + x[1]) + (x[2] + x[3]); }
                s += __shfl_xor(s, 16); s += __shfl_xor(s, 32);
                const float mw = s * (1.0f / 64.0f); float q = 0.f;
#pragma unroll
                for (int bj = 0; bj < 2; ++bj)
#pragma unroll
                    for (int n = 0; n < 2; ++n) { const f32x4 d = v[ai][bj][m][n] - mw; q += (d[0] * d[0] + d[1] * d[1]) + (d[2] * d[2] + d[3] * d[3]); }
                q += __shfl_xor(q, 16); q += __shfl_xor(q, 32);
                if (fq == 0) P[(ai * HALF + wr * 64 + m * 16 + fr) * 4 + wc] = (f32x2v){mw, q};
            }
        asm volatile("s_waitcnt lgkmcnt(0)" ::: "memory"); __builtin_amdgcn_s_barrier(); asm volatile("" ::: "memory");
#if defined(BROKEN_EXCHANGE_NO_WAIT)
#warning BROKEN CONTROL BUILD: the row-statistics exchange does not wait; results are wrong by design
        if (blockIdx.x >= 64) { const long long t0_ = clock64(); while (clock64() - t0_ < 60000) __builtin_amdgcn_s_sleep(8); }
#endif
        const int row = wid * 32 + (lane & 31);
        if (lane < 32) {
            const f32x2v a = P[row * 4 + 0], b = P[row * 4 + 1], c = P[row * 4 + 2], d = P[row * 4 + 3];
            const float mt = (a.x + b.x + c.x + d.x) * 0.25f;
            const float da = a.x - mt, db = b.x - mt, dc = c.x - mt, dd = d.x - mt;
            const float m2 = (a.y + b.y) + (c.y + d.y) + 64.0f * ((da * da + db * db) + (dc * dc + dd * dd));
            unsigned long long* slot = (unsigned long long*)xbuf + ((size_t)(u.pm * BM + row) * 4 + u.pn);
            __hip_atomic_store(slot, ((unsigned long long)__float_as_uint(m2) << 32) | __float_as_uint(mt), __ATOMIC_RELAXED, __HIP_MEMORY_SCOPE_AGENT);
        }
        asm volatile("s_waitcnt vmcnt(0)" ::: "memory");
        if (lane == 0) __hip_atomic_fetch_add(cnt + 64 * u.pm, 1u, __ATOMIC_RELAXED, __HIP_MEMORY_SCOPE_AGENT);
        if (wid == 0) {
            bool dead = false; const unsigned long long t0 = __builtin_amdgcn_s_memrealtime(); const unsigned want = 8u * (unsigned)ntn;
            for (;;) {
#if defined(BROKEN_EXCHANGE_NO_WAIT)
                break;
#endif
                if ((unsigned)__builtin_amdgcn_readfirstlane(__hip_atomic_load(cnt + 64 * u.pm, __ATOMIC_RELAXED, __HIP_MEMORY_SCOPE_AGENT)) >= want) break;
                if (__builtin_amdgcn_s_memrealtime() - t0 > 2000000ull) {
                    if (lane == 0) { unsigned expect = 0u; __hip_atomic_compare_exchange_strong(tmo + 1, &expect, code | (unsigned)(u.pm & 0xff), __ATOMIC_RELAXED, __ATOMIC_RELAXED, __HIP_MEMORY_SCOPE_AGENT);
                                     __hip_atomic_store(tmo, 1u, __ATOMIC_RELAXED, __HIP_MEMORY_SCOPE_AGENT); }
                    dead = true; break; }
                __builtin_amdgcn_s_sleep(2);
            }
            __builtin_amdgcn_fence(__ATOMIC_ACQUIRE, "agent");
            if (lane == 0) flag[0] = dead ? 1u : 0u;
        }
        asm volatile("s_waitcnt vmcnt(0) lgkmcnt(0)" ::: "memory"); __builtin_amdgcn_s_barrier(); asm volatile("" ::: "memory");
        const bool bad = flag[0] != 0u;
        if (lane < 32) {
            const unsigned long long* slot = (const unsigned long long*)xbuf + (size_t)(u.pm * BM + row) * 4; float mt[4], m2[4]; float ms = 0.f;
#pragma unroll
            for (int t = 0; t < 4; ++t) { if (t < ntn) { const unsigned long long w = __hip_atomic_load(slot + t, __ATOMIC_RELAXED, __HIP_MEMORY_SCOPE_AGENT); mt[t] = __uint_as_float((unsigned)w); m2[t] = __uint_as_float((unsigned)(w >> 32)); } else { mt[t] = 0.f; m2[t] = 0.f; } ms += mt[t]; }
            const float mean = ms / (float)ntn; float q = 0.f;
#pragma unroll
            for (int t = 0; t < 4; ++t) if (t < ntn) { const float dm = mt[t] - mean; q += m2[t] + 256.0f * dm * dm; }
            S[row] = (f32x2v){mean, 1.0f / sqrtf(q / (256.0f * (float)ntn) + eps)};
        }
        asm volatile("s_waitcnt lgkmcnt(0)" ::: "memory"); __builtin_amdgcn_s_barrier(); asm volatile("" ::: "memory");
        return bad;
    }
};
struct EpiLnRes {
    static constexpr bool PERM = false, AFTER_DRAIN = true;
    const float* base; float* out; int ldc; const float* bias; PanelStats st; unsigned poison;
    __device__ __forceinline__ void fused(f32x4 (&acc)[2][2][4][2], const Unit& u, int wr, int wc, int fr, int fq, PG8_LAS unsigned char* lds, int wid, int lane) const {
        typedef float f32x2v __attribute__((ext_vector_type(2)));
        const PG8_LAS f32x2v* S = (const PG8_LAS f32x2v*)(lds + 8192);
        const int col0 = u.pn * BM + wc * 32 + 4 * fq;
#pragma unroll
        for (int bj = 0; bj < 2; ++bj)
#pragma unroll
            for (int n = 0; n < 2; ++n) { const f32x4 bv = bias ? *(const f32x4*)(bias + col0 + bj * HALF + n * 16) : (f32x4){0.f, 0.f, 0.f, 0.f};
#pragma unroll
                for (int ai = 0; ai < 2; ++ai)
#pragma unroll
                    for (int m = 0; m < 4; ++m) acc[ai][bj][m][n] += bv; }
        f32x4 pre[4][2][2];
#pragma unroll
        for (int m = 0; m < 4; ++m) { const size_t off = (size_t)(u.pm * BM + wr * 64 + m * 16 + fr) * ldc + col0;
#pragma unroll
            for (int bj = 0; bj < 2; ++bj)
#pragma unroll
                for (int n = 0; n < 2; ++n) pre[m][bj][n] = *(const f32x4*)(base + off + bj * HALF + n * 16); }
        const bool bad = st.run(acc, u, wr, wc, fr, fq, lds, wid, lane) || poison != 0u;
        const float qnan = __builtin_nanf("");
#pragma unroll
        for (int ai = 0; ai < 2; ++ai)
#pragma unroll
            for (int m = 0; m < 4; ++m) { const int r = ai * HALF + wr * 64 + m * 16 + fr; const f32x2v sr = S[r]; const size_t off = (size_t)(u.pm * BM + r) * ldc + col0;
#pragma unroll
                for (int bj = 0; bj < 2; ++bj)
#pragma unroll
                    for (int n = 0; n < 2; ++n) { const f32x4 bs = ai == 0 ? pre[m][bj][n] : *(const f32x4*)(base + off + bj * HALF + n * 16); f32x4 o = bs + (acc[ai][bj][m][n] - sr.x) * sr.y;
                        if (bad) o = (f32x4){qnan, qnan, qnan, qnan}; *(f32x4*)(out + off + bj * HALF + n * 16) = o; }
                if (m & 1) asm volatile("" ::: "memory"); }
    }
};
struct EpiLnResLn {
    static constexpr bool PERM = false, AFTER_DRAIN = true;
    const float* base; float* out; bf16_t* xn; int ldc; const float* bias; PanelStats st1, st2; unsigned poison;
    __device__ __forceinline__ void fused(f32x4 (&acc)[2][2][4][2], const Unit& u, int wr, int wc, int fr, int fq, PG8_LAS unsigned char* lds, int wid, int lane) const {
        typedef float f32x2v __attribute__((ext_vector_type(2))); typedef unsigned u32x2v __attribute__((ext_vector_type(2)));
        const PG8_LAS f32x2v* S = (const PG8_LAS f32x2v*)(lds + 8192);
        const int col0 = u.pn * BM + wc * 32 + 4 * fq;
#pragma unroll
        for (int bj = 0; bj < 2; ++bj)
#pragma unroll
            for (int n = 0; n < 2; ++n) { const f32x4 bv = bias ? *(const f32x4*)(bias + col0 + bj * HALF + n * 16) : (f32x4){0.f, 0.f, 0.f, 0.f};
#pragma unroll
                for (int ai = 0; ai < 2; ++ai)
#pragma unroll
                    for (int m = 0; m < 4; ++m) acc[ai][bj][m][n] += bv; }
        bool bad = st1.run(acc, u, wr, wc, fr, fq, lds, wid, lane) || poison != 0u;
        const float qnan = __builtin_nanf("");
#pragma unroll
        for (int ai = 0; ai < 2; ++ai)
#pragma unroll
            for (int m = 0; m < 4; ++m) { const int r = ai * HALF + wr * 64 + m * 16 + fr; const f32x2v sr = S[r]; const size_t off = (size_t)(u.pm * BM + r) * ldc + col0;
#pragma unroll
                for (int bj = 0; bj < 2; ++bj)
#pragma unroll
                    for (int n = 0; n < 2; ++n) { const f32x4 bs = *(const f32x4*)(base + off + bj * HALF + n * 16); acc[ai][bj][m][n] = bs + (acc[ai][bj][m][n] - sr.x) * sr.y; }
                asm volatile("" : "+v"(acc[ai][0][m][0]), "+v"(acc[ai][0][m][1]), "+v"(acc[ai][1][m][0]), "+v"(acc[ai][1][m][1]));
                if (m & 1) asm volatile("" ::: "memory"); }
        const bool bad1 = bad;
        bad = st2.run(acc, u, wr, wc, fr, fq, lds, wid, lane) || bad;
#pragma unroll
        for (int ai = 0; ai < 2; ++ai)
#pragma unroll
            for (int m = 0; m < 4; ++m) { const int r = ai * HALF + wr * 64 + m * 16 + fr; const f32x2v sr = S[r]; const size_t off = (size_t)(u.pm * BM + r) * ldc + col0;
#pragma unroll
                for (int bj = 0; bj < 2; ++bj)
#pragma unroll
                    for (int n = 0; n < 2; ++n) { const f32x4 x1 = acc[ai][bj][m][n]; *(f32x4*)(out + off + bj * HALF + n * 16) = bad1 ? (f32x4){qnan, qnan, qnan, qnan} : x1;
                        const f32x4 o = (x1 - sr.x) * sr.y; u32x2v w; w.x = cvt_pk_bf16(o[0], o[1]); w.y = cvt_pk_bf16(o[2], o[3]);
                        if (bad) { w.x = 0x7fc07fc0u; w.y = 0x7fc07fc0u; } *(u32x2v*)(xn + off + bj * HALF + n * 16) = w; }
                asm volatile("" ::: "memory"); }
    }
};

template <class Epi, class Sched, bool ALIGN_EPI = false, bool SP2 = false, bool KSPLIT = false>
__device__ __forceinline__ void gemm_phase(PG8_LAS unsigned char* lds, const Gemm g, const Sched& S, const Epi& E, const int wave0) {
    int wv0_ = wave0; asm volatile("" : "+s"(wv0_));
    int z0_ = 0; asm volatile("" : "+v"(z0_)); const int tid_ = wv0_ * 64 + (int)__builtin_amdgcn_mbcnt_hi(~0u, __builtin_amdgcn_mbcnt_lo(~0u, (unsigned)z0_));
    const int tid = tid_, wid = __builtin_amdgcn_readfirstlane(tid >> 6), lane = tid & 63, wr = wid >> 2, wc = wid & 3, fr = lane & 15, fq = lane >> 4;
    const int K = g.K, nt = K / BK;
    unsigned voffA[2], voffB[2];
#pragma unroll
    for (int i = 0; i < 2; ++i) { int R, C; stage_rc(tid * 16 + i * 8192, R, C); const int Rb = Epi::PERM ? ((R & ~31) + perm32(R & 31)) : R;
        voffA[i] = (unsigned)(R * g.lda + C) * 2u; voffB[i] = (unsigned)(Rb * g.ldb + C) * 2u; }
    const unsigned kstep = (unsigned)(BK * 2);
    const unsigned hstepA = (unsigned)HALF * g.lda * 2, hstepB = (unsigned)HALF * g.ldb * 2;
    const unsigned tstepA = 2 * hstepA, tstepB = 2 * hstepB;
    const char* const baseA = (const char*)g.A; const char* const baseB = (const char*)g.Bt;
    const unsigned ldsw = (unsigned)wid * 1024u;
    const int aoff = lds_byte(wr * 64 + fr, fq * 8), boff = lds_byte(wc * 32 + fr, fq * 8);
#define PG8_SA(b, h) (((b) * 2 + (h)) * HTB)
#define PG8_SB(b, h) ((4 + (b) * 2 + (h)) * HTB)
#define PG8_STAGE_X(bufoff, base, soff, voff) do { _Pragma("unroll") for (int _i = 0; _i < 2; ++_i) \
        __builtin_amdgcn_global_load_lds((const unsigned*)((base) + (unsigned)((soff) + (voff)[_i])), (PG8_LAS unsigned*)(lds + (bufoff) + ldsw + _i * 8192), 16, 0, 0); } while (0)
#define PG8_LDA(dst, b, h) do { _Pragma("unroll") for (int m = 0; m < 4; ++m) _Pragma("unroll") for (int k = 0; k < 2; ++k) dst[m][k] = *(const PG8_LAS bf16x8*)(lds + PG8_SA(b, h) + aoff + m * 2048 + k * 1024); } while (0)
#define PG8_LDB(dst, b, h) do { _Pragma("unroll") for (int n = 0; n < 2; ++n) _Pragma("unroll") for (int k = 0; k < 2; ++k) dst[n][k] = *(const PG8_LAS bf16x8*)(lds + PG8_SB(b, h) + boff + n * 2048 + k * 1024); } while (0)
#define PG8_MMA(ai, bj, At, Bt) do { __builtin_amdgcn_s_setprio(1); _Pragma("unroll") for (int m = 0; m < 4; ++m) _Pragma("unroll") for (int n = 0; n < 2; ++n) _Pragma("unroll") for (int k = 0; k < 2; ++k) \
        acc[ai][bj][m][n] = __builtin_amdgcn_mfma_f32_16x16x32_bf16(Bt[n][k], At[m][k], acc[ai][bj][m][n], 0, 0, 0); __builtin_amdgcn_s_setprio(0); } while (0)
#define PG8_WAIT_V(n) asm volatile("s_waitcnt vmcnt(" #n ")" ::: "memory")
#define PG8_WAIT_L(n) asm volatile("s_waitcnt lgkmcnt(" #n ")" ::: "memory")
#define PG8_BAR __builtin_amdgcn_s_barrier()
#define PG8_SCHED __builtin_amdgcn_sched_barrier(0)
    Unit cur, nxt; int ui = 0;
    if (!S.next(0, cur)) return;
    f32x4 acc[2][2][4][2];
#pragma unroll
    for (int a = 0; a < 2; ++a)
#pragma unroll
        for (int b = 0; b < 2; ++b)
#pragma unroll
            for (int m = 0; m < 4; ++m)
#pragma unroll
                for (int n = 0; n < 2; ++n) acc[a][b][m][n] = (f32x4){0.f, 0.f, 0.f, 0.f};
    bf16x8 At[4][2], B0[2][2], B1[2][2];
    unsigned cA = (unsigned)cur.pm * tstepA; unsigned cB = (unsigned)cur.pn * tstepB + (KSPLIT ? (unsigned)cur.k0 * 2u : 0u);
    unsigned sB = KSPLIT ? (unsigned)cur.pn * tstepB + (unsigned)cur.k1 * 2u - (unsigned)(nt / 2) * kstep : cB;
    S.a_ready(cur);
    if constexpr (SP2) {
        PG8_STAGE_X(PG8_SB(0, 0), baseB, cB, voffB); PG8_STAGE_X(PG8_SB(0, 1), baseB, cB + hstepB, voffB); PG8_STAGE_X(PG8_SA(0, 0), baseA, cA, voffA); PG8_STAGE_X(PG8_SA(0, 1), baseA, cA + hstepA, voffA);
        if (wr == 1) PG8_BAR;
        PG8_WAIT_V(2); PG8_BAR;
        PG8_STAGE_X(PG8_SB(1, 0), baseB, cB + kstep, voffB); PG8_STAGE_X(PG8_SA(1, 0), baseA, cA + kstep, voffA); PG8_STAGE_X(PG8_SB(1, 1), baseB, cB + hstepB + kstep, voffB);
        PG8_WAIT_V(6); PG8_BAR;
    } else {
        PG8_STAGE_X(PG8_SB(0, 0), baseB, cB, voffB); PG8_STAGE_X(PG8_SA(0, 0), baseA, cA, voffA); PG8_STAGE_X(PG8_SB(0, 1), baseB, cB + hstepB, voffB); PG8_STAGE_X(PG8_SA(0, 1), baseA, cA + hstepA, voffA);
        if (wr == 1) PG8_BAR;
        PG8_WAIT_V(4); PG8_BAR;
        PG8_STAGE_X(PG8_SB(1, 0), baseB, cB + kstep, voffB); PG8_STAGE_X(PG8_SA(1, 0), baseA, cA + kstep, voffA); PG8_STAGE_X(PG8_SB(1, 1), baseB, cB + hstepB + kstep, voffB);
        PG8_WAIT_V(6); PG8_BAR;
    }
    for (;;) {
        const bool has_next = S.next(ui + 1, nxt);
        const unsigned nA = has_next ? (unsigned)nxt.pm * tstepA : cA; const unsigned nB = has_next ? (unsigned)nxt.pn * tstepB + (KSPLIT ? (unsigned)nxt.k0 * 2u : 0u) : cB;
        const unsigned nsB = (KSPLIT && has_next) ? (unsigned)nxt.pn * tstepB + (unsigned)nxt.k1 * 2u - (unsigned)(nt / 2) * kstep : sB;
        for (int t = 0; t < nt; t += 2) {
            const bool last = (t == nt - 2);
            const unsigned a1 = cA + (unsigned)(t + 1) * kstep;
            const unsigned a2 = last ? nA : cA + (unsigned)(t + 2) * kstep; const unsigned b2 = last ? nB : ((KSPLIT && (t + 2) >= nt / 2) ? sB : cB) + (unsigned)(t + 2) * kstep;
            const unsigned a3 = a2 + kstep; const unsigned b3 = b2 + kstep;
            if (last && has_next) S.a_ready(nxt);
            if constexpr (SP2) {
            PG8_LDB(B0, 0, 0); PG8_LDB(B1, 0, 1); PG8_SCHED; PG8_LDA(At, 0, 0); PG8_STAGE_X(PG8_SA(1, 1), baseA, a1 + hstepA, voffA);
            PG8_WAIT_V(8); PG8_WAIT_L(0); PG8_BAR; PG8_MMA(0, 0, At, B0); PG8_MMA(0, 1, At, B1); PG8_BAR; PG8_SCHED;
            PG8_LDA(At, 0, 1); PG8_STAGE_X(PG8_SB(0, 0), baseB, b2, voffB); PG8_STAGE_X(PG8_SB(0, 1), baseB, b2 + hstepB, voffB); PG8_STAGE_X(PG8_SA(0, 0), baseA, a2, voffA);
            PG8_WAIT_V(8); PG8_WAIT_L(0); PG8_BAR; PG8_MMA(1, 0, At, B0); PG8_MMA(1, 1, At, B1); PG8_BAR; PG8_SCHED;
            PG8_LDB(B0, 1, 0); PG8_LDB(B1, 1, 1); PG8_SCHED; PG8_LDA(At, 1, 0); PG8_STAGE_X(PG8_SA(0, 1), baseA, a2 + hstepA, voffA);
            PG8_WAIT_V(8); PG8_WAIT_L(0); PG8_BAR; PG8_MMA(0, 0, At, B0); PG8_MMA(0, 1, At, B1); PG8_BAR; PG8_SCHED;
            PG8_LDA(At, 1, 1); PG8_STAGE_X(PG8_SB(1, 0), baseB, b3, voffB); PG8_STAGE_X(PG8_SB(1, 1), baseB, b3 + hstepB, voffB); PG8_STAGE_X(PG8_SA(1, 0), baseA, a3, voffA);
            PG8_WAIT_V(8); PG8_WAIT_L(0); PG8_BAR; PG8_MMA(1, 0, At, B0); PG8_MMA(1, 1, At, B1); PG8_BAR; PG8_SCHED;
            } else {
            PG8_LDB(B0, 0, 0); PG8_SCHED; PG8_LDA(At, 0, 0); PG8_STAGE_X(PG8_SA(1, 1), baseA, a1 + hstepA, voffA);
            PG8_WAIT_L(8); PG8_BAR; PG8_WAIT_L(0); PG8_MMA(0, 0, At, B0); PG8_BAR; PG8_SCHED;
            PG8_LDB(B1, 0, 1); PG8_STAGE_X(PG8_SB(0, 0), baseB, b2, voffB);
            PG8_BAR; PG8_WAIT_L(0); PG8_MMA(0, 1, At, B1); PG8_BAR;
            PG8_LDA(At, 0, 1); PG8_STAGE_X(PG8_SA(0, 0), baseA, a2, voffA);
            PG8_BAR; PG8_WAIT_L(0); PG8_MMA(1, 0, At, B0); PG8_BAR; PG8_SCHED;
            PG8_STAGE_X(PG8_SB(0, 1), baseB, b2 + hstepB, voffB);
            PG8_WAIT_V(6); PG8_BAR; PG8_MMA(1, 1, At, B1); PG8_BAR;
            PG8_LDB(B0, 1, 0); PG8_SCHED; PG8_LDA(At, 1, 0); PG8_STAGE_X(PG8_SA(0, 1), baseA, a2 + hstepA, voffA);
            PG8_WAIT_L(8); PG8_BAR; PG8_WAIT_L(0); PG8_MMA(0, 0, At, B0); PG8_BAR; PG8_SCHED;
            PG8_LDB(B1, 1, 1); PG8_STAGE_X(PG8_SB(1, 0), baseB, b3, voffB);
            PG8_BAR; PG8_WAIT_L(0); PG8_MMA(0, 1, At, B1); PG8_BAR;
            PG8_LDA(At, 1, 1); PG8_STAGE_X(PG8_SA(1, 0), baseA, a3, voffA);
            PG8_BAR; PG8_WAIT_L(0); PG8_MMA(1, 0, At, B0); PG8_BAR; PG8_SCHED;
            PG8_STAGE_X(PG8_SB(1, 1), baseB, b3 + hstepB, voffB);
            PG8_WAIT_V(6); PG8_BAR; PG8_MMA(1, 1, At, B1); PG8_BAR;
            }
        }
        if constexpr (ALIGN_EPI) { if (wr == 0) PG8_BAR; }
        if constexpr (!Epi::AFTER_DRAIN) { E(acc, cur, wr, wc, fr, fq); S.done(cur); }
        if (!has_next) break;
#pragma unroll
        for (int a = 0; a < 2; ++a)
#pragma unroll
            for (int b = 0; b < 2; ++b)
#pragma unroll
                for (int m = 0; m < 4; ++m)
#pragma unroll
                    for (int n = 0; n < 2; ++n) acc[a][b][m][n] = (f32x4){0.f, 0.f, 0.f, 0.f};
        cur = nxt; cA = nA; cB = nB; sB = nsB; ++ui;
        if constexpr (ALIGN_EPI) { if (wr == 1) PG8_BAR; }
    }
    PG8_WAIT_V(0);
    if constexpr (!ALIGN_EPI) { if (wr == 0) PG8_BAR; }
    PG8_BAR;
    if constexpr (Epi::AFTER_DRAIN) { E.fused(acc, cur, wr, wc, fr, fq, lds, wid, lane); S.done(cur); }
#undef PG8_SA
#undef PG8_SB
#undef PG8_STAGE_X
#undef PG8_LDA
#undef PG8_LDB
#undef PG8_MMA
#undef PG8_WAIT_V
#undef PG8_WAIT_L
#undef PG8_BAR
#undef PG8_SCHED
}
}
namespace attn_body {
using bf16=__hip_bfloat16;
using bf16x8=__attribute__((ext_vector_type(8)))short;
using s16x4=__attribute__((ext_vector_type(4)))short;
using f32x16=__attribute__((ext_vector_type(16)))float;
using u32x4=__attribute__((ext_vector_type(4)))unsigned;
constexpr int BATCH=8,NHEAD=6,SEQ=4096,D=64,DM=3072;
constexpr int NW=8,QBLK=32,QB=QBLK*NW,KVBLK=64,NQB=SEQ/QB;
constexpr int ATTN_PITCH=DM, ATTN_UNIT_ROWS=QB;
__device__ __forceinline__ int crow(int r,int hi){return (r&3)+8*(r>>2)+4*hi;}
#define SBAR() __builtin_amdgcn_sched_barrier(0)
__device__ __forceinline__ void cmask(f32x16&p0,f32x16&p1,int jb,int qrel,int hi){
  const float NEG=-INFINITY; int kb=64*jb+4*hi;
  #pragma unroll
  for(int r=0;r<16;++r){int kv=kb+(r&3)+8*(r>>2); if(kv>qrel)p0[r]=NEG; if(kv+32>qrel)p1[r]=NEG;}
}

constexpr int NSLOT=3, SLOTB=8192;
constexpr int LDS_K=0, LDS_V=NSLOT*SLOTB, LDS_WS=2*NSLOT*SLOTB, LDS_OST=LDS_WS+NW*64*4, LDS_G=LDS_OST+NW*4096, LDS_BYTES=LDS_G+SEQ*4;
constexpr float C2=0.125f*1.4426950408889634f;
__device__ __forceinline__ void glds16(const void*gsrc,unsigned lds_dst){unsigned keep;
  asm volatile("s_mov_b32 %0, m0\n\ts_mov_b32 m0, %2\n\ts_nop 0\n\tglobal_load_lds_dwordx4 %1, off\n\ts_mov_b32 m0, %0":"=&s"(keep):"v"(gsrc),"s"(lds_dst):"memory");}
__device__ __forceinline__ float max3f(float a,float b,float c){float r;asm("v_max3_f32 %0, %1, %2, %3":"=v"(r):"v"(a),"v"(b),"v"(c));return r;}
__device__ __forceinline__ float max2f(float a,float b){float r;asm("v_max_f32_e32 %0, %1, %2":"=v"(r):"v"(a),"v"(b));return r;}
__device__ __forceinline__ float fadd_s(float a,float b){float r;asm("v_add_f32_e32 %0, %1, %2":"=v"(r):"v"(a),"v"(b));return r;}
__device__ __forceinline__ float fsub_s(float a,float b){float r;asm("v_sub_f32_e32 %0, %1, %2":"=v"(r):"v"(a),"v"(b));return r;}
typedef float f32x2_t __attribute__((ext_vector_type(2))); typedef __bf16 bf16x2_t __attribute__((ext_vector_type(2)));
__device__ __forceinline__ unsigned cvtpk_s(float lo,float hi){f32x2_t v={lo,hi};bf16x2_t b=__builtin_convertvector(v,bf16x2_t);return __builtin_bit_cast(unsigned,b);}
#define WAIT_BAR(N) asm volatile("s_waitcnt vmcnt(" #N ") lgkmcnt(0)\n\ts_barrier":::"memory")

__device__ __forceinline__ void qkt(f32x16&p0,f32x16&p1,const char*Kslot,const bf16x8*qr,const f32x16&negm,int r32,int hi){
  const char*kb=Kslot+hi*1024+r32*16;
  #pragma unroll
  for(int d0=0;d0<4;++d0){
    const bf16x8 b0=*reinterpret_cast<const bf16x8*>(kb+d0*2048);
    const bf16x8 b1=*reinterpret_cast<const bf16x8*>(kb+d0*2048+512);
    if(d0==0){p0=__builtin_amdgcn_mfma_f32_32x32x16_bf16(b0,qr[0],negm,0,0,0);p1=__builtin_amdgcn_mfma_f32_32x32x16_bf16(b1,qr[0],negm,0,0,0);}
    else{p0=__builtin_amdgcn_mfma_f32_32x32x16_bf16(b0,qr[d0],p0,0,0,0);p1=__builtin_amdgcn_mfma_f32_32x32x16_bf16(b1,qr[d0],p1,0,0,0);}}
}
typedef __attribute__((address_space(3))) const char* lds_cptr;
typedef short v4i16_t __attribute__((ext_vector_type(4)));
__device__ __forceinline__ void kload8(bf16x8*kf,lds_cptr kp){
  kf[0]=*(const __attribute__((address_space(3))) bf16x8*)(kp);      kf[1]=*(const __attribute__((address_space(3))) bf16x8*)(kp+512);
  kf[2]=*(const __attribute__((address_space(3))) bf16x8*)(kp+2048); kf[3]=*(const __attribute__((address_space(3))) bf16x8*)(kp+2560);
  kf[4]=*(const __attribute__((address_space(3))) bf16x8*)(kp+4096); kf[5]=*(const __attribute__((address_space(3))) bf16x8*)(kp+4608);
  kf[6]=*(const __attribute__((address_space(3))) bf16x8*)(kp+6144); kf[7]=*(const __attribute__((address_space(3))) bf16x8*)(kp+6656);
}
__device__ __forceinline__ void kload2(bf16x8*kf,lds_cptr kp,int j){ kf[2*j]=*(const __attribute__((address_space(3))) bf16x8*)(kp+j*2048); kf[2*j+1]=*(const __attribute__((address_space(3))) bf16x8*)(kp+j*2048+512); }
__device__ __forceinline__ s16x4 vtr(lds_cptr p){ return __builtin_bit_cast(s16x4,__builtin_amdgcn_ds_read_tr16_b64_v4i16((__attribute__((address_space(3))) v4i16_t*)p)); }
__device__ __forceinline__ float rowmax(const f32x16&p0,const f32x16&p1){
  float a=max3f(p0[0],p0[1],p1[0]),b=max3f(p0[2],p0[3],p1[1]);a=max3f(a,p1[2],p1[3]);
  #pragma unroll
  for(int r=4;r<16;r+=4){a=max3f(a,p0[r],p0[r+1]);b=max3f(b,p0[r+2],p0[r+3]);a=max3f(a,p1[r],p1[r+1]);b=max3f(b,p1[r+2],p1[r+3]);}
  const float m=max2f(a,b);
  auto rr=__builtin_amdgcn_permlane32_swap(__float_as_uint(m),__float_as_uint(m),false,false);
  return max2f(__uint_as_float(rr[0]),__uint_as_float(rr[1]));
}
__device__ __forceinline__ void pv(f32x16*o,int vb,bf16x8 pa0,bf16x8 pa1,bf16x8 pa2,bf16x8 pa3){
  #pragma unroll
  for(int d0=0;d0<2;++d0){s16x4 lo[4],hi[4];
    #pragma unroll
    for(int ks=0;ks<4;++ks){
      asm volatile("ds_read_b64_tr_b16 %0,%1 offset:%c2":"=&v"(lo[ks]):"v"(vb),"i"(d0*4096+ks*1024):"memory");
      asm volatile("ds_read_b64_tr_b16 %0,%1 offset:%c2":"=&v"(hi[ks]):"v"(vb),"i"(d0*4096+ks*1024+512):"memory");}
    asm volatile("s_waitcnt lgkmcnt(0)":::"memory");SBAR();
    #define PK(k) (bf16x8){lo[k][0],lo[k][1],lo[k][2],lo[k][3],hi[k][0],hi[k][1],hi[k][2],hi[k][3]}
    o[d0]=__builtin_amdgcn_mfma_f32_32x32x16_bf16(pa0,PK(0),o[d0],0,0,0);
    o[d0]=__builtin_amdgcn_mfma_f32_32x32x16_bf16(pa1,PK(1),o[d0],0,0,0);
    o[d0]=__builtin_amdgcn_mfma_f32_32x32x16_bf16(pa2,PK(2),o[d0],0,0,0);
    o[d0]=__builtin_amdgcn_mfma_f32_32x32x16_bf16(pa3,PK(3),o[d0],0,0,0);
    #undef PK
  }
}

#ifndef ATTN_STORE16
#define ATTN_STORE16(p,v) (*(u32x4*)(p)=(v))
#endif
template<int THRL> __device__ __forceinline__ void attn_unit(int b,int h,int qb,const bf16*Q,const bf16*__restrict__ K,const bf16*__restrict__ V,bf16*O,const float*Gbh,char*shm,const int wave0,const int ts,const bool do_store=true){
  int wv0_=wave0; asm volatile("":"+s"(wv0_)); int z0_=0; asm volatile("":"+v"(z0_)); const int tid=wv0_*64+(int)__builtin_amdgcn_mbcnt_hi(~0u,__builtin_amdgcn_mbcnt_lo(~0u,(unsigned)z0_)),lane=tid&63,r32=lane&31,hi=lane>>5; const int wid=__builtin_amdgcn_readfirstlane(tid>>6);
  const long rowbase=(long)b*SEQ; const int q0=qb*QB;
  const bf16*Qw=Q+(rowbase+q0+wid*QBLK)*DM+h*D;
  const bf16*Kh=K+(rowbase+(long)ts*KVBLK)*DM+h*D,*Vh=V+(rowbase+(long)ts*KVBLK)*DM+h*D;
  const int q0r=q0-ts*KVBLK; Gbh+=ts*KVBLK;
  const unsigned lds0=(unsigned)(uintptr_t)shm;
  float*wsf=(float*)(shm+LDS_WS)+wid*64;
  const bf16*ksrc=Kh+(long)lane*DM+wid*8;
  const bf16*vsrc=Vh+(long)(16*(wid&3)+(lane>>2))*DM+(wid>>2)*32+(lane&3)*8;
  const unsigned kdst=lds0+LDS_K+wid*1024, vdst=lds0+LDS_V+wid*1024;
  #define DMA_K(t,slot) glds16(ksrc+(long)(t)*KVBLK*DM,(unsigned)__builtin_amdgcn_readfirstlane(kdst+(slot)))
  #define DMA_V(t,slot) glds16(vsrc+(long)(t)*KVBLK*DM,(unsigned)__builtin_amdgcn_readfirstlane(vdst+(slot)))
  const int vb0=(int)(lds0+LDS_V)+((lane>>4)&1)*32+(lane&3)*8+(4*hi+((lane&15)>>2))*64;
  const char*Kbase=shm+LDS_K; bf16x8 kf[8];
  const lds_cptr shm3=(lds_cptr)shm; const lds_cptr kp0=shm3+LDS_K+hi*1024+r32*16; const lds_cptr vp0=shm3+LDS_V+((lane>>4)&1)*32+(lane&3)*8+(4*hi+((lane&15)>>2))*64;
  const int NT=(q0r+QB)/KVBLK;
  typedef float f32x4v __attribute__((ext_vector_type(4)));
  { float*gl=(float*)(shm+LDS_G); const int ng4=(q0r+QB)>>2; for(int i=tid;i<ng4;i+=NW*64){ *(f32x4v*)(gl+4*i)=*(const f32x4v*)(Gbh+4*i); } }
  DMA_K(0,0);DMA_V(0,0);DMA_K(1,SLOTB);
  bf16x8 qr[4];
  #pragma unroll
  for(int d0=0;d0<4;++d0)qr[d0]=*reinterpret_cast<const bf16x8*>(&Qw[(long)r32*DM+d0*16+hi*8]);
  float mhat=0.f,l_reg=0.f;f32x16 o[2];o[0]=f32x16{};o[1]=f32x16{};f32x16 negm=f32x16{};asm volatile("":"+v"(negm));
  const int qrel=wid*QBLK+r32;
  #define CMASK(P0,P1,t) do{int jb_=(t)-(NT-4); if(jb_>=0)cmask(P0,P1,jb_,qrel,hi);}while(0)
  #define KBIAS(P0,P1,t) do{ const float*gp_=(const float*)(shm+LDS_G)+64*(t)+4*hi; \
    _Pragma("unroll") for(int j_=0;j_<4;++j_){ { const f32x4v a_=*(const f32x4v*)(gp_+8*j_); P0[4*j_]+=a_.x; P0[4*j_+1]+=a_.y; P0[4*j_+2]+=a_.z; P0[4*j_+3]+=a_.w; } SBAR(); \
      { const f32x4v c_=*(const f32x4v*)(gp_+32+8*j_); P1[4*j_]+=c_.x; P1[4*j_+1]+=c_.y; P1[4*j_+2]+=c_.z; P1[4*j_+3]+=c_.w; } SBAR(); } }while(0)
  bool resc=false;
  #define START(P0,P1) do{ const float rm=rowmax(P0,P1); resc=false; \
    { const float dl=__builtin_fmaxf(rm,0.f); mhat=fadd_s(mhat,dl); \
      _Pragma("unroll") for(int r=0;r<16;++r){P0[r]=fsub_s(P0[r],dl);P1[r]=fsub_s(P1[r],dl);} \
      _Pragma("unroll") for(int r=0;r<16;++r)negm[r]=-mhat; asm volatile("":"+v"(negm)); } \
    _Pragma("unroll") for(int r=0;r<16;++r)P0[r]=__builtin_amdgcn_exp2f(P0[r]); }while(0)
  #define RESC() do{ if(resc){ asm volatile("s_waitcnt lgkmcnt(0)":::"memory"); \
      _Pragma("unroll") for(int d_=0;d_<2;++d_) _Pragma("unroll") for(int r=0;r<16;++r)o[d_][r]*=wsf[crow(r,hi)]; } }while(0)
  f32x16 pA0,pA1,pB0,pB1;
  int sl_prev=0,sl_cur=0,sl_next=SLOTB;
  #define ROT() do{sl_prev=sl_cur;sl_cur=sl_next;sl_next=(sl_next==(NSLOT-1)*SLOTB)?0:sl_next+SLOTB;}while(0)
  DMA_K(2,2*SLOTB);
  WAIT_BAR(3);
  { const float*gl=(const float*)(shm+LDS_G); mhat=gl[q0r+qrel]; _Pragma("unroll") for(int r=0;r<16;++r)negm[r]=-mhat; asm volatile("":"+v"(negm)); }
  qkt(pA0,pA1,Kbase,qr,negm,r32,hi);asm volatile("s_nop 15\n\ts_nop 7":"+v"(pA0),"+v"(pA1));KBIAS(pA0,pA1,0);CMASK(pA0,pA1,0);
  START(pA0,pA1);
  _Pragma("unroll") for(int r=0;r<16;++r)pA1[r]=__builtin_amdgcn_exp2f(pA1[r]);
  WAIT_BAR(0);
  DMA_K(3,0);DMA_V(1,SLOTB);
  ROT();
  kload8(kf,kp0+sl_cur);
  WAIT_BAR(2);
  s16x4 vlo[8],vhi[8]; u32x4 pw0,pw1,pw2,pw3;
  #define PKW(P,B) cvtpk_s(P[B],P[B+1])
  #define PAF(k) __builtin_bit_cast(bf16x8,pw##k)
  #define VFR(i) (bf16x8){vlo[i][0],vlo[i][1],vlo[i][2],vlo[i][3],vhi[i][0],vhi[i][1],vhi[i][2],vhi[i][3]}
  #define PIN(x) asm volatile("":"+v"(x))
  #define MX3(a,b,c) __builtin_fmaxf(__builtin_fmaxf((a),(b)),(c))
  #define GAPA(MF,A0,A1,A2,A3,W0,W1,PW) do{ MF; sacc+=A0; sacc+=A1; sacc+=A2; sacc+=A3; PIN(sacc); W0; W1; PIN(PW); SBAR(); }while(0)
  #define EX(v) __builtin_amdgcn_exp2f(v)
  #define GAPB(MF,X,B) do{ MF; X[B]=EX(X[B]); X[B+1]=EX(X[B+1]); X[B+2]=EX(X[B+2]); X[B+3]=EX(X[B+3]); PIN(X); SBAR(); }while(0)
  #define VRD(i) do{ vlo[i]=vtr(vp_+(((i)>>2)*4096+((i)&3)*1024)); vhi[i]=vtr(vp_+(((i)>>2)*4096+((i)&3)*1024+512)); }while(0)
  #define KRD(G,j) do{ if(G){ kload2(kf,kp0+sl_next,j); SBAR(); } }while(0)
  #define STEP(C0,C1,P0,P1,t,GK,GV,GL) do{ SBAR(); \
    const lds_cptr vp_=vp0+sl_prev; \
    VRD(0); SBAR(); float sacc=(P0[0]+P0[1]); \
    GAPA(C0=__builtin_amdgcn_mfma_f32_32x32x16_bf16(kf[0],qr[0],negm,0,0,0), P0[2],P0[3],P0[4],P0[5],     pw0[0]=PKW(P0,0), pw0[1]=PKW(P0,2), pw0); \
    VRD(4); SBAR(); GAPA(C1=__builtin_amdgcn_mfma_f32_32x32x16_bf16(kf[1],qr[0],negm,0,0,0), P0[6],P0[7],P0[8],P0[9],     pw0[2]=PKW(P0,4), pw0[3]=PKW(P0,6), pw0); \
    VRD(1); SBAR(); GAPA(C0=__builtin_amdgcn_mfma_f32_32x32x16_bf16(kf[2],qr[1],C0,0,0,0),   P0[10],P0[11],P0[12],P0[13], pw1[0]=PKW(P0,8), pw1[1]=PKW(P0,10), pw1); \
    VRD(5); SBAR(); GAPA(C1=__builtin_amdgcn_mfma_f32_32x32x16_bf16(kf[3],qr[1],C1,0,0,0),   P0[14],P0[15],P1[0],P1[1],   pw1[2]=PKW(P0,12),pw1[3]=PKW(P0,14), pw1); \
    VRD(2); SBAR(); GAPA(C0=__builtin_amdgcn_mfma_f32_32x32x16_bf16(kf[4],qr[2],C0,0,0,0),   P1[2],P1[3],P1[4],P1[5],     pw2[0]=PKW(P1,0), pw2[1]=PKW(P1,2), pw2); \
    VRD(6); SBAR(); GAPA(C1=__builtin_amdgcn_mfma_f32_32x32x16_bf16(kf[5],qr[2],C1,0,0,0),   P1[6],P1[7],P1[8],P1[9],     pw2[2]=PKW(P1,4), pw2[3]=PKW(P1,6), pw2); \
    VRD(3); SBAR(); GAPA(C0=__builtin_amdgcn_mfma_f32_32x32x16_bf16(kf[6],qr[3],C0,0,0,0),   P1[10],P1[11],P1[12],P1[13], pw3[0]=PKW(P1,8), pw3[1]=PKW(P1,10), pw3); \
    VRD(7); SBAR(); GAPA(C1=__builtin_amdgcn_mfma_f32_32x32x16_bf16(kf[7],qr[3],C1,0,0,0),   P1[14],P1[15],0.f,0.f,       pw3[2]=PKW(P1,12),pw3[3]=PKW(P1,14), pw3); \
    l_reg+=sacc; \
    if(GK){DMA_K((t)+3,sl_cur);} if(GV){DMA_V((t)+1,sl_next);} \
    KBIAS(C0,C1,t); CMASK(C0,C1,t); \
    { float a=MX3(C0[0],C0[1],C1[0]),b=MX3(C0[2],C0[3],C1[1]); a=MX3(a,C1[2],C1[3]); \
      _Pragma("unroll") for(int r=4;r<16;r+=4){a=MX3(a,C0[r],C0[r+1]);b=MX3(b,C0[r+2],C0[r+3]);a=MX3(a,C1[r],C1[r+1]);b=MX3(b,C1[r+2],C1[r+3]);} \
      float rm=__builtin_fmaxf(a,b); { auto rr=__builtin_amdgcn_permlane32_swap(__float_as_uint(rm),__float_as_uint(rm),false,false); rm=__builtin_fmaxf(__uint_as_float(rr[0]),__uint_as_float(rr[1])); } \
      resc=false; \
      if(__builtin_expect(__any(rm>(float)THRL),0)){ const float dl=__builtin_fmaxf(rm,0.f); mhat+=dl; \
        _Pragma("unroll") for(int r=0;r<16;++r){C0[r]-=dl;C1[r]-=dl;} \
        _Pragma("unroll") for(int r=0;r<16;++r)negm[r]=-mhat; asm volatile("":"+v"(negm)); \
        const float f=__builtin_amdgcn_exp2f(-dl); l_reg*=f; if(hi==0)wsf[r32]=f; resc=true; } } \
    SBAR(); \
    GAPB(o[0]=__builtin_amdgcn_mfma_f32_32x32x16_bf16(PAF(0),VFR(0),o[0],0,0,0), C0,0); \
    GAPB(o[1]=__builtin_amdgcn_mfma_f32_32x32x16_bf16(PAF(0),VFR(4),o[1],0,0,0), C0,4); \
    KRD(GL,0); GAPB(o[0]=__builtin_amdgcn_mfma_f32_32x32x16_bf16(PAF(1),VFR(1),o[0],0,0,0), C0,8); \
    KRD(GL,1); GAPB(o[1]=__builtin_amdgcn_mfma_f32_32x32x16_bf16(PAF(1),VFR(5),o[1],0,0,0), C0,12); \
    KRD(GL,2); GAPB(o[0]=__builtin_amdgcn_mfma_f32_32x32x16_bf16(PAF(2),VFR(2),o[0],0,0,0), C1,0); \
    KRD(GL,3); GAPB(o[1]=__builtin_amdgcn_mfma_f32_32x32x16_bf16(PAF(2),VFR(6),o[1],0,0,0), C1,4); \
    GAPB(o[0]=__builtin_amdgcn_mfma_f32_32x32x16_bf16(PAF(3),VFR(3),o[0],0,0,0), C1,8); \
    GAPB(o[1]=__builtin_amdgcn_mfma_f32_32x32x16_bf16(PAF(3),VFR(7),o[1],0,0,0), C1,12); \
    }while(0)
  int t=1;
  #undef CMASK
  #define CMASK(P0,P1,t) do{}while(0)
  for(;t+5<NT;t+=2){
    STEP(pB0,pB1,pA0,pA1,t,true,true,true);     WAIT_BAR(2); RESC(); ROT();
    STEP(pA0,pA1,pB0,pB1,t+1,true,true,true);   WAIT_BAR(2); RESC(); ROT();
  }
  #undef CMASK
  #define CMASK(P0,P1,t) do{int jb_=(t)-(NT-4); if(jb_>=0)cmask(P0,P1,jb_,qrel,hi);}while(0)
  #define ENDW(tt) do{ if((tt)+3<NT){WAIT_BAR(2);} else if((tt)+2<NT){WAIT_BAR(1);} else {WAIT_BAR(0);} }while(0)
  for(;t+1<NT;t+=2){
    STEP(pB0,pB1,pA0,pA1,t,(t+3<NT),(t+1<NT),(t+1<NT));       ENDW(t);   RESC(); ROT();
    STEP(pA0,pA1,pB0,pB1,t+1,(t+4<NT),(t+2<NT),(t+2<NT));     ENDW(t+1); RESC(); ROT();
  }
  STEP(pB0,pB1,pA0,pA1,NT-1,false,false,false); RESC();
  { float sacc=pB0[0]+pB0[1]; _Pragma("unroll") for(int r=2;r<16;++r)sacc+=pB0[r]; _Pragma("unroll") for(int r=0;r<16;++r)sacc+=pB1[r]; l_reg+=sacc;
    pw0=(u32x4){PKW(pB0,0),PKW(pB0,2),PKW(pB0,4),PKW(pB0,6)};pw1=(u32x4){PKW(pB0,8),PKW(pB0,10),PKW(pB0,12),PKW(pB0,14)};pw2=(u32x4){PKW(pB1,0),PKW(pB1,2),PKW(pB1,4),PKW(pB1,6)};pw3=(u32x4){PKW(pB1,8),PKW(pB1,10),PKW(pB1,12),PKW(pB1,14)};
    SBAR(); pv(o,vb0+sl_cur,PAF(0),PAF(1),PAF(2),PAF(3)); }
  #undef PKW
  #undef PAF
  #undef VFR
  #undef PIN
  #undef MX3
  #undef GAPA
  #undef GAPB
  #undef EX
  #undef VRD
  #undef KRD
  #undef STEP
  #undef ENDW
  {auto rr=__builtin_amdgcn_permlane32_swap(__float_as_uint(l_reg),__float_as_uint(l_reg),false,false);l_reg=__uint_as_float(rr[0])+__uint_as_float(rr[1]);}
  if(hi==0)wsf[32+r32]=l_reg;asm volatile("s_waitcnt lgkmcnt(0)":::"memory");
  float rli[16];
  #pragma unroll
  for(int r=0;r<16;++r)rli[r]=__builtin_amdgcn_rcpf(wsf[32+crow(r,hi)]);
  bf16*Ow=O+(rowbase+q0+wid*QBLK)*DM+h*D;
  { bf16*stg=(bf16*)(shm+LDS_OST)+wid*2048;
    #pragma unroll
    for(int r=0;r<16;++r){const int orow=crow(r,hi);
      #pragma unroll
      for(int d0=0;d0<2;++d0)stg[orow*64+d0*32+r32]=__float2bfloat16(o[d0][r]*rli[r]);}
    asm volatile("s_waitcnt lgkmcnt(0)":::"memory");
    #pragma unroll
    for(int i=0;i<4;++i){const int row=i*8+(lane>>3),ch=lane&7; const u32x4 v=*(const u32x4*)(stg+row*64+ch*8); if(do_store)ATTN_STORE16(Ow+(long)row*DM+ch*8,v);} }
  asm volatile("s_waitcnt lgkmcnt(0)\n\ts_barrier":::"memory");
  #undef DMA_K
  #undef DMA_V
  #undef CMASK
  #undef KBIAS
  #undef START
  #undef RESC
  #undef ROT
}
constexpr int ATTN_LDS_BYTES=LDS_BYTES;
struct AttnTensors { const bf16* Q; const bf16* K; const bf16* V; bf16* O; const float* G; };
struct AttnUnit { int bh; int qb; };
struct StaticOrder {
  int vcu;
  __device__ __forceinline__ explicit StaticOrder(int grid,int block):vcu((block%8)*(grid/8)+block/8){}
  __device__ __forceinline__ bool next(int i,AttnUnit&u)const{ if(i>=4)return false; const int s=vcu&7; u.bh=vcu>>3; u.qb=(i==0)?s:(i==1)?15-s:(i==2)?16+s:31-s; return true; }
  __device__ __forceinline__ void a_ready(const AttnUnit&)const{}
  __device__ __forceinline__ void done(const AttnUnit&)const{}
};
template<class Sched,int THRL=8> __device__ __forceinline__ void attn_phase(char*lds,const AttnTensors&T,const Sched&S){
  AttnUnit u;
  for(int i=0;S.next(i,u);++i){ S.a_ready(u); attn_unit<THRL>(u.bh/NHEAD,u.bh%NHEAD,u.qb,T.Q,T.K,T.V,T.O,T.G+(long)u.bh*SEQ,lds); S.done(u); }
}
#undef SBAR
#undef WAIT_BAR
}
namespace fx {
struct EpiZ {
    static constexpr bool PERM = true, AFTER_DRAIN = false;
    bf16* Z; bf16* UP; float* NLF; const float* fbias;
    __device__ __forceinline__ void operator()(const pg8::f32x4 (&acc)[2][2][4][2], const pg8::Unit& u, int wr, int wc, int fr_, int fq_) const {
        int z_ = 0; asm volatile("" : "+v"(z_)); const int ln_ = __builtin_amdgcn_mbcnt_hi(~0u, __builtin_amdgcn_mbcnt_lo(~0u, z_)); const int fr = ln_ & 15, fq = ln_ >> 4; (void)fr_; (void)fq_;
        const int row0 = u.pm * 256 + wr * 64 + fr, col0 = wc * 32 + 8 * fq;
#pragma unroll
        for (int bj = 0; bj < 2; ++bj) {
            const int hb = u.pn * 2 + bj;
            const float sc = (hb < 3) ? C2 : 1.f;
            bf16* base = Z + ((size_t)row0 * NZ + hb * 128 + col0); size_t stride = (size_t)16 * NZ;
            if (hb == 9 || hb == 10) { const int sidx = (hb - 9) * 128 + col0, g = sidx >> 4, ch0 = sidx & 15;
                base = UP + ((size_t)(g * 2048 + (row0 >> 4)) * 384 + (row0 & 15) * 16 + ch0); stride = 384; }
#pragma unroll
            for (int ai = 0; ai < 2; ++ai)
#pragma unroll
                for (int m = 0; m < 4; ++m) { const pg8::f32x4 v0 = acc[ai][bj][m][0] * sc, v1 = acc[ai][bj][m][1] * sc;
                    v4u w; w.x = pk2(v0[0], v0[1]); w.y = pk2(v0[2], v0[3]); w.z = pk2(v1[0], v1[1]); w.w = pk2(v1[2], v1[3]);
                    *(GAS v4u*)(base + (size_t)(ai * 8 + m) * stride) = w; }
        }
        if (u.pn == 11 && col0 == 0) {
#pragma unroll
            for (int ai = 0; ai < 2; ++ai)
#pragma unroll
                for (int m = 0; m < 4; ++m) { const int r = row0 + ai * 128 + m * 16, b = r >> 12, t = r & 4095; float* o = NLF + (size_t)(b * 6) * 4096 + t;
                    o[0 * 4096] = nlf1(acc[ai][1][m][0][0] + fbias[0]); o[1 * 4096] = nlf1(acc[ai][1][m][0][1] + fbias[1]); o[2 * 4096] = nlf1(acc[ai][1][m][0][2] + fbias[2]);
                    o[3 * 4096] = nlf1(acc[ai][1][m][0][3] + fbias[3]); o[4 * 4096] = nlf1(acc[ai][1][m][1][0] + fbias[4]); o[5 * 4096] = nlf1(acc[ai][1][m][1][1] + fbias[5]); }
        }
    }
    static __device__ __forceinline__ float nlf1(float x) { return -LOG2E * (fminf(x, 0.f) - __logf(1.f + __expf(-fabsf(x)))); }
};
template <bool XF32> struct EpiRes {
    static constexpr bool PERM = false, AFTER_DRAIN = false;
    const void* X; bf16* out; const float* gate;
    __device__ __forceinline__ void operator()(const pg8::f32x4 (&acc)[2][2][4][2], const pg8::Unit& u, int wr, int wc, int fr_, int fq_) const {
        int z_ = 0; asm volatile("" : "+v"(z_)); const int ln_ = __builtin_amdgcn_mbcnt_hi(~0u, __builtin_amdgcn_mbcnt_lo(~0u, z_)); const int fr = ln_ & 15, fq = ln_ >> 4; (void)fr_; (void)fq_;
        const int row0 = u.pm * 256 + wr * 64 + fr, col0 = u.pn * 256 + wc * 32 + 4 * fq;
        const float* gb = gate + (size_t)(row0 >> 12) * 6144;
#pragma unroll
        for (int bj = 0; bj < 2; ++bj)
#pragma unroll
            for (int n = 0; n < 2; ++n) { const int c = col0 + bj * 128 + n * 16; const pg8::f32x4 gv = *(const GAS pg8::f32x4*)(gb + c);
                pg8::f32x4 xv[8];
#pragma unroll
                for (int q = 0; q < 8; ++q) { const size_t off = (size_t)(row0 + (q >> 2) * 128 + (q & 3) * 16) * 1024 + c;
                    if (XF32) xv[q] = *(const GAS pg8::f32x4*)((const float*)X + off); else { const v2u w = *(const GAS v2u*)((const bf16*)X + off); xv[q] = (pg8::f32x4){bflo(w.x), bfhi(w.x), bflo(w.y), bfhi(w.y)}; } }
                asm volatile("" ::: "memory");
#pragma unroll
                for (int q = 0; q < 8; ++q) { const size_t off = (size_t)(row0 + (q >> 2) * 128 + (q & 3) * 16) * 1024 + c;
                    const pg8::f32x4 o = xv[q] + gv * acc[q >> 2][bj][q & 3][n]; v2u ow; ow.x = pk2(o[0], o[1]); ow.y = pk2(o[2], o[3]); *(GAS v2u*)(out + off) = ow; }
                asm volatile("" ::: "memory"); }
    }
};
}
namespace fx {
constexpr int MOE_ROWS = 40960, MOE_TILES = MOE_ROWS / 256, NCLS = 24;
constexpr size_t WS_TOKINFO = WS_HLOC + 8 * MiB;
constexpr size_t WS_CNT = WS_TOKINFO + (size_t)M * 16;
constexpr size_t WS_ROWTOK = WS_CNT + 256 * 32 * 4;
constexpr size_t WS_ROWW = WS_ROWTOK + (size_t)MOE_ROWS * 4;
constexpr size_t WS_TILECLS = WS_ROWW + (size_t)MOE_ROWS * 8;
constexpr size_t WS_H2S = WS_Z;
constexpr size_t WS_HID = WS_Z + (size_t)MOE_ROWS * 1024 * 2;
static_assert(WS_TILECLS + (MOE_TILES + 1) * 4 <= WS_END, "moe scratch fits");
static_assert(WS_HID + (size_t)MOE_ROWS * 512 * 2 <= WS_UP, "H2S + HID fit in the Z region");

__device__ __forceinline__ void cls_experts(int cls, int& e_lo, int& e_hi) {
    const int g = cls / 6, pr = cls % 6; const int lo = (pr < 3) ? 0 : (pr < 5 ? 1 : 2); const int hi = (pr < 3) ? pr + 1 : (pr < 5 ? pr - 1 : 3);
    e_lo = g * 4 + lo; e_hi = g * 4 + hi;
}
__device__ __forceinline__ void moe_route(const Params& p, int oz, int l, LAS unsigned char* lds, int tid, int lane, int wave, int bx, int G) {
    unsigned char* ws = p.ws + oz; constexpr int WP = 1032;
    LAS unsigned short* Whi = (LAS unsigned short*)lds; LAS unsigned short* Wlo = (LAS unsigned short*)(lds + 33024); LAS float* rstds = (LAS float*)(lds + 66048); LAS float* SR = (LAS float*)(lds + 66560); LAS int* hist = (LAS int*)(lds + 66624);
    const int tpw = M / G, t0 = bx * tpw, b = t0 >> 12; const float* mod = (const float*)(ws + WS_MOD) + l * 8 * 6144 + b * 6144; const float* nw = p.in[I_NFW + oz] + l * 1024; const float* rw = p.in[I_RW + oz]; const float* rb = p.in[I_RB + oz];
    for (int k = tid; k < 1024; k += NTHR) { const float a = nw[k] * (1.f + mod[4096 + k]);
#pragma unroll
        for (int q = 0; q < 4; ++q) { const f32x4 w4 = ((const GAS f32x4*)rw)[k * 4 + q];
#pragma unroll
            for (int e = 0; e < 4; ++e) { const float v = a * w4[e]; const unsigned hi = f2bf(v); const float r = v - __builtin_bit_cast(float, hi << 16); Whi[(4 * q + e) * WP + k] = (unsigned short)hi; Wlo[(4 * q + e) * WP + k] = (unsigned short)f2bf(r); } } }
    if (tid < 32) hist[tid] = 0;
    { float s0 = 0.f, s1 = 0.f;
        for (int k = lane; k < 1024; k += 64) { const float bv = mod[3072 + k]; s0 += bv * rw[k * 16 + 2 * wave]; s1 += bv * rw[k * 16 + 2 * wave + 1]; }
        s0 = wave_sum(s0, lane); s1 = wave_sum(s1, lane); if (lane == 0) { SR[2 * wave] = s0 + rb[2 * wave]; SR[2 * wave + 1] = s1 + rb[2 * wave + 1]; } }
    const bf16* X1 = (const bf16*)(ws + WS_XB); bf16* H = (bf16*)(ws + WS_H);
    f32x4 A[4], B[4]; adaln_factors(nw, mod + 3072, mod + 4096, lane, A, B);
    f32x4 v[4] = {}; if (wave < tpw) row_load_bf(X1, t0 + wave, lane, v);
    for (int r = wave; r < tpw; r += NWAVES) {
        const int row = t0 + r;
        f32x4 nxt[4] = {}; if (r + NWAVES < tpw) row_load_bf(X1, row + NWAVES, lane, nxt);
        float s = 0.f;
#pragma unroll
        for (int j = 0; j < 4; ++j) s += (v[j].x * v[j].x + v[j].y * v[j].y) + (v[j].z * v[j].z + v[j].w * v[j].w);
        const float rstd = __builtin_amdgcn_rsqf(wave_sum(s, lane) * (1.f / 1024.f) + 1e-6f); if (lane == 0) rstds[r] = rstd;
        GAS unsigned long long* o8 = (GAS unsigned long long*)(H + (size_t)row * 1024) + lane;
#pragma unroll
        for (int j = 0; j < 4; ++j) { const f32x4 h = (v[j] * rstd) * A[j] + B[j]; o8[64 * j] = (unsigned long long)pk2(h.x, h.y) | ((unsigned long long)pk2(h.z, h.w) << 32); }
#pragma unroll
        for (int j = 0; j < 4; ++j) v[j] = nxt[j];
    }
    __syncthreads();
    typedef short rbf16x8 __attribute__((ext_vector_type(8)));
    const int n = lane & 15, q = lane >> 4, tok = t0 + 16 * wave + n;
    f32x4 acc = {0.f, 0.f, 0.f, 0.f};
    const GAS rbf16x8* xrow = (const GAS rbf16x8*)(X1 + (size_t)tok * 1024 + 8 * q);
    const LAS unsigned short* ahi = Whi + n * WP + 8 * q; const LAS unsigned short* alo = Wlo + n * WP + 8 * q;
#pragma unroll 1
    for (int k0 = 0; k0 < 32; k0 += 8) { rbf16x8 xb[8];
#pragma unroll
        for (int u = 0; u < 8; ++u) xb[u] = xrow[(k0 + u) * 4];
#pragma unroll
        for (int u = 0; u < 8; ++u) { const rbf16x8 a1 = *(const LAS rbf16x8*)(ahi + (k0 + u) * 32), a2 = *(const LAS rbf16x8*)(alo + (k0 + u) * 32);
            acc = __builtin_amdgcn_mfma_f32_16x16x32_bf16(a1, xb[u], acc, 0, 0, 0); acc = __builtin_amdgcn_mfma_f32_16x16x32_bf16(a2, xb[u], acc, 0, 0, 0); } }
    const float rs = rstds[16 * wave + n]; float lg[4];
#pragma unroll
    for (int e = 0; e < 4; ++e) lg[e] = acc[e] * rs + SR[4 * q + e];
    float mx = fmaxf(fmaxf(lg[0], lg[1]), fmaxf(lg[2], lg[3])); mx = fmaxf(mx, lane_get(mx, lane ^ 16)); mx = fmaxf(mx, lane_get(mx, lane ^ 32));
    float sum = 0.f;
#pragma unroll
    for (int e = 0; e < 4; ++e) { lg[e] = __expf(lg[e] - mx); sum += lg[e]; }
    sum += lane_get(sum, lane ^ 16); sum += lane_get(sum, lane ^ 32); const float inv = 1.f / sum;
#pragma unroll
    for (int e = 0; e < 4; ++e) lg[e] *= inv;
    int i1 = 0; float v1 = lg[0];
#pragma unroll
    for (int i = 1; i < 4; ++i) if (lg[i] > v1) { v1 = lg[i]; i1 = i; }
    int i2 = -1; float v2 = -1.f;
#pragma unroll
    for (int i = 0; i < 4; ++i) if (i != i1 && lg[i] > v2) { v2 = lg[i]; i2 = i; }
    const float sc = v1 + v2;
    float bs = sc; int bq = q;
    { const float os = lane_get(bs, lane ^ 16); const int oq = __builtin_amdgcn_ds_bpermute((lane ^ 16) << 2, bq); if (os > bs || (os == bs && oq < bq)) { bs = os; bq = oq; } }
    { const float os = lane_get(bs, lane ^ 32); const int oq = __builtin_amdgcn_ds_bpermute((lane ^ 32) << 2, bq); if (os > bs || (os == bs && oq < bq)) { bs = os; bq = oq; } }
    if (bq == q) {
        const int lo = i1 < i2 ? i1 : i2, hi = i1 < i2 ? i2 : i1; const float w1 = v1 / (v1 + v2), w2 = v2 / (v1 + v2);
        const int cls = q * 6 + (lo * (7 - lo)) / 2 + (hi - lo - 1);
        const int rank = __hip_atomic_fetch_add(hist + cls, 1, __ATOMIC_RELAXED, __HIP_MEMORY_SCOPE_WORKGROUP);
        GAS f32x4* ti = (GAS f32x4*)(ws + WS_TOKINFO) + tok;
        *ti = (f32x4){__builtin_bit_cast(float, cls | (rank << 8)), i1 < i2 ? w1 : w2, i1 < i2 ? w2 : w1, 0.f};
    }
    __syncthreads();
    if (tid < 32) ((int*)(ws + WS_CNT))[bx * 32 + tid] = (tid < NCLS) ? hist[tid] : 0;
}
__device__ __forceinline__ void moe_gather(const Params& p, int oz, LAS unsigned char* lds, int tid, int lane, int wave, int bx, int G) {
    unsigned char* ws = p.ws + oz; LAS int* cl = (LAS int*)lds; LAS int* base = (LAS int*)(lds + 32768); LAS int* off = base + 32; LAS int* tot = off + 32;
    const int* cnt = (const int*)(ws + WS_CNT);
    for (int i = tid; i < G * 32; i += NTHR) cl[i] = cnt[i];
    __syncthreads();
    { LAS int* ps = tot + 32; const int c = tid & 31, part = tid >> 5; int s = 0, mine = 0; for (int w = part * (G / 16); w < (part + 1) * (G / 16); ++w) { if (w < bx) mine += cl[w * 32 + c]; s += cl[w * 32 + c]; } ps[part * 32 + c] = s; ps[512 + part * 32 + c] = mine; }
    __syncthreads();
    if (tid < NCLS) { LAS int* ps = tot + 32; int s = 0, mine = 0; for (int q = 0; q < 16; ++q) { s += ps[q * 32 + tid]; mine += ps[512 + q * 32 + tid]; } tot[tid] = s; off[tid] = mine; }
    __syncthreads();
    if (tid == 0) { int b = 0; for (int c = 0; c < NCLS; ++c) { base[c] = b; b += (tot[c] + 255) & ~255; } base[NCLS] = b; }
    __syncthreads();
    int* rowtok = (int*)(ws + WS_ROWTOK); float* roww = (float*)(ws + WS_ROWW);
    if (bx < NCLS) { const int c = bx, b0 = base[c], n = tot[c], b1 = base[c + 1];
        for (int r = b0 + n + tid; r < b1; r += NTHR) { rowtok[r] = -1; roww[2 * r] = (float)oz; roww[2 * r + 1] = (float)oz; }
        int* tc = (int*)(ws + WS_TILECLS); for (int t = b0 / 256 + tid; t < b1 / 256; t += NTHR) tc[t] = c;
        if (c == NCLS - 1 && tid == 0) tc[MOE_TILES] = b1 / 256; }
    const int tpw = M / G, t0 = bx * tpw; const bf16* H = (const bf16*)(ws + WS_H); bf16* H2S = (bf16*)(ws + WS_H2S);
    for (int r = wave; r < tpw; r += NWAVES) { const int row = t0 + r; const f32x4 ti = ((const GAS f32x4*)(ws + WS_TOKINFO))[row]; const int cr = __builtin_bit_cast(int, ti.x), cls = cr & 255, rank = cr >> 8;
        const int pos = base[cls] + off[cls] + rank;
        const GAS v4u* src = (const GAS v4u*)(H + (size_t)row * 1024) + lane; GAS v4u* dst = (GAS v4u*)(H2S + (size_t)pos * 1024) + lane;
        const v4u a = src[0], b = src[64]; dst[0] = a; dst[64] = b;
        if (lane == 0) { rowtok[pos] = row; roww[2 * pos] = ti.y; roww[2 * pos + 1] = ti.z; } }
}
struct ListOrder {
    const LAS int* list; int n;
    __device__ __forceinline__ bool next(int i, pg8::Unit& u) const { if (i >= n) return false; typedef int v4i_ __attribute__((ext_vector_type(4))); const v4i_ q = *(const LAS v4i_*)(list + 4 * i);
        u.pm = __builtin_amdgcn_readfirstlane(q.x); u.pn = __builtin_amdgcn_readfirstlane(q.y); u.k0 = __builtin_amdgcn_readfirstlane(q.z); u.k1 = __builtin_amdgcn_readfirstlane(q.w); return true; }
    __device__ __forceinline__ void a_ready(const pg8::Unit&) const {}
    __device__ __forceinline__ void done(const pg8::Unit&) const {}
};
template <bool DOWN>
__device__ __forceinline__ int moe_build_list(unsigned char* ws, LAS int* list, int tid, int bx, int G) {
    const int* tc = (const int*)(ws + WS_TILECLS);
    const int ntiles = __builtin_amdgcn_readfirstlane(((const GAS int*)tc)[MOE_TILES]); const int nunits = ntiles * 4; int n = 0;
    for (int L = bx; L < nunits; L += G) ++n;
    if (tid < n) { const int L = bx + tid * G, tile = L >> 2, j = L & 3; const int cls = ((const GAS int*)tc)[tile]; int e_lo, e_hi; cls_experts(cls, e_lo, e_hi);
        if (DOWN) { list[4 * tid] = tile; list[4 * tid + 1] = j; list[4 * tid + 2] = e_lo * 256; list[4 * tid + 3] = e_hi * 256; }
        else { list[4 * tid] = tile; list[4 * tid + 1] = (j < 2 ? e_lo : e_hi) * 2 + (j & 1); list[4 * tid + 2] = j; list[4 * tid + 3] = 0; } }
    __syncthreads();
    return n;
}
struct EpiHid {
    static constexpr bool PERM = true, AFTER_DRAIN = false;
    bf16* HID; const float* roww;
    __device__ __forceinline__ void operator()(const pg8::f32x4 (&acc)[2][2][4][2], const pg8::Unit& u, int wr, int wc, int fr_, int fq_) const {
        int z_ = 0; asm volatile("" : "+v"(z_)); const int ln_ = __builtin_amdgcn_mbcnt_hi(~0u, __builtin_amdgcn_mbcnt_lo(~0u, z_)); const int fr = ln_ & 15, fq = ln_ >> 4; (void)fr_; (void)fq_;
        const int row0 = u.pm * 256 + wr * 64 + fr, j = u.k0, col0 = j * 128 + wc * 32 + 8 * fq;
        float wq[8];
#pragma unroll
        for (int q = 0; q < 8; ++q) wq[q] = ((const GAS float*)roww)[2 * (row0 + (q >> 2) * 128 + (q & 3) * 16) + (j >> 1)];
        asm volatile("" ::: "memory");
#pragma unroll
        for (int ai = 0; ai < 2; ++ai)
#pragma unroll
            for (int m = 0; m < 4; ++m) { const int pos = row0 + ai * 128 + m * 16; const float w = wq[ai * 4 + m];
                float h[8];
#pragma unroll
                for (int n = 0; n < 2; ++n)
#pragma unroll
                    for (int e = 0; e < 4; ++e) { const float gt = acc[ai][0][m][n][e], up = acc[ai][1][m][n][e]; h[4 * n + e] = gt * fsigmoid(gt) * up * w; }
                v4u o; o.x = pk2(h[0], h[1]); o.y = pk2(h[2], h[3]); o.z = pk2(h[4], h[5]); o.w = pk2(h[6], h[7]);
                *(GAS v4u*)(HID + (size_t)pos * 512 + col0) = o; }
    }
};
struct EpiMoeOut {
    static constexpr bool PERM = false, AFTER_DRAIN = false;
    bf16* out; const float* gate; const int* rowtok;
    __device__ __forceinline__ void operator()(const pg8::f32x4 (&acc)[2][2][4][2], const pg8::Unit& u, int wr, int wc, int fr_, int fq_) const {
        int z_ = 0; asm volatile("" : "+v"(z_)); const int ln_ = __builtin_amdgcn_mbcnt_hi(~0u, __builtin_amdgcn_mbcnt_lo(~0u, z_)); const int fr = ln_ & 15, fq = ln_ >> 4; (void)fr_; (void)fq_;
        const int row0 = u.pm * 256 + wr * 64 + fr, col0 = u.pn * 256 + wc * 32 + 4 * fq;
        int tok[8];
#pragma unroll
        for (int q = 0; q < 8; ++q) tok[q] = ((const GAS int*)rowtok)[row0 + (q >> 2) * 128 + (q & 3) * 16];
#pragma unroll
        for (int q = 0; q < 8; ++q) { const int tk = tok[q];
            if (tk >= 0) { const float* gb = gate + (size_t)(tk >> 12) * 6144; bf16* orow = out + (size_t)tk * 1024;
                v2u w[4];
#pragma unroll
                for (int bn = 0; bn < 4; ++bn) w[bn] = *(const GAS v2u*)(orow + col0 + (bn >> 1) * 128 + (bn & 1) * 16);
                asm volatile("" ::: "memory");
#pragma unroll
                for (int bn = 0; bn < 4; ++bn) { const int c = col0 + (bn >> 1) * 128 + (bn & 1) * 16; const pg8::f32x4 gv = *(const GAS pg8::f32x4*)(gb + c);
                    const pg8::f32x4 o = (pg8::f32x4){bflo(w[bn].x), bfhi(w[bn].x), bflo(w[bn].y), bfhi(w[bn].y)} + gv * acc[q >> 2][bn >> 1][q & 3][bn & 1]; v2u ow; ow.x = pk2(o[0], o[1]); ow.y = pk2(o[2], o[3]); *(GAS v2u*)(orow + c) = ow; }
                asm volatile("" ::: "memory"); } }
    }
};
}
namespace fx {
struct EpiS5Loc {
    static constexpr bool PERM = false, AFTER_DRAIN = false;
    float* LOC;
    __device__ __forceinline__ void operator()(const pg8::f32x4 (&acc)[2][2][4][2], const pg8::Unit& u, int wr, int wc, int fr_, int fq_) const {
        int z_ = 0; asm volatile("" : "+v"(z_)); const int ln_ = __builtin_amdgcn_mbcnt_hi(~0u, __builtin_amdgcn_mbcnt_lo(~0u, z_)); const int fr = ln_ & 15, fq = ln_ >> 4; (void)fr_; (void)fq_;
        const int row0 = u.pm * 256 + wr * 64 + fr, col0 = wc * 32 + 4 * fq;
#pragma unroll
        for (int n = 0; n < 2; ++n)
#pragma unroll
            for (int ai = 0; ai < 2; ++ai)
#pragma unroll
                for (int m = 0; m < 4; ++m) *(GAS pg8::f32x4*)(LOC + (size_t)(row0 + ai * 128 + m * 16) * 128 + col0 + n * 16) = acc[ai][0][m][n];
    }
};
__device__ __forceinline__ float gelu_tanh_f(float x) { const float u = 0.7978845608028654f * (x + 0.044715f * x * x * x); const float e = __builtin_amdgcn_exp2f(-2.f * LOG2E * u); return x * __builtin_amdgcn_rcpf(1.f + e); }
struct EpiS5Y {
    static constexpr bool PERM = true, AFTER_DRAIN = false;
    bf16* Y;
    __device__ __forceinline__ void operator()(const pg8::f32x4 (&acc)[2][2][4][2], const pg8::Unit& u, int wr, int wc, int fr_, int fq_) const {
        int z_ = 0; asm volatile("" : "+v"(z_)); const int ln_ = __builtin_amdgcn_mbcnt_hi(~0u, __builtin_amdgcn_mbcnt_lo(~0u, z_)); const int fr = ln_ & 15, fq = ln_ >> 4; (void)fr_; (void)fq_;
        const int g = u.pn, b = u.pm & 7, c0 = wr * 64 + fr;
#pragma unroll
        for (int bj = 0; bj < 2; ++bj) { const int n0 = bj * 128 + wc * 32 + 8 * fq, j = n0 >> 4, ch0 = n0 & 15;
#pragma unroll
            for (int ai = 0; ai < 2; ++ai)
#pragma unroll
                for (int m = 0; m < 4; ++m) { const int c = c0 + ai * 128 + m * 16; const pg8::f32x4 v0 = acc[ai][bj][m][0], v1 = acc[ai][bj][m][1];
                    v4u w; w.x = pk2(gelu_tanh_f(v0[0]), gelu_tanh_f(v0[1])); w.y = pk2(gelu_tanh_f(v0[2]), gelu_tanh_f(v0[3])); w.z = pk2(gelu_tanh_f(v1[0]), gelu_tanh_f(v1[1])); w.w = pk2(gelu_tanh_f(v1[2]), gelu_tanh_f(v1[3]));
                    *(GAS v4u*)(Y + ((size_t)(b * 4096 + c * 16 + j) * 256 + g * 16 + ch0)) = w; } }
    }
};
struct OneUnit { int pm, pn;
    __device__ __forceinline__ bool next(int i, pg8::Unit& u) const { if (i >= 1) return false; u.pm = pm; u.pn = pn; u.k0 = 0; u.k1 = 0; return true; }
    __device__ __forceinline__ void a_ready(const pg8::Unit&) const {}
    __device__ __forceinline__ void done(const pg8::Unit&) const {} };
__device__ __forceinline__ void s5_scan(unsigned char* ws, int l, int g, int b, int tid) {
    if (tid < 64) { const int q = tid; const float* al = (const float*)(ws + WS_S5AL) + ((l * 16 + g) * 64 + q) * 2; const float ar = al[0], ai = al[1];
        const float* loc = (const float*)(ws + WS_LOC) + (size_t)(g * 2048 + b * 256) * 128; bf16* up = (bf16*)(ws + WS_UP) + (size_t)(g * 2048 + b * 256) * 384 + 256;
        float sr = 0.f, si = 0.f;
        for (int c0 = 0; c0 < 256; c0 += 8) { float lr[8], li[8];
#pragma unroll
            for (int k = 0; k < 8; ++k) { lr[k] = loc[(size_t)(c0 + k) * 128 + q]; li[k] = loc[(size_t)(c0 + k) * 128 + 64 + q]; }
#pragma unroll
            for (int k = 0; k < 8; ++k) { up[(size_t)(c0 + k) * 384 + q] = (bf16)f2bf(sr); up[(size_t)(c0 + k) * 384 + 64 + q] = (bf16)f2bf(si);
                const float nr = ar * sr - ai * si + lr[k], ni = ar * si + ai * sr + li[k]; sr = nr; si = ni; } }
    }
    asm volatile("s_waitcnt vmcnt(0)" ::: "memory");
    __syncthreads();
}
struct EpiGlu {
    static constexpr bool PERM = false, AFTER_DRAIN = true;
    const bf16* Y; const float* gb; const float* bnw; bf16* MIX;
    __device__ __forceinline__ void fused(pg8::f32x4 (&acc)[2][2][4][2], const pg8::Unit& u, int wr, int wc, int fr_, int fq_, PG8_LAS unsigned char* lds, int wid, int lane_) const {
        int z_ = 0; asm volatile("" : "+v"(z_)); const int ln_ = __builtin_amdgcn_mbcnt_hi(~0u, __builtin_amdgcn_mbcnt_lo(~0u, z_)); const int fr = ln_ & 15, fq = ln_ >> 4; (void)fr_; (void)fq_; (void)wid; (void)lane_;
        PG8_LAS float* P = (PG8_LAS float*)lds;
        const int row0 = u.pm * 256 + wr * 64 + fr, col0 = wc * 32 + 4 * fq;
#pragma unroll
        for (int ai = 0; ai < 2; ++ai)
#pragma unroll
            for (int m = 0; m < 4; ++m) { const int r = row0 + ai * 128 + m * 16; float s = 0.f;
#pragma unroll
                for (int bj = 0; bj < 2; ++bj)
#pragma unroll
                    for (int n = 0; n < 2; ++n) { const int c = col0 + bj * 128 + n * 16; const pg8::f32x4 bv = *(const GAS pg8::f32x4*)(gb + c); const v2u yw = *(const GAS v2u*)(Y + (size_t)r * 256 + c);
                        pg8::f32x4 a = acc[ai][bj][m][n] + bv; const float y0 = bflo(yw.x), y1 = bfhi(yw.x), y2 = bflo(yw.y), y3 = bfhi(yw.y);
                        a[0] = y0 * fsigmoid(a[0]); a[1] = y1 * fsigmoid(a[1]); a[2] = y2 * fsigmoid(a[2]); a[3] = y3 * fsigmoid(a[3]); acc[ai][bj][m][n] = a;
                        s += (a[0] * a[0] + a[1] * a[1]) + (a[2] * a[2] + a[3] * a[3]); }
                s += lane_get(s, ln_ ^ 16); s += lane_get(s, ln_ ^ 32);
                if (fq == 0) P[(wr * 64 + ai * 128 + m * 16 + fr) * 4 + wc] = s; }
        asm volatile("s_waitcnt lgkmcnt(0)" ::: "memory"); __builtin_amdgcn_s_barrier(); asm volatile("" ::: "memory");
        pg8::f32x4 wv4[4];
#pragma unroll
        for (int bn = 0; bn < 4; ++bn) wv4[bn] = *(const GAS pg8::f32x4*)(bnw + col0 + (bn >> 1) * 128 + (bn & 1) * 16);
        asm volatile("" ::: "memory");
#pragma unroll
        for (int ai = 0; ai < 2; ++ai)
#pragma unroll
            for (int m = 0; m < 4; ++m) { const int rl = wr * 64 + ai * 128 + m * 16 + fr, r = u.pm * 256 + rl; const PG8_LAS pg8::f32x4* pp = (const PG8_LAS pg8::f32x4*)(P + rl * 4); const pg8::f32x4 ps = *pp;
                const float rstd = __builtin_amdgcn_rsqf(((ps[0] + ps[1]) + (ps[2] + ps[3])) * (1.f / 256.f) + 1e-6f);
#pragma unroll
                for (int bj = 0; bj < 2; ++bj)
#pragma unroll
                    for (int n = 0; n < 2; ++n) { const int c = col0 + bj * 128 + n * 16; const pg8::f32x4 o = acc[ai][bj][m][n] * rstd * wv4[bj * 2 + n];
                        v2u w; w.x = pk2(o[0], o[1]); w.y = pk2(o[2], o[3]); *(GAS v2u*)(MIX + (size_t)r * 1024 + 384 + c) = w; } }
    }
};
}
namespace fx {
constexpr int HG_NSEG = 8, HG_SEGTOK = SEQ / HG_NSEG, HG_CT = 32, HG_NCH = HG_SEGTOK / HG_CT;
constexpr size_t WS_HD = WS_HLOC + 7 * MiB;
typedef short hbf16x8 __attribute__((ext_vector_type(8)));
typedef float hf32x16 __attribute__((ext_vector_type(16)));
constexpr int HL_QT = 0, HL_KT = 4608, HL_KH = 9216, HL_VT = 14336, HL_PP = 19456, HL_ST = 22016, HL_DD = 31232, HL_TOT = 31488, HL_OO = 32512, HL_END = 41216;
constexpr int HP_QK = 72, HP_T = 40, HP_OO = 68;
__device__ __forceinline__ int hcrow(int r, int hi) { return (r & 3) + 8 * (r >> 2) + 4 * hi; }

template <bool FULL>
__device__ __forceinline__ void hgrn_pair(unsigned char* ws, const float* nw_l, int l, int u0, LAS unsigned char* lds_wg, const int wave00) {
    int wave0 = wave00; asm volatile("" : "+s"(wave0));
    const int lane = lane_now(), r32 = lane & 31, hi = lane >> 5, half = wave0 >> 2, hw = wave0 & 3, htid = hw * 64 + lane;
    constexpr int NS = FULL ? HG_NSEG : HG_NSEG - 1;
    const int unit = u0 + half, bh = unit / NS, seg = unit % NS, b = bh / 6, h = bh % 6; const int d = lane, sg = hw;
    LAS unsigned char* lds = lds_wg + half * HL_END;
    const bf16* Zb = (const bf16*)(ws + WS_Z) + (size_t)(b * SEQ + seg * HG_SEGTOK) * NZ + h * 64;
    const float lbv = ((const float*)(ws + WS_LB))[l * 384 + h * 64 + d], oml = 1.f - lbv;
    LAS unsigned short* QT = (LAS unsigned short*)(lds + HL_QT); LAS unsigned short* KT = (LAS unsigned short*)(lds + HL_KT);
    LAS unsigned short* KH = (LAS unsigned short*)(lds + HL_KH); LAS unsigned short* VT = (LAS unsigned short*)(lds + HL_VT);
    LAS unsigned short* PP = (LAS unsigned short*)(lds + HL_PP); LAS unsigned short* ST = (LAS unsigned short*)(lds + HL_ST);
    LAS float* DD = (LAS float*)(lds + HL_DD); LAS float* TOT = (LAS float*)(lds + HL_TOT); LAS float* OO = (LAS float*)(lds + HL_OO);
    const int dt = hw >> 1, vt = hw & 1;
    hf32x16 S;
#pragma unroll
    for (int r = 0; r < 16; ++r) S[r] = 0.f;
    if (FULL) {
        for (int j = 0; j < seg; ++j) { const float* loc = (const float*)(ws + WS_HLOC) + (size_t)(bh * HG_NSEG + j) * 4096; const float* hd = (const float*)(ws + WS_HD) + (bh * HG_NSEG + j) * 64;
#pragma unroll
            for (int r = 0; r < 16; ++r) { const int dd = 32 * dt + hcrow(r, hi); S[r] = S[r] * hd[dd] + loc[dd * 64 + 32 * vt + r32]; } }
#pragma unroll
        for (int j = 0; j < 4; ++j) { v2u w; w.x = pk2(S[4 * j], S[4 * j + 1]); w.y = pk2(S[4 * j + 2], S[4 * j + 3]); *(LAS v2u*)(ST + (32 * vt + r32) * HP_QK + 32 * dt + 8 * j + 4 * hi) = w; }
    }
    float lsum = 0.f;
    unsigned short rf[8] = {}, rv[8] = {}, rq[8] = {}; v4u rg = {};
    { const bf16* zr = Zb + (size_t)(8 * sg) * NZ;
#pragma unroll
        for (int i = 0; i < 8; ++i) { rf[i] = zr[(size_t)i * NZ + ZC_HF + d]; rv[i] = zr[(size_t)i * NZ + ZC_HI + d]; if (FULL) rq[i] = zr[(size_t)i * NZ + ZC_HQ + d]; }
        if (FULL) rg = *(const GAS v4u*)(Zb + (size_t)(htid >> 3) * NZ + ZC_HG + 8 * (htid & 7)); }
    for (int ch = 0; ch < HG_NCH; ++ch) {
        float lf[8], kk[8], qq[8], vv[8];
#pragma unroll
        for (int i = 0; i < 8; ++i) { const float z = bf2f(rf[i]); const float s1 = fsigmoid(z); lf[i] = __logf(lbv + oml * s1); kk[i] = oml * (1.f - s1);
            vv[i] = bf2f(rv[i]); if (FULL) qq[i] = fsilu(bf2f(rq[i])); }
        const v4u gw_ = rg;
        if (ch + 1 < HG_NCH) { const bf16* zr = Zb + (size_t)((ch + 1) * HG_CT + 8 * sg) * NZ;
#pragma unroll
            for (int i = 0; i < 8; ++i) { rf[i] = zr[(size_t)i * NZ + ZC_HF + d]; rv[i] = zr[(size_t)i * NZ + ZC_HI + d]; if (FULL) rq[i] = zr[(size_t)i * NZ + ZC_HQ + d]; }
            if (FULL) rg = *(const GAS v4u*)(Zb + (size_t)((ch + 1) * HG_CT + (htid >> 3)) * NZ + ZC_HG + 8 * (htid & 7)); }
#pragma unroll
        for (int i = 1; i < 8; ++i) lf[i] += lf[i - 1];
        TOT[sg * 64 + d] = lf[7];
        __syncthreads();
        float base = 0.f, blast = 0.f;
#pragma unroll
        for (int s2 = 0; s2 < 4; ++s2) { const float tv = TOT[s2 * 64 + d]; blast += tv; if (s2 < sg) base += tv; }
        lsum += blast;
        { float kh[8];
#pragma unroll
            for (int i = 0; i < 8; ++i) { const float bi = base + lf[i]; kh[i] = kk[i] * __expf(blast - bi);
                if (FULL) { const int t = 8 * sg + i; QT[t * HP_QK + d] = (unsigned short)f2bf(qq[i] * __expf(bi)); KT[t * HP_QK + d] = (unsigned short)f2bf(kk[i] * __expf(-bi)); } }
            v4u w; w.x = pk2(kh[0], kh[1]); w.y = pk2(kh[2], kh[3]); w.z = pk2(kh[4], kh[5]); w.w = pk2(kh[6], kh[7]); *(LAS v4u*)(KH + d * HP_T + 8 * sg) = w;
            v4u wv; wv.x = pk2(vv[0], vv[1]); wv.y = pk2(vv[2], vv[3]); wv.z = pk2(vv[4], vv[5]); wv.w = pk2(vv[6], vv[7]); *(LAS v4u*)(VT + d * HP_T + 8 * sg) = wv;
            if (sg == 0) DD[d] = __expf(blast); }
        __syncthreads();
        if (FULL && hw == 0) { hf32x16 c;
#pragma unroll
            for (int r = 0; r < 16; ++r) c[r] = 0.f;
#pragma unroll
            for (int ks = 0; ks < 4; ++ks) { const hbf16x8 a = *(const LAS hbf16x8*)(QT + r32 * HP_QK + 16 * ks + 8 * hi), bb = *(const LAS hbf16x8*)(KT + r32 * HP_QK + 16 * ks + 8 * hi); c = __builtin_amdgcn_mfma_f32_32x32x16_bf16(a, bb, c, 0, 0, 0); }
#pragma unroll
            for (int r = 0; r < 16; ++r) { const int t = hcrow(r, hi); PP[t * HP_T + r32] = (unsigned short)f2bf(r32 <= t ? c[r] : 0.f); } }
        {
#pragma unroll
            for (int r = 0; r < 16; ++r) S[r] *= DD[32 * dt + hcrow(r, hi)];
#pragma unroll
            for (int ks = 0; ks < 2; ++ks) { const hbf16x8 a = *(const LAS hbf16x8*)(KH + (32 * dt + r32) * HP_T + 16 * ks + 8 * hi), bb = *(const LAS hbf16x8*)(VT + (32 * vt + r32) * HP_T + 16 * ks + 8 * hi); S = __builtin_amdgcn_mfma_f32_32x32x16_bf16(a, bb, S, 0, 0, 0); } }
        if (FULL) {
            __syncthreads();
            if (hw == 1 || hw == 2) { const int ov = hw - 1; hf32x16 c;
#pragma unroll
                for (int r = 0; r < 16; ++r) c[r] = 0.f;
#pragma unroll
                for (int ks = 0; ks < 2; ++ks) { const hbf16x8 a = *(const LAS hbf16x8*)(PP + r32 * HP_T + 16 * ks + 8 * hi), bb = *(const LAS hbf16x8*)(VT + (32 * ov + r32) * HP_T + 16 * ks + 8 * hi); c = __builtin_amdgcn_mfma_f32_32x32x16_bf16(a, bb, c, 0, 0, 0); }
#pragma unroll
                for (int ks = 0; ks < 4; ++ks) { const hbf16x8 a = *(const LAS hbf16x8*)(QT + r32 * HP_QK + 16 * ks + 8 * hi), bb = *(const LAS hbf16x8*)(ST + (32 * ov + r32) * HP_QK + 16 * ks + 8 * hi); c = __builtin_amdgcn_mfma_f32_32x32x16_bf16(a, bb, c, 0, 0, 0); }
#pragma unroll
                for (int r = 0; r < 16; ++r) OO[hcrow(r, hi) * HP_OO + 32 * ov + r32] = c[r]; }
            __syncthreads();
#pragma unroll
            for (int j = 0; j < 4; ++j) { v2u w; w.x = pk2(S[4 * j], S[4 * j + 1]); w.y = pk2(S[4 * j + 2], S[4 * j + 3]); *(LAS v2u*)(ST + (32 * vt + r32) * HP_QK + 32 * dt + 8 * j + 4 * hi) = w; }
            { const int t = htid >> 3, vg = htid & 7; const f32x4 o0 = *(const LAS f32x4*)(OO + t * HP_OO + 8 * vg), o1 = *(const LAS f32x4*)(OO + t * HP_OO + 8 * vg + 4);
                float s = ((o0.x * o0.x + o0.y * o0.y) + (o0.z * o0.z + o0.w * o0.w)) + ((o1.x * o1.x + o1.y * o1.y) + (o1.z * o1.z + o1.w * o1.w));
                s += lane_get(s, lane ^ 1); s += lane_get(s, lane ^ 2); s += lane_get(s, lane ^ 4);
                const float rstd = __builtin_amdgcn_rsqf(s * (1.f / 64.f) + 1e-6f); const size_t row = (size_t)(b * SEQ + seg * HG_SEGTOK + ch * HG_CT + t);
                const f32x4 w0 = *(const GAS f32x4*)(nw_l + 8 * vg), w1 = *(const GAS f32x4*)(nw_l + 8 * vg + 4);
                v4u w; w.x = pk2(o0.x * rstd * w0.x * fsilu(bflo(gw_.x)), o0.y * rstd * w0.y * fsilu(bfhi(gw_.x))); w.y = pk2(o0.z * rstd * w0.z * fsilu(bflo(gw_.y)), o0.w * rstd * w0.w * fsilu(bfhi(gw_.y)));
                w.z = pk2(o1.x * rstd * w1.x * fsilu(bflo(gw_.z)), o1.y * rstd * w1.y * fsilu(bfhi(gw_.z))); w.w = pk2(o1.z * rstd * w1.z * fsilu(bflo(gw_.w)), o1.w * rstd * w1.w * fsilu(bfhi(gw_.w)));
                *(GAS v4u*)((bf16*)(ws + WS_H) + row * 1024 + 640 + h * 64 + 8 * vg) = w; }
        }
    }
    if (!FULL) {
        { float* loc = (float*)(ws + WS_HLOC) + (size_t)(bh * HG_NSEG + seg) * 4096;
#pragma unroll
            for (int r = 0; r < 16; ++r) loc[(32 * dt + hcrow(r, hi)) * 64 + 32 * vt + r32] = S[r]; }
        if (sg == 0) ((float*)(ws + WS_HD))[(bh * HG_NSEG + seg) * 64 + d] = __expf(lsum);
    }
    __syncthreads();
}
}
namespace fx {
constexpr int LDS_BYTES = 147456;
constexpr int RING_BYTES = 131072, LDSCTL_OFF = RING_BYTES, MISC_OFF = LDSCTL_OFF + 320;
constexpr int PH_PRO = 0, PH_FINAL = 21, NPH = 22;

struct QueueOrder {
    unsigned* ctr; LAS unsigned* slot;
    __device__ __forceinline__ bool next(int, attn_body::AttnUnit& u) const {
        if (threadIdx.x == 0) *slot = __hip_atomic_fetch_add(ctr, 1u, __ATOMIC_RELAXED, __HIP_MEMORY_SCOPE_AGENT);
        __syncthreads(); const unsigned v = *slot; __syncthreads();
        if (v >= 768u) return false; u.bh = (int)(v >> 4); u.qb = 15 - (int)(v & 15u); return true; }
    __device__ __forceinline__ void a_ready(const attn_body::AttnUnit&) const {}
    __device__ __forceinline__ void done(const attn_body::AttnUnit&) const {}
};

__global__ void __launch_bounds__(NTHR, 2) mk_fwd(Params p) {
    extern __shared__ __attribute__((aligned(16))) unsigned char lds_raw[];
    LAS unsigned char* lds = (LAS unsigned char*)lds_raw;
    const int wave0 = __builtin_amdgcn_readfirstlane(threadIdx.x >> 6);
    for (int u = threadIdx.x; u < (LDS_BYTES - LDSCTL_OFF) / 4; u += NTHR) ((LAS unsigned*)(lds + LDSCTL_OFF))[u] = 0u;
    __syncthreads();
    const XcdBarrier bar = xcd_barrier_post((unsigned*)(p.ws + WS_CTL) + 8192 + p.li * 4096, (volatile LAS unsigned*)(lds + MISC_OFF) + 8, threadIdx.x == 0);
#ifdef EXTRA_BARS
    for (int eb = 0; eb < EXTRA_BARS; ++eb) xcd_barrier(bar, wave0 == 0 && lane_now() == 0);
#endif
    for (int ph = p.ph_lo; ph < p.ph_hi; ++ph) {
#ifdef DUP_MASK
      for (int rep = (((DUP_MASK) >> ph) & 1u) ? 0 : 1; rep < 2; ++rep) {
#else
      { const int rep = 1;
#endif
#ifdef PROBE_MASK
        if (blockIdx.x == 0 && wave0 == 0 && lane_now() == 0) __hip_atomic_store((unsigned long long*)(p.ws + WS_CTL + 512 * 1024) + ph, __builtin_amdgcn_s_memrealtime(), __ATOMIC_RELAXED, __HIP_MEMORY_SCOPE_AGENT);
#endif
        int oz = 0; asm volatile("" : "+s"(oz));
        const int G = gridDim.x, bx = blockIdx.x + oz;
#define PHASE_IDS int wv_ = wave0; asm volatile("" : "+s"(wv_)); const int lane = lane_now(), wave = wv_, tid = wv_ * 64 + lane; \
        const int vcu = (G % 8 == 0) ? (bx % 8) * (G / 8) + bx / 8 : bx; const int gw = vcu * NWAVES + wave, ngw = G * NWAVES; (void)tid; (void)lane; (void)gw; (void)ngw;
        unsigned char* ws = p.ws + oz;
#define PIN(i) (p.in[(i) + oz])
        const int l = (ph - 1) / 10, sub = (ph - 1) % 10;
#ifndef EXP_NO_PRO
        if (ph == PH_PRO) { PHASE_IDS
            { LAS float* cact = (LAS float*)lds; const float* c = PIN(I_C); for (int i = tid; i < 8192; i += NTHR) { const float cv = c[i]; cact[i] = cv * fsigmoid(cv); } __syncthreads();
              for (int it = bx; it < 192; it += G) prologue_mod_item(p, oz, it, (LAS float*)lds, tid, lane, wave); }
            __syncthreads();
            for (int it = (G >= 224 ? bx - 192 : bx); it >= 0 && it < 32; it += G) prologue_s5_item(p, oz, it / 16, it % 16, (LAS float*)lds, tid);
            __syncthreads();
            prologue_wave_items(p, oz, (LAS float*)(lds + wave * 16384), gw, ngw, lane);
        } else
#endif
        if (ph == PH_FINAL) { PHASE_IDS
            float* X = p.out + oz; const bf16* XBp = (const bf16*)(ws + WS_XB); const float* w = PIN(I_FINW);
#ifdef PROBE_MASK
            float pscale = 1.f; { unsigned long long* tsb = (unsigned long long*)(ws + WS_CTL + 512 * 1024); unsigned long long t0 = __hip_atomic_load(tsb, __ATOMIC_RELAXED, __HIP_MEMORY_SCOPE_AGENT), tl = __hip_atomic_load(tsb + PH_FINAL, __ATOMIC_RELAXED, __HIP_MEMORY_SCOPE_AGENT); unsigned long long acc = 0;
#pragma unroll 1
                for (int k = 0; k < PH_FINAL; ++k) if ((PROBE_MASK >> k) & 1u) acc += __hip_atomic_load(tsb + k + 1, __ATOMIC_RELAXED, __HIP_MEMORY_SCOPE_AGENT) - __hip_atomic_load(tsb + k, __ATOMIC_RELAXED, __HIP_MEMORY_SCOPE_AGENT);
                pscale = 1.f + (float)acc / (float)(tl - t0); }
#endif
            f32x4 W4[4];
#pragma unroll
            for (int j = 0; j < 4; ++j) W4[j] = ((const GAS f32x4*)w)[lane + 64 * j];
            f32x4 v[4] = {}; if (gw < M) row_load_bf(XBp, gw, lane, v);
            for (int m = gw; m < M; m += ngw) { GAS f32x4* xr = (GAS f32x4*)(X + (size_t)m * 1024) + lane; f32x4 nxt[4] = {}; const int mn = m + ngw; if (mn < M) row_load_bf(XBp, mn, lane, nxt); float s = 0.f;
#pragma unroll
                for (int j = 0; j < 4; ++j) s += (v[j].x * v[j].x + v[j].y * v[j].y) + (v[j].z * v[j].z + v[j].w * v[j].w);
                const float rstd = __builtin_amdgcn_rsqf(wave_sum(s, lane) * (1.f / 1024.f) + 1e-6f);
#pragma unroll
                for (int j = 0; j < 4; ++j) { f32x4 o = (v[j] * rstd) * W4[j];
#ifdef PROBE_MASK
                    o = o * pscale;
#endif
                    xr[64 * j] = o; }
#pragma unroll
                for (int j = 0; j < 4; ++j) v[j] = nxt[j]; }
        }
#ifndef EXP_NO_ROW
        else if (sub == 0) { PHASE_IDS
            const float* X = PIN(I_X); const float* mod = (const float*)(ws + WS_MOD) + l * 8 * 6144;
            const int tpw = M / G, t0 = bx * tpw, b = t0 >> 12; f32x4 A[4], B[4]; adaln_factors(PIN(I_NMW) + l * 1024, mod + b * 6144, mod + b * 6144 + 1024, lane, A, B);
            const bf16* XBp = (const bf16*)(ws + WS_XB);
            f32x4 cur[4] = {}; if (wave < tpw) { if (l == 0) row_load(X, t0 + wave, lane, cur); else row_load_bf(XBp, t0 + wave, lane, cur); }
            for (int r = wave; r < tpw; r += NWAVES) { f32x4 nxt[4] = {}; if (r + NWAVES < tpw) { if (l == 0) row_load(X, t0 + r + NWAVES, lane, nxt); else row_load_bf(XBp, t0 + r + NWAVES, lane, nxt); }
                norm_row_to_bf16(cur, A, B, (bf16*)(ws + WS_H) + (size_t)(t0 + r) * 1024, lane);
#pragma unroll
                for (int j = 0; j < 4; ++j) cur[j] = nxt[j]; }
        }
#endif
        else if (sub == 1) {
            pg8::Gemm g{(const pg8::bf16_t*)(ws + WS_H), (const pg8::bf16_t*)(ws + WS_WIN) + (size_t)l * 3072 * 1024, M, NZ, 1024, 1024, 1024};
            pg8::StaticOrder S; S.init(M, NZ, G, bx);
            EpiZ E{(bf16*)(ws + WS_Z), (bf16*)(ws + WS_UP), (float*)(ws + WS_NLF), PIN(I_FOXB) + l * 6};
#ifdef EXP_EPI_BF16
            pg8::EpiBf16<0> E2{(bf16*)(ws + WS_Z), NZ, nullptr, 0, 0, 1.f};
            pg8::gemm_phase<pg8::EpiBf16<0>, pg8::StaticOrder, true, true>(lds, g, S, E2);
#else
            pg8::gemm_phase<EpiZ, pg8::StaticOrder, true, true>(lds, g, S, E, wave0);
#endif
        }
        else if (sub == 2) {
            unsigned* qctr = (unsigned*)(ws + WS_CTL) + 1024 + ph * 64 + rep * 32; LAS unsigned* qslot = (LAS unsigned*)(lds + MISC_OFF);
            constexpr unsigned NHL = 48u * (HG_NSEG - 1) / 2u;
            for (;;) {
                int ozq = 0; asm volatile("" : "+s"(ozq)); unsigned char* wsq = p.ws + ozq;
                if (wave0 == 0 && lane_now() == 0) *qslot = __hip_atomic_fetch_add(qctr, 1u, __ATOMIC_RELAXED, __HIP_MEMORY_SCOPE_AGENT);
                __syncthreads(); const unsigned v = __builtin_amdgcn_readfirstlane(*qslot); __syncthreads();
                if (v >= NHL + 128u + 48u + 768u) break;
                if (v < NHL) { hgrn_pair<false>(wsq, p.in[I_HNW + ozq] + l * 64, l, (int)(2u * v), lds, wave0); }
                else if (v < NHL + 128u) { const int u5 = (int)(v - NHL); const OneUnit S5{u5, u5 >> 3};
                    pg8::Gemm g5{(const pg8::bf16_t*)(wsq + WS_UP), (const pg8::bf16_t*)(wsq + WS_S5WL) + (size_t)l * 16 * 256 * 256, 16 * 2048, 16 * 256, 256, 384, 256}; EpiS5Loc E5{(float*)(wsq + WS_LOC)}; pg8::gemm_phase<EpiS5Loc, OneUnit, false, true>(lds, g5, S5, E5, wave0); __syncthreads(); }
                else if (v >= NHL + 128u + 48u) {
                    const int u = (int)(v - NHL - 128u - 48u), bh = u >> 4, qb = u & 15, b = bh / 6, h = bh % 6; int wv_ = wave0; asm volatile("" : "+s"(wv_)); const int lane = lane_now();
                    const bf16* Zr = (const bf16*)(wsq + WS_Z) + (size_t)(b * SEQ + qb * 256 + wv_ * 32) * NZ + h * 64; float kmax = 0.f, qmax = 0.f;
#pragma unroll
                    for (int i = 0; i < 8; ++i) { const bf16* rp = Zr + (size_t)(4 * i + (lane >> 4)) * NZ + 4 * (lane & 15); const v2u kw = *(const GAS v2u*)(rp + ZC_FK), qw = *(const GAS v2u*)(rp + ZC_FQ);
                        float ks = (bflo(kw.x) * bflo(kw.x) + bfhi(kw.x) * bfhi(kw.x)) + (bflo(kw.y) * bflo(kw.y) + bfhi(kw.y) * bfhi(kw.y)), qs = (bflo(qw.x) * bflo(qw.x) + bfhi(qw.x) * bfhi(qw.x)) + (bflo(qw.y) * bflo(qw.y) + bfhi(qw.y) * bfhi(qw.y));
                        ks += lane_get(ks, lane ^ 1); qs += lane_get(qs, lane ^ 1); ks += lane_get(ks, lane ^ 2); qs += lane_get(qs, lane ^ 2); ks += lane_get(ks, lane ^ 4); qs += lane_get(qs, lane ^ 4); ks += lane_get(ks, lane ^ 8); qs += lane_get(qs, lane ^ 8);
                        kmax = fmaxf(kmax, ks); qmax = fmaxf(qmax, qs); }
                    kmax = fmaxf(kmax, lane_get(kmax, lane ^ 16)); qmax = fmaxf(qmax, lane_get(qmax, lane ^ 16)); kmax = fmaxf(kmax, lane_get(kmax, lane ^ 32)); qmax = fmaxf(qmax, lane_get(qmax, lane ^ 32));
                    LAS float* red = (LAS float*)lds; if (lane == 0) { red[wv_] = kmax; red[8 + wv_] = qmax; }
                    __syncthreads();
                    if (wv_ == 0 && lane < 4) ((float*)(wsq + WS_KN))[bh * 64 + qb * 4 + lane] = fmaxf(red[2 * lane], red[2 * lane + 1]) * 1.02f;
                    if (wv_ == 0 && lane == 4) { float m = red[8]; for (int w = 1; w < 8; ++w) m = fmaxf(m, red[8 + w]); ((float*)(wsq + WS_QN))[bh * 16 + qb] = m * 1.02f; }
                    __syncthreads(); }
                else { const int bh = (int)(v - NHL - 128u); int wv_ = wave0; asm volatile("" : "+s"(wv_)); const int lane = lane_now(), wave = wv_, tid = wv_ * 64 + lane; LAS float* wsum = (LAS float*)lds;
                    const float* src = (const float*)(wsq + WS_NLF) + (size_t)bh * SEQ + tid * 8; float v8[8]; float s = 0.f;
                    const f32x4 a = *(const GAS f32x4*)src, b4 = *(const GAS f32x4*)(src + 4);
                    v8[0] = a.x; v8[1] = a.y; v8[2] = a.z; v8[3] = a.w; v8[4] = b4.x; v8[5] = b4.y; v8[6] = b4.z; v8[7] = b4.w;
#pragma unroll
                    for (int i = 0; i < 8; ++i) { s += v8[i]; v8[i] = s; }
                    float incl = s;
#pragma unroll
                    for (int o = 1; o < 64; o <<= 1) { const float n = lane_get(incl, lane - o); if (lane >= o) incl += n; }
                    if (lane == 63) wsum[wave] = incl;
                    __syncthreads();
                    float base = incl - s;
                    for (int w = 0; w < wave; ++w) base += wsum[w];
                    float* dst = (float*)(wsq + WS_G) + (size_t)bh * SEQ + tid * 8;
                    *(GAS f32x4*)dst = (f32x4){v8[0] + base, v8[1] + base, v8[2] + base, v8[3] + base}; *(GAS f32x4*)(dst + 4) = (f32x4){v8[4] + base, v8[5] + base, v8[6] + base, v8[7] + base};
                    __syncthreads(); }
            }
        }
        else if (sub == 3) {
            unsigned* qctr = (unsigned*)(ws + WS_CTL) + 1024 + ph * 64 + rep * 32; LAS unsigned* qslot = (LAS unsigned*)(lds + MISC_OFF);
            for (;;) {
                int ozq = 0; asm volatile("" : "+s"(ozq)); unsigned char* wsq = p.ws + ozq;
                if (wave0 == 0 && lane_now() == 0) *qslot = __hip_atomic_fetch_add(qctr, 1u, __ATOMIC_RELAXED, __HIP_MEMORY_SCOPE_AGENT);
                __syncthreads(); const unsigned v = __builtin_amdgcn_readfirstlane(*qslot); __syncthreads();
                constexpr unsigned NHF = 48u * HG_NSEG / 2u;
                if (v >= NHF + 128u + 768u) break;
#ifdef DUP_MASK
#ifndef DUP_CSEL
                if (rep == 0 && v >= NHF + 128u) break;
#else
                if (rep == 0 && DUP_CSEL != 3 && v >= NHF + 128u) break;
#endif
#ifdef DUP_CSEL
                if (rep == 0 && DUP_CSEL == 1 && v >= NHF) break;
                if (rep == 0 && DUP_CSEL == 2 && v < NHF) continue;
                if (rep == 0 && DUP_CSEL == 3 && v < NHF + 128u) continue;
#endif
#endif
                if (v < NHF) { hgrn_pair<true>(wsq, p.in[I_HNW + ozq] + l * 64, l, (int)(2u * v), lds, wave0); }
                else if (v < NHF + 128u) { const unsigned v5 = v - NHF;
                    s5_scan(wsq, l, (int)(v5 >> 3), (int)(v5 & 7u), wave0 * 64 + lane_now());
                    pg8::Gemm g5{(const pg8::bf16_t*)(wsq + WS_UP), (const pg8::bf16_t*)(wsq + WS_S5WO) + (size_t)l * 16 * 256 * 384, 16 * 2048, 16 * 256, 384, 384, 384}; EpiS5Y E5{(bf16*)(wsq + WS_Y)};
                    const OneUnit S5{(int)v5, (int)(v5 >> 3)}; pg8::gemm_phase<EpiS5Y, OneUnit, false, false>(lds, g5, S5, E5, wave0); __syncthreads(); }
                else { const unsigned a = v - NHF - 128u; const int bh = (int)(a >> 4), qb = 15 - (int)(a & 15u);
                    const attn_body::bf16* Zq = (const attn_body::bf16*)(wsq + WS_Z);
                    int ts; { const int ln = lane_now(); const float* Gb = (const float*)(wsq + WS_G) + (size_t)bh * SEQ; const float* KN = (const float*)(wsq + WS_KN) + bh * 64; const float qn = ((const float*)(wsq + WS_QN))[bh * 16 + qb];
                        const float kd = fmaxf(fmaxf(KN[4 * qb], KN[4 * qb + 1]), fmaxf(KN[4 * qb + 2], KN[4 * qb + 3])); const float ub = __builtin_sqrtf(qn * KN[ln]) + Gb[64 * ln + 63] - Gb[256 * qb] + __builtin_sqrtf(qn * kd);
                        const unsigned long long need = __ballot((ln < 4 * qb) && !(ub < -36.f)); const int first = need ? (int)__builtin_ctzll(need) : 4 * qb; ts = __builtin_amdgcn_readfirstlane(first & ~1); }
                    attn_body::attn_unit<8>(bh / 6, bh % 6, qb, Zq + ZC_FQ, Zq + ZC_FK, Zq + ZC_FV, (attn_body::bf16*)(wsq + WS_Z) + ZC_FQ, (const float*)(wsq + WS_G) + (long)bh * SEQ, (char*)lds_raw, wave0, ts, rep != 0); }
            }
        }
        else if (sub == 4) { PHASE_IDS
            if (bx < 128) {
                pg8::Gemm gg{(const pg8::bf16_t*)(ws + WS_Y), (const pg8::bf16_t*)(ws + WS_GLU) + (size_t)l * 256 * 256, M, 256, 256, 256, 256};
                const OneUnit SG{bx, 0}; EpiGlu EG{(const bf16*)(ws + WS_Y), PIN(I_GLUB) + l * 256, PIN(I_BNS) + l * 256, (bf16*)(ws + WS_H)};
                pg8::gemm_phase<EpiGlu, OneUnit, false, true>(lds, gg, SG, EG, wave0);
            } else {
            const int gw2 = (bx - 128) * NWAVES + wave, ngw2 = (G - 128) * NWAVES;
            const bf16* Zb = (const bf16*)(ws + WS_Z); bf16* MIX = (bf16*)(ws + WS_H); const float* w = PIN(I_BNF) + l * 384;
            float wl[6];
#pragma unroll
            for (int i = 0; i < 6; ++i) wl[i] = w[lane * 6 + i];
            for (int m = gw2; m < M; m += ngw2) {
                const GAS unsigned* src = (const GAS unsigned*)(Zb + (size_t)m * NZ) + lane * 3; const unsigned a = src[0], b2 = src[1], c = src[2];
                float v[6] = {bflo(a), bfhi(a), bflo(b2), bfhi(b2), bflo(c), bfhi(c)}; float s = 0.f;
#pragma unroll
                for (int i = 0; i < 6; ++i) s += v[i] * v[i];
                const float rstd = __builtin_amdgcn_rsqf(wave_sum(s, lane) * (1.f / 384.f) + 1e-6f);
                GAS unsigned* dst = (GAS unsigned*)(MIX + (size_t)m * 1024) + lane * 3;
                dst[0] = pk2(v[0] * rstd * wl[0], v[1] * rstd * wl[1]); dst[1] = pk2(v[2] * rstd * wl[2], v[3] * rstd * wl[3]); dst[2] = pk2(v[4] * rstd * wl[4], v[5] * rstd * wl[5]);
            }
            }
        }
        else if (sub == 5) {
            pg8::Gemm g{(const pg8::bf16_t*)(ws + WS_H), (const pg8::bf16_t*)(ws + WS_WOUT) + (size_t)l * 1024 * 1024, M, 1024, 1024, 1024, 1024};
            pg8::StaticOrder S; S.init(M, 1024, G, bx);
            const float* gm = (const float*)(ws + WS_MOD) + l * 8 * 6144 + 2048;
            if (l == 0) { EpiRes<true> E{PIN(I_X), (bf16*)(ws + WS_XB), gm}; pg8::gemm_phase<EpiRes<true>, pg8::StaticOrder, true, true>(lds, g, S, E, wave0); }
            else { EpiRes<false> E{ws + WS_XB, (bf16*)(ws + WS_XB), gm}; pg8::gemm_phase<EpiRes<false>, pg8::StaticOrder, true, true>(lds, g, S, E, wave0); }
        }
        else if (sub == 6) { PHASE_IDS moe_route(p, oz, l, lds, tid, lane, wave, bx, G);
        }
        else if (sub == 7) { PHASE_IDS moe_gather(p, oz, lds, tid, lane, wave, bx, G);
        }
        else if (sub == 8) { PHASE_IDS
            LAS int* list = (LAS int*)(lds + RING_BYTES + 1024); const int n = moe_build_list<false>(ws, list, tid, bx, G);
            pg8::Gemm g{(const pg8::bf16_t*)(ws + WS_H2S), (const pg8::bf16_t*)(ws + WS_W1) + (size_t)l * 8192 * 1024, MOE_ROWS, 8192, 1024, 1024, 1024};
            ListOrder S{list, n}; EpiHid E{(bf16*)(ws + WS_HID), (const float*)(ws + WS_ROWW)};
            pg8::gemm_phase<EpiHid, ListOrder, true, true>(lds, g, S, E, wave0);
        }
        else if (sub == 9) { PHASE_IDS
            LAS int* list = (LAS int*)(lds + RING_BYTES + 1024); const int n = moe_build_list<true>(ws, list, tid, bx, G);
            pg8::Gemm g{(const pg8::bf16_t*)(ws + WS_HID), (const pg8::bf16_t*)(ws + WS_W2) + (size_t)l * 1024 * 4096, MOE_ROWS, 1024, 512, 512, 4096};
            ListOrder S{list, n}; EpiMoeOut E{(bf16*)(ws + WS_XB), (const float*)(ws + WS_MOD) + l * 8 * 6144 + 5 * 1024, (const int*)(ws + WS_ROWTOK)};
            pg8::gemm_phase<EpiMoeOut, ListOrder, false, true, true>(lds, g, S, E, wave0);
        }
        if (ph + 1 < p.ph_hi || rep == 0) xcd_barrier(bar, wave0 == 0 && lane_now() == 0); else __syncthreads();
      }
    }
}

static int g_grid = 0;
inline bool mk_setup() {
    if (g_grid) return g_grid > 0;
    int dev = 0, cus = 0;
    if (hipGetDevice(&dev) != hipSuccess || hipDeviceGetAttribute(&cus, hipDeviceAttributeMultiprocessorCount, dev) != hipSuccess) { g_grid = -1; return false; }
    if (hipFuncSetAttribute((const void*)mk_fwd, hipFuncAttributeMaxDynamicSharedMemorySize, LDS_BYTES) != hipSuccess) { fprintf(stderr, "hipFuncSetAttribute failed\n"); g_grid = -1; return false; }
    g_grid = cus; return true;
}
inline void mk_zero_ctl(void* d_ws, hipStream_t st) { (void)hipMemsetAsync((char*)d_ws + WS_CTL, 0, CTL_ZERO_BYTES, st); }
inline void mk_launch(void* const* d_in, void* d_out, void* d_ws, hipStream_t st, int lo, int hi, int li = 0) {
    if (!mk_setup()) return;
    Params p{}; for (int i = 0; i < 29; ++i) p.in[i] = (const float*)d_in[i]; p.out = (float*)d_out; p.ws = (unsigned char*)d_ws; p.ph_lo = lo; p.ph_hi = hi; p.li = li;
    hipLaunchKernelGGL(mk_fwd, dim3(g_grid), dim3(NTHR), LDS_BYTES, st, p);
}
}
extern "C" void kernel_launch(void* const* d_in, const int* in_sizes, int n_in, void* d_out, int out_size, void* d_ws, size_t ws_size, hipStream_t stream) {
    fx::mk_zero_ctl(d_ws, stream);
    fx::mk_launch(d_in, d_out, d_ws, stream, 0, 22, 0);
}
```

```cpp
#include <hip/hip_runtime.h>
#include <hip/hip_bf16.h>
#include <cstdio>
#include <cstdint>
#include <cmath>
namespace fx {
constexpr int BATCH = 8, SEQ = 4096, DM = 1024, M = BATCH * SEQ, NZ = 3072, NIN = 2950;
constexpr int NWAVES = 8, NTHR = 512;
constexpr float LOG2E = 1.4426950408889634f;
constexpr float C2 = 0.125f * LOG2E;
constexpr int ZC_FQ = 0, ZC_FK = 384, ZC_FV = 768, ZC_SU = 1152, ZC_HQ = 1408, ZC_HF = 1792, ZC_HI = 2176, ZC_HG = 2560, ZC_FF = 2944;
constexpr size_t MiB = 1u << 20;
constexpr size_t WS_CTL = 0, CTL_ZERO_BYTES = 1 * MiB;
constexpr size_t WS_MOD = 1 * MiB;
constexpr size_t WS_LB = WS_MOD + 512 * 1024;
constexpr size_t WS_S5AL = WS_LB + 4096;
constexpr size_t WS_NLF = 2 * MiB;
constexpr size_t WS_G = WS_NLF + 48 * 4096 * 4;
constexpr size_t WS_KN = WS_G + 48 * 4096 * 4;
constexpr size_t WS_QN = WS_KN + 48 * 64 * 4;
constexpr size_t WS_WIN = 4 * MiB;
constexpr size_t WS_WOUT = WS_WIN + 2ull * 3072 * 1024 * 2;
constexpr size_t WS_W1 = WS_WOUT + 2ull * 1024 * 1024 * 2;
constexpr size_t WS_W2 = WS_W1 + 2ull * 8192 * 1024 * 2;
constexpr size_t WS_GLU = WS_W2 + 2ull * 1024 * 4096 * 2;
constexpr size_t WS_S5WO = WS_GLU + 2ull * 256 * 256 * 2;
constexpr size_t WS_S5WL = WS_S5WO + 2ull * 16 * 256 * 384 * 2;
constexpr size_t WS_H = 80 * MiB;
constexpr size_t WS_Z = WS_H + (size_t)M * 1024 * 2;
constexpr size_t WS_UP = WS_Z + (size_t)M * NZ * 2;
constexpr size_t WS_LOC = WS_UP + 16ull * 2048 * 384 * 2;
constexpr size_t WS_Y = WS_LOC + 16ull * 2048 * 128 * 4;
constexpr size_t WS_HLOC = WS_Y + (size_t)M * 256 * 2;
constexpr size_t WS_XB = WS_HLOC + 16 * MiB;
constexpr size_t WS_END = WS_XB + (size_t)M * 1024 * 2;
static_assert(WS_S5WL + 2ull * 16 * 256 * 256 * 2 <= WS_H, "weights fit below H");
static_assert(WS_QN + 48 * 16 * 4 <= WS_WIN, "norm tables fit below the weights");
static_assert(WS_END <= 512 * MiB, "workspace fits 512 MiB");

#define GAS __attribute__((address_space(1)))
#define LAS __attribute__((address_space(3)))
typedef unsigned short bf16;
typedef unsigned v4u __attribute__((ext_vector_type(4)));
typedef unsigned v2u __attribute__((ext_vector_type(2)));
typedef float f32x4 __attribute__((ext_vector_type(4)));
typedef GAS unsigned gu32;
#define RLX_AGENT __ATOMIC_RELAXED, __HIP_MEMORY_SCOPE_AGENT
#define LDS_WAIT() asm volatile("s_waitcnt lgkmcnt(0)" ::: "memory")
#define VM_WAIT() asm volatile("s_waitcnt vmcnt(0)" ::: "memory")
__device__ __forceinline__ unsigned f2bf(float f) { unsigned u = __builtin_bit_cast(unsigned, f); return (u + 0x7fffu + ((u >> 16) & 1u)) >> 16; }
__device__ __forceinline__ unsigned pk2(float lo, float hi) { return f2bf(lo) | (f2bf(hi) << 16); }
__device__ __forceinline__ float bf2f(unsigned short h) { return __builtin_bit_cast(float, (unsigned)h << 16); }
__device__ __forceinline__ float bflo(unsigned w) { return __builtin_bit_cast(float, w << 16); }
__device__ __forceinline__ float bfhi(unsigned w) { return __builtin_bit_cast(float, w & 0xffff0000u); }
__device__ __forceinline__ float fsigmoid(float x) { return __builtin_amdgcn_rcpf(1.f + __builtin_amdgcn_exp2f(-LOG2E * x)); }
__device__ __forceinline__ float fsilu(float x) { return x * fsigmoid(x); }
__device__ __forceinline__ float lane_get(float v, int src_lane) { return __builtin_bit_cast(float, __builtin_amdgcn_ds_bpermute(src_lane << 2, __builtin_bit_cast(int, v))); }
__device__ __forceinline__ float wave_sum(float v, int  ) {
    v += __builtin_bit_cast(float, __builtin_amdgcn_update_dpp(0, __builtin_bit_cast(int, v), 0xB1, 0xF, 0xF, false));
    v += __builtin_bit_cast(float, __builtin_amdgcn_update_dpp(0, __builtin_bit_cast(int, v), 0x4E, 0xF, 0xF, false));
    v += __builtin_bit_cast(float, __builtin_amdgcn_update_dpp(0, __builtin_bit_cast(int, v), 0x141, 0xF, 0xF, false));
    v += __builtin_bit_cast(float, __builtin_amdgcn_update_dpp(0, __builtin_bit_cast(int, v), 0x140, 0xF, 0xF, false));
    v += __builtin_bit_cast(float, __builtin_amdgcn_update_dpp(0, __builtin_bit_cast(int, v), 0x142, 0xA, 0xF, false));
    v += __builtin_bit_cast(float, __builtin_amdgcn_update_dpp(0, __builtin_bit_cast(int, v), 0x143, 0xC, 0xF, false));
    return __builtin_bit_cast(float, __builtin_amdgcn_readlane(__builtin_bit_cast(int, v), 63));
}

__device__ __forceinline__ int lane_now() { int z = 0; asm volatile("" : "+v"(z)); return (int)__builtin_amdgcn_mbcnt_hi(~0u, __builtin_amdgcn_mbcnt_lo(~0u, (unsigned)z)); }

struct Params {
    const float* in[29]; float* out; unsigned char* ws; int ph_lo, ph_hi, li, pad;
};
enum { I_X = 0, I_C, I_ADAW, I_ADAB, I_NMW, I_NFW, I_WIN, I_FOXB, I_ARE, I_AIM, I_BRE, I_BIM, I_CRE, I_CIM, I_S5D, I_LOGDT, I_GLUW, I_GLUB, I_LBL, I_HNW, I_BNF, I_BNS, I_WOUT, I_RW, I_RB, I_WG, I_WU, I_WD, I_FINW };

__device__ __forceinline__ void transpose_item(const float* src, int ld_src, int c0, int nvalid, bf16* dst, int ldd, int k0, LAS float* scr, int lane) {
#pragma unroll 8
    for (int i = 0; i < 32; ++i) { const int kk = 2 * i + (lane >> 5), n = lane & 31; scr[kk * 33 + n] = (n < nvalid) ? src[(size_t)(k0 + kk) * ld_src + c0 + n] : 0.f; }
    LDS_WAIT(); asm volatile("" ::: "memory");
    const int c = lane & 7;
#pragma unroll
    for (int j = 0; j < 4; ++j) { const int n = (lane >> 3) + 8 * j; const LAS float* s = scr + (8 * c) * 33 + n;
        v4u o; o.x = pk2(s[0 * 33], s[1 * 33]); o.y = pk2(s[2 * 33], s[3 * 33]); o.z = pk2(s[4 * 33], s[5 * 33]); o.w = pk2(s[6 * 33], s[7 * 33]);
        *(GAS v4u*)(dst + (size_t)n * ldd + k0 + 8 * c) = o; }
    LDS_WAIT(); asm volatile("" ::: "memory");
}
__device__ __forceinline__ int win_src_col(int n) {
    if (n < 1152) return n;
    if (n < 1408) return 1158 + (n - 1152);
    if (n < 2944) return 1414 + (n - 1408);
    if (n < 2950) return 1152 + (n - 2944);
    return -1;
}
__device__ __forceinline__ void prologue_wave_items(const Params& p, int oz, LAS float* scr, int gw, int ngw, int lane) {
    unsigned char* ws = p.ws + oz;
    constexpr int IT_WIN = 2 * 16 * 96, IT_WOUT = 2 * 16 * 32, IT_W1 = 2 * 16 * 256, IT_W2 = 2 * 64 * 32, IT_GLU = 2 * 4 * 8;
    constexpr int NITEMS = IT_WIN + IT_WOUT + IT_W1 + IT_W2 + IT_GLU;
    for (int it = gw; it < NITEMS; it += ngw) {
        int r = it;
        if (r < IT_WIN) { const int l = r / (16 * 96), q = r % (16 * 96), kb = q / 96, nb = q % 96, n0 = nb * 32; const int sc = win_src_col(n0);
            int nvalid = 32; if (sc < 0) nvalid = 0; else if (n0 == 2944) nvalid = 6;
            transpose_item(p.in[I_WIN + oz] + (size_t)l * 1024 * NIN, NIN, sc < 0 ? 0 : sc, nvalid, (bf16*)(ws + WS_WIN) + ((size_t)l * 3072 + n0) * 1024, 1024, kb * 64, scr, lane); continue; }
        r -= IT_WIN;
        if (r < IT_WOUT) { const int l = r / (16 * 32), q = r % (16 * 32), kb = q / 32, nb = q % 32;
            transpose_item(p.in[I_WOUT + oz] + (size_t)l * 1024 * 1024, 1024, nb * 32, 32, (bf16*)(ws + WS_WOUT) + ((size_t)l * 1024 + nb * 32) * 1024, 1024, kb * 64, scr, lane); continue; }
        r -= IT_WOUT;
        if (r < IT_W1) {
            const int l = r / (16 * 256), q = r % (16 * 256), kb = q / 256, nb = q % 256, n0 = nb * 32; const int e = n0 / 512, j = (n0 % 512) / 256, w = n0 % 256; const bool up = w >= 128; const int f0 = j * 128 + (w % 128);
            const float* src = (up ? p.in[I_WU + oz] : p.in[I_WG + oz]) + ((size_t)l * 16 + e) * 1024 * 256;
            transpose_item(src, 256, f0, 32, (bf16*)(ws + WS_W1) + ((size_t)l * 8192 + n0) * 1024, 1024, kb * 64, scr, lane); continue; }
        r -= IT_W1;
        if (r < IT_W2) { const int l = r / (64 * 32), q = r % (64 * 32), kb = q / 32, nb = q % 32;
            transpose_item(p.in[I_WD + oz] + (size_t)l * 4096 * 1024, 1024, nb * 32, 32, (bf16*)(ws + WS_W2) + ((size_t)l * 1024 + nb * 32) * 4096, 4096, kb * 64, scr, lane); continue; }
        r -= IT_W2;
        { const int l = r / 32, q = r % 32, kb = q / 8, nb = q % 8;
            transpose_item(p.in[I_GLUW + oz] + (size_t)l * 65536, 256, nb * 32, 32, (bf16*)(ws + WS_GLU) + ((size_t)l * 256 + nb * 32) * 256, 256, kb * 64, scr, lane); }
    }
    if (gw == 0) { float* lb = (float*)(ws + WS_LB); for (int j = lane; j < 384; j += 64) { const float a = p.in[I_LBL + oz][j], b = p.in[I_LBL + oz][384 + j], m = fmaxf(a, b), ea = __expf(a - m), eb = __expf(b - m); lb[j] = 0.f; lb[384 + j] = eb / (ea + eb); } }
}
__device__ __forceinline__ void prologue_mod_item(const Params& p, int oz, int item, LAS float* lds, int tid, int lane, int wave) {
    LAS float* cact = lds; LAS float* part = lds + 8192;
    const int l = item / 96, nb = item % 96, n = nb * 64 + lane; const float* W = p.in[I_ADAW + oz] + ((size_t)l * 1024 + wave * 128) * 6144 + n;
    float acc[8];
#pragma unroll
    for (int b = 0; b < 8; ++b) acc[b] = 0.f;
    for (int k0 = 0; k0 < 128; k0 += 16) { float w[16];
#pragma unroll
        for (int u = 0; u < 16; ++u) w[u] = W[(size_t)(k0 + u) * 6144];
#pragma unroll
        for (int u = 0; u < 16; ++u)
#pragma unroll
            for (int b = 0; b < 8; ++b) acc[b] += cact[b * 1024 + wave * 128 + k0 + u] * w[u]; }
#pragma unroll
    for (int b = 0; b < 8; ++b) part[(wave * 8 + b) * 64 + lane] = acc[b];
    __syncthreads();
    { const int b = tid >> 6; float s = 0.f;
#pragma unroll
        for (int w = 0; w < 8; ++w) s += part[(w * 8 + b) * 64 + lane];
        ((float*)(p.ws + oz + WS_MOD))[(l * 8 + b) * 6144 + n] = s + p.in[I_ADAB + oz][l * 6144 + n]; }
    __syncthreads();
}
__device__ __forceinline__ void prologue_s5_item(const Params& p, int oz, int l, int g, LAS float* lds, int tid) {
    LAS float* apr = lds;
    LAS float* api = lds + 17 * 64;
    LAS float* bbr = lds + 34 * 64;
    LAS float* bbi = bbr + 1024;
    LAS float* ccr = bbi + 1024;
    LAS float* cci = ccr + 1024;
    LAS float* Kt = cci + 1024;
    unsigned char* ws = p.ws + oz;
    if (tid < 64) { const int q = tid; const float dt = __expf(p.in[I_LOGDT + oz][l * 16 + g]); const float lr = p.in[I_ARE + oz][(l * 16 + g) * 64 + q], li = p.in[I_AIM + oz][(l * 16 + g) * 64 + q];
        for (int tau = 0; tau <= 16; ++tau) { const float er = expf(lr * dt * tau); float sn, cs; sincosf(li * dt * tau, &sn, &cs); apr[tau * 64 + q] = er * cs; api[tau * 64 + q] = er * sn; }
        const float ar = apr[64 + q], ai = api[64 + q]; const float nr = ar - 1.f, ni = ai, den = lr * lr + li * li; const float fr = (nr * lr + ni * li) / den, fi = (ni * lr - nr * li) / den;
        for (int c = 0; c < 16; ++c) { const float br = p.in[I_BRE + oz][((l * 16 + g) * 64 + q) * 16 + c], bi = p.in[I_BIM + oz][((l * 16 + g) * 64 + q) * 16 + c]; bbr[q * 16 + c] = fr * br - fi * bi; bbi[q * 16 + c] = fr * bi + fi * br;
            ccr[c * 64 + q] = p.in[I_CRE + oz][((l * 16 + g) * 16 + c) * 64 + q]; cci[c * 64 + q] = p.in[I_CIM + oz][((l * 16 + g) * 16 + c) * 64 + q]; }
        float* al = (float*)(ws + WS_S5AL) + ((l * 16 + g) * 64 + q) * 2; al[0] = apr[16 * 64 + q]; al[1] = api[16 * 64 + q];
    }
    __syncthreads();
    for (int idx = tid; idx < 4096; idx += NTHR) { const int tau = idx >> 8, c = (idx >> 4) & 15, c2 = idx & 15; float acc = 0.f;
        for (int q = 0; q < 64; ++q) { const float mr = ccr[c * 64 + q] * apr[tau * 64 + q] - cci[c * 64 + q] * api[tau * 64 + q], mi = ccr[c * 64 + q] * api[tau * 64 + q] + cci[c * 64 + q] * apr[tau * 64 + q];
            acc += mr * bbr[q * 16 + c2] - mi * bbi[q * 16 + c2]; }
        if (tau == 0 && c == c2) acc += p.in[I_S5D + oz][(l * 16 + g) * 16 + c];
        Kt[idx] = acc; }
    __syncthreads();
    bf16* WO = (bf16*)(ws + WS_S5WO) + (size_t)(l * 16 + g) * 256 * 384; bf16* WL = (bf16*)(ws + WS_S5WL) + (size_t)(l * 16 + g) * 256 * 256;
    for (int ch = tid; ch < 256 * 48; ch += NTHR) { const int n = ch / 48, k0 = (ch % 48) * 8, j = n >> 4, c = n & 15; float v[8];
#pragma unroll
        for (int e = 0; e < 8; ++e) { const int k = k0 + e; float val;
            if (k < 256) { const int i = k >> 4, c2 = k & 15; val = (j >= i) ? Kt[((j - i) << 8) + (c << 4) + c2] : 0.f; }
            else { const int q = (k - 256) & 63; const float pr = apr[(j + 1) * 64 + q], pi = api[(j + 1) * 64 + q], cr = ccr[c * 64 + q], ci = cci[c * 64 + q];
                val = (k - 256 < 64) ? (cr * pr - ci * pi) : -(cr * pi + ci * pr); }
            v[e] = val; }
        v4u o; o.x = pk2(v[0], v[1]); o.y = pk2(v[2], v[3]); o.z = pk2(v[4], v[5]); o.w = pk2(v[6], v[7]);
        *(GAS v4u*)(WO + (size_t)n * 384 + k0) = o; }
    for (int ch = tid; ch < 256 * 32; ch += NTHR) { const int n = ch / 32, k0 = (ch % 32) * 8; float v[8];
#pragma unroll
        for (int e = 0; e < 8; ++e) { const int k = k0 + e, i = k >> 4, c2 = k & 15; float val = 0.f;
            if (n < 128) { const int q = n & 63; const float pr = apr[(15 - i) * 64 + q], pi = api[(15 - i) * 64 + q], br = bbr[q * 16 + c2], bi = bbi[q * 16 + c2]; val = (n < 64) ? (pr * br - pi * bi) : (pr * bi + pi * br); }
            v[e] = val; }
        v4u o; o.x = pk2(v[0], v[1]); o.y = pk2(v[2], v[3]); o.z = pk2(v[4], v[5]); o.w = pk2(v[6], v[7]);
        *(GAS v4u*)(WL + (size_t)n * 256 + k0) = o; }
    __syncthreads();
}
__device__ __forceinline__ void row_load(const float* X, int m, int lane, f32x4 (&v)[4]) { const GAS f32x4* xr = (const GAS f32x4*)(X + (size_t)m * 1024) + lane;
#pragma unroll
    for (int j = 0; j < 4; ++j) v[j] = xr[64 * j]; }
__device__ __forceinline__ void row_load_bf(const bf16* X, int m, int lane, f32x4 (&v)[4]) { const GAS v2u* xr = (const GAS v2u*)(X + (size_t)m * 1024) + lane;
#pragma unroll
    for (int j = 0; j < 4; ++j) { const v2u w = xr[64 * j]; v[j] = (f32x4){bflo(w.x), bfhi(w.x), bflo(w.y), bfhi(w.y)}; } }
__device__ __forceinline__ void adaln_factors(const float* w, const float* sh, const float* sc, int lane, f32x4 (&A)[4], f32x4 (&B)[4]) {
#pragma unroll
    for (int j = 0; j < 4; ++j) { const f32x4 ww = ((const GAS f32x4*)w)[lane + 64 * j], a = ((const GAS f32x4*)sc)[lane + 64 * j]; A[j] = ww * (a + 1.f); B[j] = ((const GAS f32x4*)sh)[lane + 64 * j]; } }
__device__ __forceinline__ void norm_row_to_bf16(f32x4 (&v)[4], const f32x4 (&A)[4], const f32x4 (&B)[4], bf16* orow, int lane) {
    float s = 0.f;
#pragma unroll
    for (int j = 0; j < 4; ++j) s += (v[j].x * v[j].x + v[j].y * v[j].y) + (v[j].z * v[j].z + v[j].w * v[j].w);
    const float rstd = __builtin_amdgcn_rsqf(wave_sum(s, lane) * (1.f / 1024.f) + 1e-6f);
    GAS unsigned long long* o8 = (GAS unsigned long long*)orow + lane;
#pragma unroll
    for (int j = 0; j < 4; ++j) { const f32x4 h = (v[j] * rstd) * A[j] + B[j]; v[j] = h;
        o8[64 * j] = (unsigned long long)pk2(h.x, h.y) | ((unsigned long long)pk2(h.z, h.w) << 32); }
}
}
namespace fx {
#define XB_TMO      128
#define XB_XCNT(j)  (256  + 64 * (j))
#define XB_XSUB(j)  (1280 + 64 * (j))
#define XB_XGEN(j)  (2304 + 64 * (j))
#define XB_TOP      3328
#define XB_TOPGEN   3392
#define XCD_BAR_WORDS 3456
#define XB_SPIN_CAP (1u << 18)

__device__ __forceinline__ unsigned xb_ld(unsigned* p)              { return __hip_atomic_load(p, __ATOMIC_RELAXED, __HIP_MEMORY_SCOPE_AGENT); }
__device__ __forceinline__ unsigned xb_add(unsigned* p, unsigned v) { return __hip_atomic_fetch_add(p, v, __ATOMIC_RELAXED, __HIP_MEMORY_SCOPE_AGENT); }
__device__ __forceinline__ unsigned xb_xcc_id() { return (unsigned)__builtin_amdgcn_s_getreg((3 << 11) | 20) & 0xFu; }
#define XB_SPIN(cond, bar) do { unsigned _sp = 0; while (cond) { __builtin_amdgcn_s_sleep(1); \
    if ((++_sp & 255u) == 0u) { if (xb_ld(&(bar)[XB_TMO])) break; if (_sp > XB_SPIN_CAP) { atomicAdd(&(bar)[XB_TMO], 1u); break; } } } } while (0)

struct XcdBarrier {
    unsigned* bar; unsigned x;
    volatile LAS unsigned* st;
};

__device__ __forceinline__ XcdBarrier xcd_barrier_post(unsigned* bar, volatile LAS unsigned* st, bool leader) {
    XcdBarrier b; b.bar = bar; b.x = xb_xcc_id(); b.st = st;
    if (leader) (void)xb_add(&bar[XB_XCNT(b.x)], 1u);
    return b;
}
__device__ __forceinline__ void xcd_barrier_complete(unsigned* bar, unsigned x, unsigned& nloc, unsigned& nx) {
    const unsigned G = gridDim.x * gridDim.y * gridDim.z;
    asm volatile("" : "+s"(x));
    unsigned sum, cnt, mine, sp = 0u;
    for (;;) {
        sum = 0u; cnt = 0u; mine = 0u;
#pragma unroll
        for (unsigned j = 0; j < 16; ++j) { const unsigned c = xb_ld(&bar[XB_XCNT(j)]); sum += c; cnt += (c > 0u) ? 1u : 0u; mine = (j == x) ? c : mine; }
        if (sum == G) break;
        __builtin_amdgcn_s_sleep(1);
        if ((++sp & 255u) == 0u) { if (xb_ld(&bar[XB_TMO])) break; if (sp > XB_SPIN_CAP) { atomicAdd(&bar[XB_TMO], 1u); break; } }
    }
    nloc = mine > 0u ? mine : 1u; nx = cnt > 0u ? cnt : 1u;
}

__device__ __forceinline__ void xcd_barrier(const XcdBarrier& b, bool leader) {
    asm volatile("s_waitcnt vmcnt(0)" ::: "memory");
    __syncthreads();
    if (leader) {
        unsigned* bar = b.bar;
        __builtin_amdgcn_s_waitcnt(0);
        unsigned nloc = b.st[0], nx = b.st[1];
        if (nloc == 0u) { xcd_barrier_complete(bar, b.x, nloc, nx); b.st[0] = nloc; b.st[1] = nx; }
        const unsigned old = xb_add(&bar[XB_XSUB(b.x)], 1u);
        const unsigned gen = old / nloc;
        if (old + 1u == (gen + 1u) * nloc) {
            __builtin_amdgcn_fence(__ATOMIC_RELEASE, "agent");
            asm volatile("s_waitcnt vmcnt(0)" ::: "memory");
            const unsigned og = xb_add(&bar[XB_TOP], 1u);
            const unsigned tg = og / nx;
            if (og + 1u == (tg + 1u) * nx) xb_add(&bar[XB_TOPGEN], 1u);
            else XB_SPIN(xb_ld(&bar[XB_TOPGEN]) == tg, bar);
            __builtin_amdgcn_fence(__ATOMIC_ACQUIRE, "agent");
            xb_add(&bar[XB_XGEN(b.x)], 1u);
            asm volatile("s_waitcnt vmcnt(0)" ::: "memory");
        } else {
            XB_SPIN(xb_ld(&bar[XB_XGEN(b.x)]) == gen, bar);
            __builtin_amdgcn_fence(__ATOMIC_ACQUIRE, "agent");
            asm volatile("s_waitcnt vmcnt(0)" ::: "memory");
        }
    }
    __syncthreads();
}

}
namespace pg8 {
#define PG8_LAS __attribute__((address_space(3)))
typedef unsigned short bf16_t;
typedef short bf16x8 __attribute__((ext_vector_type(8)));
typedef float f32x4 __attribute__((ext_vector_type(4)));
typedef unsigned u32x4 __attribute__((ext_vector_type(4)));
constexpr int BM = 256, BK = 64, HALF = 128, HTB = HALF * BK * 2  , STAGE_BYTES = 8 * HTB, NXCD = 8, WGM = 8;

__host__ __device__ __forceinline__ int lds_byte(int r, int c) { const int st = (r >> 4) * 2 + (c >> 5), rr = r & 15, cc = c & 31, ob = rr * 64 + cc * 2; return st * 1024 + (ob ^ (((ob >> 9) & 1) << 5)); }
__host__ __device__ __forceinline__ void stage_rc(int b, int& R, int& C) { const int st = b / 1024, sb = b % 1024, swz = sb ^ (((sb >> 9) & 1) << 5); R = (st >> 1) * 16 + swz / 64; C = (st & 1) * 32 + (swz % 64) / 2; }
__host__ __device__ __forceinline__ int perm32(int rho) { const int n = rho >> 4, i = rho & 15; return 8 * (i >> 2) + 4 * n + (i & 3); }

struct Unit { int pm, pn; int k0, k1; };
struct Gemm { const bf16_t* A; const bf16_t* Bt; int M, N, K, lda, ldb; };

struct StaticOrder {
    int nM, nN, nwg, G, c;
    __host__ __device__ void init(int M, int N, int G_, int c_) { nM = M / BM; nN = N / BM; nwg = nM * nN; G = G_; c = c_; }
    __host__ __device__ bool next(int i, Unit& u) const {
        const long L = (long)i * G + c; if (L >= nwg) return false;
        int wgid = (int)L; { const int q = nwg / NXCD, r = nwg % NXCD, xcd = wgid % NXCD, off = wgid / NXCD; wgid = (xcd < r ? xcd * (q + 1) : r * (q + 1) + (xcd - r) * q) + off; }
        const int nig = WGM * nN, gid = wgid / nig, fm = gid * WGM, gsz = (nM - fm) < WGM ? (nM - fm) : WGM;
        u.pm = fm + ((wgid % nig) % gsz); u.pn = (wgid % nig) / gsz; return true;
    }
    __device__ __forceinline__ void a_ready(const Unit&) const {}
    __device__ __forceinline__ void done(const Unit&) const {}
};

__device__ __forceinline__ unsigned cvt_pk_bf16(float lo, float hi) { unsigned r; asm volatile("v_cvt_pk_bf16_f32 %0, %1, %2" : "=v"(r) : "v"(lo), "v"(hi)); return r; }
typedef float f32x2 __attribute__((ext_vector_type(2)));
__device__ __forceinline__ f32x2 gelu_pk(f32x2 v) {
    const f32x2 av = __builtin_elementwise_abs(v), d = av * 0.2316418882f + 1.0f;
    f32x2 t; t.x = __builtin_amdgcn_rcpf(d.x); t.y = __builtin_amdgcn_rcpf(d.y);
    f32x2 q = t * 0.5307027145f + (-0.7265760135f); q = q * t + 0.7107068705f; q = q * t + (-0.142248368f); q = q * t + 0.127414796f; q = q * t;
    const f32x2 s = (v * v) * (-0.72134752044f);
    f32x2 e; e.x = __builtin_amdgcn_exp2f(s.x); e.y = __builtin_amdgcn_exp2f(s.y);
    const f32x2 m = v * (q * e), r = v - m;
    f32x2 o; o.x = v.x < 0.f ? m.x : r.x; o.y = v.y < 0.f ? m.y : r.y; return o;
}

template <int ACT  > struct EpiBf16 {
    static constexpr bool PERM = true, AFTER_DRAIN = false; static_assert(ACT == 0 || ACT == 1, "EpiBf16: ACT is 0 (none) or 1 (gelu_pk)");
    bf16_t* O; int ldc; const float* bias; int split_cols; size_t split_stride; float scale0;
    __device__ __forceinline__ void operator()(const f32x4 (&acc)[2][2][4][2], const Unit& u, int wr, int wc, int fr, int fq) const {
        const int row0 = u.pm * BM + wr * 64 + fr; int colt = u.pn * BM; bf16_t* base = O;
        float sc = 1.f; if (split_cols) { const int t = colt / split_cols; base += (size_t)t * split_stride; colt -= t * split_cols; if (t == 0) sc = scale0; }
        const int col0 = colt + wc * 32 + 8 * fq, bcol0 = u.pn * BM + wc * 32 + 8 * fq;
        f32x4 bv[2][2];
#pragma unroll
        for (int bj = 0; bj < 2; ++bj)
#pragma unroll
            for (int n = 0; n < 2; ++n) bv[bj][n] = bias ? *(const f32x4*)(bias + bcol0 + bj * HALF + 4 * n) : (f32x4){0.f, 0.f, 0.f, 0.f};
#pragma unroll
        for (int ai = 0; ai < 2; ++ai)
#pragma unroll
            for (int m = 0; m < 4; ++m) { bf16_t* rowp = base + (size_t)(row0 + ai * HALF + m * 16) * ldc + col0;
#pragma unroll
                for (int bj = 0; bj < 2; ++bj) { f32x4 v0 = acc[ai][bj][m][0] + bv[bj][0], v1 = acc[ai][bj][m][1] + bv[bj][1];
                    if (ACT == 1) { f32x2 a = gelu_pk((f32x2){v0[0], v0[1]}), b = gelu_pk((f32x2){v0[2], v0[3]}), c = gelu_pk((f32x2){v1[0], v1[1]}), d = gelu_pk((f32x2){v1[2], v1[3]});
                        v0 = (f32x4){a.x, a.y, b.x, b.y}; v1 = (f32x4){c.x, c.y, d.x, d.y}; }
                    v0 = v0 * sc; v1 = v1 * sc; u32x4 w; w.x = cvt_pk_bf16(v0[0], v0[1]); w.y = cvt_pk_bf16(v0[2], v0[3]); w.z = cvt_pk_bf16(v1[0], v1[1]); w.w = cvt_pk_bf16(v1[2], v1[3]);
                    *(u32x4*)(rowp + bj * HALF) = w; } }
    }
};

struct PanelStats {
    unsigned* xbuf;
    unsigned* cnt;
    unsigned* tmo;
    int ntn; float eps;
    unsigned code;
    __device__ __forceinline__ bool run(const f32x4 (&v)[2][2][4][2], const Unit& u, int wr, int wc, int fr, int fq, PG8_LAS unsigned char* lds, int wid, int lane) const {
        typedef float f32x2v __attribute__((ext_vector_type(2)));
        PG8_LAS f32x2v* P = (PG8_LAS f32x2v*)lds;
        PG8_LAS f32x2v* S = (PG8_LAS f32x2v*)(lds + 8192);
        PG8_LAS unsigned* flag = (PG8_LAS unsigned*)(lds + 8192 + 2048);
#pragma unroll
        for (int ai = 0; ai < 2; ++ai)
#pragma unroll
            for (int m = 0; m < 4; ++m) {
                float s = 0.f;
#pragma unroll
                for (int bj = 0; bj < 2; ++bj)
#pragma unroll
                    for (int n = 0; n < 2; ++n) { const f32x4 x = v[ai][bj][m][n]; s += (x[0] + x[1]) + (x[2] + x[3]); }
                s += __shfl_xor(s, 16); s += __shfl_xor(s, 32);
                const float mw = s * (1.0f / 64.0f); float q = 0.f;
#pragma unroll
                for (int bj = 0; bj < 2; ++bj)
#pragma unroll
                    for (int n = 0; n < 2; ++n) { const f32x4 d = v[ai][bj][m][n] - mw; q += (d[0] * d[0] + d[1] * d[1]) + (d[2] * d[2] + d[3] * d[3]); }
                q += __shfl_xor(q, 16); q += __shfl_xor(q, 32);
                if (fq == 0) P[(ai * HALF + wr * 64 + m * 16 + fr) * 4 + wc] = (f32x2v){mw, q};
            }
        asm volatile("s_waitcnt lgkmcnt(0)" ::: "memory"); __builtin_amdgcn_s_barrier(); asm volatile("" ::: "memory");
#if defined(BROKEN_EXCHANGE_NO_WAIT)
#warning BROKEN CONTROL BUILD: the row-statistics exchange does not wait; results are wrong by design
        if (blockIdx.x >= 64) { const long long t0_ = clock64(); while (clock64() - t0_ < 60000) __builtin_amdgcn_s_sleep(8); }
#endif
        const int row = wid * 32 + (lane & 31);
        if (lane < 32) {
            const f32x2v a = P[row * 4 + 0], b = P[row * 4 + 1], c = P[row * 4 + 2], d = P[row * 4 + 3];
            const float mt = (a.x + b.x + c.x + d.x) * 0.25f;
            const float da = a.x - mt, db = b.x - mt, dc = c.x - mt, dd = d.x - mt;
            const float m2 = (a.y + b.y) + (c.y + d.y) + 64.0f * ((da * da + db * db) + (dc * dc + dd * dd));
            unsigned long long* slot = (unsigned long long*)xbuf + ((size_t)(u.pm * BM + row) * 4 + u.pn);
            __hip_atomic_store(slot, ((unsigned long long)__float_as_uint(m2) << 32) | __float_as_uint(mt), __ATOMIC_RELAXED, __HIP_MEMORY_SCOPE_AGENT);
        }
        asm volatile("s_waitcnt vmcnt(0)" ::: "memory");
        if (lane == 0) __hip_atomic_fetch_add(cnt + 64 * u.pm, 1u, __ATOMIC_RELAXED, __HIP_MEMORY_SCOPE_AGENT);
        if (wid == 0) {
            bool dead = false; const unsigned long long t0 = __builtin_amdgcn_s_memrealtime(); const unsigned want = 8u * (unsigned)ntn;
            for (;;) {
#if defined(BROKEN_EXCHANGE_NO_WAIT)
                break;
#endif
                if ((unsigned)__builtin_amdgcn_readfirstlane(__hip_atomic_load(cnt + 64 * u.pm, __ATOMIC_RELAXED, __HIP_MEMORY_SCOPE_AGENT)) >= want) break;
                if (__builtin_amdgcn_s_memrealtime() - t0 > 2000000ull) {
                    if (lane == 0) { unsigned expect = 0u; __hip_atomic_compare_exchange_strong(tmo + 1, &expect, code | (unsigned)(u.pm & 0xff), __ATOMIC_RELAXED, __ATOMIC_RELAXED, __HIP_MEMORY_SCOPE_AGENT);
                                     __hip_atomic_store(tmo, 1u, __ATOMIC_RELAXED, __HIP_MEMORY_SCOPE_AGENT); }
                    dead = true; break; }
                __builtin_amdgcn_s_sleep(2);
            }
            __builtin_amdgcn_fence(__ATOMIC_ACQUIRE, "agent");
            if (lane == 0) flag[0] = dead ? 1u : 0u;
        }
        asm volatile("s_waitcnt vmcnt(0) lgkmcnt(0)" ::: "memory"); __builtin_amdgcn_s_barrier(); asm volatile("" ::: "memory");
        const bool bad = flag[0] != 0u;
        if (lane < 32) {
            const unsigned long long* slot = (const unsigned long long*)xbuf + (size_t)(u.pm * BM + row) * 4; float mt[4], m2[4]; float ms = 0.f;
#pragma unroll
            for (int t = 0; t < 4; ++t) { if (t < ntn) { const unsigned long long w = __hip_atomic_load(slot + t, __ATOMIC_RELAXED, __HIP_MEMORY_SCOPE_AGENT); mt[t] = __uint_as_float((unsigned)w); m2[t] = __uint_as_float((unsigned)(w >> 32)); } else { mt[t] = 0.f; m2[t] = 0.f; } ms += mt[t]; }
            const float mean = ms / (float)ntn; float q = 0.f;
#pragma unroll
            for (int t = 0; t < 4; ++t) if (t < ntn) { const float dm = mt[t] - mean; q += m2[t] + 256.0f * dm * dm; }
            S[row] = (f32x2v){mean, 1.0f / sqrtf(q / (256.0f * (float)ntn) + eps)};
        }
        asm volatile("s_waitcnt lgkmcnt(0)" ::: "memory"); __builtin_amdgcn_s_barrier(); asm volatile("" ::: "memory");
        return bad;
    }
};
struct EpiLnRes {
    static constexpr bool PERM = false, AFTER_DRAIN = true;
    const float* base; float* out; int ldc; const float* bias; PanelStats st; unsigned poison;
    __device__ __forceinline__ void fused(f32x4 (&acc)[2][2][4][2], const Unit& u, int wr, int wc, int fr, int fq, PG8_LAS unsigned char* lds, int wid, int lane) const {
        typedef float f32x2v __attribute__((ext_vector_type(2)));
        const PG8_LAS f32x2v* S = (const PG8_LAS f32x2v*)(lds + 8192);
        const int col0 = u.pn * BM + wc * 32 + 4 * fq;
#pragma unroll
        for (int bj = 0; bj < 2; ++bj)
#pragma unroll
            for (int n = 0; n < 2; ++n) { const f32x4 bv = bias ? *(const f32x4*)(bias + col0 + bj * HALF + n * 16) : (f32x4){0.f, 0.f, 0.f, 0.f};
#pragma unroll
                for (int ai = 0; ai < 2; ++ai)
#pragma unroll
                    for (int m = 0; m < 4; ++m) acc[ai][bj][m][n] += bv; }
        f32x4 pre[4][2][2];
#pragma unroll
        for (int m = 0; m < 4; ++m) { const size_t off = (size_t)(u.pm * BM + wr * 64 + m * 16 + fr) * ldc + col0;
#pragma unroll
            for (int bj = 0; bj < 2; ++bj)
#pragma unroll
                for (int n = 0; n < 2; ++n) pre[m][bj][n] = *(const f32x4*)(base + off + bj * HALF + n * 16); }
        const bool bad = st.run(acc, u, wr, wc, fr, fq, lds, wid, lane) || poison != 0u;
        const float qnan = __builtin_nanf("");
#pragma unroll
        for (int ai = 0; ai < 2; ++ai)
#pragma unroll
            for (int m = 0; m < 4; ++m) { const int r = ai * HALF + wr * 64 + m * 16 + fr; const f32x2v sr = S[r]; const size_t off = (size_t)(u.pm * BM + r) * ldc + col0;
#pragma unroll
                for (int bj = 0; bj < 2; ++bj)
#pragma unroll
                    for (int n = 0; n < 2; ++n) { const f32x4 bs = ai == 0 ? pre[m][bj][n] : *(const f32x4*)(base + off + bj * HALF + n * 16); f32x4 o = bs + (acc[ai][bj][m][n] - sr.x) * sr.y;
                        if (bad) o = (f32x4){qnan, qnan, qnan, qnan}; *(f32x4*)(out + off + bj * HALF + n * 16) = o; }
                if (m & 1) asm volatile("" ::: "memory"); }
    }
};
struct EpiLnResLn {
    static constexpr bool PERM = false, AFTER_DRAIN = true;
    const float* base; float* out; bf16_t* xn; int ldc; const float* bias; PanelStats st1, st2; unsigned poison;
    __device__ __forceinline__ void fused(f32x4 (&acc)[2][2][4][2], const Unit& u, int wr, int wc, int fr, int fq, PG8_LAS unsigned char* lds, int wid, int lane) const {
        typedef float f32x2v __attribute__((ext_vector_type(2))); typedef unsigned u32x2v __attribute__((ext_vector_type(2)));
        const PG8_LAS f32x2v* S = (const PG8_LAS f32x2v*)(lds + 8192);
        const int col0 = u.pn * BM + wc * 32 + 4 * fq;
#pragma unroll
        for (int bj = 0; bj < 2; ++bj)
#pragma unroll
            for (int n = 0; n < 2; ++n) { const f32x4 bv = bias ? *(const f32x4*)(bias + col0 + bj * HALF + n * 16) : (f32x4){0.f, 0.f, 0.f, 0.f};
#pragma unroll
                for (int ai = 0; ai < 2; ++ai)
#pragma unroll
                    for (int m = 0; m < 4; ++m) acc[ai][bj][m][n] += bv; }
        bool bad = st1.run(acc, u, wr, wc, fr, fq, lds, wid, lane) || poison != 0u;
        const float qnan = __builtin_nanf("");
#pragma unroll
        for (int ai = 0; ai < 2; ++ai)
#pragma unroll
            for (int m = 0; m < 4; ++m) { const int r = ai * HALF + wr * 64 + m * 16 + fr; const f32x2v sr = S[r]; const size_t off = (size_t)(u.pm * BM + r) * ldc + col0;
#pragma unroll
                for (int bj = 0; bj < 2; ++bj)
#pragma unroll
                    for (int n = 0; n < 2; ++n) { const f32x4 bs = *(const f32x4*)(base + off + bj * HALF + n * 16); acc[ai][bj][m][n] = bs + (acc[ai][bj][m][n] - sr.x) * sr.y; }
                asm volatile("" : "+v"(acc[ai][0][m][0]), "+v"(acc[ai][0][m][1]), "+v"(acc[ai][1][m][0]), "+v"(acc[ai][1][m][1]));
                if (m & 1) asm volatile("" ::: "memory"); }
        const bool bad1 = bad;
        bad = st2.run(acc, u, wr, wc, fr, fq, lds, wid, lane) || bad;
#pragma unroll
        for (int ai = 0; ai < 2; ++ai)
#pragma unroll
            for (int m = 0; m < 4; ++m) { const int r = ai * HALF + wr * 64 + m * 16 + fr; const f32x2v sr = S[r]; const size_t off = (size_t)(u.pm * BM + r) * ldc + col0;
#pragma unroll
                for (int bj = 0; bj < 2; ++bj)
#pragma unroll
                    for (int n = 0; n < 2; ++n) { const f32x4 x1 = acc[ai][bj][m][n]; *(f32x4*)(out + off + bj * HALF + n * 16) = bad1 ? (f32x4){qnan, qnan, qnan, qnan} : x1;
                        const f32x4 o = (x1 - sr.x) * sr.y; u32x2v w; w.x = cvt_pk_bf16(o[0], o[1]); w.y = cvt_pk_bf16(o[2], o[3]);
                        if (bad) { w.x = 0x7fc07fc0u; w.y = 0x7fc07fc0u; } *(u32x2v*)(xn + off + bj * HALF + n * 16) = w; }
                asm volatile("" ::: "memory"); }
    }
};

template <class Epi, class Sched, bool ALIGN_EPI = false, bool SP2 = false, bool KSPLIT = false>
__device__ __forceinline__ void gemm_phase(PG8_LAS unsigned char* lds, const Gemm g, const Sched& S, const Epi& E, const int wave0) {
    int wv0_ = wave0; asm volatile("" : "+s"(wv0_));
    int z0_ = 0; asm volatile("" : "+v"(z0_)); const int tid_ = wv0_ * 64 + (int)__builtin_amdgcn_mbcnt_hi(~0u, __builtin_amdgcn_mbcnt_lo(~0u, (unsigned)z0_));
    const int tid = tid_, wid = __builtin_amdgcn_readfirstlane(tid >> 6), lane = tid & 63, wr = wid >> 2, wc = wid & 3, fr = lane & 15, fq = lane >> 4;
    const int K = g.K, nt = K / BK;
    unsigned voffA[2], voffB[2];
#pragma unroll
    for (int i = 0; i < 2; ++i) { int R, C; stage_rc(tid * 16 + i * 8192, R, C); const int Rb = Epi::PERM ? ((R & ~31) + perm32(R & 31)) : R;
        voffA[i] = (unsigned)(R * g.lda + C) * 2u; voffB[i] = (unsigned)(Rb * g.ldb + C) * 2u; }
    const unsigned kstep = (unsigned)(BK * 2);
    const unsigned hstepA = (unsigned)HALF * g.lda * 2, hstepB = (unsigned)HALF * g.ldb * 2;
    const unsigned tstepA = 2 * hstepA, tstepB = 2 * hstepB;
    const char* const baseA = (const char*)g.A; const char* const baseB = (const char*)g.Bt;
    const unsigned ldsw = (unsigned)wid * 1024u;
    const int aoff = lds_byte(wr * 64 + fr, fq * 8), boff = lds_byte(wc * 32 + fr, fq * 8);
#define PG8_SA(b, h) (((b) * 2 + (h)) * HTB)
#define PG8_SB(b, h) ((4 + (b) * 2 + (h)) * HTB)
#define PG8_STAGE_X(bufoff, base, soff, voff) do { _Pragma("unroll") for (int _i = 0; _i < 2; ++_i) \
        __builtin_amdgcn_global_load_lds((const unsigned*)((base) + (unsigned)((soff) + (voff)[_i])), (PG8_LAS unsigned*)(lds + (bufoff) + ldsw + _i * 8192), 16, 0, 0); } while (0)
#define PG8_LDA(dst, b, h) do { _Pragma("unroll") for (int m = 0; m < 4; ++m) _Pragma("unroll") for (int k = 0; k < 2; ++k) dst[m][k] = *(const PG8_LAS bf16x8*)(lds + PG8_SA(b, h) + aoff + m * 2048 + k * 1024); } while (0)
#define PG8_LDB(dst, b, h) do { _Pragma("unroll") for (int n = 0; n < 2; ++n) _Pragma("unroll") for (int k = 0; k < 2; ++k) dst[n][k] = *(const PG8_LAS bf16x8*)(lds + PG8_SB(b, h) + boff + n * 2048 + k * 1024); } while (0)
#define PG8_MMA(ai, bj, At, Bt) do { __builtin_amdgcn_s_setprio(1); _Pragma("unroll") for (int m = 0; m < 4; ++m) _Pragma("unroll") for (int n = 0; n < 2; ++n) _Pragma("unroll") for (int k = 0; k < 2; ++k) \
        acc[ai][bj][m][n] = __builtin_amdgcn_mfma_f32_16x16x32_bf16(Bt[n][k], At[m][k], acc[ai][bj][m][n], 0, 0, 0); __builtin_amdgcn_s_setprio(0); } while (0)
#define PG8_WAIT_V(n) asm volatile("s_waitcnt vmcnt(" #n ")" ::: "memory")
#define PG8_WAIT_L(n) asm volatile("s_waitcnt lgkmcnt(" #n ")" ::: "memory")
#define PG8_BAR __builtin_amdgcn_s_barrier()
#define PG8_SCHED __builtin_amdgcn_sched_barrier(0)
    Unit cur, nxt; int ui = 0;
    if (!S.next(0, cur)) return;
    f32x4 acc[2][2][4][2];
#pragma unroll
    for (int a = 0; a < 2; ++a)
#pragma unroll
        for (int b = 0; b < 2; ++b)
#pragma unroll
            for (int m = 0; m < 4; ++m)
#pragma unroll
                for (int n = 0; n < 2; ++n) acc[a][b][m][n] = (f32x4){0.f, 0.f, 0.f, 0.f};
    bf16x8 At[4][2], B0[2][2], B1[2][2];
    unsigned cA = (unsigned)cur.pm * tstepA; unsigned cB = (unsigned)cur.pn * tstepB + (KSPLIT ? (unsigned)cur.k0 * 2u : 0u);
    unsigned sB = KSPLIT ? (unsigned)cur.pn * tstepB + (unsigned)cur.k1 * 2u - (unsigned)(nt / 2) * kstep : cB;
    S.a_ready(cur);
    if constexpr (SP2) {
        PG8_STAGE_X(PG8_SB(0, 0), baseB, cB, voffB); PG8_STAGE_X(PG8_SB(0, 1), baseB, cB + hstepB, voffB); PG8_STAGE_X(PG8_SA(0, 0), baseA, cA, voffA); PG8_STAGE_X(PG8_SA(0, 1), baseA, cA + hstepA, voffA);
        if (wr == 1) PG8_BAR;
        PG8_WAIT_V(2); PG8_BAR;
        PG8_STAGE_X(PG8_SB(1, 0), baseB, cB + kstep, voffB); PG8_STAGE_X(PG8_SA(1, 0), baseA, cA + kstep, voffA); PG8_STAGE_X(PG8_SB(1, 1), baseB, cB + hstepB + kstep, voffB);
        PG8_WAIT_V(6); PG8_BAR;
    } else {
        PG8_STAGE_X(PG8_SB(0, 0), baseB, cB, voffB); PG8_STAGE_X(PG8_SA(0, 0), baseA, cA, voffA); PG8_STAGE_X(PG8_SB(0, 1), baseB, cB + hstepB, voffB); PG8_STAGE_X(PG8_SA(0, 1), baseA, cA + hstepA, voffA);
        if (wr == 1) PG8_BAR;
        PG8_WAIT_V(4); PG8_BAR;
        PG8_STAGE_X(PG8_SB(1, 0), baseB, cB + kstep, voffB); PG8_STAGE_X(PG8_SA(1, 0), baseA, cA + kstep, voffA); PG8_STAGE_X(PG8_SB(1, 1), baseB, cB + hstepB + kstep, voffB);
        PG8_WAIT_V(6); PG8_BAR;
    }
    for (;;) {
        const bool has_next = S.next(ui + 1, nxt);
        const unsigned nA = has_next ? (unsigned)nxt.pm * tstepA : cA; const unsigned nB = has_next ? (unsigned)nxt.pn * tstepB + (KSPLIT ? (unsigned)nxt.k0 * 2u : 0u) : cB;
        const unsigned nsB = (KSPLIT && has_next) ? (unsigned)nxt.pn * tstepB + (unsigned)nxt.k1 * 2u - (unsigned)(nt / 2) * kstep : sB;
        for (int t = 0; t < nt; t += 2) {
            const bool last = (t == nt - 2);
            const unsigned a1 = cA + (unsigned)(t + 1) * kstep;
            const unsigned a2 = last ? nA : cA + (unsigned)(t + 2) * kstep; const unsigned b2 = last ? nB : ((KSPLIT && (t + 2) >= nt / 2) ? sB : cB) + (unsigned)(t + 2) * kstep;
            const unsigned a3 = a2 + kstep; const unsigned b3 = b2 + kstep;
            if (last && has_next) S.a_ready(nxt);
            if constexpr (SP2) {
            PG8_LDB(B0, 0, 0); PG8_LDB(B1, 0, 1); PG8_SCHED; PG8_LDA(At, 0, 0); PG8_STAGE_X(PG8_SA(1, 1), baseA, a1 + hstepA, voffA);
            PG8_WAIT_V(8); PG8_WAIT_L(0); PG8_BAR; PG8_MMA(0, 0, At, B0); PG8_MMA(0, 1, At, B1); PG8_BAR; PG8_SCHED;
            PG8_LDA(At, 0, 1); PG8_STAGE_X(PG8_SB(0, 0), baseB, b2, voffB); PG8_STAGE_X(PG8_SB(0, 1), baseB, b2 + hstepB, voffB); PG8_STAGE_X(PG8_SA(0, 0), baseA, a2, voffA);
            PG8_WAIT_V(8); PG8_WAIT_L(0); PG8_BAR; PG8_MMA(1, 0, At, B0); PG8_MMA(1, 1, At, B1); PG8_BAR; PG8_SCHED;
            PG8_LDB(B0, 1, 0); PG8_LDB(B1, 1, 1); PG8_SCHED; PG8_LDA(At, 1, 0); PG8_STAGE_X(PG8_SA(0, 1), baseA, a2 + hstepA, voffA);
            PG8_WAIT_V(8); PG8_WAIT_L(0); PG8_BAR; PG8_MMA(0, 0, At, B0); PG8_MMA(0, 1, At, B1); PG8_BAR; PG8_SCHED;
            PG8_LDA(At, 1, 1); PG8_STAGE_X(PG8_SB(1, 0), baseB, b3, voffB); PG8_STAGE_X(PG8_SB(1, 1), baseB, b3 + hstepB, voffB); PG8_STAGE_X(PG8_SA(1, 0), baseA, a3, voffA);
            PG8_WAIT_V(8); PG8_WAIT_L(0); PG8_BAR; PG8_MMA(1, 0, At, B0); PG8_MMA(1, 1, At, B1); PG8_BAR; PG8_SCHED;
            } else {
            PG8_LDB(B0, 0, 0); PG8_SCHED; PG8_LDA(At, 0, 0); PG8_STAGE_X(PG8_SA(1, 1), baseA, a1 + hstepA, voffA);
            PG8_WAIT_L(8); PG8_BAR; PG8_WAIT_L(0); PG8_MMA(0, 0, At, B0); PG8_BAR; PG8_SCHED;
            PG8_LDB(B1, 0, 1); PG8_STAGE_X(PG8_SB(0, 0), baseB, b2, voffB);
            PG8_BAR; PG8_WAIT_L(0); PG8_MMA(0, 1, At, B1); PG8_BAR;
            PG8_LDA(At, 0, 1); PG8_STAGE_X(PG8_SA(0, 0), baseA, a2, voffA);
            PG8_BAR; PG8_WAIT_L(0); PG8_MMA(1, 0, At, B0); PG8_BAR; PG8_SCHED;
            PG8_STAGE_X(PG8_SB(0, 1), baseB, b2 + hstepB, voffB);
            PG8_WAIT_V(6); PG8_BAR; PG8_MMA(1, 1, At, B1); PG8_BAR;
            PG8_LDB(B0, 1, 0); PG8_SCHED; PG8_LDA(At, 1, 0); PG8_STAGE_X(PG8_SA(0, 1), baseA, a2 + hstepA, voffA);
            PG8_WAIT_L(8); PG8_BAR; PG8_WAIT_L(0); PG8_MMA(0, 0, At, B0); PG8_BAR; PG8_SCHED;
            PG8_LDB(B1, 1, 1); PG8_STAGE_X(PG8_SB(1, 0), baseB, b3, voffB);
            PG8_BAR; PG8_WAIT_L(0); PG8_MMA(0, 1, At, B1); PG8_BAR;
            PG8_LDA(At, 1, 1); PG8_STAGE_X(PG8_SA(1, 0), baseA, a3, voffA);
            PG8_BAR; PG8_WAIT_L(0); PG8_MMA(1, 0, At, B0); PG8_BAR; PG8_SCHED;
            PG8_STAGE_X(PG8_SB(1, 1), baseB, b3 + hstepB, voffB);
            PG8_WAIT_V(6); PG8_BAR; PG8_MMA(1, 1, At, B1); PG8_BAR;
            }
        }
        if constexpr (ALIGN_EPI) { if (wr == 0) PG8_BAR; }
        if constexpr (!Epi::AFTER_DRAIN) { E(acc, cur, wr, wc, fr, fq); S.done(cur); }
        if (!has_next) break;
#pragma unroll
        for (int a = 0; a < 2; ++a)
#pragma unroll
            for (int b = 0; b < 2; ++b)
#pragma unroll
                for (int m = 0; m < 4; ++m)
#pragma unroll
                    for (int n = 0; n < 2; ++n) acc[a][b][m][n] = (f32x4){0.f, 0.f, 0.f, 0.f};
        cur = nxt; cA = nA; cB = nB; sB = nsB; ++ui;
        if constexpr (ALIGN_EPI) { if (wr == 1) PG8_BAR; }
    }
    PG8_WAIT_V(0);
    if constexpr (!ALIGN_EPI) { if (wr == 0) PG8_BAR; }
    PG8_BAR;
    if constexpr (Epi::AFTER_DRAIN) { E.fused(acc, cur, wr, wc, fr, fq, lds, wid, lane); S.done(cur); }
#undef PG8_SA
#undef PG8_SB
#undef PG8_STAGE_X
#undef PG8_LDA
#undef PG8_LDB
#undef PG8_MMA
#undef PG8_WAIT_V
#undef PG8_WAIT_L
#undef PG8_BAR
#undef PG8_SCHED
}
}
namespace attn_body {
using bf16=__hip_bfloat16;
using bf16x8=__attribute__((ext_vector_type(8)))short;
using s16x4=__attribute__((ext_vector_type(4)))short;
using f32x16=__attribute__((ext_vector_type(16)))float;
using u32x4=__attribute__((ext_vector_type(4)))unsigned;
constexpr int BATCH=8,NHEAD=6,SEQ=4096,D=64,DM=3072;
constexpr int NW=8,QBLK=32,QB=QBLK*NW,KVBLK=64,NQB=SEQ/QB;
constexpr int ATTN_PITCH=DM, ATTN_UNIT_ROWS=QB;
__device__ __forceinline__ int crow(int r,int hi){return (r&3)+8*(r>>2)+4*hi;}
#define SBAR() __builtin_amdgcn_sched_barrier(0)
__device__ __forceinline__ void cmask(f32x16&p0,f32x16&p1,int jb,int qrel,int hi){
  const float NEG=-INFINITY; int kb=64*jb+4*hi;
  #pragma unroll
  for(int r=0;r<16;++r){int kv=kb+(r&3)+8*(r>>2); if(kv>qrel)p0[r]=NEG; if(kv+32>qrel)p1[r]=NEG;}
}

constexpr int NSLOT=3, SLOTB=8192;
constexpr int LDS_K=0, LDS_V=NSLOT*SLOTB, LDS_WS=2*NSLOT*SLOTB, LDS_OST=LDS_WS+NW*64*4, LDS_G=LDS_OST+NW*4096, LDS_BYTES=LDS_G+SEQ*4;
constexpr float C2=0.125f*1.4426950408889634f;
__device__ __forceinline__ void glds16(const void*gsrc,unsigned lds_dst){unsigned keep;
  asm volatile("s_mov_b32 %0, m0\n\ts_mov_b32 m0, %2\n\ts_nop 0\n\tglobal_load_lds_dwordx4 %1, off\n\ts_mov_b32 m0, %0":"=&s"(keep):"v"(gsrc),"s"(lds_dst):"memory");}
__device__ __forceinline__ float max3f(float a,float b,float c){float r;asm("v_max3_f32 %0, %1, %2, %3":"=v"(r):"v"(a),"v"(b),"v"(c));return r;}
__device__ __forceinline__ float max2f(float a,float b){float r;asm("v_max_f32_e32 %0, %1, %2":"=v"(r):"v"(a),"v"(b));return r;}
__device__ __forceinline__ float fadd_s(float a,float b){float r;asm("v_add_f32_e32 %0, %1, %2":"=v"(r):"v"(a),"v"(b));return r;}
__device__ __forceinline__ float fsub_s(float a,float b){float r;asm("v_sub_f32_e32 %0, %1, %2":"=v"(r):"v"(a),"v"(b));return r;}
typedef float f32x2_t __attribute__((ext_vector_type(2))); typedef __bf16 bf16x2_t __attribute__((ext_vector_type(2)));
__device__ __forceinline__ unsigned cvtpk_s(float lo,float hi){f32x2_t v={lo,hi};bf16x2_t b=__builtin_convertvector(v,bf16x2_t);return __builtin_bit_cast(unsigned,b);}
#define WAIT_BAR(N) asm volatile("s_waitcnt vmcnt(" #N ") lgkmcnt(0)\n\ts_barrier":::"memory")

__device__ __forceinline__ void qkt(f32x16&p0,f32x16&p1,const char*Kslot,const bf16x8*qr,const f32x16&negm,int r32,int hi){
  const char*kb=Kslot+hi*1024+r32*16;
  #pragma unroll
  for(int d0=0;d0<4;++d0){
    const bf16x8 b0=*reinterpret_cast<const bf16x8*>(kb+d0*2048);
    const bf16x8 b1=*reinterpret_cast<const bf16x8*>(kb+d0*2048+512);
    if(d0==0){p0=__builtin_amdgcn_mfma_f32_32x32x16_bf16(b0,qr[0],negm,0,0,0);p1=__builtin_amdgcn_mfma_f32_32x32x16_bf16(b1,qr[0],negm,0,0,0);}
    else{p0=__builtin_amdgcn_mfma_f32_32x32x16_bf16(b0,qr[d0],p0,0,0,0);p1=__builtin_amdgcn_mfma_f32_32x32x16_bf16(b1,qr[d0],p1,0,0,0);}}
}
typedef __attribute__((address_space(3))) const char* lds_cptr;
typedef short v4i16_t __attribute__((ext_vector_type(4)));
__device__ __forceinline__ void kload8(bf16x8*kf,lds_cptr kp){
  kf[0]=*(const __attribute__((address_space(3))) bf16x8*)(kp);      kf[1]=*(const __attribute__((address_space(3))) bf16x8*)(kp+512);
  kf[2]=*(const __attribute__((address_space(3))) bf16x8*)(kp+2048); kf[3]=*(const __attribute__((address_space(3))) bf16x8*)(kp+2560);
  kf[4]=*(const __attribute__((address_space(3))) bf16x8*)(kp+4096); kf[5]=*(const __attribute__((address_space(3))) bf16x8*)(kp+4608);
  kf[6]=*(const __attribute__((address_space(3))) bf16x8*)(kp+6144); kf[7]=*(const __attribute__((address_space(3))) bf16x8*)(kp+6656);
}
__device__ __forceinline__ void kload2(bf16x8*kf,lds_cptr kp,int j){ kf[2*j]=*(const __attribute__((address_space(3))) bf16x8*)(kp+j*2048); kf[2*j+1]=*(const __attribute__((address_space(3))) bf16x8*)(kp+j*2048+512); }
__device__ __forceinline__ s16x4 vtr(lds_cptr p){ return __builtin_bit_cast(s16x4,__builtin_amdgcn_ds_read_tr16_b64_v4i16((__attribute__((address_space(3))) v4i16_t*)p)); }
__device__ __forceinline__ float rowmax(const f32x16&p0,const f32x16&p1){
  float a=max3f(p0[0],p0[1],p1[0]),b=max3f(p0[2],p0[3],p1[1]);a=max3f(a,p1[2],p1[3]);
  #pragma unroll
  for(int r=4;r<16;r+=4){a=max3f(a,p0[r],p0[r+1]);b=max3f(b,p0[r+2],p0[r+3]);a=max3f(a,p1[r],p1[r+1]);b=max3f(b,p1[r+2],p1[r+3]);}
  const float m=max2f(a,b);
  auto rr=__builtin_amdgcn_permlane32_swap(__float_as_uint(m),__float_as_uint(m),false,false);
  return max2f(__uint_as_float(rr[0]),__uint_as_float(rr[1]));
}
__device__ __forceinline__ void pv(f32x16*o,int vb,bf16x8 pa0,bf16x8 pa1,bf16x8 pa2,bf16x8 pa3){
  #pragma unroll
  for(int d0=0;d0<2;++d0){s16x4 lo[4],hi[4];
    #pragma unroll
    for(int ks=0;ks<4;++ks){
      asm volatile("ds_read_b64_tr_b16 %0,%1 offset:%c2":"=&v"(lo[ks]):"v"(vb),"i"(d0*4096+ks*1024):"memory");
      asm volatile("ds_read_b64_tr_b16 %0,%1 offset:%c2":"=&v"(hi[ks]):"v"(vb),"i"(d0*4096+ks*1024+512):"memory");}
    asm volatile("s_waitcnt lgkmcnt(0)":::"memory");SBAR();
    #define PK(k) (bf16x8){lo[k][0],lo[k][1],lo[k][2],lo[k][3],hi[k][0],hi[k][1],hi[k][2],hi[k][3]}
    o[d0]=__builtin_amdgcn_mfma_f32_32x32x16_bf16(pa0,PK(0),o[d0],0,0,0);
    o[d0]=__builtin_amdgcn_mfma_f32_32x32x16_bf16(pa1,PK(1),o[d0],0,0,0);
    o[d0]=__builtin_amdgcn_mfma_f32_32x32x16_bf16(pa2,PK(2),o[d0],0,0,0);
    o[d0]=__builtin_amdgcn_mfma_f32_32x32x16_bf16(pa3,PK(3),o[d0],0,0,0);
    #undef PK
  }
}

#ifndef ATTN_STORE16
#define ATTN_STORE16(p,v) (*(u32x4*)(p)=(v))
#endif
template<int THRL> __device__ __forceinline__ void attn_unit(int b,int h,int qb,const bf16*Q,const bf16*__restrict__ K,const bf16*__restrict__ V,bf16*O,const float*Gbh,char*shm,const int wave0,const int ts,const bool do_store=true){
  int wv0_=wave0; asm volatile("":"+s"(wv0_)); int z0_=0; asm volatile("":"+v"(z0_)); const int tid=wv0_*64+(int)__builtin_amdgcn_mbcnt_hi(~0u,__builtin_amdgcn_mbcnt_lo(~0u,(unsigned)z0_)),lane=tid&63,r32=lane&31,hi=lane>>5; const int wid=__builtin_amdgcn_readfirstlane(tid>>6);
  const long rowbase=(long)b*SEQ; const int q0=qb*QB;
  const bf16*Qw=Q+(rowbase+q0+wid*QBLK)*DM+h*D;
  const bf16*Kh=K+(rowbase+(long)ts*KVBLK)*DM+h*D,*Vh=V+(rowbase+(long)ts*KVBLK)*DM+h*D;
  const int q0r=q0-ts*KVBLK; Gbh+=ts*KVBLK;
  const unsigned lds0=(unsigned)(uintptr_t)shm;
  float*wsf=(float*)(shm+LDS_WS)+wid*64;
  const bf16*ksrc=Kh+(long)lane*DM+wid*8;
  const bf16*vsrc=Vh+(long)(16*(wid&3)+(lane>>2))*DM+(wid>>2)*32+(lane&3)*8;
  const unsigned kdst=lds0+LDS_K+wid*1024, vdst=lds0+LDS_V+wid*1024;
  #define DMA_K(t,slot) glds16(ksrc+(long)(t)*KVBLK*DM,(unsigned)__builtin_amdgcn_readfirstlane(kdst+(slot)))
  #define DMA_V(t,slot) glds16(vsrc+(long)(t)*KVBLK*DM,(unsigned)__builtin_amdgcn_readfirstlane(vdst+(slot)))
  const int vb0=(int)(lds0+LDS_V)+((lane>>4)&1)*32+(lane&3)*8+(4*hi+((lane&15)>>2))*64;
  const char*Kbase=shm+LDS_K; bf16x8 kf[8];
  const lds_cptr shm3=(lds_cptr)shm; const lds_cptr kp0=shm3+LDS_K+hi*1024+r32*16; const lds_cptr vp0=shm3+LDS_V+((lane>>4)&1)*32+(lane&3)*8+(4*hi+((lane&15)>>2))*64;
  const int NT=(q0r+QB)/KVBLK;
  typedef float f32x4v __attribute__((ext_vector_type(4)));
  { float*gl=(float*)(shm+LDS_G); const int ng4=(q0r+QB)>>2; for(int i=tid;i<ng4;i+=NW*64){ *(f32x4v*)(gl+4*i)=*(const f32x4v*)(Gbh+4*i); } }
  DMA_K(0,0);DMA_V(0,0);DMA_K(1,SLOTB);
  bf16x8 qr[4];
  #pragma unroll
  for(int d0=0;d0<4;++d0)qr[d0]=*reinterpret_cast<const bf16x8*>(&Qw[(long)r32*DM+d0*16+hi*8]);
  float mhat=0.f,l_reg=0.f;f32x16 o[2];o[0]=f32x16{};o[1]=f32x16{};f32x16 negm=f32x16{};asm volatile("":"+v"(negm));
  const int qrel=wid*QBLK+r32;
  #define CMASK(P0,P1,t) do{int jb_=(t)-(NT-4); if(jb_>=0)cmask(P0,P1,jb_,qrel,hi);}while(0)
  #define KBIAS(P0,P1,t) do{ const float*gp_=(const float*)(shm+LDS_G)+64*(t)+4*hi; \
    _Pragma("unroll") for(int j_=0;j_<4;++j_){ { const f32x4v a_=*(const f32x4v*)(gp_+8*j_); P0[4*j_]+=a_.x; P0[4*j_+1]+=a_.y; P0[4*j_+2]+=a_.z; P0[4*j_+3]+=a_.w; } SBAR(); \
      { const f32x4v c_=*(const f32x4v*)(gp_+32+8*j_); P1[4*j_]+=c_.x; P1[4*j_+1]+=c_.y; P1[4*j_+2]+=c_.z; P1[4*j_+3]+=c_.w; } SBAR(); } }while(0)
  bool resc=false;
  #define START(P0,P1) do{ const float rm=rowmax(P0,P1); resc=false; \
    { const float dl=__builtin_fmaxf(rm,0.f); mhat=fadd_s(mhat,dl); \
      _Pragma("unroll") for(int r=0;r<16;++r){P0[r]=fsub_s(P0[r],dl);P1[r]=fsub_s(P1[r],dl);} \
      _Pragma("unroll") for(int r=0;r<16;++r)negm[r]=-mhat; asm volatile("":"+v"(negm)); } \
    _Pragma("unroll") for(int r=0;r<16;++r)P0[r]=__builtin_amdgcn_exp2f(P0[r]); }while(0)
  #define RESC() do{ if(resc){ asm volatile("s_waitcnt lgkmcnt(0)":::"memory"); \
      _Pragma("unroll") for(int d_=0;d_<2;++d_) _Pragma("unroll") for(int r=0;r<16;++r)o[d_][r]*=wsf[crow(r,hi)]; } }while(0)
  f32x16 pA0,pA1,pB0,pB1;
  int sl_prev=0,sl_cur=0,sl_next=SLOTB;
  #define ROT() do{sl_prev=sl_cur;sl_cur=sl_next;sl_next=(sl_next==(NSLOT-1)*SLOTB)?0:sl_next+SLOTB;}while(0)
  DMA_K(2,2*SLOTB);
  WAIT_BAR(3);
  { const float*gl=(const float*)(shm+LDS_G); mhat=gl[q0r+qrel]; _Pragma("unroll") for(int r=0;r<16;++r)negm[r]=-mhat; asm volatile("":"+v"(negm)); }
  qkt(pA0,pA1,Kbase,qr,negm,r32,hi);asm volatile("s_nop 15\n\ts_nop 7":"+v"(pA0),"+v"(pA1));KBIAS(pA0,pA1,0);CMASK(pA0,pA1,0);
  START(pA0,pA1);
  _Pragma("unroll") for(int r=0;r<16;++r)pA1[r]=__builtin_amdgcn_exp2f(pA1[r]);
  WAIT_BAR(0);
  DMA_K(3,0);DMA_V(1,SLOTB);
  ROT();
  kload8(kf,kp0+sl_cur);
  WAIT_BAR(2);
  s16x4 vlo[8],vhi[8]; u32x4 pw0,pw1,pw2,pw3;
  #define PKW(P,B) cvtpk_s(P[B],P[B+1])
  #define PAF(k) __builtin_bit_cast(bf16x8,pw##k)
  #define VFR(i) (bf16x8){vlo[i][0],vlo[i][1],vlo[i][2],vlo[i][3],vhi[i][0],vhi[i][1],vhi[i][2],vhi[i][3]}
  #define PIN(x) asm volatile("":"+v"(x))
  #define MX3(a,b,c) __builtin_fmaxf(__builtin_fmaxf((a),(b)),(c))
  #define GAPA(MF,A0,A1,A2,A3,W0,W1,PW) do{ MF; sacc+=A0; sacc+=A1; sacc+=A2; sacc+=A3; PIN(sacc); W0; W1; PIN(PW); SBAR(); }while(0)
  #define EX(v) __builtin_amdgcn_exp2f(v)
  #define GAPB(MF,X,B) do{ MF; X[B]=EX(X[B]); X[B+1]=EX(X[B+1]); X[B+2]=EX(X[B+2]); X[B+3]=EX(X[B+3]); PIN(X); SBAR(); }while(0)
  #define VRD(i) do{ vlo[i]=vtr(vp_+(((i)>>2)*4096+((i)&3)*1024)); vhi[i]=vtr(vp_+(((i)>>2)*4096+((i)&3)*1024+512)); }while(0)
  #define KRD(G,j) do{ if(G){ kload2(kf,kp0+sl_next,j); SBAR(); } }while(0)
  #define STEP(C0,C1,P0,P1,t,GK,GV,GL) do{ SBAR(); \
    const lds_cptr vp_=vp0+sl_prev; \
    VRD(0); SBAR(); float sacc=(P0[0]+P0[1]); \
    GAPA(C0=__builtin_amdgcn_mfma_f32_32x32x16_bf16(kf[0],qr[0],negm,0,0,0), P0[2],P0[3],P0[4],P0[5],     pw0[0]=PKW(P0,0), pw0[1]=PKW(P0,2), pw0); \
    VRD(4); SBAR(); GAPA(C1=__builtin_amdgcn_mfma_f32_32x32x16_bf16(kf[1],qr[0],negm,0,0,0), P0[6],P0[7],P0[8],P0[9],     pw0[2]=PKW(P0,4), pw0[3]=PKW(P0,6), pw0); \
    VRD(1); SBAR(); GAPA(C0=__builtin_amdgcn_mfma_f32_32x32x16_bf16(kf[2],qr[1],C0,0,0,0),   P0[10],P0[11],P0[12],P0[13], pw1[0]=PKW(P0,8), pw1[1]=PKW(P0,10), pw1); \
    VRD(5); SBAR(); GAPA(C1=__builtin_amdgcn_mfma_f32_32x32x16_bf16(kf[3],qr[1],C1,0,0,0),   P0[14],P0[15],P1[0],P1[1],   pw1[2]=PKW(P0,12),pw1[3]=PKW(P0,14), pw1); \
    VRD(2); SBAR(); GAPA(C0=__builtin_amdgcn_mfma_f32_32x32x16_bf16(kf[4],qr[2],C0,0,0,0),   P1[2],P1[3],P1[4],P1[5],     pw2[0]=PKW(P1,0), pw2[1]=PKW(P1,2), pw2); \
    VRD(6); SBAR(); GAPA(C1=__builtin_amdgcn_mfma_f32_32x32x16_bf16(kf[5],qr[2],C1,0,0,0),   P1[6],P1[7],P1[8],P1[9],     pw2[2]=PKW(P1,4), pw2[3]=PKW(P1,6), pw2); \
    VRD(3); SBAR(); GAPA(C0=__builtin_amdgcn_mfma_f32_32x32x16_bf16(kf[6],qr[3],C0,0,0,0),   P1[10],P1[11],P1[12],P1[13], pw3[0]=PKW(P1,8), pw3[1]=PKW(P1,10), pw3); \
    VRD(7); SBAR(); GAPA(C1=__builtin_amdgcn_mfma_f32_32x32x16_bf16(kf[7],qr[3],C1,0,0,0),   P1[14],P1[15],0.f,0.f,       pw3[2]=PKW(P1,12),pw3[3]=PKW(P1,14), pw3); \
    l_reg+=sacc; \
    if(GK){DMA_K((t)+3,sl_cur);} if(GV){DMA_V((t)+1,sl_next);} \
    KBIAS(C0,C1,t); CMASK(C0,C1,t); \
    { float a=MX3(C0[0],C0[1],C1[0]),b=MX3(C0[2],C0[3],C1[1]); a=MX3(a,C1[2],C1[3]); \
      _Pragma("unroll") for(int r=4;r<16;r+=4){a=MX3(a,C0[r],C0[r+1]);b=MX3(b,C0[r+2],C0[r+3]);a=MX3(a,C1[r],C1[r+1]);b=MX3(b,C1[r+2],C1[r+3]);} \
      float rm=__builtin_fmaxf(a,b); { auto rr=__builtin_amdgcn_permlane32_swap(__float_as_uint(rm),__float_as_uint(rm),false,false); rm=__builtin_fmaxf(__uint_as_float(rr[0]),__uint_as_float(rr[1])); } \
      resc=false; \
      if(__builtin_expect(__any(rm>(float)THRL),0)){ const float dl=__builtin_fmaxf(rm,0.f); mhat+=dl; \
        _Pragma("unroll") for(int r=0;r<16;++r){C0[r]-=dl;C1[r]-=dl;} \
        _Pragma("unroll") for(int r=0;r<16;++r)negm[r]=-mhat; asm volatile("":"+v"(negm)); \
        const float f=__builtin_amdgcn_exp2f(-dl); l_reg*=f; if(hi==0)wsf[r32]=f; resc=true; } } \
    SBAR(); \
    GAPB(o[0]=__builtin_amdgcn_mfma_f32_32x32x16_bf16(PAF(0),VFR(0),o[0],0,0,0), C0,0); \
    GAPB(o[1]=__builtin_amdgcn_mfma_f32_32x32x16_bf16(PAF(0),VFR(4),o[1],0,0,0), C0,4); \
    KRD(GL,0); GAPB(o[0]=__builtin_amdgcn_mfma_f32_32x32x16_bf16(PAF(1),VFR(1),o[0],0,0,0), C0,8); \
    KRD(GL,1); GAPB(o[1]=__builtin_amdgcn_mfma_f32_32x32x16_bf16(PAF(1),VFR(5),o[1],0,0,0), C0,12); \
    KRD(GL,2); GAPB(o[0]=__builtin_amdgcn_mfma_f32_32x32x16_bf16(PAF(2),VFR(2),o[0],0,0,0), C1,0); \
    KRD(GL,3); GAPB(o[1]=__builtin_amdgcn_mfma_f32_32x32x16_bf16(PAF(2),VFR(6),o[1],0,0,0), C1,4); \
    GAPB(o[0]=__builtin_amdgcn_mfma_f32_32x32x16_bf16(PAF(3),VFR(3),o[0],0,0,0), C1,8); \
    GAPB(o[1]=__builtin_amdgcn_mfma_f32_32x32x16_bf16(PAF(3),VFR(7),o[1],0,0,0), C1,12); \
    }while(0)
  int t=1;
  #undef CMASK
  #define CMASK(P0,P1,t) do{}while(0)
  for(;t+5<NT;t+=2){
    STEP(pB0,pB1,pA0,pA1,t,true,true,true);     WAIT_BAR(2); RESC(); ROT();
    STEP(pA0,pA1,pB0,pB1,t+1,true,true,true);   WAIT_BAR(2); RESC(); ROT();
  }
  #undef CMASK
  #define CMASK(P0,P1,t) do{int jb_=(t)-(NT-4); if(jb_>=0)cmask(P0,P1,jb_,qrel,hi);}while(0)
  #define ENDW(tt) do{ if((tt)+3<NT){WAIT_BAR(2);} else if((tt)+2<NT){WAIT_BAR(1);} else {WAIT_BAR(0);} }while(0)
  for(;t+1<NT;t+=2){
    STEP(pB0,pB1,pA0,pA1,t,(t+3<NT),(t+1<NT),(t+1<NT));       ENDW(t);   RESC(); ROT();
    STEP(pA0,pA1,pB0,pB1,t+1,(t+4<NT),(t+2<NT),(t+2<NT));     ENDW(t+1); RESC(); ROT();
  }
  STEP(pB0,pB1,pA0,pA1,NT-1,false,false,false); RESC();
  { float sacc=pB0[0]+pB0[1]; _Pragma("unroll") for(int r=2;r<16;++r)sacc+=pB0[r]; _Pragma("unroll") for(int r=0;r<16;++r)sacc+=pB1[r]; l_reg+=sacc;
    pw0=(u32x4){PKW(pB0,0),PKW(pB0,2),PKW(pB0,4),PKW(pB0,6)};pw1=(u32x4){PKW(pB0,8),PKW(pB0,10),PKW(pB0,12),PKW(pB0,14)};pw2=(u32x4){PKW(pB1,0),PKW(pB1,2),PKW(pB1,4),PKW(pB1,6)};pw3=(u32x4){PKW(pB1,8),PKW(pB1,10),PKW(pB1,12),PKW(pB1,14)};
    SBAR(); pv(o,vb0+sl_cur,PAF(0),PAF(1),PAF(2),PAF(3)); }
  #undef PKW
  #undef PAF
  #undef VFR
  #undef PIN
  #undef MX3
  #undef GAPA
  #undef GAPB
  #undef EX
  #undef VRD
  #undef KRD
  #undef STEP
  #undef ENDW
  {auto rr=__builtin_amdgcn_permlane32_swap(__float_as_uint(l_reg),__float_as_uint(l_reg),false,false);l_reg=__uint_as_float(rr[0])+__uint_as_float(rr[1]);}
  if(hi==0)wsf[32+r32]=l_reg;asm volatile("s_waitcnt lgkmcnt(0)":::"memory");
  float rli[16];
  #pragma unroll
  for(int r=0;r<16;++r)rli[r]=__builtin_amdgcn_rcpf(wsf[32+crow(r,hi)]);
  bf16*Ow=O+(rowbase+q0+wid*QBLK)*DM+h*D;
  { bf16*stg=(bf16*)(shm+LDS_OST)+wid*2048;
    #pragma unroll
    for(int r=0;r<16;++r){const int orow=crow(r,hi);
      #pragma unroll
      for(int d0=0;d0<2;++d0)stg[orow*64+d0*32+r32]=__float2bfloat16(o[d0][r]*rli[r]);}
    asm volatile("s_waitcnt lgkmcnt(0)":::"memory");
    #pragma unroll
    for(int i=0;i<4;++i){const int row=i*8+(lane>>3),ch=lane&7; const u32x4 v=*(const u32x4*)(stg+row*64+ch*8); if(do_store)ATTN_STORE16(Ow+(long)row*DM+ch*8,v);} }
  asm volatile("s_waitcnt lgkmcnt(0)\n\ts_barrier":::"memory");
  #undef DMA_K
  #undef DMA_V
  #undef CMASK
  #undef KBIAS
  #undef START
  #undef RESC
  #undef ROT
}
constexpr int ATTN_LDS_BYTES=LDS_BYTES;
struct AttnTensors { const bf16* Q; const bf16* K; const bf16* V; bf16* O; const float* G; };
struct AttnUnit { int bh; int qb; };
struct StaticOrder {
  int vcu;
  __device__ __forceinline__ explicit StaticOrder(int grid,int block):vcu((block%8)*(grid/8)+block/8){}
  __device__ __forceinline__ bool next(int i,AttnUnit&u)const{ if(i>=4)return false; const int s=vcu&7; u.bh=vcu>>3; u.qb=(i==0)?s:(i==1)?15-s:(i==2)?16+s:31-s; return true; }
  __device__ __forceinline__ void a_ready(const AttnUnit&)const{}
  __device__ __forceinline__ void done(const AttnUnit&)const{}
};
template<class Sched,int THRL=8> __device__ __forceinline__ void attn_phase(char*lds,const AttnTensors&T,const Sched&S){
  AttnUnit u;
  for(int i=0;S.next(i,u);++i){ S.a_ready(u); attn_unit<THRL>(u.bh/NHEAD,u.bh%NHEAD,u.qb,T.Q,T.K,T.V,T.O,T.G+(long)u.bh*SEQ,lds); S.done(u); }
}
#undef SBAR
#undef WAIT_BAR
}
namespace fx {
struct EpiZ {
    static constexpr bool PERM = true, AFTER_DRAIN = false;
    bf16* Z; bf16* UP; float* NLF; const float* fbias;
    __device__ __forceinline__ void operator()(const pg8::f32x4 (&acc)[2][2][4][2], const pg8::Unit& u, int wr, int wc, int fr_, int fq_) const {
        int z_ = 0; asm volatile("" : "+v"(z_)); const int ln_ = __builtin_amdgcn_mbcnt_hi(~0u, __builtin_amdgcn_mbcnt_lo(~0u, z_)); const int fr = ln_ & 15, fq = ln_ >> 4; (void)fr_; (void)fq_;
        const int row0 = u.pm * 256 + wr * 64 + fr, col0 = wc * 32 + 8 * fq;
#pragma unroll
        for (int bj = 0; bj < 2; ++bj) {
            const int hb = u.pn * 2 + bj;
            const float sc = (hb < 3) ? C2 : 1.f;
            bf16* base = Z + ((size_t)row0 * NZ + hb * 128 + col0); size_t stride = (size_t)16 * NZ;
            if (hb == 9 || hb == 10) { const int sidx = (hb - 9) * 128 + col0, g = sidx >> 4, ch0 = sidx & 15;
                base = UP + ((size_t)(g * 2048 + (row0 >> 4)) * 384 + (row0 & 15) * 16 + ch0); stride = 384; }
#pragma unroll
            for (int ai = 0; ai < 2; ++ai)
#pragma unroll
                for (int m = 0; m < 4; ++m) { const pg8::f32x4 v0 = acc[ai][bj][m][0] * sc, v1 = acc[ai][bj][m][1] * sc;
                    v4u w; w.x = pk2(v0[0], v0[1]); w.y = pk2(v0[2], v0[3]); w.z = pk2(v1[0], v1[1]); w.w = pk2(v1[2], v1[3]);
                    *(GAS v4u*)(base + (size_t)(ai * 8 + m) * stride) = w; }
        }
        if (u.pn == 11 && col0 == 0) {
#pragma unroll
            for (int ai = 0; ai < 2; ++ai)
#pragma unroll
                for (int m = 0; m < 4; ++m) { const int r = row0 + ai * 128 + m * 16, b = r >> 12, t = r & 4095; float* o = NLF + (size_t)(b * 6) * 4096 + t;
                    o[0 * 4096] = nlf1(acc[ai][1][m][0][0] + fbias[0]); o[1 * 4096] = nlf1(acc[ai][1][m][0][1] + fbias[1]); o[2 * 4096] = nlf1(acc[ai][1][m][0][2] + fbias[2]);
                    o[3 * 4096] = nlf1(acc[ai][1][m][0][3] + fbias[3]); o[4 * 4096] = nlf1(acc[ai][1][m][1][0] + fbias[4]); o[5 * 4096] = nlf1(acc[ai][1][m][1][1] + fbias[5]); }
        }
    }
    static __device__ __forceinline__ float nlf1(float x) { return -LOG2E * (fminf(x, 0.f) - __logf(1.f + __expf(-fabsf(x)))); }
};
template <bool XF32> struct EpiRes {
    static constexpr bool PERM = true, AFTER_DRAIN = false;
    const void* X; bf16* out; const float* gate;
    __device__ __forceinline__ void operator()(const pg8::f32x4 (&acc)[2][2][4][2], const pg8::Unit& u, int wr, int wc, int fr_, int fq_) const {
        int z_ = 0; asm volatile("" : "+v"(z_)); const int ln_ = __builtin_amdgcn_mbcnt_hi(~0u, __builtin_amdgcn_mbcnt_lo(~0u, z_)); const int fr = ln_ & 15, fq = ln_ >> 4; (void)fr_; (void)fq_;
        const int row0 = u.pm * 256 + wr * 64 + fr, col0 = u.pn * 256 + wc * 32 + 8 * fq;
        const float* gb = gate + (size_t)(row0 >> 12) * 6144;
#pragma unroll
        for (int bj = 0; bj < 2; ++bj) { const int c = col0 + bj * 128; const pg8::f32x4 g0 = *(const GAS pg8::f32x4*)(gb + c), g1 = *(const GAS pg8::f32x4*)(gb + c + 4);
#pragma unroll
            for (int hq = 0; hq < 2; ++hq) {
                pg8::f32x4 x0[4], x1[4];
#pragma unroll
                for (int m = 0; m < 4; ++m) { const size_t off = (size_t)(row0 + hq * 128 + m * 16) * 1024 + c;
                    if (XF32) { x0[m] = *(const GAS pg8::f32x4*)((const float*)X + off); x1[m] = *(const GAS pg8::f32x4*)((const float*)X + off + 4); }
                    else { const v4u w = *(const GAS v4u*)((const bf16*)X + off); x0[m] = (pg8::f32x4){bflo(w.x), bfhi(w.x), bflo(w.y), bfhi(w.y)}; x1[m] = (pg8::f32x4){bflo(w.z), bfhi(w.z), bflo(w.w), bfhi(w.w)}; } }
                asm volatile("" ::: "memory");
#pragma unroll
                for (int m = 0; m < 4; ++m) { const size_t off = (size_t)(row0 + hq * 128 + m * 16) * 1024 + c;
                    const pg8::f32x4 o0 = x0[m] + g0 * acc[hq][bj][m][0], o1 = x1[m] + g1 * acc[hq][bj][m][1];
                    v4u ow; ow.x = pk2(o0[0], o0[1]); ow.y = pk2(o0[2], o0[3]); ow.z = pk2(o1[0], o1[1]); ow.w = pk2(o1[2], o1[3]); *(GAS v4u*)(out + off) = ow; }
                asm volatile("" ::: "memory"); } }
    }
};
}
namespace fx {
constexpr int MOE_ROWS = 40960, MOE_TILES = MOE_ROWS / 256, NCLS = 24;
constexpr size_t WS_TOKINFO = WS_HLOC + 8 * MiB;
constexpr size_t WS_CNT = WS_TOKINFO + (size_t)M * 16;
constexpr size_t WS_ROWTOK = WS_CNT + 256 * 32 * 4;
constexpr size_t WS_ROWW = WS_ROWTOK + (size_t)MOE_ROWS * 4;
constexpr size_t WS_TILECLS = WS_ROWW + (size_t)MOE_ROWS * 8;
constexpr size_t WS_H2S = WS_Z;
constexpr size_t WS_HID = WS_Z + (size_t)MOE_ROWS * 1024 * 2;
static_assert(WS_TILECLS + (MOE_TILES + 1) * 4 <= WS_END, "moe scratch fits");
static_assert(WS_HID + (size_t)MOE_ROWS * 512 * 2 <= WS_UP, "H2S + HID fit in the Z region");

__device__ __forceinline__ void cls_experts(int cls, int& e_lo, int& e_hi) {
    const int g = cls / 6, pr = cls % 6; const int lo = (pr < 3) ? 0 : (pr < 5 ? 1 : 2); const int hi = (pr < 3) ? pr + 1 : (pr < 5 ? pr - 1 : 3);
    e_lo = g * 4 + lo; e_hi = g * 4 + hi;
}
__device__ __forceinline__ void moe_route(const Params& p, int oz, int l, LAS unsigned char* lds, int tid, int lane, int wave, int bx, int G) {
    unsigned char* ws = p.ws + oz; constexpr int WP = 1032;
    LAS unsigned short* Whi = (LAS unsigned short*)lds; LAS unsigned short* Wlo = (LAS unsigned short*)(lds + 33024); LAS float* rstds = (LAS float*)(lds + 66048); LAS float* SR = (LAS float*)(lds + 66560); LAS int* hist = (LAS int*)(lds + 66624);
    const int tpw = M / G, t0 = bx * tpw, b = t0 >> 12; const float* mod = (const float*)(ws + WS_MOD) + l * 8 * 6144 + b * 6144; const float* nw = p.in[I_NFW + oz] + l * 1024; const float* rw = p.in[I_RW + oz]; const float* rb = p.in[I_RB + oz];
    for (int k = tid; k < 1024; k += NTHR) { const float a = nw[k] * (1.f + mod[4096 + k]);
#pragma unroll
        for (int q = 0; q < 4; ++q) { const f32x4 w4 = ((const GAS f32x4*)rw)[k * 4 + q];
#pragma unroll
            for (int e = 0; e < 4; ++e) { const float v = a * w4[e]; const unsigned hi = f2bf(v); const float r = v - __builtin_bit_cast(float, hi << 16); Whi[(4 * q + e) * WP + k] = (unsigned short)hi; Wlo[(4 * q + e) * WP + k] = (unsigned short)f2bf(r); } } }
    if (tid < 32) hist[tid] = 0;
    { float s0 = 0.f, s1 = 0.f;
        for (int k = lane; k < 1024; k += 64) { const float bv = mod[3072 + k]; s0 += bv * rw[k * 16 + 2 * wave]; s1 += bv * rw[k * 16 + 2 * wave + 1]; }
        s0 = wave_sum(s0, lane); s1 = wave_sum(s1, lane); if (lane == 0) { SR[2 * wave] = s0 + rb[2 * wave]; SR[2 * wave + 1] = s1 + rb[2 * wave + 1]; } }
    const bf16* X1 = (const bf16*)(ws + WS_XB); bf16* H = (bf16*)(ws + WS_H);
    f32x4 A[4], B[4]; adaln_factors(nw, mod + 3072, mod + 4096, lane, A, B);
    f32x4 v[4] = {}; if (wave < tpw) row_load_bf(X1, t0 + wave, lane, v);
    for (int r = wave; r < tpw; r += NWAVES) {
        const int row = t0 + r;
        f32x4 nxt[4] = {}; if (r + NWAVES < tpw) row_load_bf(X1, row + NWAVES, lane, nxt);
        float s = 0.f;
#pragma unroll
        for (int j = 0; j < 4; ++j) s += (v[j].x * v[j].x + v[j].y * v[j].y) + (v[j].z * v[j].z + v[j].w * v[j].w);
        const float rstd = __builtin_amdgcn_rsqf(wave_sum(s, lane) * (1.f / 1024.f) + 1e-6f); if (lane == 0) rstds[r] = rstd;
        GAS unsigned long long* o8 = (GAS unsigned long long*)(H + (size_t)row * 1024) + lane;
#pragma unroll
        for (int j = 0; j < 4; ++j) { const f32x4 h = (v[j] * rstd) * A[j] + B[j]; o8[64 * j] = (unsigned long long)pk2(h.x, h.y) | ((unsigned long long)pk2(h.z, h.w) << 32); }
#pragma unroll
        for (int j = 0; j < 4; ++j) v[j] = nxt[j];
    }
    __syncthreads();
    typedef short rbf16x8 __attribute__((ext_vector_type(8)));
    const int n = lane & 15, q = lane >> 4, tok = t0 + 16 * wave + n;
    f32x4 acc = {0.f, 0.f, 0.f, 0.f};
    const GAS rbf16x8* xrow = (const GAS rbf16x8*)(X1 + (size_t)tok * 1024 + 8 * q);
    const LAS unsigned short* ahi = Whi + n * WP + 8 * q; const LAS unsigned short* alo = Wlo + n * WP + 8 * q;
#pragma unroll 1
    for (int k0 = 0; k0 < 32; k0 += 8) { rbf16x8 xb[8];
#pragma unroll
        for (int u = 0; u < 8; ++u) xb[u] = xrow[(k0 + u) * 4];
#pragma unroll
        for (int u = 0; u < 8; ++u) { const rbf16x8 a1 = *(const LAS rbf16x8*)(ahi + (k0 + u) * 32), a2 = *(const LAS rbf16x8*)(alo + (k0 + u) * 32);
            acc = __builtin_amdgcn_mfma_f32_16x16x32_bf16(a1, xb[u], acc, 0, 0, 0); acc = __builtin_amdgcn_mfma_f32_16x16x32_bf16(a2, xb[u], acc, 0, 0, 0); } }
    const float rs = rstds[16 * wave + n]; float lg[4];
#pragma unroll
    for (int e = 0; e < 4; ++e) lg[e] = acc[e] * rs + SR[4 * q + e];
    float mx = fmaxf(fmaxf(lg[0], lg[1]), fmaxf(lg[2], lg[3])); mx = fmaxf(mx, lane_get(mx, lane ^ 16)); mx = fmaxf(mx, lane_get(mx, lane ^ 32));
    float sum = 0.f;
#pragma unroll
    for (int e = 0; e < 4; ++e) { lg[e] = __expf(lg[e] - mx); sum += lg[e]; }
    sum += lane_get(sum, lane ^ 16); sum += lane_get(sum, lane ^ 32); const float inv = 1.f / sum;
#pragma unroll
    for (int e = 0; e < 4; ++e) lg[e] *= inv;
    int i1 = 0; float v1 = lg[0];
#pragma unroll
    for (int i = 1; i < 4; ++i) if (lg[i] > v1) { v1 = lg[i]; i1 = i; }
    int i2 = -1; float v2 = -1.f;
#pragma unroll
    for (int i = 0; i < 4; ++i) if (i != i1 && lg[i] > v2) { v2 = lg[i]; i2 = i; }
    const float sc = v1 + v2;
    float bs = sc; int bq = q;
    { const float os = lane_get(bs, lane ^ 16); const int oq = __builtin_amdgcn_ds_bpermute((lane ^ 16) << 2, bq); if (os > bs || (os == bs && oq < bq)) { bs = os; bq = oq; } }
    { const float os = lane_get(bs, lane ^ 32); const int oq = __builtin_amdgcn_ds_bpermute((lane ^ 32) << 2, bq); if (os > bs || (os == bs && oq < bq)) { bs = os; bq = oq; } }
    if (bq == q) {
        const int lo = i1 < i2 ? i1 : i2, hi = i1 < i2 ? i2 : i1; const float w1 = v1 / (v1 + v2), w2 = v2 / (v1 + v2);
        const int cls = q * 6 + (lo * (7 - lo)) / 2 + (hi - lo - 1);
        const int rank = __hip_atomic_fetch_add(hist + cls, 1, __ATOMIC_RELAXED, __HIP_MEMORY_SCOPE_WORKGROUP);
        GAS f32x4* ti = (GAS f32x4*)(ws + WS_TOKINFO) + tok;
        *ti = (f32x4){__builtin_bit_cast(float, cls | (rank << 8)), i1 < i2 ? w1 : w2, i1 < i2 ? w2 : w1, 0.f};
    }
    __syncthreads();
    if (tid < 32) ((int*)(ws + WS_CNT))[bx * 32 + tid] = (tid < NCLS) ? hist[tid] : 0;
}
__device__ __forceinline__ void moe_gather(const Params& p, int oz, LAS unsigned char* lds, int tid, int lane, int wave, int bx, int G) {
    unsigned char* ws = p.ws + oz; LAS int* cl = (LAS int*)lds; LAS int* base = (LAS int*)(lds + 32768); LAS int* off = base + 32; LAS int* tot = off + 32;
    const int* cnt = (const int*)(ws + WS_CNT);
    for (int i = tid; i < G * 32; i += NTHR) cl[i] = cnt[i];
    __syncthreads();
    { LAS int* ps = tot + 32; const int c = tid & 31, part = tid >> 5; int s = 0, mine = 0; for (int w = part * (G / 16); w < (part + 1) * (G / 16); ++w) { if (w < bx) mine += cl[w * 32 + c]; s += cl[w * 32 + c]; } ps[part * 32 + c] = s; ps[512 + part * 32 + c] = mine; }
    __syncthreads();
    if (tid < NCLS) { LAS int* ps = tot + 32; int s = 0, mine = 0; for (int q = 0; q < 16; ++q) { s += ps[q * 32 + tid]; mine += ps[512 + q * 32 + tid]; } tot[tid] = s; off[tid] = mine; }
    __syncthreads();
    if (tid == 0) { int b = 0; for (int c = 0; c < NCLS; ++c) { base[c] = b; b += (tot[c] + 255) & ~255; } base[NCLS] = b; }
    __syncthreads();
    int* rowtok = (int*)(ws + WS_ROWTOK); float* roww = (float*)(ws + WS_ROWW);
    if (bx < NCLS) { const int c = bx, b0 = base[c], n = tot[c], b1 = base[c + 1];
        for (int r = b0 + n + tid; r < b1; r += NTHR) { rowtok[r] = -1; roww[2 * r] = (float)oz; roww[2 * r + 1] = (float)oz; }
        int* tc = (int*)(ws + WS_TILECLS); for (int t = b0 / 256 + tid; t < b1 / 256; t += NTHR) tc[t] = c;
        if (c == NCLS - 1 && tid == 0) tc[MOE_TILES] = b1 / 256; }
    const int tpw = M / G, t0 = bx * tpw; const bf16* H = (const bf16*)(ws + WS_H); bf16* H2S = (bf16*)(ws + WS_H2S);
    for (int r = wave; r < tpw; r += NWAVES) { const int row = t0 + r; const f32x4 ti = ((const GAS f32x4*)(ws + WS_TOKINFO))[row]; const int cr = __builtin_bit_cast(int, ti.x), cls = cr & 255, rank = cr >> 8;
        const int pos = base[cls] + off[cls] + rank;
        const GAS v4u* src = (const GAS v4u*)(H + (size_t)row * 1024) + lane; GAS v4u* dst = (GAS v4u*)(H2S + (size_t)pos * 1024) + lane;
        const v4u a = src[0], b = src[64]; dst[0] = a; dst[64] = b;
        if (lane == 0) { rowtok[pos] = row; roww[2 * pos] = ti.y; roww[2 * pos + 1] = ti.z; } }
}
struct ListOrder {
    const LAS int* list; int n;
    __device__ __forceinline__ bool next(int i, pg8::Unit& u) const { if (i >= n) return false; typedef int v4i_ __attribute__((ext_vector_type(4))); const v4i_ q = *(const LAS v4i_*)(list + 4 * i);
        u.pm = __builtin_amdgcn_readfirstlane(q.x); u.pn = __builtin_amdgcn_readfirstlane(q.y); u.k0 = __builtin_amdgcn_readfirstlane(q.z); u.k1 = __builtin_amdgcn_readfirstlane(q.w); return true; }
    __device__ __forceinline__ void a_ready(const pg8::Unit&) const {}
    __device__ __forceinline__ void done(const pg8::Unit&) const {}
};
template <bool DOWN>
__device__ __forceinline__ int moe_build_list(unsigned char* ws, LAS int* list, int tid, int bx, int G) {
    const int* tc = (const int*)(ws + WS_TILECLS);
    const int ntiles = __builtin_amdgcn_readfirstlane(((const GAS int*)tc)[MOE_TILES]); const int nunits = ntiles * 4; int n = 0;
    for (int L = bx; L < nunits; L += G) ++n;
    if (tid < n) { const int L = bx + tid * G, tile = L >> 2, j = L & 3; const int cls = ((const GAS int*)tc)[tile]; int e_lo, e_hi; cls_experts(cls, e_lo, e_hi);
        if (DOWN) { list[4 * tid] = tile; list[4 * tid + 1] = j; list[4 * tid + 2] = e_lo * 256; list[4 * tid + 3] = e_hi * 256; }
        else { list[4 * tid] = tile; list[4 * tid + 1] = (j < 2 ? e_lo : e_hi) * 2 + (j & 1); list[4 * tid + 2] = j; list[4 * tid + 3] = 0; } }
    __syncthreads();
    return n;
}
struct EpiHid {
    static constexpr bool PERM = true, AFTER_DRAIN = false;
    bf16* HID; const float* roww;
    __device__ __forceinline__ void operator()(const pg8::f32x4 (&acc)[2][2][4][2], const pg8::Unit& u, int wr, int wc, int fr_, int fq_) const {
        int z_ = 0; asm volatile("" : "+v"(z_)); const int ln_ = __builtin_amdgcn_mbcnt_hi(~0u, __builtin_amdgcn_mbcnt_lo(~0u, z_)); const int fr = ln_ & 15, fq = ln_ >> 4; (void)fr_; (void)fq_;
        const int row0 = u.pm * 256 + wr * 64 + fr, j = u.k0, col0 = j * 128 + wc * 32 + 8 * fq;
        float wq[8];
#pragma unroll
        for (int q = 0; q < 8; ++q) wq[q] = ((const GAS float*)roww)[2 * (row0 + (q >> 2) * 128 + (q & 3) * 16) + (j >> 1)];
        asm volatile("" ::: "memory");
#pragma unroll
        for (int ai = 0; ai < 2; ++ai)
#pragma unroll
            for (int m = 0; m < 4; ++m) { const int pos = row0 + ai * 128 + m * 16; const float w = wq[ai * 4 + m];
                float h[8];
#pragma unroll
                for (int n = 0; n < 2; ++n)
#pragma unroll
                    for (int e = 0; e < 4; ++e) { const float gt = acc[ai][0][m][n][e], up = acc[ai][1][m][n][e]; h[4 * n + e] = gt * fsigmoid(gt) * up * w; }
                v4u o; o.x = pk2(h[0], h[1]); o.y = pk2(h[2], h[3]); o.z = pk2(h[4], h[5]); o.w = pk2(h[6], h[7]);
                *(GAS v4u*)(HID + (size_t)pos * 512 + col0) = o; }
    }
};
struct EpiMoeOut {
    static constexpr bool PERM = true, AFTER_DRAIN = false;
    bf16* out; const float* gate; const int* rowtok;
    __device__ __forceinline__ void operator()(const pg8::f32x4 (&acc)[2][2][4][2], const pg8::Unit& u, int wr, int wc, int fr_, int fq_) const {
        int z_ = 0; asm volatile("" : "+v"(z_)); const int ln_ = __builtin_amdgcn_mbcnt_hi(~0u, __builtin_amdgcn_mbcnt_lo(~0u, z_)); const int fr = ln_ & 15, fq = ln_ >> 4; (void)fr_; (void)fq_;
        const int row0 = u.pm * 256 + wr * 64 + fr, col0 = u.pn * 256 + wc * 32 + 8 * fq;
        int tok[8];
#pragma unroll
        for (int q = 0; q < 8; ++q) tok[q] = ((const GAS int*)rowtok)[row0 + (q >> 2) * 128 + (q & 3) * 16];
#pragma unroll
        for (int hq = 0; hq < 2; ++hq)
#pragma unroll
            for (int bj = 0; bj < 2; ++bj) { const int c = col0 + bj * 128;
                v4u w[4] = {};
#pragma unroll
                for (int m = 0; m < 4; ++m) { const int tk = tok[hq * 4 + m]; if (tk >= 0) w[m] = *(const GAS v4u*)(out + (size_t)tk * 1024 + c); }
                asm volatile("" ::: "memory");
#pragma unroll
                for (int m = 0; m < 4; ++m) { const int tk = tok[hq * 4 + m];
                    if (tk >= 0) { const float* gb = gate + (size_t)(tk >> 12) * 6144 + c; const pg8::f32x4 g0 = *(const GAS pg8::f32x4*)gb, g1 = *(const GAS pg8::f32x4*)(gb + 4);
                        const pg8::f32x4 o0 = (pg8::f32x4){bflo(w[m].x), bfhi(w[m].x), bflo(w[m].y), bfhi(w[m].y)} + g0 * acc[hq][bj][m][0], o1 = (pg8::f32x4){bflo(w[m].z), bfhi(w[m].z), bflo(w[m].w), bfhi(w[m].w)} + g1 * acc[hq][bj][m][1];
                        v4u ow; ow.x = pk2(o0[0], o0[1]); ow.y = pk2(o0[2], o0[3]); ow.z = pk2(o1[0], o1[1]); ow.w = pk2(o1[2], o1[3]); *(GAS v4u*)(out + (size_t)tk * 1024 + c) = ow; } }
                asm volatile("" ::: "memory"); }
    }
};
}
namespace fx {
struct EpiS5Loc {
    static constexpr bool PERM = false, AFTER_DRAIN = false;
    float* LOC;
    __device__ __forceinline__ void operator()(const pg8::f32x4 (&acc)[2][2][4][2], const pg8::Unit& u, int wr, int wc, int fr_, int fq_) const {
        int z_ = 0; asm volatile("" : "+v"(z_)); const int ln_ = __builtin_amdgcn_mbcnt_hi(~0u, __builtin_amdgcn_mbcnt_lo(~0u, z_)); const int fr = ln_ & 15, fq = ln_ >> 4; (void)fr_; (void)fq_;
        const int row0 = u.pm * 256 + wr * 64 + fr, col0 = wc * 32 + 4 * fq;
#pragma unroll
        for (int n = 0; n < 2; ++n)
#pragma unroll
            for (int ai = 0; ai < 2; ++ai)
#pragma unroll
                for (int m = 0; m < 4; ++m) *(GAS pg8::f32x4*)(LOC + (size_t)(row0 + ai * 128 + m * 16) * 128 + col0 + n * 16) = acc[ai][0][m][n];
    }
};
__device__ __forceinline__ float gelu_tanh_f(float x) { const float u = 0.7978845608028654f * (x + 0.044715f * x * x * x); const float e = __builtin_amdgcn_exp2f(-2.f * LOG2E * u); return x * __builtin_amdgcn_rcpf(1.f + e); }
struct EpiS5Y {
    static constexpr bool PERM = true, AFTER_DRAIN = false;
    bf16* Y;
    __device__ __forceinline__ void operator()(const pg8::f32x4 (&acc)[2][2][4][2], const pg8::Unit& u, int wr, int wc, int fr_, int fq_) const {
        int z_ = 0; asm volatile("" : "+v"(z_)); const int ln_ = __builtin_amdgcn_mbcnt_hi(~0u, __builtin_amdgcn_mbcnt_lo(~0u, z_)); const int fr = ln_ & 15, fq = ln_ >> 4; (void)fr_; (void)fq_;
        const int g = u.pn, b = u.pm & 7, c0 = wr * 64 + fr;
#pragma unroll
        for (int bj = 0; bj < 2; ++bj) { const int n0 = bj * 128 + wc * 32 + 8 * fq, j = n0 >> 4, ch0 = n0 & 15;
#pragma unroll
            for (int ai = 0; ai < 2; ++ai)
#pragma unroll
                for (int m = 0; m < 4; ++m) { const int c = c0 + ai * 128 + m * 16; const pg8::f32x4 v0 = acc[ai][bj][m][0], v1 = acc[ai][bj][m][1];
                    v4u w; w.x = pk2(gelu_tanh_f(v0[0]), gelu_tanh_f(v0[1])); w.y = pk2(gelu_tanh_f(v0[2]), gelu_tanh_f(v0[3])); w.z = pk2(gelu_tanh_f(v1[0]), gelu_tanh_f(v1[1])); w.w = pk2(gelu_tanh_f(v1[2]), gelu_tanh_f(v1[3]));
                    *(GAS v4u*)(Y + ((size_t)(b * 4096 + c * 16 + j) * 256 + g * 16 + ch0)) = w; } }
    }
};
struct OneUnit { int pm, pn;
    __device__ __forceinline__ bool next(int i, pg8::Unit& u) const { if (i >= 1) return false; u.pm = pm; u.pn = pn; u.k0 = 0; u.k1 = 0; return true; }
    __device__ __forceinline__ void a_ready(const pg8::Unit&) const {}
    __device__ __forceinline__ void done(const pg8::Unit&) const {} };
__device__ __forceinline__ void s5_scan(unsigned char* ws, int l, int g, int b, int tid) {
    if (tid < 64) { const int q = tid; const float* al = (const float*)(ws + WS_S5AL) + ((l * 16 + g) * 64 + q) * 2; const float ar = al[0], ai = al[1];
        const float* loc = (const float*)(ws + WS_LOC) + (size_t)(g * 2048 + b * 256) * 128; bf16* up = (bf16*)(ws + WS_UP) + (size_t)(g * 2048 + b * 256) * 384 + 256;
        float sr = 0.f, si = 0.f;
        for (int c0 = 0; c0 < 256; c0 += 8) { float lr[8], li[8];
#pragma unroll
            for (int k = 0; k < 8; ++k) { lr[k] = loc[(size_t)(c0 + k) * 128 + q]; li[k] = loc[(size_t)(c0 + k) * 128 + 64 + q]; }
#pragma unroll
            for (int k = 0; k < 8; ++k) { up[(size_t)(c0 + k) * 384 + q] = (bf16)f2bf(sr); up[(size_t)(c0 + k) * 384 + 64 + q] = (bf16)f2bf(si);
                const float nr = ar * sr - ai * si + lr[k], ni = ar * si + ai * sr + li[k]; sr = nr; si = ni; } }
    }
    asm volatile("s_waitcnt vmcnt(0)" ::: "memory");
    __syncthreads();
}
struct EpiGlu {
    static constexpr bool PERM = false, AFTER_DRAIN = true;
    const bf16* Y; const float* gb; const float* bnw; bf16* MIX;
    __device__ __forceinline__ void fused(pg8::f32x4 (&acc)[2][2][4][2], const pg8::Unit& u, int wr, int wc, int fr_, int fq_, PG8_LAS unsigned char* lds, int wid, int lane_) const {
        int z_ = 0; asm volatile("" : "+v"(z_)); const int ln_ = __builtin_amdgcn_mbcnt_hi(~0u, __builtin_amdgcn_mbcnt_lo(~0u, z_)); const int fr = ln_ & 15, fq = ln_ >> 4; (void)fr_; (void)fq_; (void)wid; (void)lane_;
        PG8_LAS float* P = (PG8_LAS float*)lds;
        const int row0 = u.pm * 256 + wr * 64 + fr, col0 = wc * 32 + 4 * fq;
#pragma unroll
        for (int ai = 0; ai < 2; ++ai)
#pragma unroll
            for (int m = 0; m < 4; ++m) { const int r = row0 + ai * 128 + m * 16; float s = 0.f;
#pragma unroll
                for (int bj = 0; bj < 2; ++bj)
#pragma unroll
                    for (int n = 0; n < 2; ++n) { const int c = col0 + bj * 128 + n * 16; const pg8::f32x4 bv = *(const GAS pg8::f32x4*)(gb + c); const v2u yw = *(const GAS v2u*)(Y + (size_t)r * 256 + c);
                        pg8::f32x4 a = acc[ai][bj][m][n] + bv; const float y0 = bflo(yw.x), y1 = bfhi(yw.x), y2 = bflo(yw.y), y3 = bfhi(yw.y);
                        a[0] = y0 * fsigmoid(a[0]); a[1] = y1 * fsigmoid(a[1]); a[2] = y2 * fsigmoid(a[2]); a[3] = y3 * fsigmoid(a[3]); acc[ai][bj][m][n] = a;
                        s += (a[0] * a[0] + a[1] * a[1]) + (a[2] * a[2] + a[3] * a[3]); }
                s += lane_get(s, ln_ ^ 16); s += lane_get(s, ln_ ^ 32);
                if (fq == 0) P[(wr * 64 + ai * 128 + m * 16 + fr) * 4 + wc] = s; }
        asm volatile("s_waitcnt lgkmcnt(0)" ::: "memory"); __builtin_amdgcn_s_barrier(); asm volatile("" ::: "memory");
        pg8::f32x4 wv4[4];
#pragma unroll
        for (int bn = 0; bn < 4; ++bn) wv4[bn] = *(const GAS pg8::f32x4*)(bnw + col0 + (bn >> 1) * 128 + (bn & 1) * 16);
        asm volatile("" ::: "memory");
#pragma unroll
        for (int ai = 0; ai < 2; ++ai)
#pragma unroll
            for (int m = 0; m < 4; ++m) { const int rl = wr * 64 + ai * 128 + m * 16 + fr, r = u.pm * 256 + rl; const PG8_LAS pg8::f32x4* pp = (const PG8_LAS pg8::f32x4*)(P + rl * 4); const pg8::f32x4 ps = *pp;
                const float rstd = __builtin_amdgcn_rsqf(((ps[0] + ps[1]) + (ps[2] + ps[3])) * (1.f / 256.f) + 1e-6f);
#pragma unroll
                for (int bj = 0; bj < 2; ++bj)
#pragma unroll
                    for (int n = 0; n < 2; ++n) { const int c = col0 + bj * 128 + n * 16; const pg8::f32x4 o = acc[ai][bj][m][n] * rstd * wv4[bj * 2 + n];
                        v2u w; w.x = pk2(o[0], o[1]); w.y = pk2(o[2], o[3]); *(GAS v2u*)(MIX + (size_t)r * 1024 + 384 + c) = w; } }
    }
};
}
namespace fx {
constexpr int HG_NSEG = 8, HG_SEGTOK = SEQ / HG_NSEG, HG_CT = 32, HG_NCH = HG_SEGTOK / HG_CT;
constexpr size_t WS_HD = WS_HLOC + 7 * MiB;
typedef short hbf16x8 __attribute__((ext_vector_type(8)));
typedef float hf32x16 __attribute__((ext_vector_type(16)));
constexpr int HL_QT = 0, HL_KT = 4608, HL_KH = 9216, HL_VT = 14336, HL_PP = 19456, HL_ST = 22016, HL_DD = 31232, HL_TOT = 31488, HL_OO = 32512, HL_END = 41216;
constexpr int HP_QK = 72, HP_T = 40, HP_OO = 68;
__device__ __forceinline__ int hcrow(int r, int hi) { return (r & 3) + 8 * (r >> 2) + 4 * hi; }

template <bool FULL>
__device__ __forceinline__ void hgrn_pair(unsigned char* ws, const float* nw_l, int l, int u0, LAS unsigned char* lds_wg, const int wave00) {
    int wave0 = wave00; asm volatile("" : "+s"(wave0));
    const int lane = lane_now(), r32 = lane & 31, hi = lane >> 5, half = wave0 >> 2, hw = wave0 & 3, htid = hw * 64 + lane;
    constexpr int NS = FULL ? HG_NSEG : HG_NSEG - 1;
    const int unit = u0 + half, bh = unit / NS, seg = unit % NS, b = bh / 6, h = bh % 6; const int d = lane, sg = hw;
    LAS unsigned char* lds = lds_wg + half * HL_END;
    const bf16* Zb = (const bf16*)(ws + WS_Z) + (size_t)(b * SEQ + seg * HG_SEGTOK) * NZ + h * 64;
    const float lbv = ((const float*)(ws + WS_LB))[l * 384 + h * 64 + d], oml = 1.f - lbv;
    LAS unsigned short* QT = (LAS unsigned short*)(lds + HL_QT); LAS unsigned short* KT = (LAS unsigned short*)(lds + HL_KT);
    LAS unsigned short* KH = (LAS unsigned short*)(lds + HL_KH); LAS unsigned short* VT = (LAS unsigned short*)(lds + HL_VT);
    LAS unsigned short* PP = (LAS unsigned short*)(lds + HL_PP); LAS unsigned short* ST = (LAS unsigned short*)(lds + HL_ST);
    LAS float* DD = (LAS float*)(lds + HL_DD); LAS float* TOT = (LAS float*)(lds + HL_TOT); LAS float* OO = (LAS float*)(lds + HL_OO);
    const int dt = hw >> 1, vt = hw & 1;
    hf32x16 S;
#pragma unroll
    for (int r = 0; r < 16; ++r) S[r] = 0.f;
    if (FULL) {
        for (int j = 0; j < seg; ++j) { const float* loc = (const float*)(ws + WS_HLOC) + (size_t)(bh * HG_NSEG + j) * 4096; const float* hd = (const float*)(ws + WS_HD) + (bh * HG_NSEG + j) * 64;
#pragma unroll
            for (int r = 0; r < 16; ++r) { const int dd = 32 * dt + hcrow(r, hi); S[r] = S[r] * hd[dd] + loc[dd * 64 + 32 * vt + r32]; } }
#pragma unroll
        for (int j = 0; j < 4; ++j) { v2u w; w.x = pk2(S[4 * j], S[4 * j + 1]); w.y = pk2(S[4 * j + 2], S[4 * j + 3]); *(LAS v2u*)(ST + (32 * vt + r32) * HP_QK + 32 * dt + 8 * j + 4 * hi) = w; }
    }
    float lsum = 0.f;
    unsigned short rf[8] = {}, rv[8] = {}, rq[8] = {}; v4u rg = {};
    { const bf16* zr = Zb + (size_t)(8 * sg) * NZ;
#pragma unroll
        for (int i = 0; i < 8; ++i) { rf[i] = zr[(size_t)i * NZ + ZC_HF + d]; rv[i] = zr[(size_t)i * NZ + ZC_HI + d]; if (FULL) rq[i] = zr[(size_t)i * NZ + ZC_HQ + d]; }
        if (FULL) rg = *(const GAS v4u*)(Zb + (size_t)(htid >> 3) * NZ + ZC_HG + 8 * (htid & 7)); }
    for (int ch = 0; ch < HG_NCH; ++ch) {
        float lf[8], kk[8], qq[8], vv[8];
#pragma unroll
        for (int i = 0; i < 8; ++i) { const float z = bf2f(rf[i]); const float s1 = fsigmoid(z); lf[i] = __logf(lbv + oml * s1); kk[i] = oml * (1.f - s1);
            vv[i] = bf2f(rv[i]); if (FULL) qq[i] = fsilu(bf2f(rq[i])); }
        const v4u gw_ = rg;
        if (ch + 1 < HG_NCH) { const bf16* zr = Zb + (size_t)((ch + 1) * HG_CT + 8 * sg) * NZ;
#pragma unroll
            for (int i = 0; i < 8; ++i) { rf[i] = zr[(size_t)i * NZ + ZC_HF + d]; rv[i] = zr[(size_t)i * NZ + ZC_HI + d]; if (FULL) rq[i] = zr[(size_t)i * NZ + ZC_HQ + d]; }
            if (FULL) rg = *(const GAS v4u*)(Zb + (size_t)((ch + 1) * HG_CT + (htid >> 3)) * NZ + ZC_HG + 8 * (htid & 7)); }
#pragma unroll
        for (int i = 1; i < 8; ++i) lf[i] += lf[i - 1];
        TOT[sg * 64 + d] = lf[7];
        __syncthreads();
        float base = 0.f, blast = 0.f;
#pragma unroll
        for (int s2 = 0; s2 < 4; ++s2) { const float tv = TOT[s2 * 64 + d]; blast += tv; if (s2 < sg) base += tv; }
        lsum += blast;
        { float kh[8];
#pragma unroll
            for (int i = 0; i < 8; ++i) { const float bi = base + lf[i]; kh[i] = kk[i] * __expf(blast - bi);
                if (FULL) { const int t = 8 * sg + i; QT[t * HP_QK + d] = (unsigned short)f2bf(qq[i] * __expf(bi)); KT[t * HP_QK + d] = (unsigned short)f2bf(kk[i] * __expf(-bi)); } }
            v4u w; w.x = pk2(kh[0], kh[1]); w.y = pk2(kh[2], kh[3]); w.z = pk2(kh[4], kh[5]); w.w = pk2(kh[6], kh[7]); *(LAS v4u*)(KH + d * HP_T + 8 * sg) = w;
            v4u wv; wv.x = pk2(vv[0], vv[1]); wv.y = pk2(vv[2], vv[3]); wv.z = pk2(vv[4], vv[5]); wv.w = pk2(vv[6], vv[7]); *(LAS v4u*)(VT + d * HP_T + 8 * sg) = wv;
            if (sg == 0) DD[d] = __expf(blast); }
        __syncthreads();
        if (FULL && hw == 0) { hf32x16 c;
#pragma unroll
            for (int r = 0; r < 16; ++r) c[r] = 0.f;
#pragma unroll
            for (int ks = 0; ks < 4; ++ks) { const hbf16x8 a = *(const LAS hbf16x8*)(QT + r32 * HP_QK + 16 * ks + 8 * hi), bb = *(const LAS hbf16x8*)(KT + r32 * HP_QK + 16 * ks + 8 * hi); c = __builtin_amdgcn_mfma_f32_32x32x16_bf16(a, bb, c, 0, 0, 0); }
#pragma unroll
            for (int r = 0; r < 16; ++r) { const int t = hcrow(r, hi); PP[t * HP_T + r32] = (unsigned short)f2bf(r32 <= t ? c[r] : 0.f); } }
        {
#pragma unroll
            for (int r = 0; r < 16; ++r) S[r] *= DD[32 * dt + hcrow(r, hi)];
#pragma unroll
            for (int ks = 0; ks < 2; ++ks) { const hbf16x8 a = *(const LAS hbf16x8*)(KH + (32 * dt + r32) * HP_T + 16 * ks + 8 * hi), bb = *(const LAS hbf16x8*)(VT + (32 * vt + r32) * HP_T + 16 * ks + 8 * hi); S = __builtin_amdgcn_mfma_f32_32x32x16_bf16(a, bb, S, 0, 0, 0); } }
        if (FULL) {
            __syncthreads();
            if (hw == 1 || hw == 2) { const int ov = hw - 1; hf32x16 c;
#pragma unroll
                for (int r = 0; r < 16; ++r) c[r] = 0.f;
#pragma unroll
                for (int ks = 0; ks < 2; ++ks) { const hbf16x8 a = *(const LAS hbf16x8*)(PP + r32 * HP_T + 16 * ks + 8 * hi), bb = *(const LAS hbf16x8*)(VT + (32 * ov + r32) * HP_T + 16 * ks + 8 * hi); c = __builtin_amdgcn_mfma_f32_32x32x16_bf16(a, bb, c, 0, 0, 0); }
#pragma unroll
                for (int ks = 0; ks < 4; ++ks) { const hbf16x8 a = *(const LAS hbf16x8*)(QT + r32 * HP_QK + 16 * ks + 8 * hi), bb = *(const LAS hbf16x8*)(ST + (32 * ov + r32) * HP_QK + 16 * ks + 8 * hi); c = __builtin_amdgcn_mfma_f32_32x32x16_bf16(a, bb, c, 0, 0, 0); }
#pragma unroll
                for (int r = 0; r < 16; ++r) OO[hcrow(r, hi) * HP_OO + 32 * ov + r32] = c[r]; }
            __syncthreads();
#pragma unroll
            for (int j = 0; j < 4; ++j) { v2u w; w.x = pk2(S[4 * j], S[4 * j + 1]); w.y = pk2(S[4 * j + 2], S[4 * j + 3]); *(LAS v2u*)(ST + (32 * vt + r32) * HP_QK + 32 * dt + 8 * j + 4 * hi) = w; }
            { const int t = htid >> 3, vg = htid & 7; const f32x4 o0 = *(const LAS f32x4*)(OO + t * HP_OO + 8 * vg), o1 = *(const LAS f32x4*)(OO + t * HP_OO + 8 * vg + 4);
                float s = ((o0.x * o0.x + o0.y * o0.y) + (o0.z * o0.z + o0.w * o0.w)) + ((o1.x * o1.x + o1.y * o1.y) + (o1.z * o1.z + o1.w * o1.w));
                s += lane_get(s, lane ^ 1); s += lane_get(s, lane ^ 2); s += lane_get(s, lane ^ 4);
                const float rstd = __builtin_amdgcn_rsqf(s * (1.f / 64.f) + 1e-6f); const size_t row = (size_t)(b * SEQ + seg * HG_SEGTOK + ch * HG_CT + t);
                const f32x4 w0 = *(const GAS f32x4*)(nw_l + 8 * vg), w1 = *(const GAS f32x4*)(nw_l + 8 * vg + 4);
                v4u w; w.x = pk2(o0.x * rstd * w0.x * fsilu(bflo(gw_.x)), o0.y * rstd * w0.y * fsilu(bfhi(gw_.x))); w.y = pk2(o0.z * rstd * w0.z * fsilu(bflo(gw_.y)), o0.w * rstd * w0.w * fsilu(bfhi(gw_.y)));
                w.z = pk2(o1.x * rstd * w1.x * fsilu(bflo(gw_.z)), o1.y * rstd * w1.y * fsilu(bfhi(gw_.z))); w.w = pk2(o1.z * rstd * w1.z * fsilu(bflo(gw_.w)), o1.w * rstd * w1.w * fsilu(bfhi(gw_.w)));
                *(GAS v4u*)((bf16*)(ws + WS_H) + row * 1024 + 640 + h * 64 + 8 * vg) = w; }
        }
    }
    if (!FULL) {
        { float* loc = (float*)(ws + WS_HLOC) + (size_t)(bh * HG_NSEG + seg) * 4096;
#pragma unroll
            for (int r = 0; r < 16; ++r) loc[(32 * dt + hcrow(r, hi)) * 64 + 32 * vt + r32] = S[r]; }
        if (sg == 0) ((float*)(ws + WS_HD))[(bh * HG_NSEG + seg) * 64 + d] = __expf(lsum);
    }
    __syncthreads();
}
}
namespace fx {
constexpr int LDS_BYTES = 147456;
constexpr int RING_BYTES = 131072, LDSCTL_OFF = RING_BYTES, MISC_OFF = LDSCTL_OFF + 320;
constexpr int PH_PRO = 0, PH_FINAL = 21, NPH = 22;

struct QueueOrder {
    unsigned* ctr; LAS unsigned* slot;
    __device__ __forceinline__ bool next(int, attn_body::AttnUnit& u) const {
        if (threadIdx.x == 0) *slot = __hip_atomic_fetch_add(ctr, 1u, __ATOMIC_RELAXED, __HIP_MEMORY_SCOPE_AGENT);
        __syncthreads(); const unsigned v = *slot; __syncthreads();
        if (v >= 768u) return false; u.bh = (int)(v >> 4); u.qb = 15 - (int)(v & 15u); return true; }
    __device__ __forceinline__ void a_ready(const attn_body::AttnUnit&) const {}
    __device__ __forceinline__ void done(const attn_body::AttnUnit&) const {}
};

__global__ void __launch_bounds__(NTHR, 2) mk_fwd(Params p) {
    extern __shared__ __attribute__((aligned(16))) unsigned char lds_raw[];
    LAS unsigned char* lds = (LAS unsigned char*)lds_raw;
    const int wave0 = __builtin_amdgcn_readfirstlane(threadIdx.x >> 6);
    for (int u = threadIdx.x; u < (LDS_BYTES - LDSCTL_OFF) / 4; u += NTHR) ((LAS unsigned*)(lds + LDSCTL_OFF))[u] = 0u;
    __syncthreads();
    const XcdBarrier bar = xcd_barrier_post((unsigned*)(p.ws + WS_CTL) + 8192 + p.li * 4096, (volatile LAS unsigned*)(lds + MISC_OFF) + 8, threadIdx.x == 0);
#ifdef EXTRA_BARS
    for (int eb = 0; eb < EXTRA_BARS; ++eb) xcd_barrier(bar, wave0 == 0 && lane_now() == 0);
#endif
    for (int ph = p.ph_lo; ph < p.ph_hi; ++ph) {
#ifdef DUP_MASK
      for (int rep = (((DUP_MASK) >> ph) & 1u) ? 0 : 1; rep < 2; ++rep) {
#else
      { const int rep = 1;
#endif
#ifdef PROBE_MASK
        if (blockIdx.x == 0 && wave0 == 0 && lane_now() == 0) __hip_atomic_store((unsigned long long*)(p.ws + WS_CTL + 512 * 1024) + ph, __builtin_amdgcn_s_memrealtime(), __ATOMIC_RELAXED, __HIP_MEMORY_SCOPE_AGENT);
#endif
        int oz = 0; asm volatile("" : "+s"(oz));
        const int G = gridDim.x, bx = blockIdx.x + oz;
#define PHASE_IDS int wv_ = wave0; asm volatile("" : "+s"(wv_)); const int lane = lane_now(), wave = wv_, tid = wv_ * 64 + lane; \
        const int vcu = (G % 8 == 0) ? (bx % 8) * (G / 8) + bx / 8 : bx; const int gw = vcu * NWAVES + wave, ngw = G * NWAVES; (void)tid; (void)lane; (void)gw; (void)ngw;
        unsigned char* ws = p.ws + oz;
#define PIN(i) (p.in[(i) + oz])
        const int l = (ph - 1) / 10, sub = (ph - 1) % 10;
#ifndef EXP_NO_PRO
        if (ph == PH_PRO) { PHASE_IDS
            { LAS float* cact = (LAS float*)lds; const float* c = PIN(I_C); for (int i = tid; i < 8192; i += NTHR) { const float cv = c[i]; cact[i] = cv * fsigmoid(cv); } __syncthreads();
              for (int it = bx; it < 192; it += G) prologue_mod_item(p, oz, it, (LAS float*)lds, tid, lane, wave); }
            __syncthreads();
            for (int it = (G >= 224 ? bx - 192 : bx); it >= 0 && it < 32; it += G) prologue_s5_item(p, oz, it / 16, it % 16, (LAS float*)lds, tid);
            __syncthreads();
            prologue_wave_items(p, oz, (LAS float*)(lds + wave * 16384), gw, ngw, lane);
        } else
#endif
        if (ph == PH_FINAL) { PHASE_IDS
            float* X = p.out + oz; const bf16* XBp = (const bf16*)(ws + WS_XB); const float* w = PIN(I_FINW);
#ifdef PROBE_MASK
            float pscale = 1.f; { unsigned long long* tsb = (unsigned long long*)(ws + WS_CTL + 512 * 1024); unsigned long long t0 = __hip_atomic_load(tsb, __ATOMIC_RELAXED, __HIP_MEMORY_SCOPE_AGENT), tl = __hip_atomic_load(tsb + PH_FINAL, __ATOMIC_RELAXED, __HIP_MEMORY_SCOPE_AGENT); unsigned long long acc = 0;
#pragma unroll 1
                for (int k = 0; k < PH_FINAL; ++k) if ((PROBE_MASK >> k) & 1u) acc += __hip_atomic_load(tsb + k + 1, __ATOMIC_RELAXED, __HIP_MEMORY_SCOPE_AGENT) - __hip_atomic_load(tsb + k, __ATOMIC_RELAXED, __HIP_MEMORY_SCOPE_AGENT);
                pscale = 1.f + (float)acc / (float)(tl - t0); }
#endif
            f32x4 W4[4];
#pragma unroll
            for (int j = 0; j < 4; ++j) W4[j] = ((const GAS f32x4*)w)[lane + 64 * j];
            f32x4 v[4] = {}; if (gw < M) row_load_bf(XBp, gw, lane, v);
            for (int m = gw; m < M; m += ngw) { GAS f32x4* xr = (GAS f32x4*)(X + (size_t)m * 1024) + lane; f32x4 nxt[4] = {}; const int mn = m + ngw; if (mn < M) row_load_bf(XBp, mn, lane, nxt); float s = 0.f;
#pragma unroll
                for (int j = 0; j < 4; ++j) s += (v[j].x * v[j].x + v[j].y * v[j].y) + (v[j].z * v[j].z + v[j].w * v[j].w);
                const float rstd = __builtin_amdgcn_rsqf(wave_sum(s, lane) * (1.f / 1024.f) + 1e-6f);
#pragma unroll
                for (int j = 0; j < 4; ++j) { f32x4 o = (v[j] * rstd) * W4[j];
#ifdef PROBE_MASK
                    o = o * pscale;
#endif
                    xr[64 * j] = o; }
#pragma unroll
                for (int j = 0; j < 4; ++j) v[j] = nxt[j]; }
        }
#ifndef EXP_NO_ROW
        else if (sub == 0) { PHASE_IDS
            const float* X = PIN(I_X); const float* mod = (const float*)(ws + WS_MOD) + l * 8 * 6144;
            const int tpw = M / G, t0 = bx * tpw, b = t0 >> 12; f32x4 A[4], B[4]; adaln_factors(PIN(I_NMW) + l * 1024, mod + b * 6144, mod + b * 6144 + 1024, lane, A, B);
            const bf16* XBp = (const bf16*)(ws + WS_XB);
            f32x4 cur[4] = {}; if (wave < tpw) { if (l == 0) row_load(X, t0 + wave, lane, cur); else row_load_bf(XBp, t0 + wave, lane, cur); }
            for (int r = wave; r < tpw; r += NWAVES) { f32x4 nxt[4] = {}; if (r + NWAVES < tpw) { if (l == 0) row_load(X, t0 + r + NWAVES, lane, nxt); else row_load_bf(XBp, t0 + r + NWAVES, lane, nxt); }
                norm_row_to_bf16(cur, A, B, (bf16*)(ws + WS_H) + (size_t)(t0 + r) * 1024, lane);
#pragma unroll
                for (int j = 0; j < 4; ++j) cur[j] = nxt[j]; }
        }
#endif
        else if (sub == 1) {
            pg8::Gemm g{(const pg8::bf16_t*)(ws + WS_H), (const pg8::bf16_t*)(ws + WS_WIN) + (size_t)l * 3072 * 1024, M, NZ, 1024, 1024, 1024};
            pg8::StaticOrder S; S.init(M, NZ, G, bx);
            EpiZ E{(bf16*)(ws + WS_Z), (bf16*)(ws + WS_UP), (float*)(ws + WS_NLF), PIN(I_FOXB) + l * 6};
#ifdef EXP_EPI_BF16
            pg8::EpiBf16<0> E2{(bf16*)(ws + WS_Z), NZ, nullptr, 0, 0, 1.f};
            pg8::gemm_phase<pg8::EpiBf16<0>, pg8::StaticOrder, true, true>(lds, g, S, E2);
#else
            pg8::gemm_phase<EpiZ, pg8::StaticOrder, true, true>(lds, g, S, E, wave0);
#endif
        }
        else if (sub == 2) {
            unsigned* qctr = (unsigned*)(ws + WS_CTL) + 1024 + ph * 64 + rep * 32; LAS unsigned* qslot = (LAS unsigned*)(lds + MISC_OFF);
            constexpr unsigned NHL = 48u * (HG_NSEG - 1) / 2u;
            for (;;) {
                int ozq = 0; asm volatile("" : "+s"(ozq)); unsigned char* wsq = p.ws + ozq;
                if (wave0 == 0 && lane_now() == 0) *qslot = __hip_atomic_fetch_add(qctr, 1u, __ATOMIC_RELAXED, __HIP_MEMORY_SCOPE_AGENT);
                __syncthreads(); const unsigned v = __builtin_amdgcn_readfirstlane(*qslot); __syncthreads();
                if (v >= NHL + 128u + 48u + 768u) break;
                if (v < NHL) { hgrn_pair<false>(wsq, p.in[I_HNW + ozq] + l * 64, l, (int)(2u * v), lds, wave0); }
                else if (v < NHL + 128u) { const int u5 = (int)(v - NHL); const OneUnit S5{u5, u5 >> 3};
                    pg8::Gemm g5{(const pg8::bf16_t*)(wsq + WS_UP), (const pg8::bf16_t*)(wsq + WS_S5WL) + (size_t)l * 16 * 256 * 256, 16 * 2048, 16 * 256, 256, 384, 256}; EpiS5Loc E5{(float*)(wsq + WS_LOC)}; pg8::gemm_phase<EpiS5Loc, OneUnit, false, true>(lds, g5, S5, E5, wave0); __syncthreads(); }
                else if (v >= NHL + 128u + 48u) {
                    const int u = (int)(v - NHL - 128u - 48u), bh = u >> 4, qb = u & 15, b = bh / 6, h = bh % 6; int wv_ = wave0; asm volatile("" : "+s"(wv_)); const int lane = lane_now();
                    const bf16* Zr = (const bf16*)(wsq + WS_Z) + (size_t)(b * SEQ + qb * 256 + wv_ * 32) * NZ + h * 64; float kmax = 0.f, qmax = 0.f;
#pragma unroll
                    for (int i = 0; i < 8; ++i) { const bf16* rp = Zr + (size_t)(4 * i + (lane >> 4)) * NZ + 4 * (lane & 15); const v2u kw = *(const GAS v2u*)(rp + ZC_FK), qw = *(const GAS v2u*)(rp + ZC_FQ);
                        float ks = (bflo(kw.x) * bflo(kw.x) + bfhi(kw.x) * bfhi(kw.x)) + (bflo(kw.y) * bflo(kw.y) + bfhi(kw.y) * bfhi(kw.y)), qs = (bflo(qw.x) * bflo(qw.x) + bfhi(qw.x) * bfhi(qw.x)) + (bflo(qw.y) * bflo(qw.y) + bfhi(qw.y) * bfhi(qw.y));
                        ks += lane_get(ks, lane ^ 1); qs += lane_get(qs, lane ^ 1); ks += lane_get(ks, lane ^ 2); qs += lane_get(qs, lane ^ 2); ks += lane_get(ks, lane ^ 4); qs += lane_get(qs, lane ^ 4); ks += lane_get(ks, lane ^ 8); qs += lane_get(qs, lane ^ 8);
                        kmax = fmaxf(kmax, ks); qmax = fmaxf(qmax, qs); }
                    kmax = fmaxf(kmax, lane_get(kmax, lane ^ 16)); qmax = fmaxf(qmax, lane_get(qmax, lane ^ 16)); kmax = fmaxf(kmax, lane_get(kmax, lane ^ 32)); qmax = fmaxf(qmax, lane_get(qmax, lane ^ 32));
                    LAS float* red = (LAS float*)lds; if (lane == 0) { red[wv_] = kmax; red[8 + wv_] = qmax; }
                    __syncthreads();
                    if (wv_ == 0 && lane < 4) ((float*)(wsq + WS_KN))[bh * 64 + qb * 4 + lane] = fmaxf(red[2 * lane], red[2 * lane + 1]) * 1.02f;
                    if (wv_ == 0 && lane == 4) { float m = red[8]; for (int w = 1; w < 8; ++w) m = fmaxf(m, red[8 + w]); ((float*)(wsq + WS_QN))[bh * 16 + qb] = m * 1.02f; }
                    __syncthreads(); }
                else { const int bh = (int)(v - NHL - 128u); int wv_ = wave0; asm volatile("" : "+s"(wv_)); const int lane = lane_now(), wave = wv_, tid = wv_ * 64 + lane; LAS float* wsum = (LAS float*)lds;
                    const float* src = (const float*)(wsq + WS_NLF) + (size_t)bh * SEQ + tid * 8; float v8[8]; float s = 0.f;
                    const f32x4 a = *(const GAS f32x4*)src, b4 = *(const GAS f32x4*)(src + 4);
                    v8[0] = a.x; v8[1] = a.y; v8[2] = a.z; v8[3] = a.w; v8[4] = b4.x; v8[5] = b4.y; v8[6] = b4.z; v8[7] = b4.w;
#pragma unroll
                    for (int i = 0; i < 8; ++i) { s += v8[i]; v8[i] = s; }
                    float incl = s;
#pragma unroll
                    for (int o = 1; o < 64; o <<= 1) { const float n = lane_get(incl, lane - o); if (lane >= o) incl += n; }
                    if (lane == 63) wsum[wave] = incl;
                    __syncthreads();
                    float base = incl - s;
                    for (int w = 0; w < wave; ++w) base += wsum[w];
                    float* dst = (float*)(wsq + WS_G) + (size_t)bh * SEQ + tid * 8;
                    *(GAS f32x4*)dst = (f32x4){v8[0] + base, v8[1] + base, v8[2] + base, v8[3] + base}; *(GAS f32x4*)(dst + 4) = (f32x4){v8[4] + base, v8[5] + base, v8[6] + base, v8[7] + base};
                    __syncthreads(); }
            }
        }
        else if (sub == 3) {
            unsigned* qctr = (unsigned*)(ws + WS_CTL) + 1024 + ph * 64 + rep * 32; LAS unsigned* qslot = (LAS unsigned*)(lds + MISC_OFF);
            for (;;) {
                int ozq = 0; asm volatile("" : "+s"(ozq)); unsigned char* wsq = p.ws + ozq;
                if (wave0 == 0 && lane_now() == 0) *qslot = __hip_atomic_fetch_add(qctr, 1u, __ATOMIC_RELAXED, __HIP_MEMORY_SCOPE_AGENT);
                __syncthreads(); const unsigned v = __builtin_amdgcn_readfirstlane(*qslot); __syncthreads();
                constexpr unsigned NHF = 48u * HG_NSEG / 2u;
                if (v >= NHF + 128u + 768u) break;
#ifdef DUP_MASK
#ifndef DUP_CSEL
                if (rep == 0 && v >= NHF + 128u) break;
#else
                if (rep == 0 && DUP_CSEL != 3 && v >= NHF + 128u) break;
#endif
#ifdef DUP_CSEL
                if (rep == 0 && DUP_CSEL == 1 && v >= NHF) break;
                if (rep == 0 && DUP_CSEL == 2 && v < NHF) continue;
                if (rep == 0 && DUP_CSEL == 3 && v < NHF + 128u) continue;
#endif
#endif
                if (v < NHF) { hgrn_pair<true>(wsq, p.in[I_HNW + ozq] + l * 64, l, (int)(2u * v), lds, wave0); }
                else if (v < NHF + 128u) { const unsigned v5 = v - NHF;
                    s5_scan(wsq, l, (int)(v5 >> 3), (int)(v5 & 7u), wave0 * 64 + lane_now());
                    pg8::Gemm g5{(const pg8::bf16_t*)(wsq + WS_UP), (const pg8::bf16_t*)(wsq + WS_S5WO) + (size_t)l * 16 * 256 * 384, 16 * 2048, 16 * 256, 384, 384, 384}; EpiS5Y E5{(bf16*)(wsq + WS_Y)};
                    const OneUnit S5{(int)v5, (int)(v5 >> 3)}; pg8::gemm_phase<EpiS5Y, OneUnit, false, false>(lds, g5, S5, E5, wave0); __syncthreads(); }
                else { const unsigned a = v - NHF - 128u; const int bh = (int)(a >> 4), qb = 15 - (int)(a & 15u);
                    const attn_body::bf16* Zq = (const attn_body::bf16*)(wsq + WS_Z);
                    int ts; { const int ln = lane_now(); const float* Gb = (const float*)(wsq + WS_G) + (size_t)bh * SEQ; const float* KN = (const float*)(wsq + WS_KN) + bh * 64; const float qn = ((const float*)(wsq + WS_QN))[bh * 16 + qb];
                        const float kd = fmaxf(fmaxf(KN[4 * qb], KN[4 * qb + 1]), fmaxf(KN[4 * qb + 2], KN[4 * qb + 3])); const float ub = __builtin_sqrtf(qn * KN[ln]) + Gb[64 * ln + 63] - Gb[256 * qb] + __builtin_sqrtf(qn * kd);
                        const unsigned long long need = __ballot((ln < 4 * qb) && !(ub < -36.f)); const int first = need ? (int)__builtin_ctzll(need) : 4 * qb; ts = __builtin_amdgcn_readfirstlane(first & ~1); }
                    attn_body::attn_unit<8>(bh / 6, bh % 6, qb, Zq + ZC_FQ, Zq + ZC_FK, Zq + ZC_FV, (attn_body::bf16*)(wsq + WS_Z) + ZC_FQ, (const float*)(wsq + WS_G) + (long)bh * SEQ, (char*)lds_raw, wave0, ts, rep != 0); }
            }
        }
        else if (sub == 4) { PHASE_IDS
            if (bx < 128) {
                pg8::Gemm gg{(const pg8::bf16_t*)(ws + WS_Y), (const pg8::bf16_t*)(ws + WS_GLU) + (size_t)l * 256 * 256, M, 256, 256, 256, 256};
                const OneUnit SG{bx, 0}; EpiGlu EG{(const bf16*)(ws + WS_Y), PIN(I_GLUB) + l * 256, PIN(I_BNS) + l * 256, (bf16*)(ws + WS_H)};
                pg8::gemm_phase<EpiGlu, OneUnit, false, true>(lds, gg, SG, EG, wave0);
            } else {
            const int gw2 = (bx - 128) * NWAVES + wave, ngw2 = (G - 128) * NWAVES;
            const bf16* Zb = (const bf16*)(ws + WS_Z); bf16* MIX = (bf16*)(ws + WS_H); const float* w = PIN(I_BNF) + l * 384;
            float wl[6];
#pragma unroll
            for (int i = 0; i < 6; ++i) wl[i] = w[lane * 6 + i];
            for (int m = gw2; m < M; m += ngw2) {
                const GAS unsigned* src = (const GAS unsigned*)(Zb + (size_t)m * NZ) + lane * 3; const unsigned a = src[0], b2 = src[1], c = src[2];
                float v[6] = {bflo(a), bfhi(a), bflo(b2), bfhi(b2), bflo(c), bfhi(c)}; float s = 0.f;
#pragma unroll
                for (int i = 0; i < 6; ++i) s += v[i] * v[i];
                const float rstd = __builtin_amdgcn_rsqf(wave_sum(s, lane) * (1.f / 384.f) + 1e-6f);
                GAS unsigned* dst = (GAS unsigned*)(MIX + (size_t)m * 1024) + lane * 3;
                dst[0] = pk2(v[0] * rstd * wl[0], v[1] * rstd * wl[1]); dst[1] = pk2(v[2] * rstd * wl[2], v[3] * rstd * wl[3]); dst[2] = pk2(v[4] * rstd * wl[4], v[5] * rstd * wl[5]);
            }
            }
        }
        else if (sub == 5) {
            pg8::Gemm g{(const pg8::bf16_t*)(ws + WS_H), (const pg8::bf16_t*)(ws + WS_WOUT) + (size_t)l * 1024 * 1024, M, 1024, 1024, 1024, 1024};
            pg8::StaticOrder S; S.init(M, 1024, G, bx);
            const float* gm = (const float*)(ws + WS_MOD) + l * 8 * 6144 + 2048;
            if (l == 0) { EpiRes<true> E{PIN(I_X), (bf16*)(ws + WS_XB), gm}; pg8::gemm_phase<EpiRes<true>, pg8::StaticOrder, true, true>(lds, g, S, E, wave0); }
            else { EpiRes<false> E{ws + WS_XB, (bf16*)(ws + WS_XB), gm}; pg8::gemm_phase<EpiRes<false>, pg8::StaticOrder, true, true>(lds, g, S, E, wave0); }
        }
        else if (sub == 6) { PHASE_IDS moe_route(p, oz, l, lds, tid, lane, wave, bx, G);
        }
        else if (sub == 7) { PHASE_IDS moe_gather(p, oz, lds, tid, lane, wave, bx, G);
        }
        else if (sub == 8) { PHASE_IDS
            LAS int* list = (LAS int*)(lds + RING_BYTES + 1024); const int n = moe_build_list<false>(ws, list, tid, bx, G);
            pg8::Gemm g{(const pg8::bf16_t*)(ws + WS_H2S), (const pg8::bf16_t*)(ws + WS_W1) + (size_t)l * 8192 * 1024, MOE_ROWS, 8192, 1024, 1024, 1024};
            ListOrder S{list, n}; EpiHid E{(bf16*)(ws + WS_HID), (const float*)(ws + WS_ROWW)};
            pg8::gemm_phase<EpiHid, ListOrder, true, true>(lds, g, S, E, wave0);
        }
        else if (sub == 9) { PHASE_IDS
            LAS int* list = (LAS int*)(lds + RING_BYTES + 1024); const int n = moe_build_list<true>(ws, list, tid, bx, G);
            pg8::Gemm g{(const pg8::bf16_t*)(ws + WS_HID), (const pg8::bf16_t*)(ws + WS_W2) + (size_t)l * 1024 * 4096, MOE_ROWS, 1024, 512, 512, 4096};
            ListOrder S{list, n}; EpiMoeOut E{(bf16*)(ws + WS_XB), (const float*)(ws + WS_MOD) + l * 8 * 6144 + 5 * 1024, (const int*)(ws + WS_ROWTOK)};
            pg8::gemm_phase<EpiMoeOut, ListOrder, false, true, true>(lds, g, S, E, wave0);
        }
        if (ph + 1 < p.ph_hi || rep == 0) xcd_barrier(bar, wave0 == 0 && lane_now() == 0); else __syncthreads();
      }
    }
}

static int g_grid = 0;
inline bool mk_setup() {
    if (g_grid) return g_grid > 0;
    int dev = 0, cus = 0;
    if (hipGetDevice(&dev) != hipSuccess || hipDeviceGetAttribute(&cus, hipDeviceAttributeMultiprocessorCount, dev) != hipSuccess) { g_grid = -1; return false; }
    if (hipFuncSetAttribute((const void*)mk_fwd, hipFuncAttributeMaxDynamicSharedMemorySize, LDS_BYTES) != hipSuccess) { fprintf(stderr, "hipFuncSetAttribute failed\n"); g_grid = -1; return false; }
    g_grid = cus; return true;
}
inline void mk_zero_ctl(void* d_ws, hipStream_t st) { (void)hipMemsetAsync((char*)d_ws + WS_CTL, 0, CTL_ZERO_BYTES, st); }
inline void mk_launch(void* const* d_in, void* d_out, void* d_ws, hipStream_t st, int lo, int hi, int li = 0) {
    if (!mk_setup()) return;
    Params p{}; for (int i = 0; i < 29; ++i) p.in[i] = (const float*)d_in[i]; p.out = (float*)d_out; p.ws = (unsigned char*)d_ws; p.ph_lo = lo; p.ph_hi = hi; p.li = li;
    hipLaunchKernelGGL(mk_fwd, dim3(g_grid), dim3(NTHR), LDS_BYTES, st, p);
}
}
extern "C" void kernel_launch(void* const* d_in, const int* in_sizes, int n_in, void* d_out, int out_size, void* d_ws, size_t ws_size, hipStream_t stream) {
    fx::mk_zero_ctl(d_ws, stream);
    fx::mk_launch(d_in, d_out, d_ws, stream, 0, 22, 0);
}
```

```cpp
#include <hip/hip_runtime.h>
#include <hip/hip_bf16.h>
#include <cstdio>
#include <cstdint>
#include <cmath>
namespace fx {
constexpr int BATCH = 8, SEQ = 4096, DM = 1024, M = BATCH * SEQ, NZ = 3072, NIN = 2950;
constexpr int NWAVES = 8, NTHR = 512;
constexpr float LOG2E = 1.4426950408889634f;
constexpr float C2 = 0.125f * LOG2E;
constexpr int ZC_FQ = 0, ZC_FK = 384, ZC_FV = 768, ZC_SU = 1152, ZC_HQ = 1408, ZC_HF = 1792, ZC_HI = 2176, ZC_HG = 2560, ZC_FF = 2944;
constexpr size_t MiB = 1u << 20;
constexpr size_t WS_CTL = 0, CTL_ZERO_BYTES = 1 * MiB;
constexpr size_t WS_MOD = 1 * MiB;
constexpr size_t WS_LB = WS_MOD + 512 * 1024;
constexpr size_t WS_S5AL = WS_LB + 4096;
constexpr size_t WS_NLF = 2 * MiB;
constexpr size_t WS_G = WS_NLF + 48 * 4096 * 4;
constexpr size_t WS_KN = WS_G + 48 * 4096 * 4;
constexpr size_t WS_QN = WS_KN + 48 * 64 * 4;
constexpr size_t WS_WIN = 4 * MiB;
constexpr size_t WS_WOUT = WS_WIN + 2ull * 3072 * 1024 * 2;
constexpr size_t WS_W1 = WS_WOUT + 2ull * 1024 * 1024 * 2;
constexpr size_t WS_W2 = WS_W1 + 2ull * 8192 * 1024 * 2;
constexpr size_t WS_GLU = WS_W2 + 2ull * 1024 * 4096 * 2;
constexpr size_t WS_S5WO = WS_GLU + 2ull * 256 * 256 * 2;
constexpr size_t WS_S5WL = WS_S5WO + 2ull * 16 * 256 * 384 * 2;
constexpr size_t WS_H = 80 * MiB;
constexpr size_t WS_Z = WS_H + (size_t)M * 1024 * 2;
constexpr size_t WS_UP = WS_Z + (size_t)M * NZ * 2;
constexpr size_t WS_LOC = WS_UP + 16ull * 2048 * 384 * 2;
constexpr size_t WS_Y = WS_LOC + 16ull * 2048 * 128 * 4;
constexpr size_t WS_HLOC = WS_Y + (size_t)M * 256 * 2;
constexpr size_t WS_XB = WS_HLOC + 16 * MiB;
constexpr size_t WS_END = WS_XB + (size_t)M * 1024 * 2;
static_assert(WS_S5WL + 2ull * 16 * 256 * 256 * 2 <= WS_H, "weights fit below H");
static_assert(WS_QN + 48 * 16 * 4 <= WS_WIN, "norm tables fit below the weights");
static_assert(WS_END <= 512 * MiB, "workspace fits 512 MiB");

#define GAS __attribute__((address_space(1)))
#define LAS __attribute__((address_space(3)))
typedef unsigned short bf16;
typedef unsigned v4u __attribute__((ext_vector_type(4)));
typedef unsigned v2u __attribute__((ext_vector_type(2)));
typedef float f32x4 __attribute__((ext_vector_type(4)));
typedef GAS unsigned gu32;
#define RLX_AGENT __ATOMIC_RELAXED, __HIP_MEMORY_SCOPE_AGENT
#define LDS_WAIT() asm volatile("s_waitcnt lgkmcnt(0)" ::: "memory")
#define VM_WAIT() asm volatile("s_waitcnt vmcnt(0)" ::: "memory")
__device__ __forceinline__ unsigned f2bf(float f) { unsigned u = __builtin_bit_cast(unsigned, f); return (u + 0x7fffu + ((u >> 16) & 1u)) >> 16; }
__device__ __forceinline__ unsigned pk2(float lo, float hi) { return f2bf(lo) | (f2bf(hi) << 16); }
__device__ __forceinline__ float bf2f(unsigned short h) { return __builtin_bit_cast(float, (unsigned)h << 16); }
__device__ __forceinline__ float bflo(unsigned w) { return __builtin_bit_cast(float, w << 16); }
__device__ __forceinline__ float bfhi(unsigned w) { return __builtin_bit_cast(float, w & 0xffff0000u); }
__device__ __forceinline__ float fsigmoid(float x) { return __builtin_amdgcn_rcpf(1.f + __builtin_amdgcn_exp2f(-LOG2E * x)); }
__device__ __forceinline__ float fsilu(float x) { return x * fsigmoid(x); }
__device__ __forceinline__ float lane_get(float v, int src_lane) { return __builtin_bit_cast(float, __builtin_amdgcn_ds_bpermute(src_lane << 2, __builtin_bit_cast(int, v))); }
__device__ __forceinline__ float wave_sum(float v, int  ) {
    v += __builtin_bit_cast(float, __builtin_amdgcn_update_dpp(0, __builtin_bit_cast(int, v), 0xB1, 0xF, 0xF, false));
    v += __builtin_bit_cast(float, __builtin_amdgcn_update_dpp(0, __builtin_bit_cast(int, v), 0x4E, 0xF, 0xF, false));
    v += __builtin_bit_cast(float, __builtin_amdgcn_update_dpp(0, __builtin_bit_cast(int, v), 0x141, 0xF, 0xF, false));
    v += __builtin_bit_cast(float, __builtin_amdgcn_update_dpp(0, __builtin_bit_cast(int, v), 0x140, 0xF, 0xF, false));
    v += __builtin_bit_cast(float, __builtin_amdgcn_update_dpp(0, __builtin_bit_cast(int, v), 0x142, 0xA, 0xF, false));
    v += __builtin_bit_cast(float, __builtin_amdgcn_update_dpp(0, __builtin_bit_cast(int, v), 0x143, 0xC, 0xF, false));
    return __builtin_bit_cast(float, __builtin_amdgcn_readlane(__builtin_bit_cast(int, v), 63));
}

__device__ __forceinline__ int lane_now() { int z = 0; asm volatile("" : "+v"(z)); return (int)__builtin_amdgcn_mbcnt_hi(~0u, __builtin_amdgcn_mbcnt_lo(~0u, (unsigned)z)); }

struct Params {
    const float* in[29]; float* out; unsigned char* ws; int ph_lo, ph_hi, li, pad;
};
enum { I_X = 0, I_C, I_ADAW, I_ADAB, I_NMW, I_NFW, I_WIN, I_FOXB, I_ARE, I_AIM, I_BRE, I_BIM, I_CRE, I_CIM, I_S5D, I_LOGDT, I_GLUW, I_GLUB, I_LBL, I_HNW, I_BNF, I_BNS, I_WOUT, I_RW, I_RB, I_WG, I_WU, I_WD, I_FINW };

__device__ __forceinline__ void transpose_item(const float* src, int ld_src, int c0, int nvalid, bf16* dst, int ldd, int k0, LAS float* scr, int lane) {
#pragma unroll 8
    for (int i = 0; i < 32; ++i) { const int kk = 2 * i + (lane >> 5), n = lane & 31; scr[kk * 33 + n] = (n < nvalid) ? src[(size_t)(k0 + kk) * ld_src + c0 + n] : 0.f; }
    LDS_WAIT(); asm volatile("" ::: "memory");
    const int c = lane & 7;
#pragma unroll
    for (int j = 0; j < 4; ++j) { const int n = (lane >> 3) + 8 * j; const LAS float* s = scr + (8 * c) * 33 + n;
        v4u o; o.x = pk2(s[0 * 33], s[1 * 33]); o.y = pk2(s[2 * 33], s[3 * 33]); o.z = pk2(s[4 * 33], s[5 * 33]); o.w = pk2(s[6 * 33], s[7 * 33]);
        *(GAS v4u*)(dst + (size_t)n * ldd + k0 + 8 * c) = o; }
    LDS_WAIT(); asm volatile("" ::: "memory");
}
__device__ __forceinline__ int win_src_col(int n) {
    if (n < 1152) return n;
    if (n < 1408) return 1158 + (n - 1152);
    if (n < 2944) return 1414 + (n - 1408);
    if (n < 2950) return 1152 + (n - 2944);
    return -1;
}
__device__ __forceinline__ void prologue_wave_items(const Params& p, int oz, LAS float* scr, int gw, int ngw, int lane) {
    unsigned char* ws = p.ws + oz;
    constexpr int IT_WIN = 2 * 16 * 96, IT_WOUT = 2 * 16 * 32, IT_W1 = 2 * 16 * 256, IT_W2 = 2 * 64 * 32, IT_GLU = 2 * 4 * 8;
    constexpr int NITEMS = IT_WIN + IT_WOUT + IT_W1 + IT_W2 + IT_GLU;
    for (int it = gw; it < NITEMS; it += ngw) {
        int r = it;
        if (r < IT_WIN) { const int l = r / (16 * 96), q = r % (16 * 96), kb = q / 96, nb = q % 96, n0 = nb * 32; const int sc = win_src_col(n0);
            int nvalid = 32; if (sc < 0) nvalid = 0; else if (n0 == 2944) nvalid = 6;
            transpose_item(p.in[I_WIN + oz] + (size_t)l * 1024 * NIN, NIN, sc < 0 ? 0 : sc, nvalid, (bf16*)(ws + WS_WIN) + ((size_t)l * 3072 + n0) * 1024, 1024, kb * 64, scr, lane); continue; }
        r -= IT_WIN;
        if (r < IT_WOUT) { const int l = r / (16 * 32), q = r % (16 * 32), kb = q / 32, nb = q % 32;
            transpose_item(p.in[I_WOUT + oz] + (size_t)l * 1024 * 1024, 1024, nb * 32, 32, (bf16*)(ws + WS_WOUT) + ((size_t)l * 1024 + nb * 32) * 1024, 1024, kb * 64, scr, lane); continue; }
        r -= IT_WOUT;
        if (r < IT_W1) {
            const int l = r / (16 * 256), q = r % (16 * 256), kb = q / 256, nb = q % 256, n0 = nb * 32; const int e = n0 / 512, j = (n0 % 512) / 256, w = n0 % 256; const bool up = w >= 128; const int f0 = j * 128 + (w % 128);
            const float* src = (up ? p.in[I_WU + oz] : p.in[I_WG + oz]) + ((size_t)l * 16 + e) * 1024 * 256;
            transpose_item(src, 256, f0, 32, (bf16*)(ws + WS_W1) + ((size_t)l * 8192 + n0) * 1024, 1024, kb * 64, scr, lane); continue; }
        r -= IT_W1;
        if (r < IT_W2) { const int l = r / (64 * 32), q = r % (64 * 32), kb = q / 32, nb = q % 32;
            transpose_item(p.in[I_WD + oz] + (size_t)l * 4096 * 1024, 1024, nb * 32, 32, (bf16*)(ws + WS_W2) + ((size_t)l * 1024 + nb * 32) * 4096, 4096, kb * 64, scr, lane); continue; }
        r -= IT_W2;
        { const int l = r / 32, q = r % 32, kb = q / 8, nb = q % 8;
            transpose_item(p.in[I_GLUW + oz] + (size_t)l * 65536, 256, nb * 32, 32, (bf16*)(ws + WS_GLU) + ((size_t)l * 256 + nb * 32) * 256, 256, kb * 64, scr, lane); }
    }
    if (gw == 0) { float* lb = (float*)(ws + WS_LB); for (int j = lane; j < 384; j += 64) { const float a = p.in[I_LBL + oz][j], b = p.in[I_LBL + oz][384 + j], m = fmaxf(a, b), ea = __expf(a - m), eb = __expf(b - m); lb[j] = 0.f; lb[384 + j] = eb / (ea + eb); } }
}
__device__ __forceinline__ void prologue_mod_item(const Params& p, int oz, int item, LAS float* lds, int tid, int lane, int wave) {
    LAS float* cact = lds; LAS float* part = lds + 8192;
    const int l = item / 96, nb = item % 96, n = nb * 64 + lane; const float* W = p.in[I_ADAW + oz] + ((size_t)l * 1024 + wave * 128) * 6144 + n;
    float acc[8];
#pragma unroll
    for (int b = 0; b < 8; ++b) acc[b] = 0.f;
    for (int k0 = 0; k0 < 128; k0 += 16) { float w[16];
#pragma unroll
        for (int u = 0; u < 16; ++u) w[u] = W[(size_t)(k0 + u) * 6144];
#pragma unroll
        for (int u = 0; u < 16; ++u)
#pragma unroll
            for (int b = 0; b < 8; ++b) acc[b] += cact[b * 1024 + wave * 128 + k0 + u] * w[u]; }
#pragma unroll
    for (int b = 0; b < 8; ++b) part[(wave * 8 + b) * 64 + lane] = acc[b];
    __syncthreads();
    { const int b = tid >> 6; float s = 0.f;
#pragma unroll
        for (int w = 0; w < 8; ++w) s += part[(w * 8 + b) * 64 + lane];
        ((float*)(p.ws + oz + WS_MOD))[(l * 8 + b) * 6144 + n] = s + p.in[I_ADAB + oz][l * 6144 + n]; }
    __syncthreads();
}
__device__ __forceinline__ void prologue_s5_item(const Params& p, int oz, int l, int g, LAS float* lds, int tid) {
    LAS float* apr = lds;
    LAS float* api = lds + 17 * 64;
    LAS float* bbr = lds + 34 * 64;
    LAS float* bbi = bbr + 1024;
    LAS float* ccr = bbi + 1024;
    LAS float* cci = ccr + 1024;
    LAS float* Kt = cci + 1024;
    unsigned char* ws = p.ws + oz;
    if (tid < 64) { const int q = tid; const float dt = __expf(p.in[I_LOGDT + oz][l * 16 + g]); const float lr = p.in[I_ARE + oz][(l * 16 + g) * 64 + q], li = p.in[I_AIM + oz][(l * 16 + g) * 64 + q];
        for (int tau = 0; tau <= 16; ++tau) { const float er = expf(lr * dt * tau); float sn, cs; sincosf(li * dt * tau, &sn, &cs); apr[tau * 64 + q] = er * cs; api[tau * 64 + q] = er * sn; }
        const float ar = apr[64 + q], ai = api[64 + q]; const float nr = ar - 1.f, ni = ai, den = lr * lr + li * li; const float fr = (nr * lr + ni * li) / den, fi = (ni * lr - nr * li) / den;
        for (int c = 0; c < 16; ++c) { const float br = p.in[I_BRE + oz][((l * 16 + g) * 64 + q) * 16 + c], bi = p.in[I_BIM + oz][((l * 16 + g) * 64 + q) * 16 + c]; bbr[q * 16 + c] = fr * br - fi * bi; bbi[q * 16 + c] = fr * bi + fi * br;
            ccr[c * 64 + q] = p.in[I_CRE + oz][((l * 16 + g) * 16 + c) * 64 + q]; cci[c * 64 + q] = p.in[I_CIM + oz][((l * 16 + g) * 16 + c) * 64 + q]; }
        float* al = (float*)(ws + WS_S5AL) + ((l * 16 + g) * 64 + q) * 2; al[0] = apr[16 * 64 + q]; al[1] = api[16 * 64 + q];
    }
    __syncthreads();
    for (int idx = tid; idx < 4096; idx += NTHR) { const int tau = idx >> 8, c = (idx >> 4) & 15, c2 = idx & 15; float acc = 0.f;
        for (int q = 0; q < 64; ++q) { const float mr = ccr[c * 64 + q] * apr[tau * 64 + q] - cci[c * 64 + q] * api[tau * 64 + q], mi = ccr[c * 64 + q] * api[tau * 64 + q] + cci[c * 64 + q] * apr[tau * 64 + q];
            acc += mr * bbr[q * 16 + c2] - mi * bbi[q * 16 + c2]; }
        if (tau == 0 && c == c2) acc += p.in[I_S5D + oz][(l * 16 + g) * 16 + c];
        Kt[idx] = acc; }
    __syncthreads();
    bf16* WO = (bf16*)(ws + WS_S5WO) + (size_t)(l * 16 + g) * 256 * 384; bf16* WL = (bf16*)(ws + WS_S5WL) + (size_t)(l * 16 + g) * 256 * 256;
    for (int ch = tid; ch < 256 * 48; ch += NTHR) { const int n = ch / 48, k0 = (ch % 48) * 8, j = n >> 4, c = n & 15; float v[8];
#pragma unroll
        for (int e = 0; e < 8; ++e) { const int k = k0 + e; float val;
            if (k < 256) { const int i = k >> 4, c2 = k & 15; val = (j >= i) ? Kt[((j - i) << 8) + (c << 4) + c2] : 0.f; }
            else { const int q = (k - 256) & 63; const float pr = apr[(j + 1) * 64 + q], pi = api[(j + 1) * 64 + q], cr = ccr[c * 64 + q], ci = cci[c * 64 + q];
                val = (k - 256 < 64) ? (cr * pr - ci * pi) : -(cr * pi + ci * pr); }
            v[e] = val; }
        v4u o; o.x = pk2(v[0], v[1]); o.y = pk2(v[2], v[3]); o.z = pk2(v[4], v[5]); o.w = pk2(v[6], v[7]);
        *(GAS v4u*)(WO + (size_t)n * 384 + k0) = o; }
    for (int ch = tid; ch < 256 * 32; ch += NTHR) { const int n = ch / 32, k0 = (ch % 32) * 8; float v[8];
#pragma unroll
        for (int e = 0; e < 8; ++e) { const int k = k0 + e, i = k >> 4, c2 = k & 15; float val = 0.f;
            if (n < 128) { const int q = n & 63; const float pr = apr[(15 - i) * 64 + q], pi = api[(15 - i) * 64 + q], br = bbr[q * 16 + c2], bi = bbi[q * 16 + c2]; val = (n < 64) ? (pr * br - pi * bi) : (pr * bi + pi * br); }
            v[e] = val; }
        v4u o; o.x = pk2(v[0], v[1]); o.y = pk2(v[2], v[3]); o.z = pk2(v[4], v[5]); o.w = pk2(v[6], v[7]);
        *(GAS v4u*)(WL + (size_t)n * 256 + k0) = o; }
    __syncthreads();
}
__device__ __forceinline__ void row_load(const float* X, int m, int lane, f32x4 (&v)[4]) { const GAS f32x4* xr = (const GAS f32x4*)(X + (size_t)m * 1024) + lane;
#pragma unroll
    for (int j = 0; j < 4; ++j) v[j] = xr[64 * j]; }
__device__ __forceinline__ void row_load_bf(const bf16* X, int m, int lane, f32x4 (&v)[4]) { const GAS v2u* xr = (const GAS v2u*)(X + (size_t)m * 1024) + lane;
#pragma unroll
    for (int j = 0; j < 4; ++j) { const v2u w = xr[64 * j]; v[j] = (f32x4){bflo(w.x), bfhi(w.x), bflo(w.y), bfhi(w.y)}; } }
__device__ __forceinline__ void adaln_factors(const float* w, const float* sh, const float* sc, int lane, f32x4 (&A)[4], f32x4 (&B)[4]) {
#pragma unroll
    for (int j = 0; j < 4; ++j) { const f32x4 ww = ((const GAS f32x4*)w)[lane + 64 * j], a = ((const GAS f32x4*)sc)[lane + 64 * j]; A[j] = ww * (a + 1.f); B[j] = ((const GAS f32x4*)sh)[lane + 64 * j]; } }
__device__ __forceinline__ void norm_row_to_bf16(f32x4 (&v)[4], const f32x4 (&A)[4], const f32x4 (&B)[4], bf16* orow, int lane) {
    float s = 0.f;
#pragma unroll
    for (int j = 0; j < 4; ++j) s += (v[j].x * v[j].x + v[j].y * v[j].y) + (v[j].z * v[j].z + v[j].w * v[j].w);
    const float rstd = __builtin_amdgcn_rsqf(wave_sum(s, lane) * (1.f / 1024.f) + 1e-6f);
    GAS unsigned long long* o8 = (GAS unsigned long long*)orow + lane;
#pragma unroll
    for (int j = 0; j < 4; ++j) { const f32x4 h = (v[j] * rstd) * A[j] + B[j]; v[j] = h;
        o8[64 * j] = (unsigned long long)pk2(h.x, h.y) | ((unsigned long long)pk2(h.z, h.w) << 32); }
}
}
namespace fx {
#define XB_TMO      128
#define XB_XCNT(j)  (256  + 64 * (j))
#define XB_XSUB(j)  (1280 + 64 * (j))
#define XB_XGEN(j)  (2304 + 64 * (j))
#define XB_TOP      3328
#define XB_TOPGEN   3392
#define XCD_BAR_WORDS 3456
#define XB_SPIN_CAP (1u << 18)

__device__ __forceinline__ unsigned xb_ld(unsigned* p)              { return __hip_atomic_load(p, __ATOMIC_RELAXED, __HIP_MEMORY_SCOPE_AGENT); }
__device__ __forceinline__ unsigned xb_add(unsigned* p, unsigned v) { return __hip_atomic_fetch_add(p, v, __ATOMIC_RELAXED, __HIP_MEMORY_SCOPE_AGENT); }
__device__ __forceinline__ unsigned xb_xcc_id() { return (unsigned)__builtin_amdgcn_s_getreg((3 << 11) | 20) & 0xFu; }
#define XB_SPIN(cond, bar) do { unsigned _sp = 0; while (cond) { __builtin_amdgcn_s_sleep(1); \
    if ((++_sp & 255u) == 0u) { if (xb_ld(&(bar)[XB_TMO])) break; if (_sp > XB_SPIN_CAP) { atomicAdd(&(bar)[XB_TMO], 1u); break; } } } } while (0)

struct XcdBarrier {
    unsigned* bar; unsigned x;
    volatile LAS unsigned* st;
};

__device__ __forceinline__ XcdBarrier xcd_barrier_post(unsigned* bar, volatile LAS unsigned* st, bool leader) {
    XcdBarrier b; b.bar = bar; b.x = xb_xcc_id(); b.st = st;
    if (leader) (void)xb_add(&bar[XB_XCNT(b.x)], 1u);
    return b;
}
__device__ __forceinline__ void xcd_barrier_complete(unsigned* bar, unsigned x, unsigned& nloc, unsigned& nx) {
    const unsigned G = gridDim.x * gridDim.y * gridDim.z;
    asm volatile("" : "+s"(x));
    unsigned sum, cnt, mine, sp = 0u;
    for (;;) {
        sum = 0u; cnt = 0u; mine = 0u;
#pragma unroll
        for (unsigned j = 0; j < 16; ++j) { const unsigned c = xb_ld(&bar[XB_XCNT(j)]); sum += c; cnt += (c > 0u) ? 1u : 0u; mine = (j == x) ? c : mine; }
        if (sum == G) break;
        __builtin_amdgcn_s_sleep(1);
        if ((++sp & 255u) == 0u) { if (xb_ld(&bar[XB_TMO])) break; if (sp > XB_SPIN_CAP) { atomicAdd(&bar[XB_TMO], 1u); break; } }
    }
    nloc = mine > 0u ? mine : 1u; nx = cnt > 0u ? cnt : 1u;
}

__device__ __forceinline__ void xcd_barrier(const XcdBarrier& b, bool leader) {
    asm volatile("s_waitcnt vmcnt(0)" ::: "memory");
    __syncthreads();
    if (leader) {
        unsigned* bar = b.bar;
        __builtin_amdgcn_s_waitcnt(0);
        unsigned nloc = b.st[0], nx = b.st[1];
        if (nloc == 0u) { xcd_barrier_complete(bar, b.x, nloc, nx); b.st[0] = nloc; b.st[1] = nx; }
        const unsigned old = xb_add(&bar[XB_XSUB(b.x)], 1u);
        const unsigned gen = old / nloc;
        if (old + 1u == (gen + 1u) * nloc) {
            __builtin_amdgcn_fence(__ATOMIC_RELEASE, "agent");
            asm volatile("s_waitcnt vmcnt(0)" ::: "memory");
            const unsigned og = xb_add(&bar[XB_TOP], 1u);
            const unsigned tg = og / nx;
            if (og + 1u == (tg + 1u) * nx) xb_add(&bar[XB_TOPGEN], 1u);
            else XB_SPIN(xb_ld(&bar[XB_TOPGEN]) == tg, bar);
            __builtin_amdgcn_fence(__ATOMIC_ACQUIRE, "agent");
            xb_add(&bar[XB_XGEN(b.x)], 1u);
            asm volatile("s_waitcnt vmcnt(0)" ::: "memory");
        } else {
            XB_SPIN(xb_ld(&bar[XB_XGEN(b.x)]) == gen, bar);
            __builtin_amdgcn_fence(__ATOMIC_ACQUIRE, "agent");
            asm volatile("s_waitcnt vmcnt(0)" ::: "memory");
        }
    }
    __syncthreads();
}

}
namespace pg8 {
#define PG8_LAS __attribute__((address_space(3)))
typedef unsigned short bf16_t;
typedef short bf16x8 __attribute__((ext_vector_type(8)));
typedef float f32x4 __attribute__((ext_vector_type(4)));
typedef unsigned u32x4 __attribute__((ext_vector_type(4)));
constexpr int BM = 256, BK = 64, HALF = 128, HTB = HALF * BK * 2  , STAGE_BYTES = 8 * HTB, NXCD = 8, WGM = 8;

__host__ __device__ __forceinline__ int lds_byte(int r, int c) { const int st = (r >> 4) * 2 + (c >> 5), rr = r & 15, cc = c & 31, ob = rr * 64 + cc * 2; return st * 1024 + (ob ^ (((ob >> 9) & 1) << 5)); }
__host__ __device__ __forceinline__ void stage_rc(int b, int& R, int& C) { const int st = b / 1024, sb = b % 1024, swz = sb ^ (((sb >> 9) & 1) << 5); R = (st >> 1) * 16 + swz / 64; C = (st & 1) * 32 + (swz % 64) / 2; }
__host__ __device__ __forceinline__ int perm32(int rho) { const int n = rho >> 4, i = rho & 15; return 8 * (i >> 2) + 4 * n + (i & 3); }

struct Unit { int pm, pn; int k0, k1; };
struct Gemm { const bf16_t* A; const bf16_t* Bt; int M, N, K, lda, ldb; const int* rowidx; };

struct StaticOrder {
    int nM, nN, nwg, G, c;
    __host__ __device__ void init(int M, int N, int G_, int c_) { nM = M / BM; nN = N / BM; nwg = nM * nN; G = G_; c = c_; }
    __host__ __device__ bool next(int i, Unit& u) const {
        const long L = (long)i * G + c; if (L >= nwg) return false;
        int wgid = (int)L; { const int q = nwg / NXCD, r = nwg % NXCD, xcd = wgid % NXCD, off = wgid / NXCD; wgid = (xcd < r ? xcd * (q + 1) : r * (q + 1) + (xcd - r) * q) + off; }
        const int nig = WGM * nN, gid = wgid / nig, fm = gid * WGM, gsz = (nM - fm) < WGM ? (nM - fm) : WGM;
        u.pm = fm + ((wgid % nig) % gsz); u.pn = (wgid % nig) / gsz; return true;
    }
    __device__ __forceinline__ void a_ready(const Unit&) const {}
    __device__ __forceinline__ void done(const Unit&) const {}
};

__device__ __forceinline__ unsigned cvt_pk_bf16(float lo, float hi) { unsigned r; asm volatile("v_cvt_pk_bf16_f32 %0, %1, %2" : "=v"(r) : "v"(lo), "v"(hi)); return r; }
typedef float f32x2 __attribute__((ext_vector_type(2)));
__device__ __forceinline__ f32x2 gelu_pk(f32x2 v) {
    const f32x2 av = __builtin_elementwise_abs(v), d = av * 0.2316418882f + 1.0f;
    f32x2 t; t.x = __builtin_amdgcn_rcpf(d.x); t.y = __builtin_amdgcn_rcpf(d.y);
    f32x2 q = t * 0.5307027145f + (-0.7265760135f); q = q * t + 0.7107068705f; q = q * t + (-0.142248368f); q = q * t + 0.127414796f; q = q * t;
    const f32x2 s = (v * v) * (-0.72134752044f);
    f32x2 e; e.x = __builtin_amdgcn_exp2f(s.x); e.y = __builtin_amdgcn_exp2f(s.y);
    const f32x2 m = v * (q * e), r = v - m;
    f32x2 o; o.x = v.x < 0.f ? m.x : r.x; o.y = v.y < 0.f ? m.y : r.y; return o;
}

template <int ACT  > struct EpiBf16 {
    static constexpr bool PERM = true, AFTER_DRAIN = false; static_assert(ACT == 0 || ACT == 1, "EpiBf16: ACT is 0 (none) or 1 (gelu_pk)");
    bf16_t* O; int ldc; const float* bias; int split_cols; size_t split_stride; float scale0;
    __device__ __forceinline__ void operator()(const f32x4 (&acc)[2][2][4][2], const Unit& u, int wr, int wc, int fr, int fq) const {
        const int row0 = u.pm * BM + wr * 64 + fr; int colt = u.pn * BM; bf16_t* base = O;
        float sc = 1.f; if (split_cols) { const int t = colt / split_cols; base += (size_t)t * split_stride; colt -= t * split_cols; if (t == 0) sc = scale0; }
        const int col0 = colt + wc * 32 + 8 * fq, bcol0 = u.pn * BM + wc * 32 + 8 * fq;
        f32x4 bv[2][2];
#pragma unroll
        for (int bj = 0; bj < 2; ++bj)
#pragma unroll
            for (int n = 0; n < 2; ++n) bv[bj][n] = bias ? *(const f32x4*)(bias + bcol0 + bj * HALF + 4 * n) : (f32x4){0.f, 0.f, 0.f, 0.f};
#pragma unroll
        for (int ai = 0; ai < 2; ++ai)
#pragma unroll
            for (int m = 0; m < 4; ++m) { bf16_t* rowp = base + (size_t)(row0 + ai * HALF + m * 16) * ldc + col0;
#pragma unroll
                for (int bj = 0; bj < 2; ++bj) { f32x4 v0 = acc[ai][bj][m][0] + bv[bj][0], v1 = acc[ai][bj][m][1] + bv[bj][1];
                    if (ACT == 1) { f32x2 a = gelu_pk((f32x2){v0[0], v0[1]}), b = gelu_pk((f32x2){v0[2], v0[3]}), c = gelu_pk((f32x2){v1[0], v1[1]}), d = gelu_pk((f32x2){v1[2], v1[3]});
                        v0 = (f32x4){a.x, a.y, b.x, b.y}; v1 = (f32x4){c.x, c.y, d.x, d.y}; }
                    v0 = v0 * sc; v1 = v1 * sc; u32x4 w; w.x = cvt_pk_bf16(v0[0], v0[1]); w.y = cvt_pk_bf16(v0[2], v0[3]); w.z = cvt_pk_bf16(v1[0], v1[1]); w.w = cvt_pk_bf16(v1[2], v1[3]);
                    *(u32x4*)(rowp + bj * HALF) = w; } }
    }
};

struct PanelStats {
    unsigned* xbuf;
    unsigned* cnt;
    unsigned* tmo;
    int ntn; float eps;
    unsigned code;
    __device__ __forceinline__ bool run(const f32x4 (&v)[2][2][4][2], const Unit& u, int wr, int wc, int fr, int fq, PG8_LAS unsigned char* lds, int wid, int lane) const {
        typedef float f32x2v __attribute__((ext_vector_type(2)));
        PG8_LAS f32x2v* P = (PG8_LAS f32x2v*)lds;
        PG8_LAS f32x2v* S = (PG8_LAS f32x2v*)(lds + 8192);
        PG8_LAS unsigned* flag = (PG8_LAS unsigned*)(lds + 8192 + 2048);
#pragma unroll
        for (int ai = 0; ai < 2; ++ai)
#pragma unroll
            for (int m = 0; m < 4; ++m) {
                float s = 0.f;
#pragma unroll
                for (int bj = 0; bj < 2; ++bj)
#pragma unroll
                    for (int n = 0; n < 2; ++n) { const f32x4 x = v[ai][bj][m][n]; s += (x[0] + x[1]) + (x[2] + x[3]); }
                s += __shfl_xor(s, 16); s += __shfl_xor(s, 32);
                const float mw = s * (1.0f / 64.0f); float q = 0.f;
#pragma unroll
                for (int bj = 0; bj < 2; ++bj)
#pragma unroll
                    for (int n = 0; n < 2; ++n) { const f32x4 d = v[ai][bj][m][n] - mw; q += (d[0] * d[0] + d[1] * d[1]) + (d[2] * d[2] + d[3] * d[3]); }
                q += __shfl_xor(q, 16); q += __shfl_xor(q, 32);
                if (fq == 0) P[(ai * HALF + wr * 64 + m * 16 + fr) * 4 + wc] = (f32x2v){mw, q};
            }
        asm volatile("s_waitcnt lgkmcnt(0)" ::: "memory"); __builtin_amdgcn_s_barrier(); asm volatile("" ::: "memory");
#if defined(BROKEN_EXCHANGE_NO_WAIT)
#warning BROKEN CONTROL BUILD: the row-statistics exchange does not wait; results are wrong by design
        if (blockIdx.x >= 64) { const long long t0_ = clock64(); while (clock64() - t0_ < 60000) __builtin_amdgcn_s_sleep(8); }
#endif
        const int row = wid * 32 + (lane & 31);
        if (lane < 32) {
            const f32x2v a = P[row * 4 + 0], b = P[row * 4 + 1], c = P[row * 4 + 2], d = P[row * 4 + 3];
            const float mt = (a.x + b.x + c.x + d.x) * 0.25f;
            const float da = a.x - mt, db = b.x - mt, dc = c.x - mt, dd = d.x - mt;
            const float m2 = (a.y + b.y) + (c.y + d.y) + 64.0f * ((da * da + db * db) + (dc * dc + dd * dd));
            unsigned long long* slot = (unsigned long long*)xbuf + ((size_t)(u.pm * BM + row) * 4 + u.pn);
            __hip_atomic_store(slot, ((unsigned long long)__float_as_uint(m2) << 32) | __float_as_uint(mt), __ATOMIC_RELAXED, __HIP_MEMORY_SCOPE_AGENT);
        }
        asm volatile("s_waitcnt vmcnt(0)" ::: "memory");
        if (lane == 0) __hip_atomic_fetch_add(cnt + 64 * u.pm, 1u, __ATOMIC_RELAXED, __HIP_MEMORY_SCOPE_AGENT);
        if (wid == 0) {
            bool dead = false; const unsigned long long t0 = __builtin_amdgcn_s_memrealtime(); const unsigned want = 8u * (unsigned)ntn;
            for (;;) {
#if defined(BROKEN_EXCHANGE_NO_WAIT)
                break;
#endif
                if ((unsigned)__builtin_amdgcn_readfirstlane(__hip_atomic_load(cnt + 64 * u.pm, __ATOMIC_RELAXED, __HIP_MEMORY_SCOPE_AGENT)) >= want) break;
                if (__builtin_amdgcn_s_memrealtime() - t0 > 2000000ull) {
                    if (lane == 0) { unsigned expect = 0u; __hip_atomic_compare_exchange_strong(tmo + 1, &expect, code | (unsigned)(u.pm & 0xff), __ATOMIC_RELAXED, __ATOMIC_RELAXED, __HIP_MEMORY_SCOPE_AGENT);
                                     __hip_atomic_store(tmo, 1u, __ATOMIC_RELAXED, __HIP_MEMORY_SCOPE_AGENT); }
                    dead = true; break; }
                __builtin_amdgcn_s_sleep(2);
            }
            __builtin_amdgcn_fence(__ATOMIC_ACQUIRE, "agent");
            if (lane == 0) flag[0] = dead ? 1u : 0u;
        }
        asm volatile("s_waitcnt vmcnt(0) lgkmcnt(0)" ::: "memory"); __builtin_amdgcn_s_barrier(); asm volatile("" ::: "memory");
        const bool bad = flag[0] != 0u;
        if (lane < 32) {
            const unsigned long long* slot = (const unsigned long long*)xbuf + (size_t)(u.pm * BM + row) * 4; float mt[4], m2[4]; float ms = 0.f;
#pragma unroll
            for (int t = 0; t < 4; ++t) { if (t < ntn) { const unsigned long long w = __hip_atomic_load(slot + t, __ATOMIC_RELAXED, __HIP_MEMORY_SCOPE_AGENT); mt[t] = __uint_as_float((unsigned)w); m2[t] = __uint_as_float((unsigned)(w >> 32)); } else { mt[t] = 0.f; m2[t] = 0.f; } ms += mt[t]; }
            const float mean = ms / (float)ntn; float q = 0.f;
#pragma unroll
            for (int t = 0; t < 4; ++t) if (t < ntn) { const float dm = mt[t] - mean; q += m2[t] + 256.0f * dm * dm; }
            S[row] = (f32x2v){mean, 1.0f / sqrtf(q / (256.0f * (float)ntn) + eps)};
        }
        asm volatile("s_waitcnt lgkmcnt(0)" ::: "memory"); __builtin_amdgcn_s_barrier(); asm volatile("" ::: "memory");
        return bad;
    }
};
struct EpiLnRes {
    static constexpr bool PERM = false, AFTER_DRAIN = true;
    const float* base; float* out; int ldc; const float* bias; PanelStats st; unsigned poison;
    __device__ __forceinline__ void fused(f32x4 (&acc)[2][2][4][2], const Unit& u, int wr, int wc, int fr, int fq, PG8_LAS unsigned char* lds, int wid, int lane) const {
        typedef float f32x2v __attribute__((ext_vector_type(2)));
        const PG8_LAS f32x2v* S = (const PG8_LAS f32x2v*)(lds + 8192);
        const int col0 = u.pn * BM + wc * 32 + 4 * fq;
#pragma unroll
        for (int bj = 0; bj < 2; ++bj)
#pragma unroll
            for (int n = 0; n < 2; ++n) { const f32x4 bv = bias ? *(const f32x4*)(bias + col0 + bj * HALF + n * 16) : (f32x4){0.f, 0.f, 0.f, 0.f};
#pragma unroll
                for (int ai = 0; ai < 2; ++ai)
#pragma unroll
                    for (int m = 0; m < 4; ++m) acc[ai][bj][m][n] += bv; }
        f32x4 pre[4][2][2];
#pragma unroll
        for (int m = 0; m < 4; ++m) { const size_t off = (size_t)(u.pm * BM + wr * 64 + m * 16 + fr) * ldc + col0;
#pragma unroll
            for (int bj = 0; bj < 2; ++bj)
#pragma unroll
                for (int n = 0; n < 2; ++n) pre[m][bj][n] = *(const f32x4*)(base + off + bj * HALF + n * 16); }
        const bool bad = st.run(acc, u, wr, wc, fr, fq, lds, wid, lane) || poison != 0u;
        const float qnan = __builtin_nanf("");
#pragma unroll
        for (int ai = 0; ai < 2; ++ai)
#pragma unroll
            for (int m = 0; m < 4; ++m) { const int r = ai * HALF + wr * 64 + m * 16 + fr; const f32x2v sr = S[r]; const size_t off = (size_t)(u.pm * BM + r) * ldc + col0;
#pragma unroll
                for (int bj = 0; bj < 2; ++bj)
#pragma unroll
                    for (int n = 0; n < 2; ++n) { const f32x4 bs = ai == 0 ? pre[m][bj][n] : *(const f32x4*)(base + off + bj * HALF + n * 16); f32x4 o = bs + (acc[ai][bj][m][n] - sr.x) * sr.y;
                        if (bad) o = (f32x4){qnan, qnan, qnan, qnan}; *(f32x4*)(out + off + bj * HALF + n * 16) = o; }
                if (m & 1) asm volatile("" ::: "memory"); }
    }
};
struct EpiLnResLn {
    static constexpr bool PERM = false, AFTER_DRAIN = true;
    const float* base; float* out; bf16_t* xn; int ldc; const float* bias; PanelStats st1, st2; unsigned poison;
    __device__ __forceinline__ void fused(f32x4 (&acc)[2][2][4][2], const Unit& u, int wr, int wc, int fr, int fq, PG8_LAS unsigned char* lds, int wid, int lane) const {
        typedef float f32x2v __attribute__((ext_vector_type(2))); typedef unsigned u32x2v __attribute__((ext_vector_type(2)));
        const PG8_LAS f32x2v* S = (const PG8_LAS f32x2v*)(lds + 8192);
        const int col0 = u.pn * BM + wc * 32 + 4 * fq;
#pragma unroll
        for (int bj = 0; bj < 2; ++bj)
#pragma unroll
            for (int n = 0; n < 2; ++n) { const f32x4 bv = bias ? *(const f32x4*)(bias + col0 + bj * HALF + n * 16) : (f32x4){0.f, 0.f, 0.f, 0.f};
#pragma unroll
                for (int ai = 0; ai < 2; ++ai)
#pragma unroll
                    for (int m = 0; m < 4; ++m) acc[ai][bj][m][n] += bv; }
        bool bad = st1.run(acc, u, wr, wc, fr, fq, lds, wid, lane) || poison != 0u;
        const float qnan = __builtin_nanf("");
#pragma unroll
        for (int ai = 0; ai < 2; ++ai)
#pragma unroll
            for (int m = 0; m < 4; ++m) { const int r = ai * HALF + wr * 64 + m * 16 + fr; const f32x2v sr = S[r]; const size_t off = (size_t)(u.pm * BM + r) * ldc + col0;
#pragma unroll
                for (int bj = 0; bj < 2; ++bj)
#pragma unroll
                    for (int n = 0; n < 2; ++n) { const f32x4 bs = *(const f32x4*)(base + off + bj * HALF + n * 16); acc[ai][bj][m][n] = bs + (acc[ai][bj][m][n] - sr.x) * sr.y; }
                asm volatile("" : "+v"(acc[ai][0][m][0]), "+v"(acc[ai][0][m][1]), "+v"(acc[ai][1][m][0]), "+v"(acc[ai][1][m][1]));
                if (m & 1) asm volatile("" ::: "memory"); }
        const bool bad1 = bad;
        bad = st2.run(acc, u, wr, wc, fr, fq, lds, wid, lane) || bad;
#pragma unroll
        for (int ai = 0; ai < 2; ++ai)
#pragma unroll
            for (int m = 0; m < 4; ++m) { const int r = ai * HALF + wr * 64 + m * 16 + fr; const f32x2v sr = S[r]; const size_t off = (size_t)(u.pm * BM + r) * ldc + col0;
#pragma unroll
                for (int bj = 0; bj < 2; ++bj)
#pragma unroll
                    for (int n = 0; n < 2; ++n) { const f32x4 x1 = acc[ai][bj][m][n]; *(f32x4*)(out + off + bj * HALF + n * 16) = bad1 ? (f32x4){qnan, qnan, qnan, qnan} : x1;
                        const f32x4 o = (x1 - sr.x) * sr.y; u32x2v w; w.x = cvt_pk_bf16(o[0], o[1]); w.y = cvt_pk_bf16(o[2], o[3]);
                        if (bad) { w.x = 0x7fc07fc0u; w.y = 0x7fc07fc0u; } *(u32x2v*)(xn + off + bj * HALF + n * 16) = w; }
                asm volatile("" ::: "memory"); }
    }
};

template <class Epi, class Sched, bool ALIGN_EPI = false, bool SP2 = false, bool KSPLIT = false, bool INDIRECT = false>
__device__ __forceinline__ void gemm_phase(PG8_LAS unsigned char* lds, const Gemm g, const Sched& S, const Epi& E, const int wave0) {
    int wv0_ = wave0; asm volatile("" : "+s"(wv0_));
    int z0_ = 0; asm volatile("" : "+v"(z0_)); const int tid_ = wv0_ * 64 + (int)__builtin_amdgcn_mbcnt_hi(~0u, __builtin_amdgcn_mbcnt_lo(~0u, (unsigned)z0_));
    const int tid = tid_, wid = __builtin_amdgcn_readfirstlane(tid >> 6), lane = tid & 63, wr = wid >> 2, wc = wid & 3, fr = lane & 15, fq = lane >> 4;
    const int K = g.K, nt = K / BK;
    unsigned voffA[2], voffB[2]; int rcA[2];
#pragma unroll
    for (int i = 0; i < 2; ++i) { int R, C; stage_rc(tid * 16 + i * 8192, R, C); const int Rb = Epi::PERM ? ((R & ~31) + perm32(R & 31)) : R;
        voffA[i] = (unsigned)(R * g.lda + C) * 2u; voffB[i] = (unsigned)(Rb * g.ldb + C) * 2u; rcA[i] = (R << 8) | C; }
    const unsigned kstep = (unsigned)(BK * 2);
    const unsigned hstepA = INDIRECT ? 0u : (unsigned)HALF * g.lda * 2, hstepB = (unsigned)HALF * g.ldb * 2;
    const unsigned tstepA = 2 * hstepA, tstepB = 2 * hstepB;
    const char* const baseA = (const char*)g.A; const char* const baseB = (const char*)g.Bt;
    const unsigned ldsw = (unsigned)wid * 1024u;
    const int aoff = lds_byte(wr * 64 + fr, fq * 8), boff = lds_byte(wc * 32 + fr, fq * 8);
#define PG8_SA(b, h) (((b) * 2 + (h)) * HTB)
#define PG8_SB(b, h) ((4 + (b) * 2 + (h)) * HTB)
#define PG8_STAGE_X(bufoff, base, soff, voff) do { _Pragma("unroll") for (int _i = 0; _i < 2; ++_i) \
        __builtin_amdgcn_global_load_lds((const unsigned*)((base) + (unsigned)((soff) + (voff)[_i])), (PG8_LAS unsigned*)(lds + (bufoff) + ldsw + _i * 8192), 16, 0, 0); } while (0)
#define PG8_USWITCH do { if constexpr (INDIRECT) { if (last) { uA[0][0] = uN[0][0]; uA[0][1] = uN[0][1]; uA[1][0] = uN[1][0]; uA[1][1] = uN[1][1]; } } } while (0)
#define PG8_STAGE_A(bufoff, soff, h) do { if constexpr (INDIRECT) { PG8_STAGE_X(bufoff, baseA, soff, uA[h]); } else { PG8_STAGE_X(bufoff, baseA, soff, voffA); } } while (0)
#define PG8_LOADU(U, unit) do { _Pragma("unroll") for (int h_ = 0; h_ < 2; ++h_) _Pragma("unroll") for (int i_ = 0; i_ < 2; ++i_) { int t_ = ((const __attribute__((address_space(1))) int*)g.rowidx)[(unit).pm * 256 + h_ * 128 + (rcA[i_] >> 8)]; t_ = t_ < 0 ? 0 : t_; \
        U[h_][i_] = (unsigned)t_ * (unsigned)(g.lda * 2) + (unsigned)((rcA[i_] & 255) * 2); } } while (0)
#define PG8_LDA(dst, b, h) do { _Pragma("unroll") for (int m = 0; m < 4; ++m) _Pragma("unroll") for (int k = 0; k < 2; ++k) dst[m][k] = *(const PG8_LAS bf16x8*)(lds + PG8_SA(b, h) + aoff + m * 2048 + k * 1024); } while (0)
#define PG8_LDB(dst, b, h) do { _Pragma("unroll") for (int n = 0; n < 2; ++n) _Pragma("unroll") for (int k = 0; k < 2; ++k) dst[n][k] = *(const PG8_LAS bf16x8*)(lds + PG8_SB(b, h) + boff + n * 2048 + k * 1024); } while (0)
#define PG8_MMA(ai, bj, At, Bt) do { __builtin_amdgcn_s_setprio(1); _Pragma("unroll") for (int m = 0; m < 4; ++m) _Pragma("unroll") for (int n = 0; n < 2; ++n) _Pragma("unroll") for (int k = 0; k < 2; ++k) \
        acc[ai][bj][m][n] = __builtin_amdgcn_mfma_f32_16x16x32_bf16(Bt[n][k], At[m][k], acc[ai][bj][m][n], 0, 0, 0); __builtin_amdgcn_s_setprio(0); } while (0)
#define PG8_WAIT_V(n) asm volatile("s_waitcnt vmcnt(" #n ")" ::: "memory")
#define PG8_WAIT_L(n) asm volatile("s_waitcnt lgkmcnt(" #n ")" ::: "memory")
#define PG8_BAR __builtin_amdgcn_s_barrier()
#define PG8_SCHED __builtin_amdgcn_sched_barrier(0)
    Unit cur, nxt; int ui = 0;
    if (!S.next(0, cur)) return;
    f32x4 acc[2][2][4][2];
#pragma unroll
    for (int a = 0; a < 2; ++a)
#pragma unroll
        for (int b = 0; b < 2; ++b)
#pragma unroll
            for (int m = 0; m < 4; ++m)
#pragma unroll
                for (int n = 0; n < 2; ++n) acc[a][b][m][n] = (f32x4){0.f, 0.f, 0.f, 0.f};
    bf16x8 At[4][2], B0[2][2], B1[2][2];
    unsigned cA = (unsigned)cur.pm * tstepA; unsigned cB = (unsigned)cur.pn * tstepB + (KSPLIT ? (unsigned)cur.k0 * 2u : 0u);
    unsigned sB = KSPLIT ? (unsigned)cur.pn * tstepB + (unsigned)cur.k1 * 2u - (unsigned)(nt / 2) * kstep : cB;
    S.a_ready(cur);
    unsigned uA[2][2] = {}, uN[2][2] = {};
    if constexpr (INDIRECT) PG8_LOADU(uA, cur);
    if constexpr (SP2) {
        PG8_STAGE_X(PG8_SB(0, 0), baseB, cB, voffB); PG8_STAGE_X(PG8_SB(0, 1), baseB, cB + hstepB, voffB); PG8_STAGE_A(PG8_SA(0, 0), cA, 0); PG8_STAGE_A(PG8_SA(0, 1), cA + hstepA, 1);
        if (wr == 1) PG8_BAR;
        PG8_WAIT_V(2); PG8_BAR;
        PG8_STAGE_X(PG8_SB(1, 0), baseB, cB + kstep, voffB); PG8_STAGE_A(PG8_SA(1, 0), cA + kstep, 0); PG8_STAGE_X(PG8_SB(1, 1), baseB, cB + hstepB + kstep, voffB);
        PG8_WAIT_V(6); PG8_BAR;
    } else {
        PG8_STAGE_X(PG8_SB(0, 0), baseB, cB, voffB); PG8_STAGE_A(PG8_SA(0, 0), cA, 0); PG8_STAGE_X(PG8_SB(0, 1), baseB, cB + hstepB, voffB); PG8_STAGE_A(PG8_SA(0, 1), cA + hstepA, 1);
        if (wr == 1) PG8_BAR;
        PG8_WAIT_V(4); PG8_BAR;
        PG8_STAGE_X(PG8_SB(1, 0), baseB, cB + kstep, voffB); PG8_STAGE_A(PG8_SA(1, 0), cA + kstep, 0); PG8_STAGE_X(PG8_SB(1, 1), baseB, cB + hstepB + kstep, voffB);
        PG8_WAIT_V(6); PG8_BAR;
    }
    for (;;) {
        const bool has_next = S.next(ui + 1, nxt);
        const unsigned nA = has_next ? (unsigned)nxt.pm * tstepA : cA; const unsigned nB = has_next ? (unsigned)nxt.pn * tstepB + (KSPLIT ? (unsigned)nxt.k0 * 2u : 0u) : cB;
        const unsigned nsB = (KSPLIT && has_next) ? (unsigned)nxt.pn * tstepB + (unsigned)nxt.k1 * 2u - (unsigned)(nt / 2) * kstep : sB;
        for (int t = 0; t < nt; t += 2) {
            const bool last = (t == nt - 2);
            const unsigned a1 = cA + (unsigned)(t + 1) * kstep;
            const unsigned a2 = last ? nA : cA + (unsigned)(t + 2) * kstep; const unsigned b2 = last ? nB : ((KSPLIT && (t + 2) >= nt / 2) ? sB : cB) + (unsigned)(t + 2) * kstep;
            const unsigned a3 = a2 + kstep; const unsigned b3 = b2 + kstep;
            if (last && has_next) S.a_ready(nxt);
            if constexpr (INDIRECT) { if (last) { if (has_next) PG8_LOADU(uN, nxt); else { uN[0][0] = uA[0][0]; uN[0][1] = uA[0][1]; uN[1][0] = uA[1][0]; uN[1][1] = uA[1][1]; } } }
            if constexpr (SP2) {
            PG8_LDB(B0, 0, 0); PG8_LDB(B1, 0, 1); PG8_SCHED; PG8_LDA(At, 0, 0); PG8_STAGE_A(PG8_SA(1, 1), a1 + hstepA, 1); PG8_USWITCH;
            PG8_WAIT_V(8); PG8_WAIT_L(0); PG8_BAR; PG8_MMA(0, 0, At, B0); PG8_MMA(0, 1, At, B1); PG8_BAR; PG8_SCHED;
            PG8_LDA(At, 0, 1); PG8_STAGE_X(PG8_SB(0, 0), baseB, b2, voffB); PG8_STAGE_X(PG8_SB(0, 1), baseB, b2 + hstepB, voffB); PG8_STAGE_A(PG8_SA(0, 0), a2, 0);
            PG8_WAIT_V(8); PG8_WAIT_L(0); PG8_BAR; PG8_MMA(1, 0, At, B0); PG8_MMA(1, 1, At, B1); PG8_BAR; PG8_SCHED;
            PG8_LDB(B0, 1, 0); PG8_LDB(B1, 1, 1); PG8_SCHED; PG8_LDA(At, 1, 0); PG8_STAGE_A(PG8_SA(0, 1), a2 + hstepA, 1);
            PG8_WAIT_V(8); PG8_WAIT_L(0); PG8_BAR; PG8_MMA(0, 0, At, B0); PG8_MMA(0, 1, At, B1); PG8_BAR; PG8_SCHED;
            PG8_LDA(At, 1, 1); PG8_STAGE_X(PG8_SB(1, 0), baseB, b3, voffB); PG8_STAGE_X(PG8_SB(1, 1), baseB, b3 + hstepB, voffB); PG8_STAGE_A(PG8_SA(1, 0), a3, 0);
            PG8_WAIT_V(8); PG8_WAIT_L(0); PG8_BAR; PG8_MMA(1, 0, At, B0); PG8_MMA(1, 1, At, B1); PG8_BAR; PG8_SCHED;
            } else {
            PG8_LDB(B0, 0, 0); PG8_SCHED; PG8_LDA(At, 0, 0); PG8_STAGE_A(PG8_SA(1, 1), a1 + hstepA, 1); PG8_USWITCH;
            PG8_WAIT_L(8); PG8_BAR; PG8_WAIT_L(0); PG8_MMA(0, 0, At, B0); PG8_BAR; PG8_SCHED;
            PG8_LDB(B1, 0, 1); PG8_STAGE_X(PG8_SB(0, 0), baseB, b2, voffB);
            PG8_BAR; PG8_WAIT_L(0); PG8_MMA(0, 1, At, B1); PG8_BAR;
            PG8_LDA(At, 0, 1); PG8_STAGE_A(PG8_SA(0, 0), a2, 0);
            PG8_BAR; PG8_WAIT_L(0); PG8_MMA(1, 0, At, B0); PG8_BAR; PG8_SCHED;
            PG8_STAGE_X(PG8_SB(0, 1), baseB, b2 + hstepB, voffB);
            PG8_WAIT_V(6); PG8_BAR; PG8_MMA(1, 1, At, B1); PG8_BAR;
            PG8_LDB(B0, 1, 0); PG8_SCHED; PG8_LDA(At, 1, 0); PG8_STAGE_A(PG8_SA(0, 1), a2 + hstepA, 1);
            PG8_WAIT_L(8); PG8_BAR; PG8_WAIT_L(0); PG8_MMA(0, 0, At, B0); PG8_BAR; PG8_SCHED;
            PG8_LDB(B1, 1, 1); PG8_STAGE_X(PG8_SB(1, 0), baseB, b3, voffB);
            PG8_BAR; PG8_WAIT_L(0); PG8_MMA(0, 1, At, B1); PG8_BAR;
            PG8_LDA(At, 1, 1); PG8_STAGE_A(PG8_SA(1, 0), a3, 0);
            PG8_BAR; PG8_WAIT_L(0); PG8_MMA(1, 0, At, B0); PG8_BAR; PG8_SCHED;
            PG8_STAGE_X(PG8_SB(1, 1), baseB, b3 + hstepB, voffB);
            PG8_WAIT_V(6); PG8_BAR; PG8_MMA(1, 1, At, B1); PG8_BAR;
            }
        }
        if constexpr (ALIGN_EPI) { if (wr == 0) PG8_BAR; }
        if constexpr (!Epi::AFTER_DRAIN) { E(acc, cur, wr, wc, fr, fq); S.done(cur); }
        if (!has_next) break;
#pragma unroll
        for (int a = 0; a < 2; ++a)
#pragma unroll
            for (int b = 0; b < 2; ++b)
#pragma unroll
                for (int m = 0; m < 4; ++m)
#pragma unroll
                    for (int n = 0; n < 2; ++n) acc[a][b][m][n] = (f32x4){0.f, 0.f, 0.f, 0.f};
        cur = nxt; cA = nA; cB = nB; sB = nsB; ++ui;
        if constexpr (ALIGN_EPI) { if (wr == 1) PG8_BAR; }
    }
    PG8_WAIT_V(0);
    if constexpr (!ALIGN_EPI) { if (wr == 0) PG8_BAR; }
    PG8_BAR;
    if constexpr (Epi::AFTER_DRAIN) { E.fused(acc, cur, wr, wc, fr, fq, lds, wid, lane); S.done(cur); }
#undef PG8_SA
#undef PG8_SB
#undef PG8_STAGE_X
#undef PG8_STAGE_A
#undef PG8_LOADU
#undef PG8_USWITCH
#undef PG8_LDA
#undef PG8_LDB
#undef PG8_MMA
#undef PG8_WAIT_V
#undef PG8_WAIT_L
#undef PG8_BAR
#undef PG8_SCHED
}
}
namespace attn_body {
using bf16=__hip_bfloat16;
using bf16x8=__attribute__((ext_vector_type(8)))short;
using s16x4=__attribute__((ext_vector_type(4)))short;
using f32x16=__attribute__((ext_vector_type(16)))float;
using u32x4=__attribute__((ext_vector_type(4)))unsigned;
constexpr int BATCH=8,NHEAD=6,SEQ=4096,D=64,DM=3072;
constexpr int NW=8,QBLK=32,QB=QBLK*NW,KVBLK=64,NQB=SEQ/QB;
constexpr int ATTN_PITCH=DM, ATTN_UNIT_ROWS=QB;
__device__ __forceinline__ int crow(int r,int hi){return (r&3)+8*(r>>2)+4*hi;}
#define SBAR() __builtin_amdgcn_sched_barrier(0)
__device__ __forceinline__ void cmask(f32x16&p0,f32x16&p1,int jb,int qrel,int hi){
  const float NEG=-INFINITY; int kb=64*jb+4*hi;
  #pragma unroll
  for(int r=0;r<16;++r){int kv=kb+(r&3)+8*(r>>2); if(kv>qrel)p0[r]=NEG; if(kv+32>qrel)p1[r]=NEG;}
}

constexpr int NSLOT=3, SLOTB=8192;
constexpr int LDS_K=0, LDS_V=NSLOT*SLOTB, LDS_WS=2*NSLOT*SLOTB, LDS_OST=LDS_WS+NW*64*4, LDS_G=LDS_OST+NW*4096, LDS_BYTES=LDS_G+SEQ*4;
constexpr float C2=0.125f*1.4426950408889634f;
__device__ __forceinline__ void glds16(const void*gsrc,unsigned lds_dst){unsigned keep;
  asm volatile("s_mov_b32 %0, m0\n\ts_mov_b32 m0, %2\n\ts_nop 0\n\tglobal_load_lds_dwordx4 %1, off\n\ts_mov_b32 m0, %0":"=&s"(keep):"v"(gsrc),"s"(lds_dst):"memory");}
__device__ __forceinline__ float max3f(float a,float b,float c){float r;asm("v_max3_f32 %0, %1, %2, %3":"=v"(r):"v"(a),"v"(b),"v"(c));return r;}
__device__ __forceinline__ float max2f(float a,float b){float r;asm("v_max_f32_e32 %0, %1, %2":"=v"(r):"v"(a),"v"(b));return r;}
__device__ __forceinline__ float fadd_s(float a,float b){float r;asm("v_add_f32_e32 %0, %1, %2":"=v"(r):"v"(a),"v"(b));return r;}
__device__ __forceinline__ float fsub_s(float a,float b){float r;asm("v_sub_f32_e32 %0, %1, %2":"=v"(r):"v"(a),"v"(b));return r;}
typedef float f32x2_t __attribute__((ext_vector_type(2))); typedef __bf16 bf16x2_t __attribute__((ext_vector_type(2)));
__device__ __forceinline__ unsigned cvtpk_s(float lo,float hi){f32x2_t v={lo,hi};bf16x2_t b=__builtin_convertvector(v,bf16x2_t);return __builtin_bit_cast(unsigned,b);}
#define WAIT_BAR(N) asm volatile("s_waitcnt vmcnt(" #N ") lgkmcnt(0)\n\ts_barrier":::"memory")

__device__ __forceinline__ void qkt(f32x16&p0,f32x16&p1,const char*Kslot,const bf16x8*qr,const f32x16&negm,int r32,int hi){
  const char*kb=Kslot+hi*1024+r32*16;
  #pragma unroll
  for(int d0=0;d0<4;++d0){
    const bf16x8 b0=*reinterpret_cast<const bf16x8*>(kb+d0*2048);
    const bf16x8 b1=*reinterpret_cast<const bf16x8*>(kb+d0*2048+512);
    if(d0==0){p0=__builtin_amdgcn_mfma_f32_32x32x16_bf16(b0,qr[0],negm,0,0,0);p1=__builtin_amdgcn_mfma_f32_32x32x16_bf16(b1,qr[0],negm,0,0,0);}
    else{p0=__builtin_amdgcn_mfma_f32_32x32x16_bf16(b0,qr[d0],p0,0,0,0);p1=__builtin_amdgcn_mfma_f32_32x32x16_bf16(b1,qr[d0],p1,0,0,0);}}
}
typedef __attribute__((address_space(3))) const char* lds_cptr;
typedef short v4i16_t __attribute__((ext_vector_type(4)));
__device__ __forceinline__ void kload8(bf16x8*kf,lds_cptr kp){
  kf[0]=*(const __attribute__((address_space(3))) bf16x8*)(kp);      kf[1]=*(const __attribute__((address_space(3))) bf16x8*)(kp+512);
  kf[2]=*(const __attribute__((address_space(3))) bf16x8*)(kp+2048); kf[3]=*(const __attribute__((address_space(3))) bf16x8*)(kp+2560);
  kf[4]=*(const __attribute__((address_space(3))) bf16x8*)(kp+4096); kf[5]=*(const __attribute__((address_space(3))) bf16x8*)(kp+4608);
  kf[6]=*(const __attribute__((address_space(3))) bf16x8*)(kp+6144); kf[7]=*(const __attribute__((address_space(3))) bf16x8*)(kp+6656);
}
__device__ __forceinline__ void kload2(bf16x8*kf,lds_cptr kp,int j){ kf[2*j]=*(const __attribute__((address_space(3))) bf16x8*)(kp+j*2048); kf[2*j+1]=*(const __attribute__((address_space(3))) bf16x8*)(kp+j*2048+512); }
__device__ __forceinline__ s16x4 vtr(lds_cptr p){ return __builtin_bit_cast(s16x4,__builtin_amdgcn_ds_read_tr16_b64_v4i16((__attribute__((address_space(3))) v4i16_t*)p)); }
__device__ __forceinline__ float rowmax(const f32x16&p0,const f32x16&p1){
  float a=max3f(p0[0],p0[1],p1[0]),b=max3f(p0[2],p0[3],p1[1]);a=max3f(a,p1[2],p1[3]);
  #pragma unroll
  for(int r=4;r<16;r+=4){a=max3f(a,p0[r],p0[r+1]);b=max3f(b,p0[r+2],p0[r+3]);a=max3f(a,p1[r],p1[r+1]);b=max3f(b,p1[r+2],p1[r+3]);}
  const float m=max2f(a,b);
  auto rr=__builtin_amdgcn_permlane32_swap(__float_as_uint(m),__float_as_uint(m),false,false);
  return max2f(__uint_as_float(rr[0]),__uint_as_float(rr[1]));
}
__device__ __forceinline__ void pv(f32x16*o,int vb,bf16x8 pa0,bf16x8 pa1,bf16x8 pa2,bf16x8 pa3){
  #pragma unroll
  for(int d0=0;d0<2;++d0){s16x4 lo[4],hi[4];
    #pragma unroll
    for(int ks=0;ks<4;++ks){
      asm volatile("ds_read_b64_tr_b16 %0,%1 offset:%c2":"=&v"(lo[ks]):"v"(vb),"i"(d0*4096+ks*1024):"memory");
      asm volatile("ds_read_b64_tr_b16 %0,%1 offset:%c2":"=&v"(hi[ks]):"v"(vb),"i"(d0*4096+ks*1024+512):"memory");}
    asm volatile("s_waitcnt lgkmcnt(0)":::"memory");SBAR();
    #define PK(k) (bf16x8){lo[k][0],lo[k][1],lo[k][2],lo[k][3],hi[k][0],hi[k][1],hi[k][2],hi[k][3]}
    o[d0]=__builtin_amdgcn_mfma_f32_32x32x16_bf16(pa0,PK(0),o[d0],0,0,0);
    o[d0]=__builtin_amdgcn_mfma_f32_32x32x16_bf16(pa1,PK(1),o[d0],0,0,0);
    o[d0]=__builtin_amdgcn_mfma_f32_32x32x16_bf16(pa2,PK(2),o[d0],0,0,0);
    o[d0]=__builtin_amdgcn_mfma_f32_32x32x16_bf16(pa3,PK(3),o[d0],0,0,0);
    #undef PK
  }
}

#ifndef ATTN_STORE16
#define ATTN_STORE16(p,v) (*(u32x4*)(p)=(v))
#endif
template<int THRL> __device__ __forceinline__ void attn_unit(int b,int h,int qb,const bf16*Q,const bf16*__restrict__ K,const bf16*__restrict__ V,bf16*O,const float*Gbh,char*shm,const int wave0,const int ts,const bool do_store=true){
  int wv0_=wave0; asm volatile("":"+s"(wv0_)); int z0_=0; asm volatile("":"+v"(z0_)); const int tid=wv0_*64+(int)__builtin_amdgcn_mbcnt_hi(~0u,__builtin_amdgcn_mbcnt_lo(~0u,(unsigned)z0_)),lane=tid&63,r32=lane&31,hi=lane>>5; const int wid=__builtin_amdgcn_readfirstlane(tid>>6);
  const long rowbase=(long)b*SEQ; const int q0=qb*QB;
  const bf16*Qw=Q+(rowbase+q0+wid*QBLK)*DM+h*D;
  const bf16*Kh=K+(rowbase+(long)ts*KVBLK)*DM+h*D,*Vh=V+(rowbase+(long)ts*KVBLK)*DM+h*D;
  const int q0r=q0-ts*KVBLK; Gbh+=ts*KVBLK;
  const unsigned lds0=(unsigned)(uintptr_t)shm;
  float*wsf=(float*)(shm+LDS_WS)+wid*64;
  const bf16*ksrc=Kh+(long)lane*DM+wid*8;
  const bf16*vsrc=Vh+(long)(16*(wid&3)+(lane>>2))*DM+(wid>>2)*32+(lane&3)*8;
  const unsigned kdst=lds0+LDS_K+wid*1024, vdst=lds0+LDS_V+wid*1024;
  #define DMA_K(t,slot) glds16(ksrc+(long)(t)*KVBLK*DM,(unsigned)__builtin_amdgcn_readfirstlane(kdst+(slot)))
  #define DMA_V(t,slot) glds16(vsrc+(long)(t)*KVBLK*DM,(unsigned)__builtin_amdgcn_readfirstlane(vdst+(slot)))
  const int vb0=(int)(lds0+LDS_V)+((lane>>4)&1)*32+(lane&3)*8+(4*hi+((lane&15)>>2))*64;
  const char*Kbase=shm+LDS_K; bf16x8 kf[8];
  const lds_cptr shm3=(lds_cptr)shm; const lds_cptr kp0=shm3+LDS_K+hi*1024+r32*16; const lds_cptr vp0=shm3+LDS_V+((lane>>4)&1)*32+(lane&3)*8+(4*hi+((lane&15)>>2))*64;
  const int NT=(q0r+QB)/KVBLK;
  typedef float f32x4v __attribute__((ext_vector_type(4)));
  { float*gl=(float*)(shm+LDS_G); const int ng4=(q0r+QB)>>2; for(int i=tid;i<ng4;i+=NW*64){ *(f32x4v*)(gl+4*i)=*(const f32x4v*)(Gbh+4*i); } }
  DMA_K(0,0);DMA_V(0,0);DMA_K(1,SLOTB);
  bf16x8 qr[4];
  #pragma unroll
  for(int d0=0;d0<4;++d0)qr[d0]=*reinterpret_cast<const bf16x8*>(&Qw[(long)r32*DM+d0*16+hi*8]);
  float mhat=0.f,l_reg=0.f;f32x16 o[2];o[0]=f32x16{};o[1]=f32x16{};f32x16 negm=f32x16{};asm volatile("":"+v"(negm));
  const int qrel=wid*QBLK+r32;
  #define CMASK(P0,P1,t) do{int jb_=(t)-(NT-4); if(jb_>=0)cmask(P0,P1,jb_,qrel,hi);}while(0)
  #define KBIAS(P0,P1,t) do{ const float*gp_=(const float*)(shm+LDS_G)+64*(t)+4*hi; \
    _Pragma("unroll") for(int j_=0;j_<4;++j_){ { const f32x4v a_=*(const f32x4v*)(gp_+8*j_); P0[4*j_]+=a_.x; P0[4*j_+1]+=a_.y; P0[4*j_+2]+=a_.z; P0[4*j_+3]+=a_.w; } SBAR(); \
      { const f32x4v c_=*(const f32x4v*)(gp_+32+8*j_); P1[4*j_]+=c_.x; P1[4*j_+1]+=c_.y; P1[4*j_+2]+=c_.z; P1[4*j_+3]+=c_.w; } SBAR(); } }while(0)
  bool resc=false;
  #define START(P0,P1) do{ const float rm=rowmax(P0,P1); resc=false; \
    { const float dl=__builtin_fmaxf(rm,0.f); mhat=fadd_s(mhat,dl); \
      _Pragma("unroll") for(int r=0;r<16;++r){P0[r]=fsub_s(P0[r],dl);P1[r]=fsub_s(P1[r],dl);} \
      _Pragma("unroll") for(int r=0;r<16;++r)negm[r]=-mhat; asm volatile("":"+v"(negm)); } \
    _Pragma("unroll") for(int r=0;r<16;++r)P0[r]=__builtin_amdgcn_exp2f(P0[r]); }while(0)
  #define RESC() do{ if(resc){ asm volatile("s_waitcnt lgkmcnt(0)":::"memory"); \
      _Pragma("unroll") for(int d_=0;d_<2;++d_) _Pragma("unroll") for(int r=0;r<16;++r)o[d_][r]*=wsf[crow(r,hi)]; } }while(0)
  f32x16 pA0,pA1,pB0,pB1;
  int sl_prev=0,sl_cur=0,sl_next=SLOTB;
  #define ROT() do{sl_prev=sl_cur;sl_cur=sl_next;sl_next=(sl_next==(NSLOT-1)*SLOTB)?0:sl_next+SLOTB;}while(0)
  DMA_K(2,2*SLOTB);
  WAIT_BAR(3);
  { const float*gl=(const float*)(shm+LDS_G); mhat=gl[q0r+qrel]; _Pragma("unroll") for(int r=0;r<16;++r)negm[r]=-mhat; asm volatile("":"+v"(negm)); }
  qkt(pA0,pA1,Kbase,qr,negm,r32,hi);asm volatile("s_nop 15\n\ts_nop 7":"+v"(pA0),"+v"(pA1));KBIAS(pA0,pA1,0);CMASK(pA0,pA1,0);
  START(pA0,pA1);
  _Pragma("unroll") for(int r=0;r<16;++r)pA1[r]=__builtin_amdgcn_exp2f(pA1[r]);
  WAIT_BAR(0);
  DMA_K(3,0);DMA_V(1,SLOTB);
  ROT();
  kload8(kf,kp0+sl_cur);
  WAIT_BAR(2);
  s16x4 vlo[8],vhi[8]; u32x4 pw0,pw1,pw2,pw3;
  #define PKW(P,B) cvtpk_s(P[B],P[B+1])
  #define PAF(k) __builtin_bit_cast(bf16x8,pw##k)
  #define VFR(i) (bf16x8){vlo[i][0],vlo[i][1],vlo[i][2],vlo[i][3],vhi[i][0],vhi[i][1],vhi[i][2],vhi[i][3]}
  #define PIN(x) asm volatile("":"+v"(x))
  #define MX3(a,b,c) __builtin_fmaxf(__builtin_fmaxf((a),(b)),(c))
  #define GAPA(MF,A0,A1,A2,A3,W0,W1,PW) do{ MF; sacc+=A0; sacc+=A1; sacc+=A2; sacc+=A3; PIN(sacc); W0; W1; PIN(PW); SBAR(); }while(0)
  #define EX(v) __builtin_amdgcn_exp2f(v)
  #define GAPB(MF,X,B) do{ MF; X[B]=EX(X[B]); X[B+1]=EX(X[B+1]); X[B+2]=EX(X[B+2]); X[B+3]=EX(X[B+3]); PIN(X); SBAR(); }while(0)
  #define VRD(i) do{ vlo[i]=vtr(vp_+(((i)>>2)*4096+((i)&3)*1024)); vhi[i]=vtr(vp_+(((i)>>2)*4096+((i)&3)*1024+512)); }while(0)
  #define KRD(G,j) do{ if(G){ kload2(kf,kp0+sl_next,j); SBAR(); } }while(0)
  #define STEP(C0,C1,P0,P1,t,GK,GV,GL) do{ SBAR(); \
    const lds_cptr vp_=vp0+sl_prev; \
    VRD(0); SBAR(); float sacc=(P0[0]+P0[1]); \
    GAPA(C0=__builtin_amdgcn_mfma_f32_32x32x16_bf16(kf[0],qr[0],negm,0,0,0), P0[2],P0[3],P0[4],P0[5],     pw0[0]=PKW(P0,0), pw0[1]=PKW(P0,2), pw0); \
    VRD(4); SBAR(); GAPA(C1=__builtin_amdgcn_mfma_f32_32x32x16_bf16(kf[1],qr[0],negm,0,0,0), P0[6],P0[7],P0[8],P0[9],     pw0[2]=PKW(P0,4), pw0[3]=PKW(P0,6), pw0); \
    VRD(1); SBAR(); GAPA(C0=__builtin_amdgcn_mfma_f32_32x32x16_bf16(kf[2],qr[1],C0,0,0,0),   P0[10],P0[11],P0[12],P0[13], pw1[0]=PKW(P0,8), pw1[1]=PKW(P0,10), pw1); \
    VRD(5); SBAR(); GAPA(C1=__builtin_amdgcn_mfma_f32_32x32x16_bf16(kf[3],qr[1],C1,0,0,0),   P0[14],P0[15],P1[0],P1[1],   pw1[2]=PKW(P0,12),pw1[3]=PKW(P0,14), pw1); \
    VRD(2); SBAR(); GAPA(C0=__builtin_amdgcn_mfma_f32_32x32x16_bf16(kf[4],qr[2],C0,0,0,0),   P1[2],P1[3],P1[4],P1[5],     pw2[0]=PKW(P1,0), pw2[1]=PKW(P1,2), pw2); \
    VRD(6); SBAR(); GAPA(C1=__builtin_amdgcn_mfma_f32_32x32x16_bf16(kf[5],qr[2],C1,0,0,0),   P1[6],P1[7],P1[8],P1[9],     pw2[2]=PKW(P1,4), pw2[3]=PKW(P1,6), pw2); \
    VRD(3); SBAR(); GAPA(C0=__builtin_amdgcn_mfma_f32_32x32x16_bf16(kf[6],qr[3],C0,0,0,0),   P1[10],P1[11],P1[12],P1[13], pw3[0]=PKW(P1,8), pw3[1]=PKW(P1,10), pw3); \
    VRD(7); SBAR(); GAPA(C1=__builtin_amdgcn_mfma_f32_32x32x16_bf16(kf[7],qr[3],C1,0,0,0),   P1[14],P1[15],0.f,0.f,       pw3[2]=PKW(P1,12),pw3[3]=PKW(P1,14), pw3); \
    l_reg+=sacc; \
    if(GK){DMA_K((t)+3,sl_cur);} if(GV){DMA_V((t)+1,sl_next);} \
    KBIAS(C0,C1,t); CMASK(C0,C1,t); \
    { float a=MX3(C0[0],C0[1],C1[0]),b=MX3(C0[2],C0[3],C1[1]); a=MX3(a,C1[2],C1[3]); \
      _Pragma("unroll") for(int r=4;r<16;r+=4){a=MX3(a,C0[r],C0[r+1]);b=MX3(b,C0[r+2],C0[r+3]);a=MX3(a,C1[r],C1[r+1]);b=MX3(b,C1[r+2],C1[r+3]);} \
      float rm=__builtin_fmaxf(a,b); { auto rr=__builtin_amdgcn_permlane32_swap(__float_as_uint(rm),__float_as_uint(rm),false,false); rm=__builtin_fmaxf(__uint_as_float(rr[0]),__uint_as_float(rr[1])); } \
      resc=false; \
      if(__builtin_expect(__any(rm>(float)THRL),0)){ const float dl=__builtin_fmaxf(rm,0.f); mhat+=dl; \
        _Pragma("unroll") for(int r=0;r<16;++r){C0[r]-=dl;C1[r]-=dl;} \
        _Pragma("unroll") for(int r=0;r<16;++r)negm[r]=-mhat; asm volatile("":"+v"(negm)); \
        const float f=__builtin_amdgcn_exp2f(-dl); l_reg*=f; if(hi==0)wsf[r32]=f; resc=true; } } \
    SBAR(); \
    GAPB(o[0]=__builtin_amdgcn_mfma_f32_32x32x16_bf16(PAF(0),VFR(0),o[0],0,0,0), C0,0); \
    GAPB(o[1]=__builtin_amdgcn_mfma_f32_32x32x16_bf16(PAF(0),VFR(4),o[1],0,0,0), C0,4); \
    KRD(GL,0); GAPB(o[0]=__builtin_amdgcn_mfma_f32_32x32x16_bf16(PAF(1),VFR(1),o[0],0,0,0), C0,8); \
    KRD(GL,1); GAPB(o[1]=__builtin_amdgcn_mfma_f32_32x32x16_bf16(PAF(1),VFR(5),o[1],0,0,0), C0,12); \
    KRD(GL,2); GAPB(o[0]=__builtin_amdgcn_mfma_f32_32x32x16_bf16(PAF(2),VFR(2),o[0],0,0,0), C1,0); \
    KRD(GL,3); GAPB(o[1]=__builtin_amdgcn_mfma_f32_32x32x16_bf16(PAF(2),VFR(6),o[1],0,0,0), C1,4); \
    GAPB(o[0]=__builtin_amdgcn_mfma_f32_32x32x16_bf16(PAF(3),VFR(3),o[0],0,0,0), C1,8); \
    GAPB(o[1]=__builtin_amdgcn_mfma_f32_32x32x16_bf16(PAF(3),VFR(7),o[1],0,0,0), C1,12); \
    }while(0)
  int t=1;
  #undef CMASK
  #define CMASK(P0,P1,t) do{}while(0)
  for(;t+5<NT;t+=2){
    STEP(pB0,pB1,pA0,pA1,t,true,true,true);     WAIT_BAR(2); RESC(); ROT();
    STEP(pA0,pA1,pB0,pB1,t+1,true,true,true);   WAIT_BAR(2); RESC(); ROT();
  }
  #undef CMASK
  #define CMASK(P0,P1,t) do{int jb_=(t)-(NT-4); if(jb_>=0)cmask(P0,P1,jb_,qrel,hi);}while(0)
  #define ENDW(tt) do{ if((tt)+3<NT){WAIT_BAR(2);} else if((tt)+2<NT){WAIT_BAR(1);} else {WAIT_BAR(0);} }while(0)
  for(;t+1<NT;t+=2){
    STEP(pB0,pB1,pA0,pA1,t,(t+3<NT),(t+1<NT),(t+1<NT));       ENDW(t);   RESC(); ROT();
    STEP(pA0,pA1,pB0,pB1,t+1,(t+4<NT),(t+2<NT),(t+2<NT));     ENDW(t+1); RESC(); ROT();
  }
  STEP(pB0,pB1,pA0,pA1,NT-1,false,false,false); RESC();
  { float sacc=pB0[0]+pB0[1]; _Pragma("unroll") for(int r=2;r<16;++r)sacc+=pB0[r]; _Pragma("unroll") for(int r=0;r<16;++r)sacc+=pB1[r]; l_reg+=sacc;
    pw0=(u32x4){PKW(pB0,0),PKW(pB0,2),PKW(pB0,4),PKW(pB0,6)};pw1=(u32x4){PKW(pB0,8),PKW(pB0,10),PKW(pB0,12),PKW(pB0,14)};pw2=(u32x4){PKW(pB1,0),PKW(pB1,2),PKW(pB1,4),PKW(pB1,6)};pw3=(u32x4){PKW(pB1,8),PKW(pB1,10),PKW(pB1,12),PKW(pB1,14)};
    SBAR(); pv(o,vb0+sl_cur,PAF(0),PAF(1),PAF(2),PAF(3)); }
  #undef PKW
  #undef PAF
  #undef VFR
  #undef PIN
  #undef MX3
  #undef GAPA
  #undef GAPB
  #undef EX
  #undef VRD
  #undef KRD
  #undef STEP
  #undef ENDW
  {auto rr=__builtin_amdgcn_permlane32_swap(__float_as_uint(l_reg),__float_as_uint(l_reg),false,false);l_reg=__uint_as_float(rr[0])+__uint_as_float(rr[1]);}
  if(hi==0)wsf[32+r32]=l_reg;asm volatile("s_waitcnt lgkmcnt(0)":::"memory");
  float rli[16];
  #pragma unroll
  for(int r=0;r<16;++r)rli[r]=__builtin_amdgcn_rcpf(wsf[32+crow(r,hi)]);
  bf16*Ow=O+(rowbase+q0+wid*QBLK)*DM+h*D;
  { bf16*stg=(bf16*)(shm+LDS_OST)+wid*2048;
    #pragma unroll
    for(int r=0;r<16;++r){const int orow=crow(r,hi);
      #pragma unroll
      for(int d0=0;d0<2;++d0)stg[orow*64+d0*32+r32]=__float2bfloat16(o[d0][r]*rli[r]);}
    asm volatile("s_waitcnt lgkmcnt(0)":::"memory");
    #pragma unroll
    for(int i=0;i<4;++i){const int row=i*8+(lane>>3),ch=lane&7; const u32x4 v=*(const u32x4*)(stg+row*64+ch*8); if(do_store)ATTN_STORE16(Ow+(long)row*DM+ch*8,v);} }
  asm volatile("s_waitcnt lgkmcnt(0)\n\ts_barrier":::"memory");
  #undef DMA_K
  #undef DMA_V
  #undef CMASK
  #undef KBIAS
  #undef START
  #undef RESC
  #undef ROT
}
constexpr int ATTN_LDS_BYTES=LDS_BYTES;
struct AttnTensors { const bf16* Q; const bf16* K; const bf16* V; bf16* O; const float* G; };
struct AttnUnit { int bh; int qb; };
struct StaticOrder {
  int vcu;
  __device__ __forceinline__ explicit StaticOrder(int grid,int block):vcu((block%8)*(grid/8)+block/8){}
  __device__ __forceinline__ bool next(int i,AttnUnit&u)const{ if(i>=4)return false; const int s=vcu&7; u.bh=vcu>>3; u.qb=(i==0)?s:(i==1)?15-s:(i==2)?16+s:31-s; return true; }
  __device__ __forceinline__ void a_ready(const AttnUnit&)const{}
  __device__ __forceinline__ void done(const AttnUnit&)const{}
};
template<class Sched,int THRL=8> __device__ __forceinline__ void attn_phase(char*lds,const AttnTensors&T,const Sched&S){
  AttnUnit u;
  for(int i=0;S.next(i,u);++i){ S.a_ready(u); attn_unit<THRL>(u.bh/NHEAD,u.bh%NHEAD,u.qb,T.Q,T.K,T.V,T.O,T.G+(long)u.bh*SEQ,lds); S.done(u); }
}
#undef SBAR
#undef WAIT_BAR
}
namespace fx {
struct EpiZ {
    static constexpr bool PERM = true, AFTER_DRAIN = false;
    bf16* Z; bf16* UP; float* NLF; const float* fbias;
    __device__ __forceinline__ void operator()(const pg8::f32x4 (&acc)[2][2][4][2], const pg8::Unit& u, int wr, int wc, int fr_, int fq_) const {
        int z_ = 0; asm volatile("" : "+v"(z_)); const int ln_ = __builtin_amdgcn_mbcnt_hi(~0u, __builtin_amdgcn_mbcnt_lo(~0u, z_)); const int fr = ln_ & 15, fq = ln_ >> 4; (void)fr_; (void)fq_;
        const int row0 = u.pm * 256 + wr * 64 + fr, col0 = wc * 32 + 8 * fq;
#pragma unroll
        for (int bj = 0; bj < 2; ++bj) {
            const int hb = u.pn * 2 + bj;
            const float sc = (hb < 3) ? C2 : 1.f;
            bf16* base = Z + ((size_t)row0 * NZ + hb * 128 + col0); size_t stride = (size_t)16 * NZ;
            if (hb == 9 || hb == 10) { const int sidx = (hb - 9) * 128 + col0, g = sidx >> 4, ch0 = sidx & 15;
                base = UP + ((size_t)(g * 2048 + (row0 >> 4)) * 384 + (row0 & 15) * 16 + ch0); stride = 384; }
#pragma unroll
            for (int ai = 0; ai < 2; ++ai)
#pragma unroll
                for (int m = 0; m < 4; ++m) { const pg8::f32x4 v0 = acc[ai][bj][m][0] * sc, v1 = acc[ai][bj][m][1] * sc;
                    v4u w; w.x = pk2(v0[0], v0[1]); w.y = pk2(v0[2], v0[3]); w.z = pk2(v1[0], v1[1]); w.w = pk2(v1[2], v1[3]);
                    *(GAS v4u*)(base + (size_t)(ai * 8 + m) * stride) = w; }
        }
        if (u.pn == 11 && col0 == 0) {
#pragma unroll
            for (int ai = 0; ai < 2; ++ai)
#pragma unroll
                for (int m = 0; m < 4; ++m) { const int r = row0 + ai * 128 + m * 16, b = r >> 12, t = r & 4095; float* o = NLF + (size_t)(b * 6) * 4096 + t;
                    o[0 * 4096] = nlf1(acc[ai][1][m][0][0] + fbias[0]); o[1 * 4096] = nlf1(acc[ai][1][m][0][1] + fbias[1]); o[2 * 4096] = nlf1(acc[ai][1][m][0][2] + fbias[2]);
                    o[3 * 4096] = nlf1(acc[ai][1][m][0][3] + fbias[3]); o[4 * 4096] = nlf1(acc[ai][1][m][1][0] + fbias[4]); o[5 * 4096] = nlf1(acc[ai][1][m][1][1] + fbias[5]); }
        }
    }
    static __device__ __forceinline__ float nlf1(float x) { return -LOG2E * (fminf(x, 0.f) - __logf(1.f + __expf(-fabsf(x)))); }
};
template <bool XF32> struct EpiRes {
    static constexpr bool PERM = true, AFTER_DRAIN = false;
    const void* X; bf16* out; const float* gate;
    __device__ __forceinline__ void operator()(const pg8::f32x4 (&acc)[2][2][4][2], const pg8::Unit& u, int wr, int wc, int fr_, int fq_) const {
        int z_ = 0; asm volatile("" : "+v"(z_)); const int ln_ = __builtin_amdgcn_mbcnt_hi(~0u, __builtin_amdgcn_mbcnt_lo(~0u, z_)); const int fr = ln_ & 15, fq = ln_ >> 4; (void)fr_; (void)fq_;
        const int row0 = u.pm * 256 + wr * 64 + fr, col0 = u.pn * 256 + wc * 32 + 8 * fq;
        const float* gb = gate + (size_t)(row0 >> 12) * 6144;
#pragma unroll
        for (int bj = 0; bj < 2; ++bj) { const int c = col0 + bj * 128; const pg8::f32x4 g0 = *(const GAS pg8::f32x4*)(gb + c), g1 = *(const GAS pg8::f32x4*)(gb + c + 4);
#pragma unroll
            for (int hq = 0; hq < 2; ++hq) {
                pg8::f32x4 x0[4], x1[4];
#pragma unroll
                for (int m = 0; m < 4; ++m) { const size_t off = (size_t)(row0 + hq * 128 + m * 16) * 1024 + c;
                    if (XF32) { x0[m] = *(const GAS pg8::f32x4*)((const float*)X + off); x1[m] = *(const GAS pg8::f32x4*)((const float*)X + off + 4); }
                    else { const v4u w = *(const GAS v4u*)((const bf16*)X + off); x0[m] = (pg8::f32x4){bflo(w.x), bfhi(w.x), bflo(w.y), bfhi(w.y)}; x1[m] = (pg8::f32x4){bflo(w.z), bfhi(w.z), bflo(w.w), bfhi(w.w)}; } }
                asm volatile("" ::: "memory");
#pragma unroll
                for (int m = 0; m < 4; ++m) { const size_t off = (size_t)(row0 + hq * 128 + m * 16) * 1024 + c;
                    const pg8::f32x4 o0 = x0[m] + g0 * acc[hq][bj][m][0], o1 = x1[m] + g1 * acc[hq][bj][m][1];
                    v4u ow; ow.x = pk2(o0[0], o0[1]); ow.y = pk2(o0[2], o0[3]); ow.z = pk2(o1[0], o1[1]); ow.w = pk2(o1[2], o1[3]); *(GAS v4u*)(out + off) = ow; }
                asm volatile("" ::: "memory"); } }
    }
};
}
namespace fx {
constexpr int MOE_ROWS = 40960, MOE_TILES = MOE_ROWS / 256, NCLS = 24;
constexpr size_t WS_TOKINFO = WS_HLOC + 8 * MiB;
constexpr size_t WS_CNT = WS_TOKINFO + (size_t)M * 16;
constexpr size_t WS_ROWTOK = WS_CNT + 256 * 32 * 4;
constexpr size_t WS_ROWW = WS_ROWTOK + (size_t)MOE_ROWS * 4;
constexpr size_t WS_TILECLS = WS_ROWW + (size_t)MOE_ROWS * 8;
constexpr size_t WS_H2S = WS_Z;
constexpr size_t WS_HID = WS_Z + (size_t)MOE_ROWS * 1024 * 2;
static_assert(WS_TILECLS + (MOE_TILES + 1) * 4 <= WS_END, "moe scratch fits");
static_assert(WS_HID + (size_t)MOE_ROWS * 512 * 2 <= WS_UP, "H2S + HID fit in the Z region");

__device__ __forceinline__ void cls_experts(int cls, int& e_lo, int& e_hi) {
    const int g = cls / 6, pr = cls % 6; const int lo = (pr < 3) ? 0 : (pr < 5 ? 1 : 2); const int hi = (pr < 3) ? pr + 1 : (pr < 5 ? pr - 1 : 3);
    e_lo = g * 4 + lo; e_hi = g * 4 + hi;
}
__device__ __forceinline__ void moe_route(const Params& p, int oz, int l, LAS unsigned char* lds, int tid, int lane, int wave, int bx, int G) {
    unsigned char* ws = p.ws + oz; constexpr int WP = 1032;
    LAS unsigned short* Whi = (LAS unsigned short*)lds; LAS unsigned short* Wlo = (LAS unsigned short*)(lds + 33024); LAS float* rstds = (LAS float*)(lds + 66048); LAS float* SR = (LAS float*)(lds + 66560); LAS int* hist = (LAS int*)(lds + 66624);
    const int tpw = M / G, t0 = bx * tpw, b = t0 >> 12; const float* mod = (const float*)(ws + WS_MOD) + l * 8 * 6144 + b * 6144; const float* nw = p.in[I_NFW + oz] + l * 1024; const float* rw = p.in[I_RW + oz]; const float* rb = p.in[I_RB + oz];
    for (int k = tid; k < 1024; k += NTHR) { const float a = nw[k] * (1.f + mod[4096 + k]);
#pragma unroll
        for (int q = 0; q < 4; ++q) { const f32x4 w4 = ((const GAS f32x4*)rw)[k * 4 + q];
#pragma unroll
            for (int e = 0; e < 4; ++e) { const float v = a * w4[e]; const unsigned hi = f2bf(v); const float r = v - __builtin_bit_cast(float, hi << 16); Whi[(4 * q + e) * WP + k] = (unsigned short)hi; Wlo[(4 * q + e) * WP + k] = (unsigned short)f2bf(r); } } }
    if (tid < 32) hist[tid] = 0;
    { float s0 = 0.f, s1 = 0.f;
        for (int k = lane; k < 1024; k += 64) { const float bv = mod[3072 + k]; s0 += bv * rw[k * 16 + 2 * wave]; s1 += bv * rw[k * 16 + 2 * wave + 1]; }
        s0 = wave_sum(s0, lane); s1 = wave_sum(s1, lane); if (lane == 0) { SR[2 * wave] = s0 + rb[2 * wave]; SR[2 * wave + 1] = s1 + rb[2 * wave + 1]; } }
    const bf16* X1 = (const bf16*)(ws + WS_XB); bf16* H = (bf16*)(ws + WS_H);
    f32x4 A[4], B[4]; adaln_factors(nw, mod + 3072, mod + 4096, lane, A, B);
    f32x4 v[4] = {}; if (wave < tpw) row_load_bf(X1, t0 + wave, lane, v);
    for (int r = wave; r < tpw; r += NWAVES) {
        const int row = t0 + r;
        f32x4 nxt[4] = {}; if (r + NWAVES < tpw) row_load_bf(X1, row + NWAVES, lane, nxt);
        float s = 0.f;
#pragma unroll
        for (int j = 0; j < 4; ++j) s += (v[j].x * v[j].x + v[j].y * v[j].y) + (v[j].z * v[j].z + v[j].w * v[j].w);
        const float rstd = __builtin_amdgcn_rsqf(wave_sum(s, lane) * (1.f / 1024.f) + 1e-6f); if (lane == 0) rstds[r] = rstd;
        GAS unsigned long long* o8 = (GAS unsigned long long*)(H + (size_t)row * 1024) + lane;
#pragma unroll
        for (int j = 0; j < 4; ++j) { const f32x4 h = (v[j] * rstd) * A[j] + B[j]; o8[64 * j] = (unsigned long long)pk2(h.x, h.y) | ((unsigned long long)pk2(h.z, h.w) << 32); }
#pragma unroll
        for (int j = 0; j < 4; ++j) v[j] = nxt[j];
    }
    __syncthreads();
    typedef short rbf16x8 __attribute__((ext_vector_type(8)));
    const int n = lane & 15, q = lane >> 4, tok = t0 + 16 * wave + n;
    f32x4 acc = {0.f, 0.f, 0.f, 0.f};
    const GAS rbf16x8* xrow = (const GAS rbf16x8*)(X1 + (size_t)tok * 1024 + 8 * q);
    const LAS unsigned short* ahi = Whi + n * WP + 8 * q; const LAS unsigned short* alo = Wlo + n * WP + 8 * q;
#pragma unroll 1
    for (int k0 = 0; k0 < 32; k0 += 8) { rbf16x8 xb[8];
#pragma unroll
        for (int u = 0; u < 8; ++u) xb[u] = xrow[(k0 + u) * 4];
#pragma unroll
        for (int u = 0; u < 8; ++u) { const rbf16x8 a1 = *(const LAS rbf16x8*)(ahi + (k0 + u) * 32), a2 = *(const LAS rbf16x8*)(alo + (k0 + u) * 32);
            acc = __builtin_amdgcn_mfma_f32_16x16x32_bf16(a1, xb[u], acc, 0, 0, 0); acc = __builtin_amdgcn_mfma_f32_16x16x32_bf16(a2, xb[u], acc, 0, 0, 0); } }
    const float rs = rstds[16 * wave + n]; float lg[4];
#pragma unroll
    for (int e = 0; e < 4; ++e) lg[e] = acc[e] * rs + SR[4 * q + e];
    float mx = fmaxf(fmaxf(lg[0], lg[1]), fmaxf(lg[2], lg[3])); mx = fmaxf(mx, lane_get(mx, lane ^ 16)); mx = fmaxf(mx, lane_get(mx, lane ^ 32));
    float sum = 0.f;
#pragma unroll
    for (int e = 0; e < 4; ++e) { lg[e] = __expf(lg[e] - mx); sum += lg[e]; }
    sum += lane_get(sum, lane ^ 16); sum += lane_get(sum, lane ^ 32); const float inv = 1.f / sum;
#pragma unroll
    for (int e = 0; e < 4; ++e) lg[e] *= inv;
    int i1 = 0; float v1 = lg[0];
#pragma unroll
    for (int i = 1; i < 4; ++i) if (lg[i] > v1) { v1 = lg[i]; i1 = i; }
    int i2 = -1; float v2 = -1.f;
#pragma unroll
    for (int i = 0; i < 4; ++i) if (i != i1 && lg[i] > v2) { v2 = lg[i]; i2 = i; }
    const float sc = v1 + v2;
    float bs = sc; int bq = q;
    { const float os = lane_get(bs, lane ^ 16); const int oq = __builtin_amdgcn_ds_bpermute((lane ^ 16) << 2, bq); if (os > bs || (os == bs && oq < bq)) { bs = os; bq = oq; } }
    { const float os = lane_get(bs, lane ^ 32); const int oq = __builtin_amdgcn_ds_bpermute((lane ^ 32) << 2, bq); if (os > bs || (os == bs && oq < bq)) { bs = os; bq = oq; } }
    if (bq == q) {
        const int lo = i1 < i2 ? i1 : i2, hi = i1 < i2 ? i2 : i1; const float w1 = v1 / (v1 + v2), w2 = v2 / (v1 + v2);
        const int cls = q * 6 + (lo * (7 - lo)) / 2 + (hi - lo - 1);
        const int rank = __hip_atomic_fetch_add(hist + cls, 1, __ATOMIC_RELAXED, __HIP_MEMORY_SCOPE_WORKGROUP);
        GAS f32x4* ti = (GAS f32x4*)(ws + WS_TOKINFO) + tok;
        *ti = (f32x4){__builtin_bit_cast(float, cls | (rank << 8)), i1 < i2 ? w1 : w2, i1 < i2 ? w2 : w1, 0.f};
    }
    __syncthreads();
    if (tid < 32) ((int*)(ws + WS_CNT))[bx * 32 + tid] = (tid < NCLS) ? hist[tid] : 0;
}
__device__ __forceinline__ void moe_gather(const Params& p, int oz, LAS unsigned char* lds, int tid, int lane, int wave, int bx, int G) {
    unsigned char* ws = p.ws + oz; LAS int* cl = (LAS int*)lds; LAS int* base = (LAS int*)(lds + 32768); LAS int* off = base + 32; LAS int* tot = off + 32;
    const int* cnt = (const int*)(ws + WS_CNT);
    for (int i = tid; i < G * 32; i += NTHR) cl[i] = cnt[i];
    __syncthreads();
    { LAS int* ps = tot + 32; const int c = tid & 31, part = tid >> 5; int s = 0, mine = 0; for (int w = part * (G / 16); w < (part + 1) * (G / 16); ++w) { if (w < bx) mine += cl[w * 32 + c]; s += cl[w * 32 + c]; } ps[part * 32 + c] = s; ps[512 + part * 32 + c] = mine; }
    __syncthreads();
    if (tid < NCLS) { LAS int* ps = tot + 32; int s = 0, mine = 0; for (int q = 0; q < 16; ++q) { s += ps[q * 32 + tid]; mine += ps[512 + q * 32 + tid]; } tot[tid] = s; off[tid] = mine; }
    __syncthreads();
    if (tid == 0) { int b = 0; for (int c = 0; c < NCLS; ++c) { base[c] = b; b += (tot[c] + 255) & ~255; } base[NCLS] = b; }
    __syncthreads();
    int* rowtok = (int*)(ws + WS_ROWTOK); float* roww = (float*)(ws + WS_ROWW);
    if (bx < NCLS) { const int c = bx, b0 = base[c], n = tot[c], b1 = base[c + 1];
        for (int r = b0 + n + tid; r < b1; r += NTHR) { rowtok[r] = -1; roww[2 * r] = (float)oz; roww[2 * r + 1] = (float)oz; }
        int* tc = (int*)(ws + WS_TILECLS); for (int t = b0 / 256 + tid; t < b1 / 256; t += NTHR) tc[t] = c;
        if (c == NCLS - 1 && tid == 0) tc[MOE_TILES] = b1 / 256; }
    const int tpw = M / G, t0 = bx * tpw;
    for (int r = tid; r < tpw; r += NTHR) { const int row = t0 + r; const f32x4 ti = ((const GAS f32x4*)(ws + WS_TOKINFO))[row]; const int cr = __builtin_bit_cast(int, ti.x), cls = cr & 255, rank = cr >> 8;
        const int pos = base[cls] + off[cls] + rank;
        rowtok[pos] = row; roww[2 * pos] = ti.y; roww[2 * pos + 1] = ti.z; }
}
struct ListOrder {
    const LAS int* list; int n;
    __device__ __forceinline__ bool next(int i, pg8::Unit& u) const { if (i >= n) return false; typedef int v4i_ __attribute__((ext_vector_type(4))); const v4i_ q = *(const LAS v4i_*)(list + 4 * i);
        u.pm = __builtin_amdgcn_readfirstlane(q.x); u.pn = __builtin_amdgcn_readfirstlane(q.y); u.k0 = __builtin_amdgcn_readfirstlane(q.z); u.k1 = __builtin_amdgcn_readfirstlane(q.w); return true; }
    __device__ __forceinline__ void a_ready(const pg8::Unit&) const {}
    __device__ __forceinline__ void done(const pg8::Unit&) const {}
};
template <bool DOWN>
__device__ __forceinline__ int moe_build_list(unsigned char* ws, LAS int* list, int tid, int bx, int G) {
    const int* tc = (const int*)(ws + WS_TILECLS);
    const int ntiles = __builtin_amdgcn_readfirstlane(((const GAS int*)tc)[MOE_TILES]); const int nunits = ntiles * 4; int n = 0;
    for (int L = bx; L < nunits; L += G) ++n;
    if (tid < n) { const int L = bx + tid * G, tile = L >> 2, j = L & 3; const int cls = ((const GAS int*)tc)[tile]; int e_lo, e_hi; cls_experts(cls, e_lo, e_hi);
        if (DOWN) { list[4 * tid] = tile; list[4 * tid + 1] = j; list[4 * tid + 2] = e_lo * 256; list[4 * tid + 3] = e_hi * 256; }
        else { list[4 * tid] = tile; list[4 * tid + 1] = (j < 2 ? e_lo : e_hi) * 2 + (j & 1); list[4 * tid + 2] = j; list[4 * tid + 3] = 0; } }
    __syncthreads();
    return n;
}
struct EpiHid {
    static constexpr bool PERM = true, AFTER_DRAIN = false;
    bf16* HID; const float* roww;
    __device__ __forceinline__ void operator()(const pg8::f32x4 (&acc)[2][2][4][2], const pg8::Unit& u, int wr, int wc, int fr_, int fq_) const {
        int z_ = 0; asm volatile("" : "+v"(z_)); const int ln_ = __builtin_amdgcn_mbcnt_hi(~0u, __builtin_amdgcn_mbcnt_lo(~0u, z_)); const int fr = ln_ & 15, fq = ln_ >> 4; (void)fr_; (void)fq_;
        const int row0 = u.pm * 256 + wr * 64 + fr, j = u.k0, col0 = j * 128 + wc * 32 + 8 * fq;
        float wq[8];
#pragma unroll
        for (int q = 0; q < 8; ++q) wq[q] = ((const GAS float*)roww)[2 * (row0 + (q >> 2) * 128 + (q & 3) * 16) + (j >> 1)];
        asm volatile("" ::: "memory");
#pragma unroll
        for (int ai = 0; ai < 2; ++ai)
#pragma unroll
            for (int m = 0; m < 4; ++m) { const int pos = row0 + ai * 128 + m * 16; const float w = wq[ai * 4 + m];
                float h[8];
#pragma unroll
                for (int n = 0; n < 2; ++n)
#pragma unroll
                    for (int e = 0; e < 4; ++e) { const float gt = acc[ai][0][m][n][e], up = acc[ai][1][m][n][e]; h[4 * n + e] = gt * fsigmoid(gt) * up * w; }
                v4u o; o.x = pk2(h[0], h[1]); o.y = pk2(h[2], h[3]); o.z = pk2(h[4], h[5]); o.w = pk2(h[6], h[7]);
                *(GAS v4u*)(HID + (size_t)pos * 512 + col0) = o; }
    }
};
struct EpiMoeOut {
    static constexpr bool PERM = true, AFTER_DRAIN = false;
    bf16* out; const float* gate; const int* rowtok;
    __device__ __forceinline__ void operator()(const pg8::f32x4 (&acc)[2][2][4][2], const pg8::Unit& u, int wr, int wc, int fr_, int fq_) const {
        int z_ = 0; asm volatile("" : "+v"(z_)); const int ln_ = __builtin_amdgcn_mbcnt_hi(~0u, __builtin_amdgcn_mbcnt_lo(~0u, z_)); const int fr = ln_ & 15, fq = ln_ >> 4; (void)fr_; (void)fq_;
        const int row0 = u.pm * 256 + wr * 64 + fr, col0 = u.pn * 256 + wc * 32 + 8 * fq;
        int tok[8];
#pragma unroll
        for (int q = 0; q < 8; ++q) tok[q] = ((const GAS int*)rowtok)[row0 + (q >> 2) * 128 + (q & 3) * 16];
#pragma unroll
        for (int hq = 0; hq < 2; ++hq)
#pragma unroll
            for (int bj = 0; bj < 2; ++bj) { const int c = col0 + bj * 128;
                v4u w[4] = {};
#pragma unroll
                for (int m = 0; m < 4; ++m) { const int tk = tok[hq * 4 + m]; if (tk >= 0) w[m] = *(const GAS v4u*)(out + (size_t)tk * 1024 + c); }
                asm volatile("" ::: "memory");
#pragma unroll
                for (int m = 0; m < 4; ++m) { const int tk = tok[hq * 4 + m];
                    if (tk >= 0) { const float* gb = gate + (size_t)(tk >> 12) * 6144 + c; const pg8::f32x4 g0 = *(const GAS pg8::f32x4*)gb, g1 = *(const GAS pg8::f32x4*)(gb + 4);
                        const pg8::f32x4 o0 = (pg8::f32x4){bflo(w[m].x), bfhi(w[m].x), bflo(w[m].y), bfhi(w[m].y)} + g0 * acc[hq][bj][m][0], o1 = (pg8::f32x4){bflo(w[m].z), bfhi(w[m].z), bflo(w[m].w), bfhi(w[m].w)} + g1 * acc[hq][bj][m][1];
                        v4u ow; ow.x = pk2(o0[0], o0[1]); ow.y = pk2(o0[2], o0[3]); ow.z = pk2(o1[0], o1[1]); ow.w = pk2(o1[2], o1[3]); *(GAS v4u*)(out + (size_t)tk * 1024 + c) = ow; } }
                asm volatile("" ::: "memory"); }
    }
};
}
namespace fx {
struct EpiS5Loc {
    static constexpr bool PERM = false, AFTER_DRAIN = false;
    float* LOC;
    __device__ __forceinline__ void operator()(const pg8::f32x4 (&acc)[2][2][4][2], const pg8::Unit& u, int wr, int wc, int fr_, int fq_) const {
        int z_ = 0; asm volatile("" : "+v"(z_)); const int ln_ = __builtin_amdgcn_mbcnt_hi(~0u, __builtin_amdgcn_mbcnt_lo(~0u, z_)); const int fr = ln_ & 15, fq = ln_ >> 4; (void)fr_; (void)fq_;
        const int row0 = u.pm * 256 + wr * 64 + fr, col0 = wc * 32 + 4 * fq;
#pragma unroll
        for (int n = 0; n < 2; ++n)
#pragma unroll
            for (int ai = 0; ai < 2; ++ai)
#pragma unroll
                for (int m = 0; m < 4; ++m) *(GAS pg8::f32x4*)(LOC + (size_t)(row0 + ai * 128 + m * 16) * 128 + col0 + n * 16) = acc[ai][0][m][n];
    }
};
__device__ __forceinline__ float gelu_tanh_f(float x) { const float u = 0.7978845608028654f * (x + 0.044715f * x * x * x); const float e = __builtin_amdgcn_exp2f(-2.f * LOG2E * u); return x * __builtin_amdgcn_rcpf(1.f + e); }
struct EpiS5Y {
    static constexpr bool PERM = true, AFTER_DRAIN = false;
    bf16* Y;
    __device__ __forceinline__ void operator()(const pg8::f32x4 (&acc)[2][2][4][2], const pg8::Unit& u, int wr, int wc, int fr_, int fq_) const {
        int z_ = 0; asm volatile("" : "+v"(z_)); const int ln_ = __builtin_amdgcn_mbcnt_hi(~0u, __builtin_amdgcn_mbcnt_lo(~0u, z_)); const int fr = ln_ & 15, fq = ln_ >> 4; (void)fr_; (void)fq_;
        const int g = u.pn, b = u.pm & 7, c0 = wr * 64 + fr;
#pragma unroll
        for (int bj = 0; bj < 2; ++bj) { const int n0 = bj * 128 + wc * 32 + 8 * fq, j = n0 >> 4, ch0 = n0 & 15;
#pragma unroll
            for (int ai = 0; ai < 2; ++ai)
#pragma unroll
                for (int m = 0; m < 4; ++m) { const int c = c0 + ai * 128 + m * 16; const pg8::f32x4 v0 = acc[ai][bj][m][0], v1 = acc[ai][bj][m][1];
                    v4u w; w.x = pk2(gelu_tanh_f(v0[0]), gelu_tanh_f(v0[1])); w.y = pk2(gelu_tanh_f(v0[2]), gelu_tanh_f(v0[3])); w.z = pk2(gelu_tanh_f(v1[0]), gelu_tanh_f(v1[1])); w.w = pk2(gelu_tanh_f(v1[2]), gelu_tanh_f(v1[3]));
                    *(GAS v4u*)(Y + ((size_t)(b * 4096 + c * 16 + j) * 256 + g * 16 + ch0)) = w; } }
    }
};
struct OneUnit { int pm, pn;
    __device__ __forceinline__ bool next(int i, pg8::Unit& u) const { if (i >= 1) return false; u.pm = pm; u.pn = pn; u.k0 = 0; u.k1 = 0; return true; }
    __device__ __forceinline__ void a_ready(const pg8::Unit&) const {}
    __device__ __forceinline__ void done(const pg8::Unit&) const {} };
__device__ __forceinline__ void s5_scan(unsigned char* ws, int l, int g, int b, int tid) {
    if (tid < 64) { const int q = tid; const float* al = (const float*)(ws + WS_S5AL) + ((l * 16 + g) * 64 + q) * 2; const float ar = al[0], ai = al[1];
        const float* loc = (const float*)(ws + WS_LOC) + (size_t)(g * 2048 + b * 256) * 128; bf16* up = (bf16*)(ws + WS_UP) + (size_t)(g * 2048 + b * 256) * 384 + 256;
        float sr = 0.f, si = 0.f;
        for (int c0 = 0; c0 < 256; c0 += 8) { float lr[8], li[8];
#pragma unroll
            for (int k = 0; k < 8; ++k) { lr[k] = loc[(size_t)(c0 + k) * 128 + q]; li[k] = loc[(size_t)(c0 + k) * 128 + 64 + q]; }
#pragma unroll
            for (int k = 0; k < 8; ++k) { up[(size_t)(c0 + k) * 384 + q] = (bf16)f2bf(sr); up[(size_t)(c0 + k) * 384 + 64 + q] = (bf16)f2bf(si);
                const float nr = ar * sr - ai * si + lr[k], ni = ar * si + ai * sr + li[k]; sr = nr; si = ni; } }
    }
    asm volatile("s_waitcnt vmcnt(0)" ::: "memory");
    __syncthreads();
}
struct EpiGlu {
    static constexpr bool PERM = false, AFTER_DRAIN = true;
    const bf16* Y; const float* gb; const float* bnw; bf16* MIX;
    __device__ __forceinline__ void fused(pg8::f32x4 (&acc)[2][2][4][2], const pg8::Unit& u, int wr, int wc, int fr_, int fq_, PG8_LAS unsigned char* lds, int wid, int lane_) const {
        int z_ = 0; asm volatile("" : "+v"(z_)); const int ln_ = __builtin_amdgcn_mbcnt_hi(~0u, __builtin_amdgcn_mbcnt_lo(~0u, z_)); const int fr = ln_ & 15, fq = ln_ >> 4; (void)fr_; (void)fq_; (void)wid; (void)lane_;
        PG8_LAS float* P = (PG8_LAS float*)lds;
        const int row0 = u.pm * 256 + wr * 64 + fr, col0 = wc * 32 + 4 * fq;
#pragma unroll
        for (int ai = 0; ai < 2; ++ai)
#pragma unroll
            for (int m = 0; m < 4; ++m) { const int r = row0 + ai * 128 + m * 16; float s = 0.f;
#pragma unroll
                for (int bj = 0; bj < 2; ++bj)
#pragma unroll
                    for (int n = 0; n < 2; ++n) { const int c = col0 + bj * 128 + n * 16; const pg8::f32x4 bv = *(const GAS pg8::f32x4*)(gb + c); const v2u yw = *(const GAS v2u*)(Y + (size_t)r * 256 + c);
                        pg8::f32x4 a = acc[ai][bj][m][n] + bv; const float y0 = bflo(yw.x), y1 = bfhi(yw.x), y2 = bflo(yw.y), y3 = bfhi(yw.y);
                        a[0] = y0 * fsigmoid(a[0]); a[1] = y1 * fsigmoid(a[1]); a[2] = y2 * fsigmoid(a[2]); a[3] = y3 * fsigmoid(a[3]); acc[ai][bj][m][n] = a;
                        s += (a[0] * a[0] + a[1] * a[1]) + (a[2] * a[2] + a[3] * a[3]); }
                s += lane_get(s, ln_ ^ 16); s += lane_get(s, ln_ ^ 32);
                if (fq == 0) P[(wr * 64 + ai * 128 + m * 16 + fr) * 4 + wc] = s; }
        asm volatile("s_waitcnt lgkmcnt(0)" ::: "memory"); __builtin_amdgcn_s_barrier(); asm volatile("" ::: "memory");
        pg8::f32x4 wv4[4];
#pragma unroll
        for (int bn = 0; bn < 4; ++bn) wv4[bn] = *(const GAS pg8::f32x4*)(bnw + col0 + (bn >> 1) * 128 + (bn & 1) * 16);
        asm volatile("" ::: "memory");
#pragma unroll
        for (int ai = 0; ai < 2; ++ai)
#pragma unroll
            for (int m = 0; m < 4; ++m) { const int rl = wr * 64 + ai * 128 + m * 16 + fr, r = u.pm * 256 + rl; const PG8_LAS pg8::f32x4* pp = (const PG8_LAS pg8::f32x4*)(P + rl * 4); const pg8::f32x4 ps = *pp;
                const float rstd = __builtin_amdgcn_rsqf(((ps[0] + ps[1]) + (ps[2] + ps[3])) * (1.f / 256.f) + 1e-6f);
#pragma unroll
                for (int bj = 0; bj < 2; ++bj)
#pragma unroll
                    for (int n = 0; n < 2; ++n) { const int c = col0 + bj * 128 + n * 16; const pg8::f32x4 o = acc[ai][bj][m][n] * rstd * wv4[bj * 2 + n];
                        v2u w; w.x = pk2(o[0], o[1]); w.y = pk2(o[2], o[3]); *(GAS v2u*)(MIX + (size_t)r * 1024 + 384 + c) = w; } }
    }
};
}
namespace fx {
constexpr int HG_NSEG = 8, HG_SEGTOK = SEQ / HG_NSEG, HG_CT = 32, HG_NCH = HG_SEGTOK / HG_CT;
constexpr size_t WS_HD = WS_HLOC + 7 * MiB;
typedef short hbf16x8 __attribute__((ext_vector_type(8)));
typedef float hf32x16 __attribute__((ext_vector_type(16)));
constexpr int HL_QT = 0, HL_KT = 4608, HL_KH = 9216, HL_VT = 14336, HL_PP = 19456, HL_ST = 22016, HL_DD = 31232, HL_TOT = 31488, HL_OO = 32512, HL_END = 41216;
constexpr int HP_QK = 72, HP_T = 40, HP_OO = 68;
__device__ __forceinline__ int hcrow(int r, int hi) { return (r & 3) + 8 * (r >> 2) + 4 * hi; }

template <bool FULL>
__device__ __forceinline__ void hgrn_pair(unsigned char* ws, const float* nw_l, int l, int u0, LAS unsigned char* lds_wg, const int wave00) {
    int wave0 = wave00; asm volatile("" : "+s"(wave0));
    const int lane = lane_now(), r32 = lane & 31, hi = lane >> 5, half = wave0 >> 2, hw = wave0 & 3, htid = hw * 64 + lane;
    constexpr int NS = FULL ? HG_NSEG : HG_NSEG - 1;
    const int unit = u0 + half, bh = unit / NS, seg = unit % NS, b = bh / 6, h = bh % 6; const int d = lane, sg = hw;
    LAS unsigned char* lds = lds_wg + half * HL_END;
    const bf16* Zb = (const bf16*)(ws + WS_Z) + (size_t)(b * SEQ + seg * HG_SEGTOK) * NZ + h * 64;
    const float lbv = ((const float*)(ws + WS_LB))[l * 384 + h * 64 + d], oml = 1.f - lbv;
    LAS unsigned short* QT = (LAS unsigned short*)(lds + HL_QT); LAS unsigned short* KT = (LAS unsigned short*)(lds + HL_KT);
    LAS unsigned short* KH = (LAS unsigned short*)(lds + HL_KH); LAS unsigned short* VT = (LAS unsigned short*)(lds + HL_VT);
    LAS unsigned short* PP = (LAS unsigned short*)(lds + HL_PP); LAS unsigned short* ST = (LAS unsigned short*)(lds + HL_ST);
    LAS float* DD = (LAS float*)(lds + HL_DD); LAS float* TOT = (LAS float*)(lds + HL_TOT); LAS float* OO = (LAS float*)(lds + HL_OO);
    const int dt = hw >> 1, vt = hw & 1;
    hf32x16 S;
#pragma unroll
    for (int r = 0; r < 16; ++r) S[r] = 0.f;
    if (FULL) {
        for (int j = 0; j < seg; ++j) { const float* loc = (const float*)(ws + WS_HLOC) + (size_t)(bh * HG_NSEG + j) * 4096; const float* hd = (const float*)(ws + WS_HD) + (bh * HG_NSEG + j) * 64;
#pragma unroll
            for (int r = 0; r < 16; ++r) { const int dd = 32 * dt + hcrow(r, hi); S[r] = S[r] * hd[dd] + loc[dd * 64 + 32 * vt + r32]; } }
#pragma unroll
        for (int j = 0; j < 4; ++j) { v2u w; w.x = pk2(S[4 * j], S[4 * j + 1]); w.y = pk2(S[4 * j + 2], S[4 * j + 3]); *(LAS v2u*)(ST + (32 * vt + r32) * HP_QK + 32 * dt + 8 * j + 4 * hi) = w; }
    }
    float lsum = 0.f;
    unsigned short rf[8] = {}, rv[8] = {}, rq[8] = {}; v4u rg = {};
    { const bf16* zr = Zb + (size_t)(8 * sg) * NZ;
#pragma unroll
        for (int i = 0; i < 8; ++i) { rf[i] = zr[(size_t)i * NZ + ZC_HF + d]; rv[i] = zr[(size_t)i * NZ + ZC_HI + d]; if (FULL) rq[i] = zr[(size_t)i * NZ + ZC_HQ + d]; }
        if (FULL) rg = *(const GAS v4u*)(Zb + (size_t)(htid >> 3) * NZ + ZC_HG + 8 * (htid & 7)); }
    for (int ch = 0; ch < HG_NCH; ++ch) {
        float lf[8], kk[8], qq[8], vv[8];
#pragma unroll
        for (int i = 0; i < 8; ++i) { const float z = bf2f(rf[i]); const float s1 = fsigmoid(z); lf[i] = __logf(lbv + oml * s1); kk[i] = oml * (1.f - s1);
            vv[i] = bf2f(rv[i]); if (FULL) qq[i] = fsilu(bf2f(rq[i])); }
        const v4u gw_ = rg;
        if (ch + 1 < HG_NCH) { const bf16* zr = Zb + (size_t)((ch + 1) * HG_CT + 8 * sg) * NZ;
#pragma unroll
            for (int i = 0; i < 8; ++i) { rf[i] = zr[(size_t)i * NZ + ZC_HF + d]; rv[i] = zr[(size_t)i * NZ + ZC_HI + d]; if (FULL) rq[i] = zr[(size_t)i * NZ + ZC_HQ + d]; }
            if (FULL) rg = *(const GAS v4u*)(Zb + (size_t)((ch + 1) * HG_CT + (htid >> 3)) * NZ + ZC_HG + 8 * (htid & 7)); }
#pragma unroll
        for (int i = 1; i < 8; ++i) lf[i] += lf[i - 1];
        TOT[sg * 64 + d] = lf[7];
        __syncthreads();
        float base = 0.f, blast = 0.f;
#pragma unroll
        for (int s2 = 0; s2 < 4; ++s2) { const float tv = TOT[s2 * 64 + d]; blast += tv; if (s2 < sg) base += tv; }
        lsum += blast;
        { float kh[8];
#pragma unroll
            for (int i = 0; i < 8; ++i) { const float bi = base + lf[i]; kh[i] = kk[i] * __expf(blast - bi);
                if (FULL) { const int t = 8 * sg + i; QT[t * HP_QK + d] = (unsigned short)f2bf(qq[i] * __expf(bi)); KT[t * HP_QK + d] = (unsigned short)f2bf(kk[i] * __expf(-bi)); } }
            v4u w; w.x = pk2(kh[0], kh[1]); w.y = pk2(kh[2], kh[3]); w.z = pk2(kh[4], kh[5]); w.w = pk2(kh[6], kh[7]); *(LAS v4u*)(KH + d * HP_T + 8 * sg) = w;
            v4u wv; wv.x = pk2(vv[0], vv[1]); wv.y = pk2(vv[2], vv[3]); wv.z = pk2(vv[4], vv[5]); wv.w = pk2(vv[6], vv[7]); *(LAS v4u*)(VT + d * HP_T + 8 * sg) = wv;
            if (sg == 0) DD[d] = __expf(blast); }
        __syncthreads();
        if (FULL && hw == 0) { hf32x16 c;
#pragma unroll
            for (int r = 0; r < 16; ++r) c[r] = 0.f;
#pragma unroll
            for (int ks = 0; ks < 4; ++ks) { const hbf16x8 a = *(const LAS hbf16x8*)(QT + r32 * HP_QK + 16 * ks + 8 * hi), bb = *(const LAS hbf16x8*)(KT + r32 * HP_QK + 16 * ks + 8 * hi); c = __builtin_amdgcn_mfma_f32_32x32x16_bf16(a, bb, c, 0, 0, 0); }
#pragma unroll
            for (int r = 0; r < 16; ++r) { const int t = hcrow(r, hi); PP[t * HP_T + r32] = (unsigned short)f2bf(r32 <= t ? c[r] : 0.f); } }
        {
#pragma unroll
            for (int r = 0; r < 16; ++r) S[r] *= DD[32 * dt + hcrow(r, hi)];
#pragma unroll
            for (int ks = 0; ks < 2; ++ks) { const hbf16x8 a = *(const LAS hbf16x8*)(KH + (32 * dt + r32) * HP_T + 16 * ks + 8 * hi), bb = *(const LAS hbf16x8*)(VT + (32 * vt + r32) * HP_T + 16 * ks + 8 * hi); S = __builtin_amdgcn_mfma_f32_32x32x16_bf16(a, bb, S, 0, 0, 0); } }
        if (FULL) {
            __syncthreads();
            if (hw == 1 || hw == 2) { const int ov = hw - 1; hf32x16 c;
#pragma unroll
                for (int r = 0; r < 16; ++r) c[r] = 0.f;
#pragma unroll
                for (int ks = 0; ks < 2; ++ks) { const hbf16x8 a = *(const LAS hbf16x8*)(PP + r32 * HP_T + 16 * ks + 8 * hi), bb = *(const LAS hbf16x8*)(VT + (32 * ov + r32) * HP_T + 16 * ks + 8 * hi); c = __builtin_amdgcn_mfma_f32_32x32x16_bf16(a, bb, c, 0, 0, 0); }
#pragma unroll
                for (int ks = 0; ks < 4; ++ks) { const hbf16x8 a = *(const LAS hbf16x8*)(QT + r32 * HP_QK + 16 * ks + 8 * hi), bb = *(const LAS hbf16x8*)(ST + (32 * ov + r32) * HP_QK + 16 * ks + 8 * hi); c = __builtin_amdgcn_mfma_f32_32x32x16_bf16(a, bb, c, 0, 0, 0); }
#pragma unroll
                for (int r = 0; r < 16; ++r) OO[hcrow(r, hi) * HP_OO + 32 * ov + r32] = c[r]; }
            __syncthreads();
#pragma unroll
            for (int j = 0; j < 4; ++j) { v2u w; w.x = pk2(S[4 * j], S[4 * j + 1]); w.y = pk2(S[4 * j + 2], S[4 * j + 3]); *(LAS v2u*)(ST + (32 * vt + r32) * HP_QK + 32 * dt + 8 * j + 4 * hi) = w; }
            { const int t = htid >> 3, vg = htid & 7; const f32x4 o0 = *(const LAS f32x4*)(OO + t * HP_OO + 8 * vg), o1 = *(const LAS f32x4*)(OO + t * HP_OO + 8 * vg + 4);
                float s = ((o0.x * o0.x + o0.y * o0.y) + (o0.z * o0.z + o0.w * o0.w)) + ((o1.x * o1.x + o1.y * o1.y) + (o1.z * o1.z + o1.w * o1.w));
                s += lane_get(s, lane ^ 1); s += lane_get(s, lane ^ 2); s += lane_get(s, lane ^ 4);
                const float rstd = __builtin_amdgcn_rsqf(s * (1.f / 64.f) + 1e-6f); const size_t row = (size_t)(b * SEQ + seg * HG_SEGTOK + ch * HG_CT + t);
                const f32x4 w0 = *(const GAS f32x4*)(nw_l + 8 * vg), w1 = *(const GAS f32x4*)(nw_l + 8 * vg + 4);
                v4u w; w.x = pk2(o0.x * rstd * w0.x * fsilu(bflo(gw_.x)), o0.y * rstd * w0.y * fsilu(bfhi(gw_.x))); w.y = pk2(o0.z * rstd * w0.z * fsilu(bflo(gw_.y)), o0.w * rstd * w0.w * fsilu(bfhi(gw_.y)));
                w.z = pk2(o1.x * rstd * w1.x * fsilu(bflo(gw_.z)), o1.y * rstd * w1.y * fsilu(bfhi(gw_.z))); w.w = pk2(o1.z * rstd * w1.z * fsilu(bflo(gw_.w)), o1.w * rstd * w1.w * fsilu(bfhi(gw_.w)));
                *(GAS v4u*)((bf16*)(ws + WS_H) + row * 1024 + 640 + h * 64 + 8 * vg) = w; }
        }
    }
    if (!FULL) {
        { float* loc = (float*)(ws + WS_HLOC) + (size_t)(bh * HG_NSEG + seg) * 4096;
#pragma unroll
            for (int r = 0; r < 16; ++r) loc[(32 * dt + hcrow(r, hi)) * 64 + 32 * vt + r32] = S[r]; }
        if (sg == 0) ((float*)(ws + WS_HD))[(bh * HG_NSEG + seg) * 64 + d] = __expf(lsum);
    }
    __syncthreads();
}
}
namespace fx {
constexpr int LDS_BYTES = 147456;
constexpr int RING_BYTES = 131072, LDSCTL_OFF = RING_BYTES, MISC_OFF = LDSCTL_OFF + 320;
constexpr int PH_PRO = 0, PH_FINAL = 21, NPH = 22;

struct QueueOrder {
    unsigned* ctr; LAS unsigned* slot;
    __device__ __forceinline__ bool next(int, attn_body::AttnUnit& u) const {
        if (threadIdx.x == 0) *slot = __hip_atomic_fetch_add(ctr, 1u, __ATOMIC_RELAXED, __HIP_MEMORY_SCOPE_AGENT);
        __syncthreads(); const unsigned v = *slot; __syncthreads();
        if (v >= 768u) return false; u.bh = (int)(v >> 4); u.qb = 15 - (int)(v & 15u); return true; }
    __device__ __forceinline__ void a_ready(const attn_body::AttnUnit&) const {}
    __device__ __forceinline__ void done(const attn_body::AttnUnit&) const {}
};

__global__ void __launch_bounds__(NTHR, 2) mk_fwd(Params p) {
    extern __shared__ __attribute__((aligned(16))) unsigned char lds_raw[];
    LAS unsigned char* lds = (LAS unsigned char*)lds_raw;
    const int wave0 = __builtin_amdgcn_readfirstlane(threadIdx.x >> 6);
    for (int u = threadIdx.x; u < (LDS_BYTES - LDSCTL_OFF) / 4; u += NTHR) ((LAS unsigned*)(lds + LDSCTL_OFF))[u] = 0u;
    __syncthreads();
    const XcdBarrier bar = xcd_barrier_post((unsigned*)(p.ws + WS_CTL) + 8192 + p.li * 4096, (volatile LAS unsigned*)(lds + MISC_OFF) + 8, threadIdx.x == 0);
#ifdef EXTRA_BARS
    for (int eb = 0; eb < EXTRA_BARS; ++eb) xcd_barrier(bar, wave0 == 0 && lane_now() == 0);
#endif
    for (int ph = p.ph_lo; ph < p.ph_hi; ++ph) {
#ifdef DUP_MASK
      for (int rep = (((DUP_MASK) >> ph) & 1u) ? 0 : 1; rep < 2; ++rep) {
#else
      { const int rep = 1;
#endif
#ifdef PROBE_MASK
        if (blockIdx.x == 0 && wave0 == 0 && lane_now() == 0) __hip_atomic_store((unsigned long long*)(p.ws + WS_CTL + 512 * 1024) + ph, __builtin_amdgcn_s_memrealtime(), __ATOMIC_RELAXED, __HIP_MEMORY_SCOPE_AGENT);
#endif
        int oz = 0; asm volatile("" : "+s"(oz));
        const int G = gridDim.x, bx = blockIdx.x + oz;
#define PHASE_IDS int wv_ = wave0; asm volatile("" : "+s"(wv_)); const int lane = lane_now(), wave = wv_, tid = wv_ * 64 + lane; \
        const int vcu = (G % 8 == 0) ? (bx % 8) * (G / 8) + bx / 8 : bx; const int gw = vcu * NWAVES + wave, ngw = G * NWAVES; (void)tid; (void)lane; (void)gw; (void)ngw;
        unsigned char* ws = p.ws + oz;
#define PIN(i) (p.in[(i) + oz])
        const int l = (ph - 1) / 10, sub = (ph - 1) % 10;
#ifndef EXP_NO_PRO
        if (ph == PH_PRO) { PHASE_IDS
            { LAS float* cact = (LAS float*)lds; const float* c = PIN(I_C); for (int i = tid; i < 8192; i += NTHR) { const float cv = c[i]; cact[i] = cv * fsigmoid(cv); } __syncthreads();
              for (int it = bx; it < 192; it += G) prologue_mod_item(p, oz, it, (LAS float*)lds, tid, lane, wave); }
            __syncthreads();
            for (int it = (G >= 224 ? bx - 192 : bx); it >= 0 && it < 32; it += G) prologue_s5_item(p, oz, it / 16, it % 16, (LAS float*)lds, tid);
            __syncthreads();
            prologue_wave_items(p, oz, (LAS float*)(lds + wave * 16384), gw, ngw, lane);
        } else
#endif
        if (ph == PH_FINAL) { PHASE_IDS
            float* X = p.out + oz; const bf16* XBp = (const bf16*)(ws + WS_XB); const float* w = PIN(I_FINW);
#ifdef PROBE_MASK
            float pscale = 1.f; { unsigned long long* tsb = (unsigned long long*)(ws + WS_CTL + 512 * 1024); unsigned long long t0 = __hip_atomic_load(tsb, __ATOMIC_RELAXED, __HIP_MEMORY_SCOPE_AGENT), tl = __hip_atomic_load(tsb + PH_FINAL, __ATOMIC_RELAXED, __HIP_MEMORY_SCOPE_AGENT); unsigned long long acc = 0;
#pragma unroll 1
                for (int k = 0; k < PH_FINAL; ++k) if ((PROBE_MASK >> k) & 1u) acc += __hip_atomic_load(tsb + k + 1, __ATOMIC_RELAXED, __HIP_MEMORY_SCOPE_AGENT) - __hip_atomic_load(tsb + k, __ATOMIC_RELAXED, __HIP_MEMORY_SCOPE_AGENT);
                pscale = 1.f + (float)acc / (float)(tl - t0); }
#endif
            f32x4 W4[4];
#pragma unroll
            for (int j = 0; j < 4; ++j) W4[j] = ((const GAS f32x4*)w)[lane + 64 * j];
            f32x4 v[4] = {}; if (gw < M) row_load_bf(XBp, gw, lane, v);
            for (int m = gw; m < M; m += ngw) { GAS f32x4* xr = (GAS f32x4*)(X + (size_t)m * 1024) + lane; f32x4 nxt[4] = {}; const int mn = m + ngw; if (mn < M) row_load_bf(XBp, mn, lane, nxt); float s = 0.f;
#pragma unroll
                for (int j = 0; j < 4; ++j) s += (v[j].x * v[j].x + v[j].y * v[j].y) + (v[j].z * v[j].z + v[j].w * v[j].w);
                const float rstd = __builtin_amdgcn_rsqf(wave_sum(s, lane) * (1.f / 1024.f) + 1e-6f);
#pragma unroll
                for (int j = 0; j < 4; ++j) { f32x4 o = (v[j] * rstd) * W4[j];
#ifdef PROBE_MASK
                    o = o * pscale;
#endif
                    xr[64 * j] = o; }
#pragma unroll
                for (int j = 0; j < 4; ++j) v[j] = nxt[j]; }
        }
#ifndef EXP_NO_ROW
        else if (sub == 0) { PHASE_IDS
            const float* X = PIN(I_X); const float* mod = (const float*)(ws + WS_MOD) + l * 8 * 6144;
            const int tpw = M / G, t0 = bx * tpw, b = t0 >> 12; f32x4 A[4], B[4]; adaln_factors(PIN(I_NMW) + l * 1024, mod + b * 6144, mod + b * 6144 + 1024, lane, A, B);
            const bf16* XBp = (const bf16*)(ws + WS_XB);
            f32x4 cur[4] = {}; if (wave < tpw) { if (l == 0) row_load(X, t0 + wave, lane, cur); else row_load_bf(XBp, t0 + wave, lane, cur); }
            for (int r = wave; r < tpw; r += NWAVES) { f32x4 nxt[4] = {}; if (r + NWAVES < tpw) { if (l == 0) row_load(X, t0 + r + NWAVES, lane, nxt); else row_load_bf(XBp, t0 + r + NWAVES, lane, nxt); }
                norm_row_to_bf16(cur, A, B, (bf16*)(ws + WS_H) + (size_t)(t0 + r) * 1024, lane);
#pragma unroll
                for (int j = 0; j < 4; ++j) cur[j] = nxt[j]; }
        }
#endif
        else if (sub == 1) {
            pg8::Gemm g{(const pg8::bf16_t*)(ws + WS_H), (const pg8::bf16_t*)(ws + WS_WIN) + (size_t)l * 3072 * 1024, M, NZ, 1024, 1024, 1024};
            pg8::StaticOrder S; S.init(M, NZ, G, bx);
            EpiZ E{(bf16*)(ws + WS_Z), (bf16*)(ws + WS_UP), (float*)(ws + WS_NLF), PIN(I_FOXB) + l * 6};
#ifdef EXP_EPI_BF16
            pg8::EpiBf16<0> E2{(bf16*)(ws + WS_Z), NZ, nullptr, 0, 0, 1.f};
            pg8::gemm_phase<pg8::EpiBf16<0>, pg8::StaticOrder, true, true>(lds, g, S, E2);
#else
            pg8::gemm_phase<EpiZ, pg8::StaticOrder, true, true>(lds, g, S, E, wave0);
#endif
        }
        else if (sub == 2) {
            unsigned* qctr = (unsigned*)(ws + WS_CTL) + 1024 + ph * 64 + rep * 32; LAS unsigned* qslot = (LAS unsigned*)(lds + MISC_OFF);
            constexpr unsigned NHL = 48u * (HG_NSEG - 1) / 2u;
            for (;;) {
                int ozq = 0; asm volatile("" : "+s"(ozq)); unsigned char* wsq = p.ws + ozq;
                if (wave0 == 0 && lane_now() == 0) *qslot = __hip_atomic_fetch_add(qctr, 1u, __ATOMIC_RELAXED, __HIP_MEMORY_SCOPE_AGENT);
                __syncthreads(); const unsigned v = __builtin_amdgcn_readfirstlane(*qslot); __syncthreads();
                if (v >= NHL + 128u + 48u + 768u) break;
                if (v < NHL) { hgrn_pair<false>(wsq, p.in[I_HNW + ozq] + l * 64, l, (int)(2u * v), lds, wave0); }
                else if (v < NHL + 128u) { const int u5 = (int)(v - NHL); const OneUnit S5{u5, u5 >> 3};
                    pg8::Gemm g5{(const pg8::bf16_t*)(wsq + WS_UP), (const pg8::bf16_t*)(wsq + WS_S5WL) + (size_t)l * 16 * 256 * 256, 16 * 2048, 16 * 256, 256, 384, 256}; EpiS5Loc E5{(float*)(wsq + WS_LOC)}; pg8::gemm_phase<EpiS5Loc, OneUnit, false, true>(lds, g5, S5, E5, wave0); __syncthreads(); }
                else if (v >= NHL + 128u + 48u) {
                    const int u = (int)(v - NHL - 128u - 48u), bh = u >> 4, qb = u & 15, b = bh / 6, h = bh % 6; int wv_ = wave0; asm volatile("" : "+s"(wv_)); const int lane = lane_now();
                    const bf16* Zr = (const bf16*)(wsq + WS_Z) + (size_t)(b * SEQ + qb * 256 + wv_ * 32) * NZ + h * 64; float kmax = 0.f, qmax = 0.f;
#pragma unroll
                    for (int i = 0; i < 8; ++i) { const bf16* rp = Zr + (size_t)(4 * i + (lane >> 4)) * NZ + 4 * (lane & 15); const v2u kw = *(const GAS v2u*)(rp + ZC_FK), qw = *(const GAS v2u*)(rp + ZC_FQ);
                        float ks = (bflo(kw.x) * bflo(kw.x) + bfhi(kw.x) * bfhi(kw.x)) + (bflo(kw.y) * bflo(kw.y) + bfhi(kw.y) * bfhi(kw.y)), qs = (bflo(qw.x) * bflo(qw.x) + bfhi(qw.x) * bfhi(qw.x)) + (bflo(qw.y) * bflo(qw.y) + bfhi(qw.y) * bfhi(qw.y));
                        ks += lane_get(ks, lane ^ 1); qs += lane_get(qs, lane ^ 1); ks += lane_get(ks, lane ^ 2); qs += lane_get(qs, lane ^ 2); ks += lane_get(ks, lane ^ 4); qs += lane_get(qs, lane ^ 4); ks += lane_get(ks, lane ^ 8); qs += lane_get(qs, lane ^ 8);
                        kmax = fmaxf(kmax, ks); qmax = fmaxf(qmax, qs); }
                    kmax = fmaxf(kmax, lane_get(kmax, lane ^ 16)); qmax = fmaxf(qmax, lane_get(qmax, lane ^ 16)); kmax = fmaxf(kmax, lane_get(kmax, lane ^ 32)); qmax = fmaxf(qmax, lane_get(qmax, lane ^ 32));
                    LAS float* red = (LAS float*)lds; if (lane == 0) { red[wv_] = kmax; red[8 + wv_] = qmax; }
                    __syncthreads();
                    if (wv_ == 0 && lane < 4) ((float*)(wsq + WS_KN))[bh * 64 + qb * 4 + lane] = fmaxf(red[2 * lane], red[2 * lane + 1]) * 1.02f;
                    if (wv_ == 0 && lane == 4) { float m = red[8]; for (int w = 1; w < 8; ++w) m = fmaxf(m, red[8 + w]); ((float*)(wsq + WS_QN))[bh * 16 + qb] = m * 1.02f; }
                    __syncthreads(); }
                else { const int bh = (int)(v - NHL - 128u); int wv_ = wave0; asm volatile("" : "+s"(wv_)); const int lane = lane_now(), wave = wv_, tid = wv_ * 64 + lane; LAS float* wsum = (LAS float*)lds;
                    const float* src = (const float*)(wsq + WS_NLF) + (size_t)bh * SEQ + tid * 8; float v8[8]; float s = 0.f;
                    const f32x4 a = *(const GAS f32x4*)src, b4 = *(const GAS f32x4*)(src + 4);
                    v8[0] = a.x; v8[1] = a.y; v8[2] = a.z; v8[3] = a.w; v8[4] = b4.x; v8[5] = b4.y; v8[6] = b4.z; v8[7] = b4.w;
#pragma unroll
                    for (int i = 0; i < 8; ++i) { s += v8[i]; v8[i] = s; }
                    float incl = s;
#pragma unroll
                    for (int o = 1; o < 64; o <<= 1) { const float n = lane_get(incl, lane - o); if (lane >= o) incl += n; }
                    if (lane == 63) wsum[wave] = incl;
                    __syncthreads();
                    float base = incl - s;
                    for (int w = 0; w < wave; ++w) base += wsum[w];
                    float* dst = (float*)(wsq + WS_G) + (size_t)bh * SEQ + tid * 8;
                    *(GAS f32x4*)dst = (f32x4){v8[0] + base, v8[1] + base, v8[2] + base, v8[3] + base}; *(GAS f32x4*)(dst + 4) = (f32x4){v8[4] + base, v8[5] + base, v8[6] + base, v8[7] + base};
                    __syncthreads(); }
            }
        }
        else if (sub == 3) {
            unsigned* qctr = (unsigned*)(ws + WS_CTL) + 1024 + ph * 64 + rep * 32; LAS unsigned* qslot = (LAS unsigned*)(lds + MISC_OFF);
            for (;;) {
                int ozq = 0; asm volatile("" : "+s"(ozq)); unsigned char* wsq = p.ws + ozq;
                if (wave0 == 0 && lane_now() == 0) *qslot = __hip_atomic_fetch_add(qctr, 1u, __ATOMIC_RELAXED, __HIP_MEMORY_SCOPE_AGENT);
                __syncthreads(); const unsigned v = __builtin_amdgcn_readfirstlane(*qslot); __syncthreads();
                constexpr unsigned NHF = 48u * HG_NSEG / 2u;
                if (v >= NHF + 128u + 768u) break;
#ifdef DUP_MASK
#ifndef DUP_CSEL
                if (rep == 0 && v >= NHF + 128u) break;
#else
                if (rep == 0 && DUP_CSEL != 3 && v >= NHF + 128u) break;
#endif
#ifdef DUP_CSEL
                if (rep == 0 && DUP_CSEL == 1 && v >= NHF) break;
                if (rep == 0 && DUP_CSEL == 2 && v < NHF) continue;
                if (rep == 0 && DUP_CSEL == 3 && v < NHF + 128u) continue;
#endif
#endif
                if (v < NHF) { hgrn_pair<true>(wsq, p.in[I_HNW + ozq] + l * 64, l, (int)(2u * v), lds, wave0); }
                else if (v < NHF + 128u) { const unsigned v5 = v - NHF;
                    s5_scan(wsq, l, (int)(v5 >> 3), (int)(v5 & 7u), wave0 * 64 + lane_now());
                    pg8::Gemm g5{(const pg8::bf16_t*)(wsq + WS_UP), (const pg8::bf16_t*)(wsq + WS_S5WO) + (size_t)l * 16 * 256 * 384, 16 * 2048, 16 * 256, 384, 384, 384}; EpiS5Y E5{(bf16*)(wsq + WS_Y)};
                    const OneUnit S5{(int)v5, (int)(v5 >> 3)}; pg8::gemm_phase<EpiS5Y, OneUnit, false, false>(lds, g5, S5, E5, wave0); __syncthreads(); }
                else { const unsigned a = v - NHF - 128u; const int bh = (int)(a >> 4), qb = 15 - (int)(a & 15u);
                    const attn_body::bf16* Zq = (const attn_body::bf16*)(wsq + WS_Z);
                    int ts; { const int ln = lane_now(); const float* Gb = (const float*)(wsq + WS_G) + (size_t)bh * SEQ; const float* KN = (const float*)(wsq + WS_KN) + bh * 64; const float qn = ((const float*)(wsq + WS_QN))[bh * 16 + qb];
                        const float kd = fmaxf(fmaxf(KN[4 * qb], KN[4 * qb + 1]), fmaxf(KN[4 * qb + 2], KN[4 * qb + 3])); const float ub = __builtin_sqrtf(qn * KN[ln]) + Gb[64 * ln + 63] - Gb[256 * qb] + __builtin_sqrtf(qn * kd);
                        const unsigned long long need = __ballot((ln < 4 * qb) && !(ub < -36.f)); const int first = need ? (int)__builtin_ctzll(need) : 4 * qb; ts = __builtin_amdgcn_readfirstlane(first & ~1); }
                    attn_body::attn_unit<8>(bh / 6, bh % 6, qb, Zq + ZC_FQ, Zq + ZC_FK, Zq + ZC_FV, (attn_body::bf16*)(wsq + WS_Z) + ZC_FQ, (const float*)(wsq + WS_G) + (long)bh * SEQ, (char*)lds_raw, wave0, ts, rep != 0); }
            }
        }
        else if (sub == 4) { PHASE_IDS
            if (bx < 128) {
                pg8::Gemm gg{(const pg8::bf16_t*)(ws + WS_Y), (const pg8::bf16_t*)(ws + WS_GLU) + (size_t)l * 256 * 256, M, 256, 256, 256, 256};
                const OneUnit SG{bx, 0}; EpiGlu EG{(const bf16*)(ws + WS_Y), PIN(I_GLUB) + l * 256, PIN(I_BNS) + l * 256, (bf16*)(ws + WS_H)};
                pg8::gemm_phase<EpiGlu, OneUnit, false, true>(lds, gg, SG, EG, wave0);
            } else {
            const int gw2 = (bx - 128) * NWAVES + wave, ngw2 = (G - 128) * NWAVES;
            const bf16* Zb = (const bf16*)(ws + WS_Z); bf16* MIX = (bf16*)(ws + WS_H); const float* w = PIN(I_BNF) + l * 384;
            float wl[6];
#pragma unroll
            for (int i = 0; i < 6; ++i) wl[i] = w[lane * 6 + i];
            for (int m = gw2; m < M; m += ngw2) {
                const GAS unsigned* src = (const GAS unsigned*)(Zb + (size_t)m * NZ) + lane * 3; const unsigned a = src[0], b2 = src[1], c = src[2];
                float v[6] = {bflo(a), bfhi(a), bflo(b2), bfhi(b2), bflo(c), bfhi(c)}; float s = 0.f;
#pragma unroll
                for (int i = 0; i < 6; ++i) s += v[i] * v[i];
                const float rstd = __builtin_amdgcn_rsqf(wave_sum(s, lane) * (1.f / 384.f) + 1e-6f);
                GAS unsigned* dst = (GAS unsigned*)(MIX + (size_t)m * 1024) + lane * 3;
                dst[0] = pk2(v[0] * rstd * wl[0], v[1] * rstd * wl[1]); dst[1] = pk2(v[2] * rstd * wl[2], v[3] * rstd * wl[3]); dst[2] = pk2(v[4] * rstd * wl[4], v[5] * rstd * wl[5]);
            }
            }
        }
        else if (sub == 5) {
            pg8::Gemm g{(const pg8::bf16_t*)(ws + WS_H), (const pg8::bf16_t*)(ws + WS_WOUT) + (size_t)l * 1024 * 1024, M, 1024, 1024, 1024, 1024};
            pg8::StaticOrder S; S.init(M, 1024, G, bx);
            const float* gm = (const float*)(ws + WS_MOD) + l * 8 * 6144 + 2048;
            if (l == 0) { EpiRes<true> E{PIN(I_X), (bf16*)(ws + WS_XB), gm}; pg8::gemm_phase<EpiRes<true>, pg8::StaticOrder, true, true>(lds, g, S, E, wave0); }
            else { EpiRes<false> E{ws + WS_XB, (bf16*)(ws + WS_XB), gm}; pg8::gemm_phase<EpiRes<false>, pg8::StaticOrder, true, true>(lds, g, S, E, wave0); }
        }
        else if (sub == 6) { PHASE_IDS moe_route(p, oz, l, lds, tid, lane, wave, bx, G);
        }
        else if (sub == 7) { PHASE_IDS moe_gather(p, oz, lds, tid, lane, wave, bx, G);
        }
        else if (sub == 8) { PHASE_IDS
            LAS int* list = (LAS int*)(lds + RING_BYTES + 1024); const int n = moe_build_list<false>(ws, list, tid, bx, G);
            pg8::Gemm g{(const pg8::bf16_t*)(ws + WS_H), (const pg8::bf16_t*)(ws + WS_W1) + (size_t)l * 8192 * 1024, MOE_ROWS, 8192, 1024, 1024, 1024, (const int*)(ws + WS_ROWTOK)};
            ListOrder S{list, n}; EpiHid E{(bf16*)(ws + WS_HID), (const float*)(ws + WS_ROWW)};
            pg8::gemm_phase<EpiHid, ListOrder, true, true, false, true>(lds, g, S, E, wave0);
        }
        else if (sub == 9) { PHASE_IDS
            LAS int* list = (LAS int*)(lds + RING_BYTES + 1024); const int n = moe_build_list<true>(ws, list, tid, bx, G);
            pg8::Gemm g{(const pg8::bf16_t*)(ws + WS_HID), (const pg8::bf16_t*)(ws + WS_W2) + (size_t)l * 1024 * 4096, MOE_ROWS, 1024, 512, 512, 4096};
            ListOrder S{list, n}; EpiMoeOut E{(bf16*)(ws + WS_XB), (const float*)(ws + WS_MOD) + l * 8 * 6144 + 5 * 1024, (const int*)(ws + WS_ROWTOK)};
            pg8::gemm_phase<EpiMoeOut, ListOrder, false, true, true>(lds, g, S, E, wave0);
        }
        if (ph + 1 < p.ph_hi || rep == 0) xcd_barrier(bar, wave0 == 0 && lane_now() == 0); else __syncthreads();
      }
    }
}

static int g_grid = 0;
inline bool mk_setup() {
    if (g_grid) return g_grid > 0;
    int dev = 0, cus = 0;
    if (hipGetDevice(&dev) != hipSuccess || hipDeviceGetAttribute(&cus, hipDeviceAttributeMultiprocessorCount, dev) != hipSuccess) { g_grid = -1; return false; }
    if (hipFuncSetAttribute((const void*)mk_fwd, hipFuncAttributeMaxDynamicSharedMemorySize, LDS_BYTES) != hipSuccess) { fprintf(stderr, "hipFuncSetAttribute failed\n"); g_grid = -1; return false; }
    g_grid = cus; return true;
}
inline void mk_zero_ctl(void* d_ws, hipStream_t st) { (void)hipMemsetAsync((char*)d_ws + WS_CTL, 0, CTL_ZERO_BYTES, st); }
inline void mk_launch(void* const* d_in, void* d_out, void* d_ws, hipStream_t st, int lo, int hi, int li = 0) {
    if (!mk_setup()) return;
    Params p{}; for (int i = 0; i < 29; ++i) p.in[i] = (const float*)d_in[i]; p.out = (float*)d_out; p.ws = (unsigned char*)d_ws; p.ph_lo = lo; p.ph_hi = hi; p.li = li;
    hipLaunchKernelGGL(mk_fwd, dim3(g_grid), dim3(NTHR), LDS_BYTES, st, p);
}
}
extern "C" void kernel_launch(void* const* d_in, const int* in_sizes, int n_in, void* d_out, int out_size, void* d_ws, size_t ws_size, hipStream_t stream) {
    fx::mk_zero_ctl(d_ws, stream);
    fx::mk_launch(d_in, d_out, d_ws, stream, 0, 22, 0);
}
```

```cpp
#include <hip/hip_runtime.h>
#include <hip/hip_bf16.h>
#include <cstdio>
#include <cstdint>
#include <cmath>
namespace fx {
constexpr int BATCH = 8, SEQ = 4096, DM = 1024, M = BATCH * SEQ, NZ = 3072, NIN = 2950;
constexpr int NWAVES = 8, NTHR = 512;
constexpr float LOG2E = 1.4426950408889634f;
constexpr float C2 = 0.125f * LOG2E;
constexpr int ZC_FQ = 0, ZC_FK = 384, ZC_FV = 768, ZC_SU = 1152, ZC_HQ = 1408, ZC_HF = 1792, ZC_HI = 2176, ZC_HG = 2560, ZC_FF = 2944;
constexpr size_t MiB = 1u << 20;
constexpr size_t WS_CTL = 0, CTL_ZERO_BYTES = 1 * MiB;
constexpr size_t WS_MOD = 1 * MiB;
constexpr size_t WS_LB = WS_MOD + 512 * 1024;
constexpr size_t WS_S5AL = WS_LB + 4096;
constexpr size_t WS_NLF = 2 * MiB;
constexpr size_t WS_G = WS_NLF + 48 * 4096 * 4;
constexpr size_t WS_KN = WS_G + 48 * 4096 * 4;
constexpr size_t WS_QN = WS_KN + 48 * 64 * 4;
constexpr size_t WS_WIN = 4 * MiB;
constexpr size_t WS_WOUT = WS_WIN + 2ull * 3072 * 1024 * 2;
constexpr size_t WS_W1 = WS_WOUT + 2ull * 1024 * 1024 * 2;
constexpr size_t WS_W2 = WS_W1 + 2ull * 8192 * 1024 * 2;
constexpr size_t WS_GLU = WS_W2 + 2ull * 1024 * 4096 * 2;
constexpr size_t WS_S5WO = WS_GLU + 2ull * 256 * 256 * 2;
constexpr size_t WS_S5WL = WS_S5WO + 2ull * 16 * 256 * 384 * 2;
constexpr size_t WS_H = 80 * MiB;
constexpr size_t WS_Z = WS_H + (size_t)M * 1024 * 2;
constexpr size_t WS_UP = WS_Z + (size_t)M * NZ * 2;
constexpr size_t WS_LOC = WS_UP + 16ull * 2048 * 384 * 2;
constexpr size_t WS_Y = WS_LOC + 16ull * 2048 * 128 * 4;
constexpr size_t WS_HLOC = WS_Y + (size_t)M * 256 * 2;
constexpr size_t WS_XB = WS_HLOC + 16 * MiB;
constexpr size_t WS_END = WS_XB + (size_t)M * 1024 * 2;
static_assert(WS_S5WL + 2ull * 16 * 256 * 256 * 2 <= WS_H, "weights fit below H");
static_assert(WS_QN + 48 * 16 * 4 <= WS_WIN, "norm tables fit below the weights");
static_assert(WS_END <= 512 * MiB, "workspace fits 512 MiB");

#define GAS __attribute__((address_space(1)))
#define LAS __attribute__((address_space(3)))
typedef unsigned short bf16;
typedef unsigned v4u __attribute__((ext_vector_type(4)));
typedef unsigned v2u __attribute__((ext_vector_type(2)));
typedef float f32x4 __attribute__((ext_vector_type(4)));
typedef GAS unsigned gu32;
#define RLX_AGENT __ATOMIC_RELAXED, __HIP_MEMORY_SCOPE_AGENT
#define LDS_WAIT() asm volatile("s_waitcnt lgkmcnt(0)" ::: "memory")
#define VM_WAIT() asm volatile("s_waitcnt vmcnt(0)" ::: "memory")
__device__ __forceinline__ unsigned f2bf(float f) { unsigned u = __builtin_bit_cast(unsigned, f); return (u + 0x7fffu + ((u >> 16) & 1u)) >> 16; }
__device__ __forceinline__ unsigned pk2(float lo, float hi) { return f2bf(lo) | (f2bf(hi) << 16); }
__device__ __forceinline__ float bf2f(unsigned short h) { return __builtin_bit_cast(float, (unsigned)h << 16); }
__device__ __forceinline__ float bflo(unsigned w) { return __builtin_bit_cast(float, w << 16); }
__device__ __forceinline__ float bfhi(unsigned w) { return __builtin_bit_cast(float, w & 0xffff0000u); }
__device__ __forceinline__ float fsigmoid(float x) { return __builtin_amdgcn_rcpf(1.f + __builtin_amdgcn_exp2f(-LOG2E * x)); }
__device__ __forceinline__ float fsilu(float x) { return x * fsigmoid(x); }
__device__ __forceinline__ float lane_get(float v, int src_lane) { return __builtin_bit_cast(float, __builtin_amdgcn_ds_bpermute(src_lane << 2, __builtin_bit_cast(int, v))); }
__device__ __forceinline__ float wave_sum(float v, int  ) {
    v += __builtin_bit_cast(float, __builtin_amdgcn_update_dpp(0, __builtin_bit_cast(int, v), 0xB1, 0xF, 0xF, false));
    v += __builtin_bit_cast(float, __builtin_amdgcn_update_dpp(0, __builtin_bit_cast(int, v), 0x4E, 0xF, 0xF, false));
    v += __builtin_bit_cast(float, __builtin_amdgcn_update_dpp(0, __builtin_bit_cast(int, v), 0x141, 0xF, 0xF, false));
    v += __builtin_bit_cast(float, __builtin_amdgcn_update_dpp(0, __builtin_bit_cast(int, v), 0x140, 0xF, 0xF, false));
    v += __builtin_bit_cast(float, __builtin_amdgcn_update_dpp(0, __builtin_bit_cast(int, v), 0x142, 0xA, 0xF, false));
    v += __builtin_bit_cast(float, __builtin_amdgcn_update_dpp(0, __builtin_bit_cast(int, v), 0x143, 0xC, 0xF, false));
    return __builtin_bit_cast(float, __builtin_amdgcn_readlane(__builtin_bit_cast(int, v), 63));
}

__device__ __forceinline__ int lane_now() { int z = 0; asm volatile("" : "+v"(z)); return (int)__builtin_amdgcn_mbcnt_hi(~0u, __builtin_amdgcn_mbcnt_lo(~0u, (unsigned)z)); }

struct Params {
    const float* in[29]; float* out; unsigned char* ws; int ph_lo, ph_hi, li, pad;
};
enum { I_X = 0, I_C, I_ADAW, I_ADAB, I_NMW, I_NFW, I_WIN, I_FOXB, I_ARE, I_AIM, I_BRE, I_BIM, I_CRE, I_CIM, I_S5D, I_LOGDT, I_GLUW, I_GLUB, I_LBL, I_HNW, I_BNF, I_BNS, I_WOUT, I_RW, I_RB, I_WG, I_WU, I_WD, I_FINW };

__device__ __forceinline__ void transpose_item(const float* src, int ld_src, int c0, int nvalid, bf16* dst, int ldd, int k0, LAS float* scr, int lane) {
#pragma unroll 8
    for (int i = 0; i < 32; ++i) { const int kk = 2 * i + (lane >> 5), n = lane & 31; scr[kk * 33 + n] = (n < nvalid) ? src[(size_t)(k0 + kk) * ld_src + c0 + n] : 0.f; }
    LDS_WAIT(); asm volatile("" ::: "memory");
    const int c = lane & 7;
#pragma unroll
    for (int j = 0; j < 4; ++j) { const int n = (lane >> 3) + 8 * j; const LAS float* s = scr + (8 * c) * 33 + n;
        v4u o; o.x = pk2(s[0 * 33], s[1 * 33]); o.y = pk2(s[2 * 33], s[3 * 33]); o.z = pk2(s[4 * 33], s[5 * 33]); o.w = pk2(s[6 * 33], s[7 * 33]);
        *(GAS v4u*)(dst + (size_t)n * ldd + k0 + 8 * c) = o; }
    LDS_WAIT(); asm volatile("" ::: "memory");
}
__device__ __forceinline__ int win_src_col(int n) {
    if (n < 1152) return n;
    if (n < 1408) return 1158 + (n - 1152);
    if (n < 2944) return 1414 + (n - 1408);
    if (n < 2950) return 1152 + (n - 2944);
    return -1;
}
__device__ __forceinline__ void prologue_wave_items(const Params& p, int oz, LAS float* scr, int gw, int ngw, int lane) {
    unsigned char* ws = p.ws + oz;
    constexpr int IT_WIN = 2 * 16 * 96, IT_WOUT = 2 * 16 * 32, IT_W1 = 2 * 16 * 256, IT_W2 = 2 * 64 * 32, IT_GLU = 2 * 4 * 8;
    constexpr int NITEMS = IT_WIN + IT_WOUT + IT_W1 + IT_W2 + IT_GLU;
    for (int it = gw; it < NITEMS; it += ngw) {
        int r = it;
        if (r < IT_WIN) { const int l = r / (16 * 96), q = r % (16 * 96), kb = q / 96, nb = q % 96, n0 = nb * 32; const int sc = win_src_col(n0);
            int nvalid = 32; if (sc < 0) nvalid = 0; else if (n0 == 2944) nvalid = 6;
            transpose_item(p.in[I_WIN + oz] + (size_t)l * 1024 * NIN, NIN, sc < 0 ? 0 : sc, nvalid, (bf16*)(ws + WS_WIN) + ((size_t)l * 3072 + n0) * 1024, 1024, kb * 64, scr, lane); continue; }
        r -= IT_WIN;
        if (r < IT_WOUT) { const int l = r / (16 * 32), q = r % (16 * 32), kb = q / 32, nb = q % 32;
            transpose_item(p.in[I_WOUT + oz] + (size_t)l * 1024 * 1024, 1024, nb * 32, 32, (bf16*)(ws + WS_WOUT) + ((size_t)l * 1024 + nb * 32) * 1024, 1024, kb * 64, scr, lane); continue; }
        r -= IT_WOUT;
        if (r < IT_W1) {
            const int l = r / (16 * 256), q = r % (16 * 256), kb = q / 256, nb = q % 256, n0 = nb * 32; const int e = n0 / 512, j = (n0 % 512) / 256, w = n0 % 256; const bool up = w >= 128; const int f0 = j * 128 + (w % 128);
            const float* src = (up ? p.in[I_WU + oz] : p.in[I_WG + oz]) + ((size_t)l * 16 + e) * 1024 * 256;
            transpose_item(src, 256, f0, 32, (bf16*)(ws + WS_W1) + ((size_t)l * 8192 + n0) * 1024, 1024, kb * 64, scr, lane); continue; }
        r -= IT_W1;
        if (r < IT_W2) { const int l = r / (64 * 32), q = r % (64 * 32), kb = q / 32, nb = q % 32;
            transpose_item(p.in[I_WD + oz] + (size_t)l * 4096 * 1024, 1024, nb * 32, 32, (bf16*)(ws + WS_W2) + ((size_t)l * 1024 + nb * 32) * 4096, 4096, kb * 64, scr, lane); continue; }
        r -= IT_W2;
        { const int l = r / 32, q = r % 32, kb = q / 8, nb = q % 8;
            transpose_item(p.in[I_GLUW + oz] + (size_t)l * 65536, 256, nb * 32, 32, (bf16*)(ws + WS_GLU) + ((size_t)l * 256 + nb * 32) * 256, 256, kb * 64, scr, lane); }
    }
    if (gw == 0) { float* lb = (float*)(ws + WS_LB); for (int j = lane; j < 384; j += 64) { const float a = p.in[I_LBL + oz][j], b = p.in[I_LBL + oz][384 + j], m = fmaxf(a, b), ea = __expf(a - m), eb = __expf(b - m); lb[j] = 0.f; lb[384 + j] = eb / (ea + eb); } }
}
__device__ __forceinline__ void prologue_mod_item(const Params& p, int oz, int item, LAS float* lds, int tid, int lane, int wave) {
    LAS float* cact = lds; LAS float* part = lds + 8192;
    const int l = item / 96, nb = item % 96, n = nb * 64 + lane; const float* W = p.in[I_ADAW + oz] + ((size_t)l * 1024 + wave * 128) * 6144 + n;
    float acc[8];
#pragma unroll
    for (int b = 0; b < 8; ++b) acc[b] = 0.f;
    for (int k0 = 0; k0 < 128; k0 += 16) { float w[16];
#pragma unroll
        for (int u = 0; u < 16; ++u) w[u] = W[(size_t)(k0 + u) * 6144];
#pragma unroll
        for (int u = 0; u < 16; ++u)
#pragma unroll
            for (int b = 0; b < 8; ++b) acc[b] += cact[b * 1024 + wave * 128 + k0 + u] * w[u]; }
#pragma unroll
    for (int b = 0; b < 8; ++b) part[(wave * 8 + b) * 64 + lane] = acc[b];
    __syncthreads();
    { const int b = tid >> 6; float s = 0.f;
#pragma unroll
        for (int w = 0; w < 8; ++w) s += part[(w * 8 + b) * 64 + lane];
        ((float*)(p.ws + oz + WS_MOD))[(l * 8 + b) * 6144 + n] = s + p.in[I_ADAB + oz][l * 6144 + n]; }
    __syncthreads();
}
__device__ __forceinline__ void prologue_s5_item(const Params& p, int oz, int l, int g, LAS float* lds, int tid) {
    LAS float* apr = lds;
    LAS float* api = lds + 17 * 64;
    LAS float* bbr = lds + 34 * 64;
    LAS float* bbi = bbr + 1024;
    LAS float* ccr = bbi + 1024;
    LAS float* cci = ccr + 1024;
    LAS float* Kt = cci + 1024;
    unsigned char* ws = p.ws + oz;
    if (tid < 64) { const int q = tid; const float dt = __expf(p.in[I_LOGDT + oz][l * 16 + g]); const float lr = p.in[I_ARE + oz][(l * 16 + g) * 64 + q], li = p.in[I_AIM + oz][(l * 16 + g) * 64 + q];
        for (int tau = 0; tau <= 16; ++tau) { const float er = expf(lr * dt * tau); float sn, cs; sincosf(li * dt * tau, &sn, &cs); apr[tau * 64 + q] = er * cs; api[tau * 64 + q] = er * sn; }
        const float ar = apr[64 + q], ai = api[64 + q]; const float nr = ar - 1.f, ni = ai, den = lr * lr + li * li; const float fr = (nr * lr + ni * li) / den, fi = (ni * lr - nr * li) / den;
        for (int c = 0; c < 16; ++c) { const float br = p.in[I_BRE + oz][((l * 16 + g) * 64 + q) * 16 + c], bi = p.in[I_BIM + oz][((l * 16 + g) * 64 + q) * 16 + c]; bbr[q * 16 + c] = fr * br - fi * bi; bbi[q * 16 + c] = fr * bi + fi * br;
            ccr[c * 64 + q] = p.in[I_CRE + oz][((l * 16 + g) * 16 + c) * 64 + q]; cci[c * 64 + q] = p.in[I_CIM + oz][((l * 16 + g) * 16 + c) * 64 + q]; }
        float* al = (float*)(ws + WS_S5AL) + ((l * 16 + g) * 64 + q) * 2; al[0] = apr[16 * 64 + q]; al[1] = api[16 * 64 + q];
    }
    __syncthreads();
    for (int idx = tid; idx < 4096; idx += NTHR) { const int tau = idx >> 8, c = (idx >> 4) & 15, c2 = idx & 15; float acc = 0.f;
        for (int q = 0; q < 64; ++q) { const float mr = ccr[c * 64 + q] * apr[tau * 64 + q] - cci[c * 64 + q] * api[tau * 64 + q], mi = ccr[c * 64 + q] * api[tau * 64 + q] + cci[c * 64 + q] * apr[tau * 64 + q];
            acc += mr * bbr[q * 16 + c2] - mi * bbi[q * 16 + c2]; }
        if (tau == 0 && c == c2) acc += p.in[I_S5D + oz][(l * 16 + g) * 16 + c];
        Kt[idx] = acc; }
    __syncthreads();
    bf16* WO = (bf16*)(ws + WS_S5WO) + (size_t)(l * 16 + g) * 256 * 384; bf16* WL = (bf16*)(ws + WS_S5WL) + (size_t)(l * 16 + g) * 256 * 256;
    for (int ch = tid; ch < 256 * 48; ch += NTHR) { const int n = ch / 48, k0 = (ch % 48) * 8, j = n >> 4, c = n & 15; float v[8];
#pragma unroll
        for (int e = 0; e < 8; ++e) { const int k = k0 + e; float val;
            if (k < 256) { const int i = k >> 4, c2 = k & 15; val = (j >= i) ? Kt[((j - i) << 8) + (c << 4) + c2] : 0.f; }
            else { const int q = (k - 256) & 63; const float pr = apr[(j + 1) * 64 + q], pi = api[(j + 1) * 64 + q], cr = ccr[c * 64 + q], ci = cci[c * 64 + q];
                val = (k - 256 < 64) ? (cr * pr - ci * pi) : -(cr * pi + ci * pr); }
            v[e] = val; }
        v4u o; o.x = pk2(v[0], v[1]); o.y = pk2(v[2], v[3]); o.z = pk2(v[4], v[5]); o.w = pk2(v[6], v[7]);
        *(GAS v4u*)(WO + (size_t)n * 384 + k0) = o; }
    for (int ch = tid; ch < 256 * 32; ch += NTHR) { const int n = ch / 32, k0 = (ch % 32) * 8; float v[8];
#pragma unroll
        for (int e = 0; e < 8; ++e) { const int k = k0 + e, i = k >> 4, c2 = k & 15; float val = 0.f;
            if (n < 128) { const int q = n & 63; const float pr = apr[(15 - i) * 64 + q], pi = api[(15 - i) * 64 + q], br = bbr[q * 16 + c2], bi = bbi[q * 16 + c2]; val = (n < 64) ? (pr * br - pi * bi) : (pr * bi + pi * br); }
            v[e] = val; }
        v4u o; o.x = pk2(v[0], v[1]); o.y = pk2(v[2], v[3]); o.z = pk2(v[4], v[5]); o.w = pk2(v[6], v[7]);
        *(GAS v4u*)(WL + (size_t)n * 256 + k0) = o; }
    __syncthreads();
}
__device__ __forceinline__ void row_load(const float* X, int m, int lane, f32x4 (&v)[4]) { const GAS f32x4* xr = (const GAS f32x4*)(X + (size_t)m * 1024) + lane;
#pragma unroll
    for (int j = 0; j < 4; ++j) v[j] = xr[64 * j]; }
__device__ __forceinline__ void row_load_bf(const bf16* X, int m, int lane, f32x4 (&v)[4]) { const GAS v2u* xr = (const GAS v2u*)(X + (size_t)m * 1024) + lane;
#pragma unroll
    for (int j = 0; j < 4; ++j) { const v2u w = xr[64 * j]; v[j] = (f32x4){bflo(w.x), bfhi(w.x), bflo(w.y), bfhi(w.y)}; } }
__device__ __forceinline__ void adaln_factors(const float* w, const float* sh, const float* sc, int lane, f32x4 (&A)[4], f32x4 (&B)[4]) {
#pragma unroll
    for (int j = 0; j < 4; ++j) { const f32x4 ww = ((const GAS f32x4*)w)[lane + 64 * j], a = ((const GAS f32x4*)sc)[lane + 64 * j]; A[j] = ww * (a + 1.f); B[j] = ((const GAS f32x4*)sh)[lane + 64 * j]; } }
__device__ __forceinline__ void norm_row_to_bf16(f32x4 (&v)[4], const f32x4 (&A)[4], const f32x4 (&B)[4], bf16* orow, int lane) {
    float s = 0.f;
#pragma unroll
    for (int j = 0; j < 4; ++j) s += (v[j].x * v[j].x + v[j].y * v[j].y) + (v[j].z * v[j].z + v[j].w * v[j].w);
    const float rstd = __builtin_amdgcn_rsqf(wave_sum(s, lane) * (1.f / 1024.f) + 1e-6f);
    GAS unsigned long long* o8 = (GAS unsigned long long*)orow + lane;
#pragma unroll
    for (int j = 0; j < 4; ++j) { const f32x4 h = (v[j] * rstd) * A[j] + B[j]; v[j] = h;
        o8[64 * j] = (unsigned long long)pk2(h.x, h.y) | ((unsigned long long)pk2(h.z, h.w) << 32); }
}
}
namespace fx {
#define XB_TMO      128
#define XB_XCNT(j)  (256  + 64 * (j))
#define XB_XSUB(j)  (1280 + 64 * (j))
#define XB_XGEN(j)  (2304 + 64 * (j))
#define XB_TOP      3328
#define XB_TOPGEN   3392
#define XCD_BAR_WORDS 3456
#define XB_SPIN_CAP (1u << 18)

__device__ __forceinline__ unsigned xb_ld(unsigned* p)              { return __hip_atomic_load(p, __ATOMIC_RELAXED, __HIP_MEMORY_SCOPE_AGENT); }
__device__ __forceinline__ unsigned xb_add(unsigned* p, unsigned v) { return __hip_atomic_fetch_add(p, v, __ATOMIC_RELAXED, __HIP_MEMORY_SCOPE_AGENT); }
__device__ __forceinline__ unsigned xb_xcc_id() { return (unsigned)__builtin_amdgcn_s_getreg((3 << 11) | 20) & 0xFu; }
#define XB_SPIN(cond, bar) do { unsigned _sp = 0; while (cond) { __builtin_amdgcn_s_sleep(1); \
    if ((++_sp & 255u) == 0u) { if (xb_ld(&(bar)[XB_TMO])) break; if (_sp > XB_SPIN_CAP) { atomicAdd(&(bar)[XB_TMO], 1u); break; } } } } while (0)

struct XcdBarrier {
    unsigned* bar; unsigned x;
    volatile LAS unsigned* st;
};

__device__ __forceinline__ XcdBarrier xcd_barrier_post(unsigned* bar, volatile LAS unsigned* st, bool leader) {
    XcdBarrier b; b.bar = bar; b.x = xb_xcc_id(); b.st = st;
    if (leader) (void)xb_add(&bar[XB_XCNT(b.x)], 1u);
    return b;
}
__device__ __forceinline__ void xcd_barrier_complete(unsigned* bar, unsigned x, unsigned& nloc, unsigned& nx) {
    const unsigned G = gridDim.x * gridDim.y * gridDim.z;
    asm volatile("" : "+s"(x));
    unsigned sum, cnt, mine, sp = 0u;
    for (;;) {
        sum = 0u; cnt = 0u; mine = 0u;
#pragma unroll
        for (unsigned j = 0; j < 16; ++j) { const unsigned c = xb_ld(&bar[XB_XCNT(j)]); sum += c; cnt += (c > 0u) ? 1u : 0u; mine = (j == x) ? c : mine; }
        if (sum == G) break;
        __builtin_amdgcn_s_sleep(1);
        if ((++sp & 255u) == 0u) { if (xb_ld(&bar[XB_TMO])) break; if (sp > XB_SPIN_CAP) { atomicAdd(&bar[XB_TMO], 1u); break; } }
    }
    nloc = mine > 0u ? mine : 1u; nx = cnt > 0u ? cnt : 1u;
}

__device__ __forceinline__ void xcd_barrier(const XcdBarrier& b, bool leader) {
    asm volatile("s_waitcnt vmcnt(0)" ::: "memory");
    __syncthreads();
    if (leader) {
        unsigned* bar = b.bar;
        __builtin_amdgcn_s_waitcnt(0);
        unsigned nloc = b.st[0], nx = b.st[1];
        if (nloc == 0u) { xcd_barrier_complete(bar, b.x, nloc, nx); b.st[0] = nloc; b.st[1] = nx; }
        const unsigned old = xb_add(&bar[XB_XSUB(b.x)], 1u);
        const unsigned gen = old / nloc;
        if (old + 1u == (gen + 1u) * nloc) {
            __builtin_amdgcn_fence(__ATOMIC_RELEASE, "agent");
            asm volatile("s_waitcnt vmcnt(0)" ::: "memory");
            const unsigned og = xb_add(&bar[XB_TOP], 1u);
            const unsigned tg = og / nx;
            if (og + 1u == (tg + 1u) * nx) xb_add(&bar[XB_TOPGEN], 1u);
            else XB_SPIN(xb_ld(&bar[XB_TOPGEN]) == tg, bar);
            __builtin_amdgcn_fence(__ATOMIC_ACQUIRE, "agent");
            xb_add(&bar[XB_XGEN(b.x)], 1u);
            asm volatile("s_waitcnt vmcnt(0)" ::: "memory");
        } else {
            XB_SPIN(xb_ld(&bar[XB_XGEN(b.x)]) == gen, bar);
            __builtin_amdgcn_fence(__ATOMIC_ACQUIRE, "agent");
            asm volatile("s_waitcnt vmcnt(0)" ::: "memory");
        }
    }
    __syncthreads();
}

}
namespace pg8 {
#define PG8_LAS __attribute__((address_space(3)))
typedef unsigned short bf16_t;
typedef short bf16x8 __attribute__((ext_vector_type(8)));
typedef float f32x4 __attribute__((ext_vector_type(4)));
typedef unsigned u32x4 __attribute__((ext_vector_type(4)));
constexpr int BM = 256, BK = 64, HALF = 128, HTB = HALF * BK * 2  , STAGE_BYTES = 8 * HTB, NXCD = 8, WGM = 8;

__host__ __device__ __forceinline__ int lds_byte(int r, int c) { const int st = (r >> 4) * 2 + (c >> 5), rr = r & 15, cc = c & 31, ob = rr * 64 + cc * 2; return st * 1024 + (ob ^ (((ob >> 9) & 1) << 5)); }
__host__ __device__ __forceinline__ void stage_rc(int b, int& R, int& C) { const int st = b / 1024, sb = b % 1024, swz = sb ^ (((sb >> 9) & 1) << 5); R = (st >> 1) * 16 + swz / 64; C = (st & 1) * 32 + (swz % 64) / 2; }
__host__ __device__ __forceinline__ int perm32(int rho) { const int n = rho >> 4, i = rho & 15; return 8 * (i >> 2) + 4 * n + (i & 3); }

struct Unit { int pm, pn; int k0, k1; };
struct Gemm { const bf16_t* A; const bf16_t* Bt; int M, N, K, lda, ldb; const int* rowidx; };

struct StaticOrder {
    int nM, nN, nwg, G, c;
    __host__ __device__ void init(int M, int N, int G_, int c_) { nM = M / BM; nN = N / BM; nwg = nM * nN; G = G_; c = c_; }
    __host__ __device__ bool next(int i, Unit& u) const {
        const long L = (long)i * G + c; if (L >= nwg) return false;
        int wgid = (int)L; { const int q = nwg / NXCD, r = nwg % NXCD, xcd = wgid % NXCD, off = wgid / NXCD; wgid = (xcd < r ? xcd * (q + 1) : r * (q + 1) + (xcd - r) * q) + off; }
        const int nig = WGM * nN, gid = wgid / nig, fm = gid * WGM, gsz = (nM - fm) < WGM ? (nM - fm) : WGM;
        u.pm = fm + ((wgid % nig) % gsz); u.pn = (wgid % nig) / gsz; return true;
    }
    __device__ __forceinline__ void a_ready(const Unit&) const {}
    __device__ __forceinline__ void done(const Unit&) const {}
};

__device__ __forceinline__ unsigned cvt_pk_bf16(float lo, float hi) { unsigned r; asm volatile("v_cvt_pk_bf16_f32 %0, %1, %2" : "=v"(r) : "v"(lo), "v"(hi)); return r; }
typedef float f32x2 __attribute__((ext_vector_type(2)));
__device__ __forceinline__ f32x2 gelu_pk(f32x2 v) {
    const f32x2 av = __builtin_elementwise_abs(v), d = av * 0.2316418882f + 1.0f;
    f32x2 t; t.x = __builtin_amdgcn_rcpf(d.x); t.y = __builtin_amdgcn_rcpf(d.y);
    f32x2 q = t * 0.5307027145f + (-0.7265760135f); q = q * t + 0.7107068705f; q = q * t + (-0.142248368f); q = q * t + 0.127414796f; q = q * t;
    const f32x2 s = (v * v) * (-0.72134752044f);
    f32x2 e; e.x = __builtin_amdgcn_exp2f(s.x); e.y = __builtin_amdgcn_exp2f(s.y);
    const f32x2 m = v * (q * e), r = v - m;
    f32x2 o; o.x = v.x < 0.f ? m.x : r.x; o.y = v.y < 0.f ? m.y : r.y; return o;
}

template <int ACT  > struct EpiBf16 {
    static constexpr bool PERM = true, AFTER_DRAIN = false; static_assert(ACT == 0 || ACT == 1, "EpiBf16: ACT is 0 (none) or 1 (gelu_pk)");
    bf16_t* O; int ldc; const float* bias; int split_cols; size_t split_stride; float scale0;
    __device__ __forceinline__ void operator()(const f32x4 (&acc)[2][2][4][2], const Unit& u, int wr, int wc, int fr, int fq) const {
        const int row0 = u.pm * BM + wr * 64 + fr; int colt = u.pn * BM; bf16_t* base = O;
        float sc = 1.f; if (split_cols) { const int t = colt / split_cols; base += (size_t)t * split_stride; colt -= t * split_cols; if (t == 0) sc = scale0; }
        const int col0 = colt + wc * 32 + 8 * fq, bcol0 = u.pn * BM + wc * 32 + 8 * fq;
        f32x4 bv[2][2];
#pragma unroll
        for (int bj = 0; bj < 2; ++bj)
#pragma unroll
            for (int n = 0; n < 2; ++n) bv[bj][n] = bias ? *(const f32x4*)(bias + bcol0 + bj * HALF + 4 * n) : (f32x4){0.f, 0.f, 0.f, 0.f};
#pragma unroll
        for (int ai = 0; ai < 2; ++ai)
#pragma unroll
            for (int m = 0; m < 4; ++m) { bf16_t* rowp = base + (size_t)(row0 + ai * HALF + m * 16) * ldc + col0;
#pragma unroll
                for (int bj = 0; bj < 2; ++bj) { f32x4 v0 = acc[ai][bj][m][0] + bv[bj][0], v1 = acc[ai][bj][m][1] + bv[bj][1];
                    if (ACT == 1) { f32x2 a = gelu_pk((f32x2){v0[0], v0[1]}), b = gelu_pk((f32x2){v0[2], v0[3]}), c = gelu_pk((f32x2){v1[0], v1[1]}), d = gelu_pk((f32x2){v1[2], v1[3]});
                        v0 = (f32x4){a.x, a.y, b.x, b.y}; v1 = (f32x4){c.x, c.y, d.x, d.y}; }
                    v0 = v0 * sc; v1 = v1 * sc; u32x4 w; w.x = cvt_pk_bf16(v0[0], v0[1]); w.y = cvt_pk_bf16(v0[2], v0[3]); w.z = cvt_pk_bf16(v1[0], v1[1]); w.w = cvt_pk_bf16(v1[2], v1[3]);
                    *(u32x4*)(rowp + bj * HALF) = w; } }
    }
};

struct PanelStats {
    unsigned* xbuf;
    unsigned* cnt;
    unsigned* tmo;
    int ntn; float eps;
    unsigned code;
    __device__ __forceinline__ bool run(const f32x4 (&v)[2][2][4][2], const Unit& u, int wr, int wc, int fr, int fq, PG8_LAS unsigned char* lds, int wid, int lane) const {
        typedef float f32x2v __attribute__((ext_vector_type(2)));
        PG8_LAS f32x2v* P = (PG8_LAS f32x2v*)lds;
        PG8_LAS f32x2v* S = (PG8_LAS f32x2v*)(lds + 8192);
        PG8_LAS unsigned* flag = (PG8_LAS unsigned*)(lds + 8192 + 2048);
#pragma unroll
        for (int ai = 0; ai < 2; ++ai)
#pragma unroll
            for (int m = 0; m < 4; ++m) {
                float s = 0.f;
#pragma unroll
                for (int bj = 0; bj < 2; ++bj)
#pragma unroll
                    for (int n = 0; n < 2; ++n) { const f32x4 x = v[ai][bj][m][n]; s += (x[0] + x[1]) + (x[2] + x[3]); }
                s += __shfl_xor(s, 16); s += __shfl_xor(s, 32);
                const float mw = s * (1.0f / 64.0f); float q = 0.f;
#pragma unroll
                for (int bj = 0; bj < 2; ++bj)
#pragma unroll
                    for (int n = 0; n < 2; ++n) { const f32x4 d = v[ai][bj][m][n] - mw; q += (d[0] * d[0] + d[1] * d[1]) + (d[2] * d[2] + d[3] * d[3]); }
                q += __shfl_xor(q, 16); q += __shfl_xor(q, 32);
                if (fq == 0) P[(ai * HALF + wr * 64 + m * 16 + fr) * 4 + wc] = (f32x2v){mw, q};
            }
        asm volatile("s_waitcnt lgkmcnt(0)" ::: "memory"); __builtin_amdgcn_s_barrier(); asm volatile("" ::: "memory");
#if defined(BROKEN_EXCHANGE_NO_WAIT)
#warning BROKEN CONTROL BUILD: the row-statistics exchange does not wait; results are wrong by design
        if (blockIdx.x >= 64) { const long long t0_ = clock64(); while (clock64() - t0_ < 60000) __builtin_amdgcn_s_sleep(8); }
#endif
        const int row = wid * 32 + (lane & 31);
        if (lane < 32) {
            const f32x2v a = P[row * 4 + 0], b = P[row * 4 + 1], c = P[row * 4 + 2], d = P[row * 4 + 3];
            const float mt = (a.x + b.x + c.x + d.x) * 0.25f;
            const float da = a.x - mt, db = b.x - mt, dc = c.x - mt, dd = d.x - mt;
            const float m2 = (a.y + b.y) + (c.y + d.y) + 64.0f * ((da * da + db * db) + (dc * dc + dd * dd));
            unsigned long long* slot = (unsigned long long*)xbuf + ((size_t)(u.pm * BM + row) * 4 + u.pn);
            __hip_atomic_store(slot, ((unsigned long long)__float_as_uint(m2) << 32) | __float_as_uint(mt), __ATOMIC_RELAXED, __HIP_MEMORY_SCOPE_AGENT);
        }
        asm volatile("s_waitcnt vmcnt(0)" ::: "memory");
        if (lane == 0) __hip_atomic_fetch_add(cnt + 64 * u.pm, 1u, __ATOMIC_RELAXED, __HIP_MEMORY_SCOPE_AGENT);
        if (wid == 0) {
            bool dead = false; const unsigned long long t0 = __builtin_amdgcn_s_memrealtime(); const unsigned want = 8u * (unsigned)ntn;
            for (;;) {
#if defined(BROKEN_EXCHANGE_NO_WAIT)
                break;
#endif
                if ((unsigned)__builtin_amdgcn_readfirstlane(__hip_atomic_load(cnt + 64 * u.pm, __ATOMIC_RELAXED, __HIP_MEMORY_SCOPE_AGENT)) >= want) break;
                if (__builtin_amdgcn_s_memrealtime() - t0 > 2000000ull) {
                    if (lane == 0) { unsigned expect = 0u; __hip_atomic_compare_exchange_strong(tmo + 1, &expect, code | (unsigned)(u.pm & 0xff), __ATOMIC_RELAXED, __ATOMIC_RELAXED, __HIP_MEMORY_SCOPE_AGENT);
                                     __hip_atomic_store(tmo, 1u, __ATOMIC_RELAXED, __HIP_MEMORY_SCOPE_AGENT); }
                    dead = true; break; }
                __builtin_amdgcn_s_sleep(2);
            }
            __builtin_amdgcn_fence(__ATOMIC_ACQUIRE, "agent");
            if (lane == 0) flag[0] = dead ? 1u : 0u;
        }
        asm volatile("s_waitcnt vmcnt(0) lgkmcnt(0)" ::: "memory"); __builtin_amdgcn_s_barrier(); asm volatile("" ::: "memory");
        const bool bad = flag[0] != 0u;
        if (lane < 32) {
            const unsigned long long* slot = (const unsigned long long*)xbuf + (size_t)(u.pm * BM + row) * 4; float mt[4], m2[4]; float ms = 0.f;
#pragma unroll
            for (int t = 0; t < 4; ++t) { if (t < ntn) { const unsigned long long w = __hip_atomic_load(slot + t, __ATOMIC_RELAXED, __HIP_MEMORY_SCOPE_AGENT); mt[t] = __uint_as_float((unsigned)w); m2[t] = __uint_as_float((unsigned)(w >> 32)); } else { mt[t] = 0.f; m2[t] = 0.f; } ms += mt[t]; }
            const float mean = ms / (float)ntn; float q = 0.f;
#pragma unroll
            for (int t = 0; t < 4; ++t) if (t < ntn) { const float dm = mt[t] - mean; q += m2[t] + 256.0f * dm * dm; }
            S[row] = (f32x2v){mean, 1.0f / sqrtf(q / (256.0f * (float)ntn) + eps)};
        }
        asm volatile("s_waitcnt lgkmcnt(0)" ::: "memory"); __builtin_amdgcn_s_barrier(); asm volatile("" ::: "memory");
        return bad;
    }
};
struct EpiLnRes {
    static constexpr bool PERM = false, AFTER_DRAIN = true;
    const float* base; float* out; int ldc; const float* bias; PanelStats st; unsigned poison;
    __device__ __forceinline__ void fused(f32x4 (&acc)[2][2][4][2], const Unit& u, int wr, int wc, int fr, int fq, PG8_LAS unsigned char* lds, int wid, int lane) const {
        typedef float f32x2v __attribute__((ext_vector_type(2)));
        const PG8_LAS f32x2v* S = (const PG8_LAS f32x2v*)(lds + 8192);
        const int col0 = u.pn * BM + wc * 32 + 4 * fq;
#pragma unroll
        for (int bj = 0; bj < 2; ++bj)
#pragma unroll
            for (int n = 0; n < 2; ++n) { const f32x4 bv = bias ? *(const f32x4*)(bias + col0 + bj * HALF + n * 16) : (f32x4){0.f, 0.f, 0.f, 0.f};
#pragma unroll
                for (int ai = 0; ai < 2; ++ai)
#pragma unroll
                    for (int m = 0; m < 4; ++m) acc[ai][bj][m][n] += bv; }
        f32x4 pre[4][2][2];
#pragma unroll
        for (int m = 0; m < 4; ++m) { const size_t off = (size_t)(u.pm * BM + wr * 64 + m * 16 + fr) * ldc + col0;
#pragma unroll
            for (int bj = 0; bj < 2; ++bj)
#pragma unroll
                for (int n = 0; n < 2; ++n) pre[m][bj][n] = *(const f32x4*)(base + off + bj * HALF + n * 16); }
        const bool bad = st.run(acc, u, wr, wc, fr, fq, lds, wid, lane) || poison != 0u;
        const float qnan = __builtin_nanf("");
#pragma unroll
        for (int ai = 0; ai < 2; ++ai)
#pragma unroll
            for (int m = 0; m < 4; ++m) { const int r = ai * HALF + wr * 64 + m * 16 + fr; const f32x2v sr = S[r]; const size_t off = (size_t)(u.pm * BM + r) * ldc + col0;
#pragma unroll
                for (int bj = 0; bj < 2; ++bj)
#pragma unroll
                    for (int n = 0; n < 2; ++n) { const f32x4 bs = ai == 0 ? pre[m][bj][n] : *(const f32x4*)(base + off + bj * HALF + n * 16); f32x4 o = bs + (acc[ai][bj][m][n] - sr.x) * sr.y;
                        if (bad) o = (f32x4){qnan, qnan, qnan, qnan}; *(f32x4*)(out + off + bj * HALF + n * 16) = o; }
                if (m & 1) asm volatile("" ::: "memory"); }
    }
};
struct EpiLnResLn {
    static constexpr bool PERM = false, AFTER_DRAIN = true;
    const float* base; float* out; bf16_t* xn; int ldc; const float* bias; PanelStats st1, st2; unsigned poison;
    __device__ __forceinline__ void fused(f32x4 (&acc)[2][2][4][2], const Unit& u, int wr, int wc, int fr, int fq, PG8_LAS unsigned char* lds, int wid, int lane) const {
        typedef float f32x2v __attribute__((ext_vector_type(2))); typedef unsigned u32x2v __attribute__((ext_vector_type(2)));
        const PG8_LAS f32x2v* S = (const PG8_LAS f32x2v*)(lds + 8192);
        const int col0 = u.pn * BM + wc * 32 + 4 * fq;
#pragma unroll
        for (int bj = 0; bj < 2; ++bj)
#pragma unroll
            for (int n = 0; n < 2; ++n) { const f32x4 bv = bias ? *(const f32x4*)(bias + col0 + bj * HALF + n * 16) : (f32x4){0.f, 0.f, 0.f, 0.f};
#pragma unroll
                for (int ai = 0; ai < 2; ++ai)
#pragma unroll
                    for (int m = 0; m < 4; ++m) acc[ai][bj][m][n] += bv; }
        bool bad = st1.run(acc, u, wr, wc, fr, fq, lds, wid, lane) || poison != 0u;
        const float qnan = __builtin_nanf("");
#pragma unroll
        for (int ai = 0; ai < 2; ++ai)
#pragma unroll
            for (int m = 0; m < 4; ++m) { const int r = ai * HALF + wr * 64 + m * 16 + fr; const f32x2v sr = S[r]; const size_t off = (size_t)(u.pm * BM + r) * ldc + col0;
#pragma unroll
                for (int bj = 0; bj < 2; ++bj)
#pragma unroll
                    for (int n = 0; n < 2; ++n) { const f32x4 bs = *(const f32x4*)(base + off + bj * HALF + n * 16); acc[ai][bj][m][n] = bs + (acc[ai][bj][m][n] - sr.x) * sr.y; }
                asm volatile("" : "+v"(acc[ai][0][m][0]), "+v"(acc[ai][0][m][1]), "+v"(acc[ai][1][m][0]), "+v"(acc[ai][1][m][1]));
                if (m & 1) asm volatile("" ::: "memory"); }
        const bool bad1 = bad;
        bad = st2.run(acc, u, wr, wc, fr, fq, lds, wid, lane) || bad;
#pragma unroll
        for (int ai = 0; ai < 2; ++ai)
#pragma unroll
            for (int m = 0; m < 4; ++m) { const int r = ai * HALF + wr * 64 + m * 16 + fr; const f32x2v sr = S[r]; const size_t off = (size_t)(u.pm * BM + r) * ldc + col0;
#pragma unroll
                for (int bj = 0; bj < 2; ++bj)
#pragma unroll
                    for (int n = 0; n < 2; ++n) { const f32x4 x1 = acc[ai][bj][m][n]; *(f32x4*)(out + off + bj * HALF + n * 16) = bad1 ? (f32x4){qnan, qnan, qnan, qnan} : x1;
                        const f32x4 o = (x1 - sr.x) * sr.y; u32x2v w; w.x = cvt_pk_bf16(o[0], o[1]); w.y = cvt_pk_bf16(o[2], o[3]);
                        if (bad) { w.x = 0x7fc07fc0u; w.y = 0x7fc07fc0u; } *(u32x2v*)(xn + off + bj * HALF + n * 16) = w; }
                asm volatile("" ::: "memory"); }
    }
};

template <class Epi, class Sched, bool ALIGN_EPI = false, bool SP2 = false, bool KSPLIT = false, bool INDIRECT = false>
__device__ __forceinline__ void gemm_phase(PG8_LAS unsigned char* lds, const Gemm g, const Sched& S, const Epi& E, const int wave0) {
    int wv0_ = wave0; asm volatile("" : "+s"(wv0_));
    int z0_ = 0; asm volatile("" : "+v"(z0_)); const int tid_ = wv0_ * 64 + (int)__builtin_amdgcn_mbcnt_hi(~0u, __builtin_amdgcn_mbcnt_lo(~0u, (unsigned)z0_));
    const int tid = tid_, wid = __builtin_amdgcn_readfirstlane(tid >> 6), lane = tid & 63, wr = wid >> 2, wc = wid & 3, fr = lane & 15, fq = lane >> 4;
    const int K = g.K, nt = K / BK;
    unsigned voffA[2], voffB[2]; int rcA[2];
#pragma unroll
    for (int i = 0; i < 2; ++i) { int R, C; stage_rc(tid * 16 + i * 8192, R, C); const int Rb = Epi::PERM ? ((R & ~31) + perm32(R & 31)) : R;
        voffA[i] = (unsigned)(R * g.lda + C) * 2u; voffB[i] = (unsigned)(Rb * g.ldb + C) * 2u; rcA[i] = (R << 8) | C; }
    const unsigned kstep = (unsigned)(BK * 2);
    const unsigned hstepA = INDIRECT ? 0u : (unsigned)HALF * g.lda * 2, hstepB = (unsigned)HALF * g.ldb * 2;
    const unsigned tstepA = 2 * hstepA, tstepB = 2 * hstepB;
    const char* const baseA = (const char*)g.A; const char* const baseB = (const char*)g.Bt;
    const unsigned ldsw = (unsigned)wid * 1024u;
    const int aoff = lds_byte(wr * 64 + fr, fq * 8), boff = lds_byte(wc * 32 + fr, fq * 8);
#define PG8_SA(b, h) (((b) * 2 + (h)) * HTB)
#define PG8_SB(b, h) ((4 + (b) * 2 + (h)) * HTB)
#define PG8_STAGE_X(bufoff, base, soff, voff) do { _Pragma("unroll") for (int _i = 0; _i < 2; ++_i) \
        __builtin_amdgcn_global_load_lds((const unsigned*)((base) + (unsigned)((soff) + (voff)[_i])), (PG8_LAS unsigned*)(lds + (bufoff) + ldsw + _i * 8192), 16, 0, 0); } while (0)
#define PG8_USWITCH do { if constexpr (INDIRECT) { if (last) { uA[0][0] = uN[0][0]; uA[0][1] = uN[0][1]; uA[1][0] = uN[1][0]; uA[1][1] = uN[1][1]; } } } while (0)
#define PG8_STAGE_A(bufoff, soff, h) do { if constexpr (INDIRECT) { PG8_STAGE_X(bufoff, baseA, soff, uA[h]); } else { PG8_STAGE_X(bufoff, baseA, soff, voffA); } } while (0)
#define PG8_LOADU(U, unit) do { _Pragma("unroll") for (int h_ = 0; h_ < 2; ++h_) _Pragma("unroll") for (int i_ = 0; i_ < 2; ++i_) { int t_ = ((const __attribute__((address_space(1))) int*)g.rowidx)[(unit).pm * 256 + h_ * 128 + (rcA[i_] >> 8)]; t_ = t_ < 0 ? 0 : t_; \
        U[h_][i_] = (unsigned)t_ * (unsigned)(g.lda * 2) + (unsigned)((rcA[i_] & 255) * 2); } } while (0)
#define PG8_LDA(dst, b, h) do { _Pragma("unroll") for (int m = 0; m < 4; ++m) _Pragma("unroll") for (int k = 0; k < 2; ++k) dst[m][k] = *(const PG8_LAS bf16x8*)(lds + PG8_SA(b, h) + aoff + m * 2048 + k * 1024); } while (0)
#define PG8_LDB(dst, b, h) do { _Pragma("unroll") for (int n = 0; n < 2; ++n) _Pragma("unroll") for (int k = 0; k < 2; ++k) dst[n][k] = *(const PG8_LAS bf16x8*)(lds + PG8_SB(b, h) + boff + n * 2048 + k * 1024); } while (0)
#define PG8_MMA(ai, bj, At, Bt) do { __builtin_amdgcn_s_setprio(1); _Pragma("unroll") for (int m = 0; m < 4; ++m) _Pragma("unroll") for (int n = 0; n < 2; ++n) _Pragma("unroll") for (int k = 0; k < 2; ++k) \
        acc[ai][bj][m][n] = __builtin_amdgcn_mfma_f32_16x16x32_bf16(Bt[n][k], At[m][k], acc[ai][bj][m][n], 0, 0, 0); __builtin_amdgcn_s_setprio(0); } while (0)
#define PG8_WAIT_V(n) asm volatile("s_waitcnt vmcnt(" #n ")" ::: "memory")
#define PG8_WAIT_L(n) asm volatile("s_waitcnt lgkmcnt(" #n ")" ::: "memory")
#define PG8_BAR __builtin_amdgcn_s_barrier()
#define PG8_SCHED __builtin_amdgcn_sched_barrier(0)
    Unit cur, nxt; int ui = 0;
    if (!S.next(0, cur)) return;
    f32x4 acc[2][2][4][2];
#pragma unroll
    for (int a = 0; a < 2; ++a)
#pragma unroll
        for (int b = 0; b < 2; ++b)
#pragma unroll
            for (int m = 0; m < 4; ++m)
#pragma unroll
                for (int n = 0; n < 2; ++n) acc[a][b][m][n] = (f32x4){0.f, 0.f, 0.f, 0.f};
    bf16x8 At[4][2], B0[2][2], B1[2][2];
    unsigned cA = (unsigned)cur.pm * tstepA; unsigned cB = (unsigned)cur.pn * tstepB + (KSPLIT ? (unsigned)cur.k0 * 2u : 0u);
    unsigned sB = KSPLIT ? (unsigned)cur.pn * tstepB + (unsigned)cur.k1 * 2u - (unsigned)(nt / 2) * kstep : cB;
    S.a_ready(cur);
    unsigned uA[2][2] = {}, uN[2][2] = {};
    if constexpr (INDIRECT) PG8_LOADU(uA, cur);
    if constexpr (SP2) {
        PG8_STAGE_X(PG8_SB(0, 0), baseB, cB, voffB); PG8_STAGE_X(PG8_SB(0, 1), baseB, cB + hstepB, voffB); PG8_STAGE_A(PG8_SA(0, 0), cA, 0); PG8_STAGE_A(PG8_SA(0, 1), cA + hstepA, 1);
        if (wr == 1) PG8_BAR;
        PG8_WAIT_V(2); PG8_BAR;
        PG8_STAGE_X(PG8_SB(1, 0), baseB, cB + kstep, voffB); PG8_STAGE_A(PG8_SA(1, 0), cA + kstep, 0); PG8_STAGE_X(PG8_SB(1, 1), baseB, cB + hstepB + kstep, voffB);
        PG8_WAIT_V(6); PG8_BAR;
    } else {
        PG8_STAGE_X(PG8_SB(0, 0), baseB, cB, voffB); PG8_STAGE_A(PG8_SA(0, 0), cA, 0); PG8_STAGE_X(PG8_SB(0, 1), baseB, cB + hstepB, voffB); PG8_STAGE_A(PG8_SA(0, 1), cA + hstepA, 1);
        if (wr == 1) PG8_BAR;
        PG8_WAIT_V(4); PG8_BAR;
        PG8_STAGE_X(PG8_SB(1, 0), baseB, cB + kstep, voffB); PG8_STAGE_A(PG8_SA(1, 0), cA + kstep, 0); PG8_STAGE_X(PG8_SB(1, 1), baseB, cB + hstepB + kstep, voffB);
        PG8_WAIT_V(6); PG8_BAR;
    }
    for (;;) {
        const bool has_next = S.next(ui + 1, nxt);
        const unsigned nA = has_next ? (unsigned)nxt.pm * tstepA : cA; const unsigned nB = has_next ? (unsigned)nxt.pn * tstepB + (KSPLIT ? (unsigned)nxt.k0 * 2u : 0u) : cB;
        const unsigned nsB = (KSPLIT && has_next) ? (unsigned)nxt.pn * tstepB + (unsigned)nxt.k1 * 2u - (unsigned)(nt / 2) * kstep : sB;
        for (int t = 0; t < nt; t += 2) {
            const bool last = (t == nt - 2);
            const unsigned a1 = cA + (unsigned)(t + 1) * kstep;
            const unsigned a2 = last ? nA : cA + (unsigned)(t + 2) * kstep; const unsigned b2 = last ? nB : ((KSPLIT && (t + 2) >= nt / 2) ? sB : cB) + (unsigned)(t + 2) * kstep;
            const unsigned a3 = a2 + kstep; const unsigned b3 = b2 + kstep;
            if (last && has_next) S.a_ready(nxt);
            if constexpr (INDIRECT) { if (last) { if (has_next) PG8_LOADU(uN, nxt); else { uN[0][0] = uA[0][0]; uN[0][1] = uA[0][1]; uN[1][0] = uA[1][0]; uN[1][1] = uA[1][1]; } } }
            if constexpr (SP2) {
            PG8_LDB(B0, 0, 0); PG8_LDB(B1, 0, 1); PG8_SCHED; PG8_LDA(At, 0, 0); PG8_STAGE_A(PG8_SA(1, 1), a1 + hstepA, 1); PG8_USWITCH;
            PG8_WAIT_V(8); PG8_WAIT_L(0); PG8_BAR; PG8_MMA(0, 0, At, B0); PG8_MMA(0, 1, At, B1); PG8_BAR; PG8_SCHED;
            PG8_LDA(At, 0, 1); PG8_STAGE_X(PG8_SB(0, 0), baseB, b2, voffB); PG8_STAGE_X(PG8_SB(0, 1), baseB, b2 + hstepB, voffB); PG8_STAGE_A(PG8_SA(0, 0), a2, 0);
            PG8_WAIT_V(8); PG8_WAIT_L(0); PG8_BAR; PG8_MMA(1, 0, At, B0); PG8_MMA(1, 1, At, B1); PG8_BAR; PG8_SCHED;
            PG8_LDB(B0, 1, 0); PG8_LDB(B1, 1, 1); PG8_SCHED; PG8_LDA(At, 1, 0); PG8_STAGE_A(PG8_SA(0, 1), a2 + hstepA, 1);
            PG8_WAIT_V(8); PG8_WAIT_L(0); PG8_BAR; PG8_MMA(0, 0, At, B0); PG8_MMA(0, 1, At, B1); PG8_BAR; PG8_SCHED;
            PG8_LDA(At, 1, 1); PG8_STAGE_X(PG8_SB(1, 0), baseB, b3, voffB); PG8_STAGE_X(PG8_SB(1, 1), baseB, b3 + hstepB, voffB); PG8_STAGE_A(PG8_SA(1, 0), a3, 0);
            PG8_WAIT_V(8); PG8_WAIT_L(0); PG8_BAR; PG8_MMA(1, 0, At, B0); PG8_MMA(1, 1, At, B1); PG8_BAR; PG8_SCHED;
            } else {
            PG8_LDB(B0, 0, 0); PG8_SCHED; PG8_LDA(At, 0, 0); PG8_STAGE_A(PG8_SA(1, 1), a1 + hstepA, 1); PG8_USWITCH;
            PG8_WAIT_L(8); PG8_BAR; PG8_WAIT_L(0); PG8_MMA(0, 0, At, B0); PG8_BAR; PG8_SCHED;
            PG8_LDB(B1, 0, 1); PG8_STAGE_X(PG8_SB(0, 0), baseB, b2, voffB);
            PG8_BAR; PG8_WAIT_L(0); PG8_MMA(0, 1, At, B1); PG8_BAR;
            PG8_LDA(At, 0, 1); PG8_STAGE_A(PG8_SA(0, 0), a2, 0);
            PG8_BAR; PG8_WAIT_L(0); PG8_MMA(1, 0, At, B0); PG8_BAR; PG8_SCHED;
            PG8_STAGE_X(PG8_SB(0, 1), baseB, b2 + hstepB, voffB);
            PG8_WAIT_V(6); PG8_BAR; PG8_MMA(1, 1, At, B1); PG8_BAR;
            PG8_LDB(B0, 1, 0); PG8_SCHED; PG8_LDA(At, 1, 0); PG8_STAGE_A(PG8_SA(0, 1), a2 + hstepA, 1);
            PG8_WAIT_L(8); PG8_BAR; PG8_WAIT_L(0); PG8_MMA(0, 0, At, B0); PG8_BAR; PG8_SCHED;
            PG8_LDB(B1, 1, 1); PG8_STAGE_X(PG8_SB(1, 0), baseB, b3, voffB);
            PG8_BAR; PG8_WAIT_L(0); PG8_MMA(0, 1, At, B1); PG8_BAR;
            PG8_LDA(At, 1, 1); PG8_STAGE_A(PG8_SA(1, 0), a3, 0);
            PG8_BAR; PG8_WAIT_L(0); PG8_MMA(1, 0, At, B0); PG8_BAR; PG8_SCHED;
            PG8_STAGE_X(PG8_SB(1, 1), baseB, b3 + hstepB, voffB);
            PG8_WAIT_V(6); PG8_BAR; PG8_MMA(1, 1, At, B1); PG8_BAR;
            }
        }
        if constexpr (ALIGN_EPI) { if (wr == 0) PG8_BAR; }
        if constexpr (!Epi::AFTER_DRAIN) { E(acc, cur, wr, wc, fr, fq); S.done(cur); }
        if (!has_next) break;
#pragma unroll
        for (int a = 0; a < 2; ++a)
#pragma unroll
            for (int b = 0; b < 2; ++b)
#pragma unroll
                for (int m = 0; m < 4; ++m)
#pragma unroll
                    for (int n = 0; n < 2; ++n) acc[a][b][m][n] = (f32x4){0.f, 0.f, 0.f, 0.f};
        cur = nxt; cA = nA; cB = nB; sB = nsB; ++ui;
        if constexpr (ALIGN_EPI) { if (wr == 1) PG8_BAR; }
    }
    PG8_WAIT_V(0);
    if constexpr (!ALIGN_EPI) { if (wr == 0) PG8_BAR; }
    PG8_BAR;
    if constexpr (Epi::AFTER_DRAIN) { E.fused(acc, cur, wr, wc, fr, fq, lds, wid, lane); S.done(cur); }
#undef PG8_SA
#undef PG8_SB
#undef PG8_STAGE_X
#undef PG8_STAGE_A
#undef PG8_LOADU
#undef PG8_USWITCH
#undef PG8_LDA
#undef PG8_LDB
#undef PG8_MMA
#undef PG8_WAIT_V
#undef PG8_WAIT_L
#undef PG8_BAR
#undef PG8_SCHED
}
}
namespace attn_body {
using bf16=__hip_bfloat16;
using bf16x8=__attribute__((ext_vector_type(8)))short;
using s16x4=__attribute__((ext_vector_type(4)))short;
using f32x16=__attribute__((ext_vector_type(16)))float;
using u32x4=__attribute__((ext_vector_type(4)))unsigned;
constexpr int BATCH=8,NHEAD=6,SEQ=4096,D=64,DM=3072;
constexpr int NW=8,QBLK=32,QB=QBLK*NW,KVBLK=64,NQB=SEQ/QB;
constexpr int ATTN_PITCH=DM, ATTN_UNIT_ROWS=QB;
__device__ __forceinline__ int crow(int r,int hi){return (r&3)+8*(r>>2)+4*hi;}
#define SBAR() __builtin_amdgcn_sched_barrier(0)
__device__ __forceinline__ void cmask(f32x16&p0,f32x16&p1,int jb,int qrel,int hi){
  const float NEG=-INFINITY; int kb=64*jb+4*hi;
  #pragma unroll
  for(int r=0;r<16;++r){int kv=kb+(r&3)+8*(r>>2); if(kv>qrel)p0[r]=NEG; if(kv+32>qrel)p1[r]=NEG;}
}

constexpr int NSLOT=3, SLOTB=8192;
constexpr int LDS_K=0, LDS_V=NSLOT*SLOTB, LDS_WS=2*NSLOT*SLOTB, LDS_OST=LDS_WS+NW*64*4, LDS_G=LDS_OST+NW*4096, LDS_BYTES=LDS_G+SEQ*4;
constexpr float C2=0.125f*1.4426950408889634f;
__device__ __forceinline__ void glds16(const void*gsrc,unsigned lds_dst){unsigned keep;
  asm volatile("s_mov_b32 %0, m0\n\ts_mov_b32 m0, %2\n\ts_nop 0\n\tglobal_load_lds_dwordx4 %1, off\n\ts_mov_b32 m0, %0":"=&s"(keep):"v"(gsrc),"s"(lds_dst):"memory");}
__device__ __forceinline__ float max3f(float a,float b,float c){float r;asm("v_max3_f32 %0, %1, %2, %3":"=v"(r):"v"(a),"v"(b),"v"(c));return r;}
__device__ __forceinline__ float max2f(float a,float b){float r;asm("v_max_f32_e32 %0, %1, %2":"=v"(r):"v"(a),"v"(b));return r;}
__device__ __forceinline__ float fadd_s(float a,float b){float r;asm("v_add_f32_e32 %0, %1, %2":"=v"(r):"v"(a),"v"(b));return r;}
__device__ __forceinline__ float fsub_s(float a,float b){float r;asm("v_sub_f32_e32 %0, %1, %2":"=v"(r):"v"(a),"v"(b));return r;}
typedef float f32x2_t __attribute__((ext_vector_type(2))); typedef __bf16 bf16x2_t __attribute__((ext_vector_type(2)));
__device__ __forceinline__ unsigned cvtpk_s(float lo,float hi){f32x2_t v={lo,hi};bf16x2_t b=__builtin_convertvector(v,bf16x2_t);return __builtin_bit_cast(unsigned,b);}
#define WAIT_BAR(N) asm volatile("s_waitcnt vmcnt(" #N ") lgkmcnt(0)\n\ts_barrier":::"memory")

__device__ __forceinline__ void qkt(f32x16&p0,f32x16&p1,const char*Kslot,const bf16x8*qr,const f32x16&negm,int r32,int hi){
  const char*kb=Kslot+hi*1024+r32*16;
  #pragma unroll
  for(int d0=0;d0<4;++d0){
    const bf16x8 b0=*reinterpret_cast<const bf16x8*>(kb+d0*2048);
    const bf16x8 b1=*reinterpret_cast<const bf16x8*>(kb+d0*2048+512);
    if(d0==0){p0=__builtin_amdgcn_mfma_f32_32x32x16_bf16(b0,qr[0],negm,0,0,0);p1=__builtin_amdgcn_mfma_f32_32x32x16_bf16(b1,qr[0],negm,0,0,0);}
    else{p0=__builtin_amdgcn_mfma_f32_32x32x16_bf16(b0,qr[d0],p0,0,0,0);p1=__builtin_amdgcn_mfma_f32_32x32x16_bf16(b1,qr[d0],p1,0,0,0);}}
}
typedef __attribute__((address_space(3))) const char* lds_cptr;
typedef short v4i16_t __attribute__((ext_vector_type(4)));
__device__ __forceinline__ void kload8(bf16x8*kf,lds_cptr kp){
  kf[0]=*(const __attribute__((address_space(3))) bf16x8*)(kp);      kf[1]=*(const __attribute__((address_space(3))) bf16x8*)(kp+512);
  kf[2]=*(const __attribute__((address_space(3))) bf16x8*)(kp+2048); kf[3]=*(const __attribute__((address_space(3))) bf16x8*)(kp+2560);
  kf[4]=*(const __attribute__((address_space(3))) bf16x8*)(kp+4096); kf[5]=*(const __attribute__((address_space(3))) bf16x8*)(kp+4608);
  kf[6]=*(const __attribute__((address_space(3))) bf16x8*)(kp+6144); kf[7]=*(const __attribute__((address_space(3))) bf16x8*)(kp+6656);
}
__device__ __forceinline__ void kload2(bf16x8*kf,lds_cptr kp,int j){ kf[2*j]=*(const __attribute__((address_space(3))) bf16x8*)(kp+j*2048); kf[2*j+1]=*(const __attribute__((address_space(3))) bf16x8*)(kp+j*2048+512); }
__device__ __forceinline__ s16x4 vtr(lds_cptr p){ return __builtin_bit_cast(s16x4,__builtin_amdgcn_ds_read_tr16_b64_v4i16((__attribute__((address_space(3))) v4i16_t*)p)); }
__device__ __forceinline__ float rowmax(const f32x16&p0,const f32x16&p1){
  float a=max3f(p0[0],p0[1],p1[0]),b=max3f(p0[2],p0[3],p1[1]);a=max3f(a,p1[2],p1[3]);
  #pragma unroll
  for(int r=4;r<16;r+=4){a=max3f(a,p0[r],p0[r+1]);b=max3f(b,p0[r+2],p0[r+3]);a=max3f(a,p1[r],p1[r+1]);b=max3f(b,p1[r+2],p1[r+3]);}
  const float m=max2f(a,b);
  auto rr=__builtin_amdgcn_permlane32_swap(__float_as_uint(m),__float_as_uint(m),false,false);
  return max2f(__uint_as_float(rr[0]),__uint_as_float(rr[1]));
}
__device__ __forceinline__ void pv(f32x16*o,int vb,bf16x8 pa0,bf16x8 pa1,bf16x8 pa2,bf16x8 pa3){
  #pragma unroll
  for(int d0=0;d0<2;++d0){s16x4 lo[4],hi[4];
    #pragma unroll
    for(int ks=0;ks<4;++ks){
      asm volatile("ds_read_b64_tr_b16 %0,%1 offset:%c2":"=&v"(lo[ks]):"v"(vb),"i"(d0*4096+ks*1024):"memory");
      asm volatile("ds_read_b64_tr_b16 %0,%1 offset:%c2":"=&v"(hi[ks]):"v"(vb),"i"(d0*4096+ks*1024+512):"memory");}
    asm volatile("s_waitcnt lgkmcnt(0)":::"memory");SBAR();
    #define PK(k) (bf16x8){lo[k][0],lo[k][1],lo[k][2],lo[k][3],hi[k][0],hi[k][1],hi[k][2],hi[k][3]}
    o[d0]=__builtin_amdgcn_mfma_f32_32x32x16_bf16(pa0,PK(0),o[d0],0,0,0);
    o[d0]=__builtin_amdgcn_mfma_f32_32x32x16_bf16(pa1,PK(1),o[d0],0,0,0);
    o[d0]=__builtin_amdgcn_mfma_f32_32x32x16_bf16(pa2,PK(2),o[d0],0,0,0);
    o[d0]=__builtin_amdgcn_mfma_f32_32x32x16_bf16(pa3,PK(3),o[d0],0,0,0);
    #undef PK
  }
}

#ifndef ATTN_STORE16
#define ATTN_STORE16(p,v) (*(u32x4*)(p)=(v))
#endif
template<int THRL> __device__ __forceinline__ void attn_unit(int b,int h,int qb,const bf16*Q,const bf16*__restrict__ K,const bf16*__restrict__ V,bf16*O,const float*Gbh,char*shm,const int wave0,const int ts,const bool do_store=true){
  int wv0_=wave0; asm volatile("":"+s"(wv0_)); int z0_=0; asm volatile("":"+v"(z0_)); const int tid=wv0_*64+(int)__builtin_amdgcn_mbcnt_hi(~0u,__builtin_amdgcn_mbcnt_lo(~0u,(unsigned)z0_)),lane=tid&63,r32=lane&31,hi=lane>>5; const int wid=__builtin_amdgcn_readfirstlane(tid>>6);
  const long rowbase=(long)b*SEQ; const int q0=qb*QB;
  const bf16*Qw=Q+(rowbase+q0+wid*QBLK)*DM+h*D;
  const bf16*Kh=K+(rowbase+(long)ts*KVBLK)*DM+h*D,*Vh=V+(rowbase+(long)ts*KVBLK)*DM+h*D;
  const int q0r=q0-ts*KVBLK; Gbh+=ts*KVBLK;
  const unsigned lds0=(unsigned)(uintptr_t)shm;
  float*wsf=(float*)(shm+LDS_WS)+wid*64;
  const bf16*ksrc=Kh+(long)lane*DM+wid*8;
  const bf16*vsrc=Vh+(long)(16*(wid&3)+(lane>>2))*DM+(wid>>2)*32+(lane&3)*8;
  const unsigned kdst=lds0+LDS_K+wid*1024, vdst=lds0+LDS_V+wid*1024;
  #define DMA_K(t,slot) glds16(ksrc+(long)(t)*KVBLK*DM,(unsigned)__builtin_amdgcn_readfirstlane(kdst+(slot)))
  #define DMA_V(t,slot) glds16(vsrc+(long)(t)*KVBLK*DM,(unsigned)__builtin_amdgcn_readfirstlane(vdst+(slot)))
  const int vb0=(int)(lds0+LDS_V)+((lane>>4)&1)*32+(lane&3)*8+(4*hi+((lane&15)>>2))*64;
  const char*Kbase=shm+LDS_K; bf16x8 kf[8];
  const lds_cptr shm3=(lds_cptr)shm; const lds_cptr kp0=shm3+LDS_K+hi*1024+r32*16; const lds_cptr vp0=shm3+LDS_V+((lane>>4)&1)*32+(lane&3)*8+(4*hi+((lane&15)>>2))*64;
  const int NT=(q0r+QB)/KVBLK;
  typedef float f32x4v __attribute__((ext_vector_type(4)));
  { float*gl=(float*)(shm+LDS_G); const int ng4=(q0r+QB)>>2; for(int i=tid;i<ng4;i+=NW*64){ *(f32x4v*)(gl+4*i)=*(const f32x4v*)(Gbh+4*i); } }
  DMA_K(0,0);DMA_V(0,0);DMA_K(1,SLOTB);
  bf16x8 qr[4];
  #pragma unroll
  for(int d0=0;d0<4;++d0)qr[d0]=*reinterpret_cast<const bf16x8*>(&Qw[(long)r32*DM+d0*16+hi*8]);
  float mhat=0.f,l_reg=0.f;f32x16 o[2];o[0]=f32x16{};o[1]=f32x16{};f32x16 negm=f32x16{};asm volatile("":"+v"(negm));
  const int qrel=wid*QBLK+r32;
  #define CMASK(P0,P1,t) do{int jb_=(t)-(NT-4); if(jb_>=0)cmask(P0,P1,jb_,qrel,hi);}while(0)
  #define KBIAS(P0,P1,t) do{ const float*gp_=(const float*)(shm+LDS_G)+64*(t)+4*hi; \
    _Pragma("unroll") for(int j_=0;j_<4;++j_){ { const f32x4v a_=*(const f32x4v*)(gp_+8*j_); P0[4*j_]+=a_.x; P0[4*j_+1]+=a_.y; P0[4*j_+2]+=a_.z; P0[4*j_+3]+=a_.w; } SBAR(); \
      { const f32x4v c_=*(const f32x4v*)(gp_+32+8*j_); P1[4*j_]+=c_.x; P1[4*j_+1]+=c_.y; P1[4*j_+2]+=c_.z; P1[4*j_+3]+=c_.w; } SBAR(); } }while(0)
  bool resc=false;
  #define START(P0,P1) do{ const float rm=rowmax(P0,P1); resc=false; \
    { const float dl=__builtin_fmaxf(rm,0.f); mhat=fadd_s(mhat,dl); \
      _Pragma("unroll") for(int r=0;r<16;++r){P0[r]=fsub_s(P0[r],dl);P1[r]=fsub_s(P1[r],dl);} \
      _Pragma("unroll") for(int r=0;r<16;++r)negm[r]=-mhat; asm volatile("":"+v"(negm)); } \
    _Pragma("unroll") for(int r=0;r<16;++r)P0[r]=__builtin_amdgcn_exp2f(P0[r]); }while(0)
  #define RESC() do{ if(resc){ asm volatile("s_waitcnt lgkmcnt(0)":::"memory"); \
      _Pragma("unroll") for(int d_=0;d_<2;++d_) _Pragma("unroll") for(int r=0;r<16;++r)o[d_][r]*=wsf[crow(r,hi)]; } }while(0)
  f32x16 pA0,pA1,pB0,pB1;
  int sl_prev=0,sl_cur=0,sl_next=SLOTB;
  #define ROT() do{sl_prev=sl_cur;sl_cur=sl_next;sl_next=(sl_next==(NSLOT-1)*SLOTB)?0:sl_next+SLOTB;}while(0)
  DMA_K(2,2*SLOTB);
  WAIT_BAR(3);
  { const float*gl=(const float*)(shm+LDS_G); mhat=gl[q0r+qrel]; _Pragma("unroll") for(int r=0;r<16;++r)negm[r]=-mhat; asm volatile("":"+v"(negm)); }
  qkt(pA0,pA1,Kbase,qr,negm,r32,hi);asm volatile("s_nop 15\n\ts_nop 7":"+v"(pA0),"+v"(pA1));KBIAS(pA0,pA1,0);CMASK(pA0,pA1,0);
  START(pA0,pA1);
  _Pragma("unroll") for(int r=0;r<16;++r)pA1[r]=__builtin_amdgcn_exp2f(pA1[r]);
  WAIT_BAR(0);
  DMA_K(3,0);DMA_V(1,SLOTB);
  ROT();
  kload8(kf,kp0+sl_cur);
  WAIT_BAR(2);
  s16x4 vlo[8],vhi[8]; u32x4 pw0,pw1,pw2,pw3;
  #define PKW(P,B) cvtpk_s(P[B],P[B+1])
  #define PAF(k) __builtin_bit_cast(bf16x8,pw##k)
  #define VFR(i) (bf16x8){vlo[i][0],vlo[i][1],vlo[i][2],vlo[i][3],vhi[i][0],vhi[i][1],vhi[i][2],vhi[i][3]}
  #define PIN(x) asm volatile("":"+v"(x))
  #define MX3(a,b,c) __builtin_fmaxf(__builtin_fmaxf((a),(b)),(c))
  #define GAPA(MF,A0,A1,A2,A3,W0,W1,PW) do{ MF; sacc+=A0; sacc+=A1; sacc+=A2; sacc+=A3; PIN(sacc); W0; W1; PIN(PW); SBAR(); }while(0)
  #define EX(v) __builtin_amdgcn_exp2f(v)
  #define GAPB(MF,X,B) do{ MF; X[B]=EX(X[B]); X[B+1]=EX(X[B+1]); X[B+2]=EX(X[B+2]); X[B+3]=EX(X[B+3]); PIN(X); SBAR(); }while(0)
  #define VRD(i) do{ vlo[i]=vtr(vp_+(((i)>>2)*4096+((i)&3)*1024)); vhi[i]=vtr(vp_+(((i)>>2)*4096+((i)&3)*1024+512)); }while(0)
  #define KRD(G,j) do{ if(G){ kload2(kf,kp0+sl_next,j); SBAR(); } }while(0)
  #define STEP(C0,C1,P0,P1,t,GK,GV,GL) do{ SBAR(); \
    const lds_cptr vp_=vp0+sl_prev; \
    VRD(0); SBAR(); float sacc=(P0[0]+P0[1]); \
    GAPA(C0=__builtin_amdgcn_mfma_f32_32x32x16_bf16(kf[0],qr[0],negm,0,0,0), P0[2],P0[3],P0[4],P0[5],     pw0[0]=PKW(P0,0), pw0[1]=PKW(P0,2), pw0); \
    VRD(4); SBAR(); GAPA(C1=__builtin_amdgcn_mfma_f32_32x32x16_bf16(kf[1],qr[0],negm,0,0,0), P0[6],P0[7],P0[8],P0[9],     pw0[2]=PKW(P0,4), pw0[3]=PKW(P0,6), pw0); \
    VRD(1); SBAR(); GAPA(C0=__builtin_amdgcn_mfma_f32_32x32x16_bf16(kf[2],qr[1],C0,0,0,0),   P0[10],P0[11],P0[12],P0[13], pw1[0]=PKW(P0,8), pw1[1]=PKW(P0,10), pw1); \
    VRD(5); SBAR(); GAPA(C1=__builtin_amdgcn_mfma_f32_32x32x16_bf16(kf[3],qr[1],C1,0,0,0),   P0[14],P0[15],P1[0],P1[1],   pw1[2]=PKW(P0,12),pw1[3]=PKW(P0,14), pw1); \
    VRD(2); SBAR(); GAPA(C0=__builtin_amdgcn_mfma_f32_32x32x16_bf16(kf[4],qr[2],C0,0,0,0),   P1[2],P1[3],P1[4],P1[5],     pw2[0]=PKW(P1,0), pw2[1]=PKW(P1,2), pw2); \
    VRD(6); SBAR(); GAPA(C1=__builtin_amdgcn_mfma_f32_32x32x16_bf16(kf[5],qr[2],C1,0,0,0),   P1[6],P1[7],P1[8],P1[9],     pw2[2]=PKW(P1,4), pw2[3]=PKW(P1,6), pw2); \
    VRD(3); SBAR(); GAPA(C0=__builtin_amdgcn_mfma_f32_32x32x16_bf16(kf[6],qr[3],C0,0,0,0),   P1[10],P1[11],P1[12],P1[13], pw3[0]=PKW(P1,8), pw3[1]=PKW(P1,10), pw3); \
    VRD(7); SBAR(); GAPA(C1=__builtin_amdgcn_mfma_f32_32x32x16_bf16(kf[7],qr[3],C1,0,0,0),   P1[14],P1[15],0.f,0.f,       pw3[2]=PKW(P1,12),pw3[3]=PKW(P1,14), pw3); \
    l_reg+=sacc; \
    if(GK){DMA_K((t)+3,sl_cur);} if(GV){DMA_V((t)+1,sl_next);} \
    KBIAS(C0,C1,t); CMASK(C0,C1,t); \
    { float a=MX3(C0[0],C0[1],C1[0]),b=MX3(C0[2],C0[3],C1[1]); a=MX3(a,C1[2],C1[3]); \
      _Pragma("unroll") for(int r=4;r<16;r+=4){a=MX3(a,C0[r],C0[r+1]);b=MX3(b,C0[r+2],C0[r+3]);a=MX3(a,C1[r],C1[r+1]);b=MX3(b,C1[r+2],C1[r+3]);} \
      float rm=__builtin_fmaxf(a,b); { auto rr=__builtin_amdgcn_permlane32_swap(__float_as_uint(rm),__float_as_uint(rm),false,false); rm=__builtin_fmaxf(__uint_as_float(rr[0]),__uint_as_float(rr[1])); } \
      resc=false; \
      if(__builtin_expect(__any(rm>(float)THRL),0)){ const float dl=__builtin_fmaxf(rm,0.f); mhat+=dl; \
        _Pragma("unroll") for(int r=0;r<16;++r){C0[r]-=dl;C1[r]-=dl;} \
        _Pragma("unroll") for(int r=0;r<16;++r)negm[r]=-mhat; asm volatile("":"+v"(negm)); \
        const float f=__builtin_amdgcn_exp2f(-dl); l_reg*=f; if(hi==0)wsf[r32]=f; resc=true; } } \
    SBAR(); \
    GAPB(o[0]=__builtin_amdgcn_mfma_f32_32x32x16_bf16(PAF(0),VFR(0),o[0],0,0,0), C0,0); \
    GAPB(o[1]=__builtin_amdgcn_mfma_f32_32x32x16_bf16(PAF(0),VFR(4),o[1],0,0,0), C0,4); \
    KRD(GL,0); GAPB(o[0]=__builtin_amdgcn_mfma_f32_32x32x16_bf16(PAF(1),VFR(1),o[0],0,0,0), C0,8); \
    KRD(GL,1); GAPB(o[1]=__builtin_amdgcn_mfma_f32_32x32x16_bf16(PAF(1),VFR(5),o[1],0,0,0), C0,12); \
    KRD(GL,2); GAPB(o[0]=__builtin_amdgcn_mfma_f32_32x32x16_bf16(PAF(2),VFR(2),o[0],0,0,0), C1,0); \
    KRD(GL,3); GAPB(o[1]=__builtin_amdgcn_mfma_f32_32x32x16_bf16(PAF(2),VFR(6),o[1],0,0,0), C1,4); \
    GAPB(o[0]=__builtin_amdgcn_mfma_f32_32x32x16_bf16(PAF(3),VFR(3),o[0],0,0,0), C1,8); \
    GAPB(o[1]=__builtin_amdgcn_mfma_f32_32x32x16_bf16(PAF(3),VFR(7),o[1],0,0,0), C1,12); \
    }while(0)
  int t=1;
  #undef CMASK
  #define CMASK(P0,P1,t) do{}while(0)
  for(;t+5<NT;t+=2){
    STEP(pB0,pB1,pA0,pA1,t,true,true,true);     WAIT_BAR(2); RESC(); ROT();
    STEP(pA0,pA1,pB0,pB1,t+1,true,true,true);   WAIT_BAR(2); RESC(); ROT();
  }
  #undef CMASK
  #define CMASK(P0,P1,t) do{int jb_=(t)-(NT-4); if(jb_>=0)cmask(P0,P1,jb_,qrel,hi);}while(0)
  #define ENDW(tt) do{ if((tt)+3<NT){WAIT_BAR(2);} else if((tt)+2<NT){WAIT_BAR(1);} else {WAIT_BAR(0);} }while(0)
  for(;t+1<NT;t+=2){
    STEP(pB0,pB1,pA0,pA1,t,(t+3<NT),(t+1<NT),(t+1<NT));       ENDW(t);   RESC(); ROT();
    STEP(pA0,pA1,pB0,pB1,t+1,(t+4<NT),(t+2<NT),(t+2<NT));     ENDW(t+1); RESC(); ROT();
  }
  STEP(pB0,pB1,pA0,pA1,NT-1,false,false,false); RESC();
  { float sacc=pB0[0]+pB0[1]; _Pragma("unroll") for(int r=2;r<16;++r)sacc+=pB0[r]; _Pragma("unroll") for(int r=0;r<16;++r)sacc+=pB1[r]; l_reg+=sacc;
    pw0=(u32x4){PKW(pB0,0),PKW(pB0,2),PKW(pB0,4),PKW(pB0,6)};pw1=(u32x4){PKW(pB0,8),PKW(pB0,10),PKW(pB0,12),PKW(pB0,14)};pw2=(u32x4){PKW(pB1,0),PKW(pB1,2),PKW(pB1,4),PKW(pB1,6)};pw3=(u32x4){PKW(pB1,8),PKW(pB1,10),PKW(pB1,12),PKW(pB1,14)};
    SBAR(); pv(o,vb0+sl_cur,PAF(0),PAF(1),PAF(2),PAF(3)); }
  #undef PKW
  #undef PAF
  #undef VFR
  #undef PIN
  #undef MX3
  #undef GAPA
  #undef GAPB
  #undef EX
  #undef VRD
  #undef KRD
  #undef STEP
  #undef ENDW
  {auto rr=__builtin_amdgcn_permlane32_swap(__float_as_uint(l_reg),__float_as_uint(l_reg),false,false);l_reg=__uint_as_float(rr[0])+__uint_as_float(rr[1]);}
  if(hi==0)wsf[32+r32]=l_reg;asm volatile("s_waitcnt lgkmcnt(0)":::"memory");
  float rli[16];
  #pragma unroll
  for(int r=0;r<16;++r)rli[r]=__builtin_amdgcn_rcpf(wsf[32+crow(r,hi)]);
  bf16*Ow=O+(rowbase+q0+wid*QBLK)*DM+h*D;
  { bf16*stg=(bf16*)(shm+LDS_OST)+wid*2048;
    #pragma unroll
    for(int r=0;r<16;++r){const int orow=crow(r,hi);
      #pragma unroll
      for(int d0=0;d0<2;++d0)stg[orow*64+d0*32+r32]=__float2bfloat16(o[d0][r]*rli[r]);}
    asm volatile("s_waitcnt lgkmcnt(0)":::"memory");
    #pragma unroll
    for(int i=0;i<4;++i){const int row=i*8+(lane>>3),ch=lane&7; const u32x4 v=*(const u32x4*)(stg+row*64+ch*8); if(do_store)ATTN_STORE16(Ow+(long)row*DM+ch*8,v);} }
  asm volatile("s_waitcnt lgkmcnt(0)\n\ts_barrier":::"memory");
  #undef DMA_K
  #undef DMA_V
  #undef CMASK
  #undef KBIAS
  #undef START
  #undef RESC
  #undef ROT
}
constexpr int ATTN_LDS_BYTES=LDS_BYTES;
struct AttnTensors { const bf16* Q; const bf16* K; const bf16* V; bf16* O; const float* G; };
struct AttnUnit { int bh; int qb; };
struct StaticOrder {
  int vcu;
  __device__ __forceinline__ explicit StaticOrder(int grid,int block):vcu((block%8)*(grid/8)+block/8){}
  __device__ __forceinline__ bool next(int i,AttnUnit&u)const{ if(i>=4)return false; const int s=vcu&7; u.bh=vcu>>3; u.qb=(i==0)?s:(i==1)?15-s:(i==2)?16+s:31-s; return true; }
  __device__ __forceinline__ void a_ready(const AttnUnit&)const{}
  __device__ __forceinline__ void done(const AttnUnit&)const{}
};
template<class Sched,int THRL=8> __device__ __forceinline__ void attn_phase(char*lds,const AttnTensors&T,const Sched&S){
  AttnUnit u;
  for(int i=0;S.next(i,u);++i){ S.a_ready(u); attn_unit<THRL>(u.bh/NHEAD,u.bh%NHEAD,u.qb,T.Q,T.K,T.V,T.O,T.G+(long)u.bh*SEQ,lds); S.done(u); }
}
#undef SBAR
#undef WAIT_BAR
}
namespace fx {
struct EpiZ {
    static constexpr bool PERM = true, AFTER_DRAIN = false;
    bf16* Z; bf16* UP; float* NLF; const float* fbias;
    __device__ __forceinline__ void operator()(const pg8::f32x4 (&acc)[2][2][4][2], const pg8::Unit& u, int wr, int wc, int fr_, int fq_) const {
        int z_ = 0; asm volatile("" : "+v"(z_)); const int ln_ = __builtin_amdgcn_mbcnt_hi(~0u, __builtin_amdgcn_mbcnt_lo(~0u, z_)); const int fr = ln_ & 15, fq = ln_ >> 4; (void)fr_; (void)fq_;
        const int row0 = u.pm * 256 + wr * 64 + fr, col0 = wc * 32 + 8 * fq;
#pragma unroll
        for (int bj = 0; bj < 2; ++bj) {
            const int hb = u.pn * 2 + bj;
            const float sc = (hb < 3) ? C2 : 1.f;
            bf16* base = Z + ((size_t)row0 * NZ + hb * 128 + col0); size_t stride = (size_t)16 * NZ;
            if (hb == 9 || hb == 10) { const int sidx = (hb - 9) * 128 + col0, g = sidx >> 4, ch0 = sidx & 15;
                base = UP + ((size_t)(g * 2048 + (row0 >> 4)) * 384 + (row0 & 15) * 16 + ch0); stride = 384; }
#pragma unroll
            for (int ai = 0; ai < 2; ++ai)
#pragma unroll
                for (int m = 0; m < 4; ++m) { const pg8::f32x4 v0 = acc[ai][bj][m][0] * sc, v1 = acc[ai][bj][m][1] * sc;
                    v4u w; w.x = pk2(v0[0], v0[1]); w.y = pk2(v0[2], v0[3]); w.z = pk2(v1[0], v1[1]); w.w = pk2(v1[2], v1[3]);
                    *(GAS v4u*)(base + (size_t)(ai * 8 + m) * stride) = w; }
        }
        if (u.pn == 11 && col0 == 0) {
#pragma unroll
            for (int ai = 0; ai < 2; ++ai)
#pragma unroll
                for (int m = 0; m < 4; ++m) { const int r = row0 + ai * 128 + m * 16, b = r >> 12, t = r & 4095; float* o = NLF + (size_t)(b * 6) * 4096 + t;
                    o[0 * 4096] = nlf1(acc[ai][1][m][0][0] + fbias[0]); o[1 * 4096] = nlf1(acc[ai][1][m][0][1] + fbias[1]); o[2 * 4096] = nlf1(acc[ai][1][m][0][2] + fbias[2]);
                    o[3 * 4096] = nlf1(acc[ai][1][m][0][3] + fbias[3]); o[4 * 4096] = nlf1(acc[ai][1][m][1][0] + fbias[4]); o[5 * 4096] = nlf1(acc[ai][1][m][1][1] + fbias[5]); }
        }
    }
    static __device__ __forceinline__ float nlf1(float x) { return -LOG2E * (fminf(x, 0.f) - __logf(1.f + __expf(-fabsf(x)))); }
};
template <bool XF32> struct EpiRes {
    static constexpr bool PERM = true, AFTER_DRAIN = false;
    const void* X; bf16* out; const float* gate;
    __device__ __forceinline__ void operator()(const pg8::f32x4 (&acc)[2][2][4][2], const pg8::Unit& u, int wr, int wc, int fr_, int fq_) const {
        int z_ = 0; asm volatile("" : "+v"(z_)); const int ln_ = __builtin_amdgcn_mbcnt_hi(~0u, __builtin_amdgcn_mbcnt_lo(~0u, z_)); const int fr = ln_ & 15, fq = ln_ >> 4; (void)fr_; (void)fq_;
        const int row0 = u.pm * 256 + wr * 64 + fr, col0 = u.pn * 256 + wc * 32 + 8 * fq;
        const float* gb = gate + (size_t)(row0 >> 12) * 6144;
#pragma unroll
        for (int bj = 0; bj < 2; ++bj) { const int c = col0 + bj * 128; const pg8::f32x4 g0 = *(const GAS pg8::f32x4*)(gb + c), g1 = *(const GAS pg8::f32x4*)(gb + c + 4);
#pragma unroll
            for (int hq = 0; hq < 2; ++hq) {
                pg8::f32x4 x0[4], x1[4];
#pragma unroll
                for (int m = 0; m < 4; ++m) { const size_t off = (size_t)(row0 + hq * 128 + m * 16) * 1024 + c;
                    if (XF32) { x0[m] = *(const GAS pg8::f32x4*)((const float*)X + off); x1[m] = *(const GAS pg8::f32x4*)((const float*)X + off + 4); }
                    else { const v4u w = *(const GAS v4u*)((const bf16*)X + off); x0[m] = (pg8::f32x4){bflo(w.x), bfhi(w.x), bflo(w.y), bfhi(w.y)}; x1[m] = (pg8::f32x4){bflo(w.z), bfhi(w.z), bflo(w.w), bfhi(w.w)}; } }
                asm volatile("" ::: "memory");
#pragma unroll
                for (int m = 0; m < 4; ++m) { const size_t off = (size_t)(row0 + hq * 128 + m * 16) * 1024 + c;
                    const pg8::f32x4 o0 = x0[m] + g0 * acc[hq][bj][m][0], o1 = x1[m] + g1 * acc[hq][bj][m][1];
                    v4u ow; ow.x = pk2(o0[0], o0[1]); ow.y = pk2(o0[2], o0[3]); ow.z = pk2(o1[0], o1[1]); ow.w = pk2(o1[2], o1[3]); *(GAS v4u*)(out + off) = ow; }
                asm volatile("" ::: "memory"); } }
    }
};
}
namespace fx {
constexpr int MOE_ROWS = 40960, MOE_TILES = MOE_ROWS / 256, NCLS = 24;
constexpr size_t WS_TOKINFO = WS_HLOC + 8 * MiB;
constexpr size_t WS_CNT = WS_TOKINFO + (size_t)M * 16;
constexpr size_t WS_ROWTOK = WS_CNT + 256 * 32 * 4;
constexpr size_t WS_ROWW = WS_ROWTOK + (size_t)MOE_ROWS * 4;
constexpr size_t WS_TILECLS = WS_ROWW + (size_t)MOE_ROWS * 8;
constexpr size_t WS_H2S = WS_Z;
constexpr size_t WS_HID = WS_Z + (size_t)MOE_ROWS * 1024 * 2;
static_assert(WS_TILECLS + (MOE_TILES + 1) * 4 <= WS_END, "moe scratch fits");
static_assert(WS_HID + (size_t)MOE_ROWS * 512 * 2 <= WS_UP, "H2S + HID fit in the Z region");

__device__ __forceinline__ void cls_experts(int cls, int& e_lo, int& e_hi) {
    const int g = cls / 6, pr = cls % 6; const int lo = (pr < 3) ? 0 : (pr < 5 ? 1 : 2); const int hi = (pr < 3) ? pr + 1 : (pr < 5 ? pr - 1 : 3);
    e_lo = g * 4 + lo; e_hi = g * 4 + hi;
}
__device__ __forceinline__ void moe_route(const Params& p, int oz, int l, LAS unsigned char* lds, int tid, int lane, int wave, int bx, int G) {
    unsigned char* ws = p.ws + oz; constexpr int WP = 1032;
    LAS unsigned short* Whi = (LAS unsigned short*)lds; LAS unsigned short* Wlo = (LAS unsigned short*)(lds + 33024); LAS float* rstds = (LAS float*)(lds + 66048); LAS float* SR = (LAS float*)(lds + 66560); LAS int* hist = (LAS int*)(lds + 66624);
    const int tpw = M / G, t0 = bx * tpw, b = t0 >> 12; const float* mod = (const float*)(ws + WS_MOD) + l * 8 * 6144 + b * 6144; const float* nw = p.in[I_NFW + oz] + l * 1024; const float* rw = p.in[I_RW + oz]; const float* rb = p.in[I_RB + oz];
    for (int k = tid; k < 1024; k += NTHR) { const float a = nw[k] * (1.f + mod[4096 + k]);
#pragma unroll
        for (int q = 0; q < 4; ++q) { const f32x4 w4 = ((const GAS f32x4*)rw)[k * 4 + q];
#pragma unroll
            for (int e = 0; e < 4; ++e) { const float v = a * w4[e]; const unsigned hi = f2bf(v); const float r = v - __builtin_bit_cast(float, hi << 16); Whi[(4 * q + e) * WP + k] = (unsigned short)hi; Wlo[(4 * q + e) * WP + k] = (unsigned short)f2bf(r); } } }
    if (tid < 32) hist[tid] = 0;
    { float s0 = 0.f, s1 = 0.f;
        for (int k = lane; k < 1024; k += 64) { const float bv = mod[3072 + k]; s0 += bv * rw[k * 16 + 2 * wave]; s1 += bv * rw[k * 16 + 2 * wave + 1]; }
        s0 = wave_sum(s0, lane); s1 = wave_sum(s1, lane); if (lane == 0) { SR[2 * wave] = s0 + rb[2 * wave]; SR[2 * wave + 1] = s1 + rb[2 * wave + 1]; } }
    const bf16* X1 = (const bf16*)(ws + WS_XB); bf16* H = (bf16*)(ws + WS_H);
    f32x4 A[4], B[4]; adaln_factors(nw, mod + 3072, mod + 4096, lane, A, B);
    f32x4 v[4] = {}; if (wave < tpw) row_load_bf(X1, t0 + wave, lane, v);
    for (int r = wave; r < tpw; r += NWAVES) {
        const int row = t0 + r;
        f32x4 nxt[4] = {}; if (r + NWAVES < tpw) row_load_bf(X1, row + NWAVES, lane, nxt);
        float s = 0.f;
#pragma unroll
        for (int j = 0; j < 4; ++j) s += (v[j].x * v[j].x + v[j].y * v[j].y) + (v[j].z * v[j].z + v[j].w * v[j].w);
        const float rstd = __builtin_amdgcn_rsqf(wave_sum(s, lane) * (1.f / 1024.f) + 1e-6f); if (lane == 0) rstds[r] = rstd;
        GAS unsigned long long* o8 = (GAS unsigned long long*)(H + (size_t)row * 1024) + lane;
#pragma unroll
        for (int j = 0; j < 4; ++j) { const f32x4 h = (v[j] * rstd) * A[j] + B[j]; o8[64 * j] = (unsigned long long)pk2(h.x, h.y) | ((unsigned long long)pk2(h.z, h.w) << 32); }
#pragma unroll
        for (int j = 0; j < 4; ++j) v[j] = nxt[j];
    }
    __syncthreads();
    typedef short rbf16x8 __attribute__((ext_vector_type(8)));
    const int n = lane & 15, q = lane >> 4, tok = t0 + 16 * wave + n;
    f32x4 acc = {0.f, 0.f, 0.f, 0.f};
    const GAS rbf16x8* xrow = (const GAS rbf16x8*)(X1 + (size_t)tok * 1024 + 8 * q);
    const LAS unsigned short* ahi = Whi + n * WP + 8 * q; const LAS unsigned short* alo = Wlo + n * WP + 8 * q;
#pragma unroll 1
    for (int k0 = 0; k0 < 32; k0 += 8) { rbf16x8 xb[8];
#pragma unroll
        for (int u = 0; u < 8; ++u) xb[u] = xrow[(k0 + u) * 4];
#pragma unroll
        for (int u = 0; u < 8; ++u) { const rbf16x8 a1 = *(const LAS rbf16x8*)(ahi + (k0 + u) * 32), a2 = *(const LAS rbf16x8*)(alo + (k0 + u) * 32);
            acc = __builtin_amdgcn_mfma_f32_16x16x32_bf16(a1, xb[u], acc, 0, 0, 0); acc = __builtin_amdgcn_mfma_f32_16x16x32_bf16(a2, xb[u], acc, 0, 0, 0); } }
    const float rs = rstds[16 * wave + n]; float lg[4];
#pragma unroll
    for (int e = 0; e < 4; ++e) lg[e] = acc[e] * rs + SR[4 * q + e];
    float mx = fmaxf(fmaxf(lg[0], lg[1]), fmaxf(lg[2], lg[3])); mx = fmaxf(mx, lane_get(mx, lane ^ 16)); mx = fmaxf(mx, lane_get(mx, lane ^ 32));
    float sum = 0.f;
#pragma unroll
    for (int e = 0; e < 4; ++e) { lg[e] = __expf(lg[e] - mx); sum += lg[e]; }
    sum += lane_get(sum, lane ^ 16); sum += lane_get(sum, lane ^ 32); const float inv = 1.f / sum;
#pragma unroll
    for (int e = 0; e < 4; ++e) lg[e] *= inv;
    int i1 = 0; float v1 = lg[0];
#pragma unroll
    for (int i = 1; i < 4; ++i) if (lg[i] > v1) { v1 = lg[i]; i1 = i; }
    int i2 = -1; float v2 = -1.f;
#pragma unroll
    for (int i = 0; i < 4; ++i) if (i != i1 && lg[i] > v2) { v2 = lg[i]; i2 = i; }
    const float sc = v1 + v2;
    float bs = sc; int bq = q;
    { const float os = lane_get(bs, lane ^ 16); const int oq = __builtin_amdgcn_ds_bpermute((lane ^ 16) << 2, bq); if (os > bs || (os == bs && oq < bq)) { bs = os; bq = oq; } }
    { const float os = lane_get(bs, lane ^ 32); const int oq = __builtin_amdgcn_ds_bpermute((lane ^ 32) << 2, bq); if (os > bs || (os == bs && oq < bq)) { bs = os; bq = oq; } }
    if (bq == q) {
        const int lo = i1 < i2 ? i1 : i2, hi = i1 < i2 ? i2 : i1; const float w1 = v1 / (v1 + v2), w2 = v2 / (v1 + v2);
        const int cls = q * 6 + (lo * (7 - lo)) / 2 + (hi - lo - 1);
        const int rank = __hip_atomic_fetch_add(hist + cls, 1, __ATOMIC_RELAXED, __HIP_MEMORY_SCOPE_WORKGROUP);
        GAS f32x4* ti = (GAS f32x4*)(ws + WS_TOKINFO) + tok;
        *ti = (f32x4){__builtin_bit_cast(float, cls | (rank << 8)), i1 < i2 ? w1 : w2, i1 < i2 ? w2 : w1, 0.f};
    }
    __syncthreads();
    if (tid < 32) ((int*)(ws + WS_CNT))[bx * 32 + tid] = (tid < NCLS) ? hist[tid] : 0;
}
__device__ __forceinline__ void moe_gather(const Params& p, int oz, LAS unsigned char* lds, int tid, int lane, int wave, int bx, int G) {
    unsigned char* ws = p.ws + oz; LAS int* cl = (LAS int*)lds; LAS int* base = (LAS int*)(lds + 32768); LAS int* off = base + 32; LAS int* tot = off + 32;
    const int* cnt = (const int*)(ws + WS_CNT);
    for (int i = tid; i < G * 32; i += NTHR) cl[i] = cnt[i];
    __syncthreads();
    { LAS int* ps = tot + 32; const int c = tid & 31, part = tid >> 5; int s = 0, mine = 0; for (int w = part * (G / 16); w < (part + 1) * (G / 16); ++w) { if (w < bx) mine += cl[w * 32 + c]; s += cl[w * 32 + c]; } ps[part * 32 + c] = s; ps[512 + part * 32 + c] = mine; }
    __syncthreads();
    if (tid < NCLS) { LAS int* ps = tot + 32; int s = 0, mine = 0; for (int q = 0; q < 16; ++q) { s += ps[q * 32 + tid]; mine += ps[512 + q * 32 + tid]; } tot[tid] = s; off[tid] = mine; }
    __syncthreads();
    if (tid == 0) { int b = 0; for (int c = 0; c < NCLS; ++c) { base[c] = b; b += (tot[c] + 255) & ~255; } base[NCLS] = b; }
    __syncthreads();
    int* rowtok = (int*)(ws + WS_ROWTOK); float* roww = (float*)(ws + WS_ROWW);
    if (bx < NCLS) { const int c = bx, b0 = base[c], n = tot[c], b1 = base[c + 1];
        for (int r = b0 + n + tid; r < b1; r += NTHR) { rowtok[r] = -1; roww[2 * r] = (float)oz; roww[2 * r + 1] = (float)oz; }
        int* tc = (int*)(ws + WS_TILECLS); for (int t = b0 / 256 + tid; t < b1 / 256; t += NTHR) tc[t] = c;
        if (c == NCLS - 1 && tid == 0) tc[MOE_TILES] = b1 / 256; }
    const int tpw = M / G, t0 = bx * tpw;
    for (int r = tid; r < tpw; r += NTHR) { const int row = t0 + r; const f32x4 ti = ((const GAS f32x4*)(ws + WS_TOKINFO))[row]; const int cr = __builtin_bit_cast(int, ti.x), cls = cr & 255, rank = cr >> 8;
        const int pos = base[cls] + off[cls] + rank;
        rowtok[pos] = row; roww[2 * pos] = ti.y; roww[2 * pos + 1] = ti.z; }
}
struct ListOrder {
    const LAS int* list; int n;
    __device__ __forceinline__ bool next(int i, pg8::Unit& u) const { if (i >= n) return false; typedef int v4i_ __attribute__((ext_vector_type(4))); const v4i_ q = *(const LAS v4i_*)(list + 4 * i);
        u.pm = __builtin_amdgcn_readfirstlane(q.x); u.pn = __builtin_amdgcn_readfirstlane(q.y); u.k0 = __builtin_amdgcn_readfirstlane(q.z); u.k1 = __builtin_amdgcn_readfirstlane(q.w); return true; }
    __device__ __forceinline__ void a_ready(const pg8::Unit&) const {}
    __device__ __forceinline__ void done(const pg8::Unit&) const {}
};
template <bool DOWN>
__device__ __forceinline__ int moe_build_list(unsigned char* ws, LAS int* list, int tid, int bx, int G) {
    const int* tc = (const int*)(ws + WS_TILECLS);
    const int ntiles = __builtin_amdgcn_readfirstlane(((const GAS int*)tc)[MOE_TILES]); const int nunits = ntiles * 4; int n = 0;
    for (int L = bx; L < nunits; L += G) ++n;
    if (tid < n) { const int L = bx + tid * G, tile = L >> 2, j = L & 3; const int cls = ((const GAS int*)tc)[tile]; int e_lo, e_hi; cls_experts(cls, e_lo, e_hi);
        if (DOWN) { list[4 * tid] = tile; list[4 * tid + 1] = j; list[4 * tid + 2] = e_lo * 256; list[4 * tid + 3] = e_hi * 256; }
        else { list[4 * tid] = tile; list[4 * tid + 1] = (j < 2 ? e_lo : e_hi) * 2 + (j & 1); list[4 * tid + 2] = j; list[4 * tid + 3] = 0; } }
    __syncthreads();
    return n;
}
struct EpiHid {
    static constexpr bool PERM = true, AFTER_DRAIN = false;
    bf16* HID; const float* roww;
    __device__ __forceinline__ void operator()(const pg8::f32x4 (&acc)[2][2][4][2], const pg8::Unit& u, int wr, int wc, int fr_, int fq_) const {
        int z_ = 0; asm volatile("" : "+v"(z_)); const int ln_ = __builtin_amdgcn_mbcnt_hi(~0u, __builtin_amdgcn_mbcnt_lo(~0u, z_)); const int fr = ln_ & 15, fq = ln_ >> 4; (void)fr_; (void)fq_;
        const int row0 = u.pm * 256 + wr * 64 + fr, j = u.k0, col0 = j * 128 + wc * 32 + 8 * fq;
        float wq[8];
#pragma unroll
        for (int q = 0; q < 8; ++q) wq[q] = ((const GAS float*)roww)[2 * (row0 + (q >> 2) * 128 + (q & 3) * 16) + (j >> 1)];
        asm volatile("" ::: "memory");
#pragma unroll
        for (int ai = 0; ai < 2; ++ai)
#pragma unroll
            for (int m = 0; m < 4; ++m) { const int pos = row0 + ai * 128 + m * 16; const float w = wq[ai * 4 + m];
                float h[8];
#pragma unroll
                for (int n = 0; n < 2; ++n)
#pragma unroll
                    for (int e = 0; e < 4; ++e) { const float gt = acc[ai][0][m][n][e], up = acc[ai][1][m][n][e]; h[4 * n + e] = gt * fsigmoid(gt) * up * w; }
                v4u o; o.x = pk2(h[0], h[1]); o.y = pk2(h[2], h[3]); o.z = pk2(h[4], h[5]); o.w = pk2(h[6], h[7]);
                *(GAS v4u*)(HID + (size_t)pos * 512 + col0) = o; }
    }
};
struct EpiMoeOut {
    static constexpr bool PERM = true, AFTER_DRAIN = false;
    bf16* out; const float* gate; const int* rowtok;
    __device__ __forceinline__ void operator()(const pg8::f32x4 (&acc)[2][2][4][2], const pg8::Unit& u, int wr, int wc, int fr_, int fq_) const {
        int z_ = 0; asm volatile("" : "+v"(z_)); const int ln_ = __builtin_amdgcn_mbcnt_hi(~0u, __builtin_amdgcn_mbcnt_lo(~0u, z_)); const int fr = ln_ & 15, fq = ln_ >> 4; (void)fr_; (void)fq_;
        const int row0 = u.pm * 256 + wr * 64 + fr, col0 = u.pn * 256 + wc * 32 + 8 * fq;
        int tok[8];
#pragma unroll
        for (int q = 0; q < 8; ++q) tok[q] = ((const GAS int*)rowtok)[row0 + (q >> 2) * 128 + (q & 3) * 16];
#pragma unroll
        for (int hq = 0; hq < 2; ++hq)
#pragma unroll
            for (int bj = 0; bj < 2; ++bj) { const int c = col0 + bj * 128;
                v4u w[4] = {};
#pragma unroll
                for (int m = 0; m < 4; ++m) { const int tk = tok[hq * 4 + m]; if (tk >= 0) w[m] = *(const GAS v4u*)(out + (size_t)tk * 1024 + c); }
                asm volatile("" ::: "memory");
#pragma unroll
                for (int m = 0; m < 4; ++m) { const int tk = tok[hq * 4 + m];
                    if (tk >= 0) { const float* gb = gate + (size_t)(tk >> 12) * 6144 + c; const pg8::f32x4 g0 = *(const GAS pg8::f32x4*)gb, g1 = *(const GAS pg8::f32x4*)(gb + 4);
                        const pg8::f32x4 o0 = (pg8::f32x4){bflo(w[m].x), bfhi(w[m].x), bflo(w[m].y), bfhi(w[m].y)} + g0 * acc[hq][bj][m][0], o1 = (pg8::f32x4){bflo(w[m].z), bfhi(w[m].z), bflo(w[m].w), bfhi(w[m].w)} + g1 * acc[hq][bj][m][1];
                        v4u ow; ow.x = pk2(o0[0], o0[1]); ow.y = pk2(o0[2], o0[3]); ow.z = pk2(o1[0], o1[1]); ow.w = pk2(o1[2], o1[3]); *(GAS v4u*)(out + (size_t)tk * 1024 + c) = ow; } }
                asm volatile("" ::: "memory"); }
    }
};
}
namespace fx {
struct EpiS5Loc {
    static constexpr bool PERM = false, AFTER_DRAIN = false;
    float* LOC;
    __device__ __forceinline__ void operator()(const pg8::f32x4 (&acc)[2][2][4][2], const pg8::Unit& u, int wr, int wc, int fr_, int fq_) const {
        int z_ = 0; asm volatile("" : "+v"(z_)); const int ln_ = __builtin_amdgcn_mbcnt_hi(~0u, __builtin_amdgcn_mbcnt_lo(~0u, z_)); const int fr = ln_ & 15, fq = ln_ >> 4; (void)fr_; (void)fq_;
        const int row0 = u.pm * 256 + wr * 64 + fr, col0 = wc * 32 + 4 * fq;
#pragma unroll
        for (int n = 0; n < 2; ++n)
#pragma unroll
            for (int ai = 0; ai < 2; ++ai)
#pragma unroll
                for (int m = 0; m < 4; ++m) *(GAS pg8::f32x4*)(LOC + (size_t)(row0 + ai * 128 + m * 16) * 128 + col0 + n * 16) = acc[ai][0][m][n];
    }
};
__device__ __forceinline__ float gelu_tanh_f(float x) { const float u = 0.7978845608028654f * (x + 0.044715f * x * x * x); const float e = __builtin_amdgcn_exp2f(-2.f * LOG2E * u); return x * __builtin_amdgcn_rcpf(1.f + e); }
struct EpiS5Y {
    static constexpr bool PERM = true, AFTER_DRAIN = false;
    bf16* Y;
    __device__ __forceinline__ void operator()(const pg8::f32x4 (&acc)[2][2][4][2], const pg8::Unit& u, int wr, int wc, int fr_, int fq_) const {
        int z_ = 0; asm volatile("" : "+v"(z_)); const int ln_ = __builtin_amdgcn_mbcnt_hi(~0u, __builtin_amdgcn_mbcnt_lo(~0u, z_)); const int fr = ln_ & 15, fq = ln_ >> 4; (void)fr_; (void)fq_;
        const int g = u.pn, b = u.pm & 7, c0 = wr * 64 + fr;
#pragma unroll
        for (int bj = 0; bj < 2; ++bj) { const int n0 = bj * 128 + wc * 32 + 8 * fq, j = n0 >> 4, ch0 = n0 & 15;
#pragma unroll
            for (int ai = 0; ai < 2; ++ai)
#pragma unroll
                for (int m = 0; m < 4; ++m) { const int c = c0 + ai * 128 + m * 16; const pg8::f32x4 v0 = acc[ai][bj][m][0], v1 = acc[ai][bj][m][1];
                    v4u w; w.x = pk2(gelu_tanh_f(v0[0]), gelu_tanh_f(v0[1])); w.y = pk2(gelu_tanh_f(v0[2]), gelu_tanh_f(v0[3])); w.z = pk2(gelu_tanh_f(v1[0]), gelu_tanh_f(v1[1])); w.w = pk2(gelu_tanh_f(v1[2]), gelu_tanh_f(v1[3]));
                    *(GAS v4u*)(Y + ((size_t)(b * 4096 + c * 16 + j) * 256 + g * 16 + ch0)) = w; } }
    }
};
struct OneUnit { int pm, pn;
    __device__ __forceinline__ bool next(int i, pg8::Unit& u) const { if (i >= 1) return false; u.pm = pm; u.pn = pn; u.k0 = 0; u.k1 = 0; return true; }
    __device__ __forceinline__ void a_ready(const pg8::Unit&) const {}
    __device__ __forceinline__ void done(const pg8::Unit&) const {} };
__device__ __forceinline__ void s5_scan(unsigned char* ws, int l, int g, int b, int tid, LAS float* lds) {
    const int q = tid & 63, w = tid >> 6; const float* al = (const float*)(ws + WS_S5AL) + ((l * 16 + g) * 64 + q) * 2; const float ar = al[0], ai = al[1];
    const float* loc = (const float*)(ws + WS_LOC) + (size_t)(g * 2048 + b * 256 + 32 * w) * 128; bf16* up = (bf16*)(ws + WS_UP) + (size_t)(g * 2048 + b * 256 + 32 * w) * 384 + 256;
    float lr[32], li[32];
#pragma unroll
    for (int k = 0; k < 32; ++k) { lr[k] = loc[(size_t)k * 128 + q]; li[k] = loc[(size_t)k * 128 + 64 + q]; }
    float sr = 0.f, si = 0.f;
#pragma unroll
    for (int k = 0; k < 32; ++k) { const float nr = ar * sr - ai * si + lr[k], ni = ar * si + ai * sr + li[k]; lr[k] = sr; li[k] = si; sr = nr; si = ni; }
    lds[w * 128 + q] = sr; lds[w * 128 + 64 + q] = si;
    float pr = ar, pi = ai;
#pragma unroll
    for (int s = 0; s < 5; ++s) { const float nr = pr * pr - pi * pi, ni = 2.f * pr * pi; pr = nr; pi = ni; }
    __syncthreads();
    float br = 0.f, bi = 0.f;
    for (int w2 = 0; w2 < w; ++w2) { const float er = lds[w2 * 128 + q], ei = lds[w2 * 128 + 64 + q]; const float nr = pr * br - pi * bi + er, ni = pr * bi + pi * br + ei; br = nr; bi = ni; }
#pragma unroll
    for (int k = 0; k < 32; ++k) { up[(size_t)k * 384 + q] = (bf16)f2bf(lr[k] + br); up[(size_t)k * 384 + 64 + q] = (bf16)f2bf(li[k] + bi);
        const float nr = ar * br - ai * bi, ni = ar * bi + ai * br; br = nr; bi = ni; }
    asm volatile("s_waitcnt vmcnt(0)" ::: "memory");
    __syncthreads();
}
struct EpiGlu {
    static constexpr bool PERM = true, AFTER_DRAIN = true;
    const bf16* Y; const float* gb; const float* bnw; bf16* MIX;
    __device__ __forceinline__ void fused(pg8::f32x4 (&acc)[2][2][4][2], const pg8::Unit& u, int wr, int wc, int fr_, int fq_, PG8_LAS unsigned char* lds, int wid, int lane_) const {
        int z_ = 0; asm volatile("" : "+v"(z_)); const int ln_ = __builtin_amdgcn_mbcnt_hi(~0u, __builtin_amdgcn_mbcnt_lo(~0u, z_)); const int fr = ln_ & 15, fq = ln_ >> 4; (void)fr_; (void)fq_; (void)wid; (void)lane_;
        PG8_LAS float* P = (PG8_LAS float*)lds;
        const int row0 = u.pm * 256 + wr * 64 + fr, col0 = wc * 32 + 8 * fq;
        pg8::f32x4 bv[2][2];
#pragma unroll
        for (int bj = 0; bj < 2; ++bj) { bv[bj][0] = *(const GAS pg8::f32x4*)(gb + col0 + bj * 128); bv[bj][1] = *(const GAS pg8::f32x4*)(gb + col0 + bj * 128 + 4); }
#pragma unroll
        for (int ai = 0; ai < 2; ++ai)
#pragma unroll
            for (int m = 0; m < 4; ++m) { const int r = row0 + ai * 128 + m * 16; float s = 0.f;
#pragma unroll
                for (int bj = 0; bj < 2; ++bj) { const v4u yw = *(const GAS v4u*)(Y + (size_t)r * 256 + col0 + bj * 128);
                    pg8::f32x4 a0 = acc[ai][bj][m][0] + bv[bj][0], a1 = acc[ai][bj][m][1] + bv[bj][1];
                    a0[0] = bflo(yw.x) * fsigmoid(a0[0]); a0[1] = bfhi(yw.x) * fsigmoid(a0[1]); a0[2] = bflo(yw.y) * fsigmoid(a0[2]); a0[3] = bfhi(yw.y) * fsigmoid(a0[3]);
                    a1[0] = bflo(yw.z) * fsigmoid(a1[0]); a1[1] = bfhi(yw.z) * fsigmoid(a1[1]); a1[2] = bflo(yw.w) * fsigmoid(a1[2]); a1[3] = bfhi(yw.w) * fsigmoid(a1[3]);
                    acc[ai][bj][m][0] = a0; acc[ai][bj][m][1] = a1;
                    s += ((a0[0] * a0[0] + a0[1] * a0[1]) + (a0[2] * a0[2] + a0[3] * a0[3])) + ((a1[0] * a1[0] + a1[1] * a1[1]) + (a1[2] * a1[2] + a1[3] * a1[3])); }
                s += lane_get(s, ln_ ^ 16); s += lane_get(s, ln_ ^ 32);
                if (fq == 0) P[(wr * 64 + ai * 128 + m * 16 + fr) * 4 + wc] = s; }
        asm volatile("s_waitcnt lgkmcnt(0)" ::: "memory"); __builtin_amdgcn_s_barrier(); asm volatile("" ::: "memory");
        pg8::f32x4 wv[2][2];
#pragma unroll
        for (int bj = 0; bj < 2; ++bj) { wv[bj][0] = *(const GAS pg8::f32x4*)(bnw + col0 + bj * 128); wv[bj][1] = *(const GAS pg8::f32x4*)(bnw + col0 + bj * 128 + 4); }
        asm volatile("" ::: "memory");
#pragma unroll
        for (int ai = 0; ai < 2; ++ai)
#pragma unroll
            for (int m = 0; m < 4; ++m) { const int rl = wr * 64 + ai * 128 + m * 16 + fr, r = u.pm * 256 + rl; const PG8_LAS pg8::f32x4* pp = (const PG8_LAS pg8::f32x4*)(P + rl * 4); const pg8::f32x4 ps = *pp;
                const float rstd = __builtin_amdgcn_rsqf(((ps[0] + ps[1]) + (ps[2] + ps[3])) * (1.f / 256.f) + 1e-6f);
#pragma unroll
                for (int bj = 0; bj < 2; ++bj) { const pg8::f32x4 o0 = acc[ai][bj][m][0] * rstd * wv[bj][0], o1 = acc[ai][bj][m][1] * rstd * wv[bj][1];
                    v4u w; w.x = pk2(o0[0], o0[1]); w.y = pk2(o0[2], o0[3]); w.z = pk2(o1[0], o1[1]); w.w = pk2(o1[2], o1[3]); *(GAS v4u*)(MIX + (size_t)r * 1024 + 384 + col0 + bj * 128) = w; } }
    }
};
}
namespace fx {
constexpr int HG_NSEG = 8, HG_SEGTOK = SEQ / HG_NSEG, HG_CT = 32, HG_NCH = HG_SEGTOK / HG_CT;
constexpr size_t WS_HD = WS_HLOC + 7 * MiB;
typedef short hbf16x8 __attribute__((ext_vector_type(8)));
typedef float hf32x16 __attribute__((ext_vector_type(16)));
constexpr int HL_QT = 0, HL_KT = 4608, HL_KH = 9216, HL_VT = 14336, HL_PP = 19456, HL_ST = 22016, HL_DD = 31232, HL_TOT = 31488, HL_OO = 32512, HL_END = 41216;
constexpr int HP_QK = 72, HP_T = 40, HP_OO = 68;
__device__ __forceinline__ int hcrow(int r, int hi) { return (r & 3) + 8 * (r >> 2) + 4 * hi; }

template <bool FULL>
__device__ __forceinline__ void hgrn_pair(unsigned char* ws, const float* nw_l, int l, int u0, LAS unsigned char* lds_wg, const int wave00) {
    int wave0 = wave00; asm volatile("" : "+s"(wave0));
    const int lane = lane_now(), r32 = lane & 31, hi = lane >> 5, half = wave0 >> 2, hw = wave0 & 3, htid = hw * 64 + lane;
    constexpr int NS = FULL ? HG_NSEG : HG_NSEG - 1;
    const int unit = u0 + half, bh = unit / NS, seg = unit % NS, b = bh / 6, h = bh % 6; const int d = lane, sg = hw;
    LAS unsigned char* lds = lds_wg + half * HL_END;
    const bf16* Zb = (const bf16*)(ws + WS_Z) + (size_t)(b * SEQ + seg * HG_SEGTOK) * NZ + h * 64;
    const float lbv = ((const float*)(ws + WS_LB))[l * 384 + h * 64 + d], oml = 1.f - lbv;
    LAS unsigned short* QT = (LAS unsigned short*)(lds + HL_QT); LAS unsigned short* KT = (LAS unsigned short*)(lds + HL_KT);
    LAS unsigned short* KH = (LAS unsigned short*)(lds + HL_KH); LAS unsigned short* VT = (LAS unsigned short*)(lds + HL_VT);
    LAS unsigned short* PP = (LAS unsigned short*)(lds + HL_PP); LAS unsigned short* ST = (LAS unsigned short*)(lds + HL_ST);
    LAS float* DD = (LAS float*)(lds + HL_DD); LAS float* TOT = (LAS float*)(lds + HL_TOT); LAS float* OO = (LAS float*)(lds + HL_OO);
    const int dt = hw >> 1, vt = hw & 1;
    hf32x16 S;
#pragma unroll
    for (int r = 0; r < 16; ++r) S[r] = 0.f;
    if (FULL) {
        for (int j = 0; j < seg; ++j) { const float* loc = (const float*)(ws + WS_HLOC) + (size_t)(bh * HG_NSEG + j) * 4096; const float* hd = (const float*)(ws + WS_HD) + (bh * HG_NSEG + j) * 64;
#pragma unroll
            for (int r = 0; r < 16; ++r) { const int dd = 32 * dt + hcrow(r, hi); S[r] = S[r] * hd[dd] + loc[dd * 64 + 32 * vt + r32]; } }
#pragma unroll
        for (int j = 0; j < 4; ++j) { v2u w; w.x = pk2(S[4 * j], S[4 * j + 1]); w.y = pk2(S[4 * j + 2], S[4 * j + 3]); *(LAS v2u*)(ST + (32 * vt + r32) * HP_QK + 32 * dt + 8 * j + 4 * hi) = w; }
    }
    float lsum = 0.f;
    unsigned short rf[8] = {}, rv[8] = {}, rq[8] = {}; v4u rg = {};
    { const bf16* zr = Zb + (size_t)(8 * sg) * NZ;
#pragma unroll
        for (int i = 0; i < 8; ++i) { rf[i] = zr[(size_t)i * NZ + ZC_HF + d]; rv[i] = zr[(size_t)i * NZ + ZC_HI + d]; if (FULL) rq[i] = zr[(size_t)i * NZ + ZC_HQ + d]; }
        if (FULL) rg = *(const GAS v4u*)(Zb + (size_t)(htid >> 3) * NZ + ZC_HG + 8 * (htid & 7)); }
    for (int ch = 0; ch < HG_NCH; ++ch) {
        float lf[8], kk[8], qq[8], vv[8];
#pragma unroll
        for (int i = 0; i < 8; ++i) { const float z = bf2f(rf[i]); const float s1 = fsigmoid(z); lf[i] = __logf(lbv + oml * s1); kk[i] = oml * (1.f - s1);
            vv[i] = bf2f(rv[i]); if (FULL) qq[i] = fsilu(bf2f(rq[i])); }
        const v4u gw_ = rg;
        if (ch + 1 < HG_NCH) { const bf16* zr = Zb + (size_t)((ch + 1) * HG_CT + 8 * sg) * NZ;
#pragma unroll
            for (int i = 0; i < 8; ++i) { rf[i] = zr[(size_t)i * NZ + ZC_HF + d]; rv[i] = zr[(size_t)i * NZ + ZC_HI + d]; if (FULL) rq[i] = zr[(size_t)i * NZ + ZC_HQ + d]; }
            if (FULL) rg = *(const GAS v4u*)(Zb + (size_t)((ch + 1) * HG_CT + (htid >> 3)) * NZ + ZC_HG + 8 * (htid & 7)); }
#pragma unroll
        for (int i = 1; i < 8; ++i) lf[i] += lf[i - 1];
        TOT[sg * 64 + d] = lf[7];
        __syncthreads();
        float base = 0.f, blast = 0.f;
#pragma unroll
        for (int s2 = 0; s2 < 4; ++s2) { const float tv = TOT[s2 * 64 + d]; blast += tv; if (s2 < sg) base += tv; }
        lsum += blast;
        { float kh[8];
#pragma unroll
            for (int i = 0; i < 8; ++i) { const float bi = base + lf[i]; kh[i] = kk[i] * __expf(blast - bi);
                if (FULL) { const int t = 8 * sg + i; QT[t * HP_QK + d] = (unsigned short)f2bf(qq[i] * __expf(bi)); KT[t * HP_QK + d] = (unsigned short)f2bf(kk[i] * __expf(-bi)); } }
            v4u w; w.x = pk2(kh[0], kh[1]); w.y = pk2(kh[2], kh[3]); w.z = pk2(kh[4], kh[5]); w.w = pk2(kh[6], kh[7]); *(LAS v4u*)(KH + d * HP_T + 8 * sg) = w;
            v4u wv; wv.x = pk2(vv[0], vv[1]); wv.y = pk2(vv[2], vv[3]); wv.z = pk2(vv[4], vv[5]); wv.w = pk2(vv[6], vv[7]); *(LAS v4u*)(VT + d * HP_T + 8 * sg) = wv;
            if (sg == 0) DD[d] = __expf(blast); }
        __syncthreads();
        if (FULL && hw == 0) { hf32x16 c;
#pragma unroll
            for (int r = 0; r < 16; ++r) c[r] = 0.f;
#pragma unroll
            for (int ks = 0; ks < 4; ++ks) { const hbf16x8 a = *(const LAS hbf16x8*)(QT + r32 * HP_QK + 16 * ks + 8 * hi), bb = *(const LAS hbf16x8*)(KT + r32 * HP_QK + 16 * ks + 8 * hi); c = __builtin_amdgcn_mfma_f32_32x32x16_bf16(a, bb, c, 0, 0, 0); }
#pragma unroll
            for (int r = 0; r < 16; ++r) { const int t = hcrow(r, hi); PP[t * HP_T + r32] = (unsigned short)f2bf(r32 <= t ? c[r] : 0.f); } }
        {
#pragma unroll
            for (int r = 0; r < 16; ++r) S[r] *= DD[32 * dt + hcrow(r, hi)];
#pragma unroll
            for (int ks = 0; ks < 2; ++ks) { const hbf16x8 a = *(const LAS hbf16x8*)(KH + (32 * dt + r32) * HP_T + 16 * ks + 8 * hi), bb = *(const LAS hbf16x8*)(VT + (32 * vt + r32) * HP_T + 16 * ks + 8 * hi); S = __builtin_amdgcn_mfma_f32_32x32x16_bf16(a, bb, S, 0, 0, 0); } }
        if (FULL) {
            __syncthreads();
            if (hw == 1 || hw == 2) { const int ov = hw - 1; hf32x16 c;
#pragma unroll
                for (int r = 0; r < 16; ++r) c[r] = 0.f;
#pragma unroll
                for (int ks = 0; ks < 2; ++ks) { const hbf16x8 a = *(const LAS hbf16x8*)(PP + r32 * HP_T + 16 * ks + 8 * hi), bb = *(const LAS hbf16x8*)(VT + (32 * ov + r32) * HP_T + 16 * ks + 8 * hi); c = __builtin_amdgcn_mfma_f32_32x32x16_bf16(a, bb, c, 0, 0, 0); }
#pragma unroll
                for (int ks = 0; ks < 4; ++ks) { const hbf16x8 a = *(const LAS hbf16x8*)(QT + r32 * HP_QK + 16 * ks + 8 * hi), bb = *(const LAS hbf16x8*)(ST + (32 * ov + r32) * HP_QK + 16 * ks + 8 * hi); c = __builtin_amdgcn_mfma_f32_32x32x16_bf16(a, bb, c, 0, 0, 0); }
#pragma unroll
                for (int r = 0; r < 16; ++r) OO[hcrow(r, hi) * HP_OO + 32 * ov + r32] = c[r]; }
            __syncthreads();
#pragma unroll
            for (int j = 0; j < 4; ++j) { v2u w; w.x = pk2(S[4 * j], S[4 * j + 1]); w.y = pk2(S[4 * j + 2], S[4 * j + 3]); *(LAS v2u*)(ST + (32 * vt + r32) * HP_QK + 32 * dt + 8 * j + 4 * hi) = w; }
            { const int t = htid >> 3, vg = htid & 7; const f32x4 o0 = *(const LAS f32x4*)(OO + t * HP_OO + 8 * vg), o1 = *(const LAS f32x4*)(OO + t * HP_OO + 8 * vg + 4);
                float s = ((o0.x * o0.x + o0.y * o0.y) + (o0.z * o0.z + o0.w * o0.w)) + ((o1.x * o1.x + o1.y * o1.y) + (o1.z * o1.z + o1.w * o1.w));
                s += lane_get(s, lane ^ 1); s += lane_get(s, lane ^ 2); s += lane_get(s, lane ^ 4);
                const float rstd = __builtin_amdgcn_rsqf(s * (1.f / 64.f) + 1e-6f); const size_t row = (size_t)(b * SEQ + seg * HG_SEGTOK + ch * HG_CT + t);
                const f32x4 w0 = *(const GAS f32x4*)(nw_l + 8 * vg), w1 = *(const GAS f32x4*)(nw_l + 8 * vg + 4);
                v4u w; w.x = pk2(o0.x * rstd * w0.x * fsilu(bflo(gw_.x)), o0.y * rstd * w0.y * fsilu(bfhi(gw_.x))); w.y = pk2(o0.z * rstd * w0.z * fsilu(bflo(gw_.y)), o0.w * rstd * w0.w * fsilu(bfhi(gw_.y)));
                w.z = pk2(o1.x * rstd * w1.x * fsilu(bflo(gw_.z)), o1.y * rstd * w1.y * fsilu(bfhi(gw_.z))); w.w = pk2(o1.z * rstd * w1.z * fsilu(bflo(gw_.w)), o1.w * rstd * w1.w * fsilu(bfhi(gw_.w)));
                *(GAS v4u*)((bf16*)(ws + WS_H) + row * 1024 + 640 + h * 64 + 8 * vg) = w; }
        }
    }
    if (!FULL) {
        { float* loc = (float*)(ws + WS_HLOC) + (size_t)(bh * HG_NSEG + seg) * 4096;
#pragma unroll
            for (int r = 0; r < 16; ++r) loc[(32 * dt + hcrow(r, hi)) * 64 + 32 * vt + r32] = S[r]; }
        if (sg == 0) ((float*)(ws + WS_HD))[(bh * HG_NSEG + seg) * 64 + d] = __expf(lsum);
    }
    __syncthreads();
}
}
namespace fx {
constexpr int LDS_BYTES = 147456;
constexpr int RING_BYTES = 131072, LDSCTL_OFF = RING_BYTES, MISC_OFF = LDSCTL_OFF + 320;
constexpr int PH_PRO = 0, PH_FINAL = 21, NPH = 22;

struct QueueOrder {
    unsigned* ctr; LAS unsigned* slot;
    __device__ __forceinline__ bool next(int, attn_body::AttnUnit& u) const {
        if (threadIdx.x == 0) *slot = __hip_atomic_fetch_add(ctr, 1u, __ATOMIC_RELAXED, __HIP_MEMORY_SCOPE_AGENT);
        __syncthreads(); const unsigned v = *slot; __syncthreads();
        if (v >= 768u) return false; u.bh = (int)(v >> 4); u.qb = 15 - (int)(v & 15u); return true; }
    __device__ __forceinline__ void a_ready(const attn_body::AttnUnit&) const {}
    __device__ __forceinline__ void done(const attn_body::AttnUnit&) const {}
};

__global__ void __launch_bounds__(NTHR, 2) mk_fwd(Params p) {
    extern __shared__ __attribute__((aligned(16))) unsigned char lds_raw[];
    LAS unsigned char* lds = (LAS unsigned char*)lds_raw;
    const int wave0 = __builtin_amdgcn_readfirstlane(threadIdx.x >> 6);
    for (int u = threadIdx.x; u < (LDS_BYTES - LDSCTL_OFF) / 4; u += NTHR) ((LAS unsigned*)(lds + LDSCTL_OFF))[u] = 0u;
    __syncthreads();
    const XcdBarrier bar = xcd_barrier_post((unsigned*)(p.ws + WS_CTL) + 8192 + p.li * 4096, (volatile LAS unsigned*)(lds + MISC_OFF) + 8, threadIdx.x == 0);
#ifdef EXTRA_BARS
    for (int eb = 0; eb < EXTRA_BARS; ++eb) xcd_barrier(bar, wave0 == 0 && lane_now() == 0);
#endif
    for (int ph = p.ph_lo; ph < p.ph_hi; ++ph) {
#ifdef DUP_MASK
      for (int rep = (((DUP_MASK) >> ph) & 1u) ? 0 : 1; rep < 2; ++rep) {
#else
      { const int rep = 1;
#endif
#ifdef PROBE_MASK
        if (blockIdx.x == 0 && wave0 == 0 && lane_now() == 0) __hip_atomic_store((unsigned long long*)(p.ws + WS_CTL + 512 * 1024) + ph, __builtin_amdgcn_s_memrealtime(), __ATOMIC_RELAXED, __HIP_MEMORY_SCOPE_AGENT);
#endif
        int oz = 0; asm volatile("" : "+s"(oz));
        const int G = gridDim.x, bx = blockIdx.x + oz;
#define PHASE_IDS int wv_ = wave0; asm volatile("" : "+s"(wv_)); const int lane = lane_now(), wave = wv_, tid = wv_ * 64 + lane; \
        const int vcu = (G % 8 == 0) ? (bx % 8) * (G / 8) + bx / 8 : bx; const int gw = vcu * NWAVES + wave, ngw = G * NWAVES; (void)tid; (void)lane; (void)gw; (void)ngw;
        unsigned char* ws = p.ws + oz;
#define PIN(i) (p.in[(i) + oz])
        const int l = (ph - 1) / 10, sub = (ph - 1) % 10;
#ifndef EXP_NO_PRO
        if (ph == PH_PRO) { PHASE_IDS
            { LAS float* cact = (LAS float*)lds; const float* c = PIN(I_C); for (int i = tid; i < 8192; i += NTHR) { const float cv = c[i]; cact[i] = cv * fsigmoid(cv); } __syncthreads();
              for (int it = bx; it < 192; it += G) prologue_mod_item(p, oz, it, (LAS float*)lds, tid, lane, wave); }
            __syncthreads();
            for (int it = (G >= 224 ? bx - 192 : bx); it >= 0 && it < 32; it += G) prologue_s5_item(p, oz, it / 16, it % 16, (LAS float*)lds, tid);
            __syncthreads();
            prologue_wave_items(p, oz, (LAS float*)(lds + wave * 16384), gw, ngw, lane);
        } else
#endif
        if (ph == PH_FINAL) { PHASE_IDS
            float* X = p.out + oz; const bf16* XBp = (const bf16*)(ws + WS_XB); const float* w = PIN(I_FINW);
#ifdef PROBE_MASK
            float pscale = 1.f; { unsigned long long* tsb = (unsigned long long*)(ws + WS_CTL + 512 * 1024); unsigned long long t0 = __hip_atomic_load(tsb, __ATOMIC_RELAXED, __HIP_MEMORY_SCOPE_AGENT), tl = __hip_atomic_load(tsb + PH_FINAL, __ATOMIC_RELAXED, __HIP_MEMORY_SCOPE_AGENT); unsigned long long acc = 0;
#pragma unroll 1
                for (int k = 0; k < PH_FINAL; ++k) if ((PROBE_MASK >> k) & 1u) acc += __hip_atomic_load(tsb + k + 1, __ATOMIC_RELAXED, __HIP_MEMORY_SCOPE_AGENT) - __hip_atomic_load(tsb + k, __ATOMIC_RELAXED, __HIP_MEMORY_SCOPE_AGENT);
                pscale = 1.f + (float)acc / (float)(tl - t0); }
#endif
            f32x4 W4[4];
#pragma unroll
            for (int j = 0; j < 4; ++j) W4[j] = ((const GAS f32x4*)w)[lane + 64 * j];
            f32x4 v[4] = {}; if (gw < M) row_load_bf(XBp, gw, lane, v);
            for (int m = gw; m < M; m += ngw) { GAS f32x4* xr = (GAS f32x4*)(X + (size_t)m * 1024) + lane; f32x4 nxt[4] = {}; const int mn = m + ngw; if (mn < M) row_load_bf(XBp, mn, lane, nxt); float s = 0.f;
#pragma unroll
                for (int j = 0; j < 4; ++j) s += (v[j].x * v[j].x + v[j].y * v[j].y) + (v[j].z * v[j].z + v[j].w * v[j].w);
                const float rstd = __builtin_amdgcn_rsqf(wave_sum(s, lane) * (1.f / 1024.f) + 1e-6f);
#pragma unroll
                for (int j = 0; j < 4; ++j) { f32x4 o = (v[j] * rstd) * W4[j];
#ifdef PROBE_MASK
                    o = o * pscale;
#endif
                    xr[64 * j] = o; }
#pragma unroll
                for (int j = 0; j < 4; ++j) v[j] = nxt[j]; }
        }
#ifndef EXP_NO_ROW
        else if (sub == 0) { PHASE_IDS
            const float* X = PIN(I_X); const float* mod = (const float*)(ws + WS_MOD) + l * 8 * 6144;
            const int tpw = M / G, t0 = bx * tpw, b = t0 >> 12; f32x4 A[4], B[4]; adaln_factors(PIN(I_NMW) + l * 1024, mod + b * 6144, mod + b * 6144 + 1024, lane, A, B);
            const bf16* XBp = (const bf16*)(ws + WS_XB);
            f32x4 cur[4] = {}; if (wave < tpw) { if (l == 0) row_load(X, t0 + wave, lane, cur); else row_load_bf(XBp, t0 + wave, lane, cur); }
            for (int r = wave; r < tpw; r += NWAVES) { f32x4 nxt[4] = {}; if (r + NWAVES < tpw) { if (l == 0) row_load(X, t0 + r + NWAVES, lane, nxt); else row_load_bf(XBp, t0 + r + NWAVES, lane, nxt); }
                norm_row_to_bf16(cur, A, B, (bf16*)(ws + WS_H) + (size_t)(t0 + r) * 1024, lane);
#pragma unroll
                for (int j = 0; j < 4; ++j) cur[j] = nxt[j]; }
        }
#endif
        else if (sub == 1) {
            pg8::Gemm g{(const pg8::bf16_t*)(ws + WS_H), (const pg8::bf16_t*)(ws + WS_WIN) + (size_t)l * 3072 * 1024, M, NZ, 1024, 1024, 1024};
            pg8::StaticOrder S; S.init(M, NZ, G, bx);
            EpiZ E{(bf16*)(ws + WS_Z), (bf16*)(ws + WS_UP), (float*)(ws + WS_NLF), PIN(I_FOXB) + l * 6};
#ifdef EXP_EPI_BF16
            pg8::EpiBf16<0> E2{(bf16*)(ws + WS_Z), NZ, nullptr, 0, 0, 1.f};
            pg8::gemm_phase<pg8::EpiBf16<0>, pg8::StaticOrder, true, true>(lds, g, S, E2);
#else
            pg8::gemm_phase<EpiZ, pg8::StaticOrder, true, true>(lds, g, S, E, wave0);
#endif
        }
        else if (sub == 2) {
            unsigned* qctr = (unsigned*)(ws + WS_CTL) + 1024 + ph * 64 + rep * 32; LAS unsigned* qslot = (LAS unsigned*)(lds + MISC_OFF);
            constexpr unsigned NHL = 48u * (HG_NSEG - 1) / 2u;
            for (;;) {
                int ozq = 0; asm volatile("" : "+s"(ozq)); unsigned char* wsq = p.ws + ozq;
                if (wave0 == 0 && lane_now() == 0) *qslot = __hip_atomic_fetch_add(qctr, 1u, __ATOMIC_RELAXED, __HIP_MEMORY_SCOPE_AGENT);
                __syncthreads(); const unsigned v = __builtin_amdgcn_readfirstlane(*qslot); __syncthreads();
                if (v >= NHL + 128u + 48u + 768u) break;
                if (v < NHL) { hgrn_pair<false>(wsq, p.in[I_HNW + ozq] + l * 64, l, (int)(2u * v), lds, wave0); }
                else if (v < NHL + 128u) { const int u5 = (int)(v - NHL); const OneUnit S5{u5, u5 >> 3};
                    pg8::Gemm g5{(const pg8::bf16_t*)(wsq + WS_UP), (const pg8::bf16_t*)(wsq + WS_S5WL) + (size_t)l * 16 * 256 * 256, 16 * 2048, 16 * 256, 256, 384, 256}; EpiS5Loc E5{(float*)(wsq + WS_LOC)}; pg8::gemm_phase<EpiS5Loc, OneUnit, false, true>(lds, g5, S5, E5, wave0); __syncthreads(); }
                else if (v >= NHL + 128u + 48u) {
                    const int u = (int)(v - NHL - 128u - 48u), bh = u >> 4, qb = u & 15, b = bh / 6, h = bh % 6; int wv_ = wave0; asm volatile("" : "+s"(wv_)); const int lane = lane_now();
                    const bf16* Zr = (const bf16*)(wsq + WS_Z) + (size_t)(b * SEQ + qb * 256 + wv_ * 32) * NZ + h * 64; float kmax = 0.f, qmax = 0.f;
#pragma unroll
                    for (int i = 0; i < 8; ++i) { const bf16* rp = Zr + (size_t)(4 * i + (lane >> 4)) * NZ + 4 * (lane & 15); const v2u kw = *(const GAS v2u*)(rp + ZC_FK), qw = *(const GAS v2u*)(rp + ZC_FQ);
                        float ks = (bflo(kw.x) * bflo(kw.x) + bfhi(kw.x) * bfhi(kw.x)) + (bflo(kw.y) * bflo(kw.y) + bfhi(kw.y) * bfhi(kw.y)), qs = (bflo(qw.x) * bflo(qw.x) + bfhi(qw.x) * bfhi(qw.x)) + (bflo(qw.y) * bflo(qw.y) + bfhi(qw.y) * bfhi(qw.y));
                        ks += lane_get(ks, lane ^ 1); qs += lane_get(qs, lane ^ 1); ks += lane_get(ks, lane ^ 2); qs += lane_get(qs, lane ^ 2); ks += lane_get(ks, lane ^ 4); qs += lane_get(qs, lane ^ 4); ks += lane_get(ks, lane ^ 8); qs += lane_get(qs, lane ^ 8);
                        kmax = fmaxf(kmax, ks); qmax = fmaxf(qmax, qs); }
                    kmax = fmaxf(kmax, lane_get(kmax, lane ^ 16)); qmax = fmaxf(qmax, lane_get(qmax, lane ^ 16)); kmax = fmaxf(kmax, lane_get(kmax, lane ^ 32)); qmax = fmaxf(qmax, lane_get(qmax, lane ^ 32));
                    LAS float* red = (LAS float*)lds; if (lane == 0) { red[wv_] = kmax; red[8 + wv_] = qmax; }
                    __syncthreads();
                    if (wv_ == 0 && lane < 4) ((float*)(wsq + WS_KN))[bh * 64 + qb * 4 + lane] = fmaxf(red[2 * lane], red[2 * lane + 1]) * 1.02f;
                    if (wv_ == 0 && lane == 4) { float m = red[8]; for (int w = 1; w < 8; ++w) m = fmaxf(m, red[8 + w]); ((float*)(wsq + WS_QN))[bh * 16 + qb] = m * 1.02f; }
                    __syncthreads(); }
                else { const int bh = (int)(v - NHL - 128u); int wv_ = wave0; asm volatile("" : "+s"(wv_)); const int lane = lane_now(), wave = wv_, tid = wv_ * 64 + lane; LAS float* wsum = (LAS float*)lds;
                    const float* src = (const float*)(wsq + WS_NLF) + (size_t)bh * SEQ + tid * 8; float v8[8]; float s = 0.f;
                    const f32x4 a = *(const GAS f32x4*)src, b4 = *(const GAS f32x4*)(src + 4);
                    v8[0] = a.x; v8[1] = a.y; v8[2] = a.z; v8[3] = a.w; v8[4] = b4.x; v8[5] = b4.y; v8[6] = b4.z; v8[7] = b4.w;
#pragma unroll
                    for (int i = 0; i < 8; ++i) { s += v8[i]; v8[i] = s; }
                    float incl = s;
#pragma unroll
                    for (int o = 1; o < 64; o <<= 1) { const float n = lane_get(incl, lane - o); if (lane >= o) incl += n; }
                    if (lane == 63) wsum[wave] = incl;
                    __syncthreads();
                    float base = incl - s;
                    for (int w = 0; w < wave; ++w) base += wsum[w];
                    float* dst = (float*)(wsq + WS_G) + (size_t)bh * SEQ + tid * 8;
                    *(GAS f32x4*)dst = (f32x4){v8[0] + base, v8[1] + base, v8[2] + base, v8[3] + base}; *(GAS f32x4*)(dst + 4) = (f32x4){v8[4] + base, v8[5] + base, v8[6] + base, v8[7] + base};
                    __syncthreads(); }
            }
        }
        else if (sub == 3) {
            unsigned* qctr = (unsigned*)(ws + WS_CTL) + 1024 + ph * 64 + rep * 32; LAS unsigned* qslot = (LAS unsigned*)(lds + MISC_OFF);
            for (;;) {
                int ozq = 0; asm volatile("" : "+s"(ozq)); unsigned char* wsq = p.ws + ozq;
                if (wave0 == 0 && lane_now() == 0) *qslot = __hip_atomic_fetch_add(qctr, 1u, __ATOMIC_RELAXED, __HIP_MEMORY_SCOPE_AGENT);
                __syncthreads(); const unsigned v = __builtin_amdgcn_readfirstlane(*qslot); __syncthreads();
                constexpr unsigned NHF = 48u * HG_NSEG / 2u;
                if (v >= NHF + 128u + 768u) break;
#ifdef DUP_MASK
#ifndef DUP_CSEL
                if (rep == 0 && v >= NHF + 128u) break;
#else
                if (rep == 0 && DUP_CSEL != 3 && v >= NHF + 128u) break;
#endif
#ifdef DUP_CSEL
                if (rep == 0 && DUP_CSEL == 1 && v >= NHF) break;
                if (rep == 0 && DUP_CSEL == 2 && v < NHF) continue;
                if (rep == 0 && DUP_CSEL == 3 && v < NHF + 128u) continue;
#endif
#endif
                if (v < NHF) { hgrn_pair<true>(wsq, p.in[I_HNW + ozq] + l * 64, l, (int)(2u * v), lds, wave0); }
                else if (v < NHF + 128u) { const unsigned v5 = v - NHF;
                    s5_scan(wsq, l, (int)(v5 >> 3), (int)(v5 & 7u), wave0 * 64 + lane_now(), (LAS float*)lds);
                    pg8::Gemm g5{(const pg8::bf16_t*)(wsq + WS_UP), (const pg8::bf16_t*)(wsq + WS_S5WO) + (size_t)l * 16 * 256 * 384, 16 * 2048, 16 * 256, 384, 384, 384}; EpiS5Y E5{(bf16*)(wsq + WS_Y)};
                    const OneUnit S5{(int)v5, (int)(v5 >> 3)}; pg8::gemm_phase<EpiS5Y, OneUnit, false, false>(lds, g5, S5, E5, wave0); __syncthreads(); }
                else { const unsigned a = v - NHF - 128u; const int bh = (int)(a >> 4), qb = 15 - (int)(a & 15u);
                    const attn_body::bf16* Zq = (const attn_body::bf16*)(wsq + WS_Z);
                    int ts; { const int ln = lane_now(); const float* Gb = (const float*)(wsq + WS_G) + (size_t)bh * SEQ; const float* KN = (const float*)(wsq + WS_KN) + bh * 64; const float qn = ((const float*)(wsq + WS_QN))[bh * 16 + qb];
                        const float kd = fmaxf(fmaxf(KN[4 * qb], KN[4 * qb + 1]), fmaxf(KN[4 * qb + 2], KN[4 * qb + 3])); const float ub = __builtin_sqrtf(qn * KN[ln]) + Gb[64 * ln + 63] - Gb[256 * qb] + __builtin_sqrtf(qn * kd);
                        const unsigned long long need = __ballot((ln < 4 * qb) && !(ub < -36.f)); const int first = need ? (int)__builtin_ctzll(need) : 4 * qb; ts = __builtin_amdgcn_readfirstlane(first & ~1); }
                    attn_body::attn_unit<8>(bh / 6, bh % 6, qb, Zq + ZC_FQ, Zq + ZC_FK, Zq + ZC_FV, (attn_body::bf16*)(wsq + WS_Z) + ZC_FQ, (const float*)(wsq + WS_G) + (long)bh * SEQ, (char*)lds_raw, wave0, ts, rep != 0); }
            }
        }
        else if (sub == 4) { PHASE_IDS
            if (bx < 128) {
                pg8::Gemm gg{(const pg8::bf16_t*)(ws + WS_Y), (const pg8::bf16_t*)(ws + WS_GLU) + (size_t)l * 256 * 256, M, 256, 256, 256, 256};
                const OneUnit SG{bx, 0}; EpiGlu EG{(const bf16*)(ws + WS_Y), PIN(I_GLUB) + l * 256, PIN(I_BNS) + l * 256, (bf16*)(ws + WS_H)};
                pg8::gemm_phase<EpiGlu, OneUnit, false, true>(lds, gg, SG, EG, wave0);
            } else {
            const int gw2 = (bx - 128) * NWAVES + wave, ngw2 = (G - 128) * NWAVES;
            const bf16* Zb = (const bf16*)(ws + WS_Z); bf16* MIX = (bf16*)(ws + WS_H); const float* w = PIN(I_BNF) + l * 384;
            float wl[6];
#pragma unroll
            for (int i = 0; i < 6; ++i) wl[i] = w[lane * 6 + i];
            for (int m = gw2; m < M; m += ngw2) {
                const GAS unsigned* src = (const GAS unsigned*)(Zb + (size_t)m * NZ) + lane * 3; const unsigned a = src[0], b2 = src[1], c = src[2];
                float v[6] = {bflo(a), bfhi(a), bflo(b2), bfhi(b2), bflo(c), bfhi(c)}; float s = 0.f;
#pragma unroll
                for (int i = 0; i < 6; ++i) s += v[i] * v[i];
                const float rstd = __builtin_amdgcn_rsqf(wave_sum(s, lane) * (1.f / 384.f) + 1e-6f);
                GAS unsigned* dst = (GAS unsigned*)(MIX + (size_t)m * 1024) + lane * 3;
                dst[0] = pk2(v[0] * rstd * wl[0], v[1] * rstd * wl[1]); dst[1] = pk2(v[2] * rstd * wl[2], v[3] * rstd * wl[3]); dst[2] = pk2(v[4] * rstd * wl[4], v[5] * rstd * wl[5]);
            }
            }
        }
        else if (sub == 5) {
            pg8::Gemm g{(const pg8::bf16_t*)(ws + WS_H), (const pg8::bf16_t*)(ws + WS_WOUT) + (size_t)l * 1024 * 1024, M, 1024, 1024, 1024, 1024};
            pg8::StaticOrder S; S.init(M, 1024, G, bx);
            const float* gm = (const float*)(ws + WS_MOD) + l * 8 * 6144 + 2048;
            if (l == 0) { EpiRes<true> E{PIN(I_X), (bf16*)(ws + WS_XB), gm}; pg8::gemm_phase<EpiRes<true>, pg8::StaticOrder, true, true>(lds, g, S, E, wave0); }
            else { EpiRes<false> E{ws + WS_XB, (bf16*)(ws + WS_XB), gm}; pg8::gemm_phase<EpiRes<false>, pg8::StaticOrder, true, true>(lds, g, S, E, wave0); }
        }
        else if (sub == 6) { PHASE_IDS moe_route(p, oz, l, lds, tid, lane, wave, bx, G);
        }
        else if (sub == 7) { PHASE_IDS moe_gather(p, oz, lds, tid, lane, wave, bx, G);
        }
        else if (sub == 8) { PHASE_IDS
            LAS int* list = (LAS int*)(lds + RING_BYTES + 1024); const int n = moe_build_list<false>(ws, list, tid, bx, G);
            pg8::Gemm g{(const pg8::bf16_t*)(ws + WS_H), (const pg8::bf16_t*)(ws + WS_W1) + (size_t)l * 8192 * 1024, MOE_ROWS, 8192, 1024, 1024, 1024, (const int*)(ws + WS_ROWTOK)};
            ListOrder S{list, n}; EpiHid E{(bf16*)(ws + WS_HID), (const float*)(ws + WS_ROWW)};
            pg8::gemm_phase<EpiHid, ListOrder, true, true, false, true>(lds, g, S, E, wave0);
        }
        else if (sub == 9) { PHASE_IDS
            LAS int* list = (LAS int*)(lds + RING_BYTES + 1024); const int n = moe_build_list<true>(ws, list, tid, bx, G);
            pg8::Gemm g{(const pg8::bf16_t*)(ws + WS_HID), (const pg8::bf16_t*)(ws + WS_W2) + (size_t)l * 1024 * 4096, MOE_ROWS, 1024, 512, 512, 4096};
            ListOrder S{list, n}; EpiMoeOut E{(bf16*)(ws + WS_XB), (const float*)(ws + WS_MOD) + l * 8 * 6144 + 5 * 1024, (const int*)(ws + WS_ROWTOK)};
            pg8::gemm_phase<EpiMoeOut, ListOrder, false, true, true>(lds, g, S, E, wave0);
        }
        if (ph + 1 < p.ph_hi || rep == 0) xcd_barrier(bar, wave0 == 0 && lane_now() == 0); else __syncthreads();
      }
    }
}

static int g_grid = 0;
inline bool mk_setup() {
    if (g_grid) return g_grid > 0;
    int dev = 0, cus = 0;
    if (hipGetDevice(&dev) != hipSuccess || hipDeviceGetAttribute(&cus, hipDeviceAttributeMultiprocessorCount, dev) != hipSuccess) { g_grid = -1; return false; }
    if (hipFuncSetAttribute((const void*)mk_fwd, hipFuncAttributeMaxDynamicSharedMemorySize, LDS_BYTES) != hipSuccess) { fprintf(stderr, "hipFuncSetAttribute failed\n"); g_grid = -1; return false; }
    g_grid = cus; return true;
}
inline void mk_zero_ctl(void* d_ws, hipStream_t st) { (void)hipMemsetAsync((char*)d_ws + WS_CTL, 0, CTL_ZERO_BYTES, st); }
inline void mk_launch(void* const* d_in, void* d_out, void* d_ws, hipStream_t st, int lo, int hi, int li = 0) {
    if (!mk_setup()) return;
    Params p{}; for (int i = 0; i < 29; ++i) p.in[i] = (const float*)d_in[i]; p.out = (float*)d_out; p.ws = (unsigned char*)d_ws; p.ph_lo = lo; p.ph_hi = hi; p.li = li;
    hipLaunchKernelGGL(mk_fwd, dim3(g_grid), dim3(NTHR), LDS_BYTES, st, p);
}
}
extern "C" void kernel_launch(void* const* d_in, const int* in_sizes, int n_in, void* d_out, int out_size, void* d_ws, size_t ws_size, hipStream_t stream) {
    fx::mk_zero_ctl(d_ws, stream);
    fx::mk_launch(d_in, d_out, d_ws, stream, 0, 22, 0);
}
```

```cpp
#include <hip/hip_runtime.h>
#include <hip/hip_bf16.h>
#include <cstdio>
#include <cstdint>
#include <cmath>
namespace fx {
constexpr int BATCH = 8, SEQ = 4096, DM = 1024, M = BATCH * SEQ, NZ = 3072, NIN = 2950;
constexpr int NWAVES = 8, NTHR = 512;
constexpr float LOG2E = 1.4426950408889634f;
constexpr float C2 = 0.125f * LOG2E;
constexpr int ZC_FQ = 0, ZC_FK = 384, ZC_FV = 768, ZC_SU = 1152, ZC_HQ = 1408, ZC_HF = 1792, ZC_HI = 2176, ZC_HG = 2560, ZC_FF = 2944;
constexpr size_t MiB = 1u << 20;
constexpr size_t WS_CTL = 0, CTL_ZERO_BYTES = 1 * MiB;
constexpr size_t WS_MOD = 1 * MiB;
constexpr size_t WS_LB = WS_MOD + 512 * 1024;
constexpr size_t WS_S5AL = WS_LB + 4096;
constexpr size_t WS_NLF = 2 * MiB;
constexpr size_t WS_G = WS_NLF + 48 * 4096 * 4;
constexpr size_t WS_KN = WS_G + 48 * 4096 * 4;
constexpr size_t WS_QN = WS_KN + 48 * 64 * 4;
constexpr size_t WS_WIN = 4 * MiB;
constexpr size_t WS_WOUT = WS_WIN + 2ull * 3072 * 1024 * 2;
constexpr size_t WS_W1 = WS_WOUT + 2ull * 1024 * 1024 * 2;
constexpr size_t WS_W2 = WS_W1 + 2ull * 8192 * 1024 * 2;
constexpr size_t WS_GLU = WS_W2 + 2ull * 1024 * 4096 * 2;
constexpr size_t WS_S5WO = WS_GLU + 2ull * 256 * 256 * 2;
constexpr size_t WS_S5WL = WS_S5WO + 2ull * 16 * 256 * 384 * 2;
constexpr size_t WS_H = 80 * MiB;
constexpr size_t WS_Z = WS_H + (size_t)M * 1024 * 2;
constexpr size_t WS_UP = WS_Z + (size_t)M * NZ * 2;
constexpr size_t WS_LOC = WS_UP + 16ull * 2048 * 384 * 2;
constexpr size_t WS_Y = WS_LOC + 16ull * 2048 * 128 * 4;
constexpr size_t WS_HLOC = WS_Y + (size_t)M * 256 * 2;
constexpr size_t WS_XB = WS_HLOC + 16 * MiB;
constexpr size_t WS_END = WS_XB + (size_t)M * 1024 * 2;
static_assert(WS_S5WL + 2ull * 16 * 256 * 256 * 2 <= WS_H, "weights fit below H");
static_assert(WS_QN + 48 * 16 * 4 <= WS_WIN, "norm tables fit below the weights");
static_assert(WS_END <= 512 * MiB, "workspace fits 512 MiB");

#define GAS __attribute__((address_space(1)))
#define LAS __attribute__((address_space(3)))
typedef unsigned short bf16;
typedef unsigned v4u __attribute__((ext_vector_type(4)));
typedef unsigned v2u __attribute__((ext_vector_type(2)));
typedef float f32x4 __attribute__((ext_vector_type(4)));
typedef GAS unsigned gu32;
#define RLX_AGENT __ATOMIC_RELAXED, __HIP_MEMORY_SCOPE_AGENT
#define LDS_WAIT() asm volatile("s_waitcnt lgkmcnt(0)" ::: "memory")
#define VM_WAIT() asm volatile("s_waitcnt vmcnt(0)" ::: "memory")
__device__ __forceinline__ unsigned f2bf(float f) { unsigned u = __builtin_bit_cast(unsigned, f); return (u + 0x7fffu + ((u >> 16) & 1u)) >> 16; }
__device__ __forceinline__ unsigned pk2(float lo, float hi) { return f2bf(lo) | (f2bf(hi) << 16); }
__device__ __forceinline__ float bf2f(unsigned short h) { return __builtin_bit_cast(float, (unsigned)h << 16); }
__device__ __forceinline__ float bflo(unsigned w) { return __builtin_bit_cast(float, w << 16); }
__device__ __forceinline__ float bfhi(unsigned w) { return __builtin_bit_cast(float, w & 0xffff0000u); }
__device__ __forceinline__ float fsigmoid(float x) { return __builtin_amdgcn_rcpf(1.f + __builtin_amdgcn_exp2f(-LOG2E * x)); }
__device__ __forceinline__ float fsilu(float x) { return x * fsigmoid(x); }
__device__ __forceinline__ float lane_get(float v, int src_lane) { return __builtin_bit_cast(float, __builtin_amdgcn_ds_bpermute(src_lane << 2, __builtin_bit_cast(int, v))); }
__device__ __forceinline__ float wave_sum(float v, int  ) {
    v += __builtin_bit_cast(float, __builtin_amdgcn_update_dpp(0, __builtin_bit_cast(int, v), 0xB1, 0xF, 0xF, false));
    v += __builtin_bit_cast(float, __builtin_amdgcn_update_dpp(0, __builtin_bit_cast(int, v), 0x4E, 0xF, 0xF, false));
    v += __builtin_bit_cast(float, __builtin_amdgcn_update_dpp(0, __builtin_bit_cast(int, v), 0x141, 0xF, 0xF, false));
    v += __builtin_bit_cast(float, __builtin_amdgcn_update_dpp(0, __builtin_bit_cast(int, v), 0x140, 0xF, 0xF, false));
    v += __builtin_bit_cast(float, __builtin_amdgcn_update_dpp(0, __builtin_bit_cast(int, v), 0x142, 0xA, 0xF, false));
    v += __builtin_bit_cast(float, __builtin_amdgcn_update_dpp(0, __builtin_bit_cast(int, v), 0x143, 0xC, 0xF, false));
    return __builtin_bit_cast(float, __builtin_amdgcn_readlane(__builtin_bit_cast(int, v), 63));
}

__device__ __forceinline__ int lane_now() { int z = 0; asm volatile("" : "+v"(z)); return (int)__builtin_amdgcn_mbcnt_hi(~0u, __builtin_amdgcn_mbcnt_lo(~0u, (unsigned)z)); }

struct Params {
    const float* in[29]; float* out; unsigned char* ws; int ph_lo, ph_hi, li, pad;
};
enum { I_X = 0, I_C, I_ADAW, I_ADAB, I_NMW, I_NFW, I_WIN, I_FOXB, I_ARE, I_AIM, I_BRE, I_BIM, I_CRE, I_CIM, I_S5D, I_LOGDT, I_GLUW, I_GLUB, I_LBL, I_HNW, I_BNF, I_BNS, I_WOUT, I_RW, I_RB, I_WG, I_WU, I_WD, I_FINW };

__device__ __forceinline__ void transpose_item(const float* src, int ld_src, int c0, int nvalid, bf16* dst, int ldd, int k0, LAS float* scr, int lane) {
    if (nvalid == 32) {
        f32x4 tq[8];
#pragma unroll
        for (int i = 0; i < 8; ++i) tq[i] = *(const GAS f32x4*)(src + (size_t)(k0 + 8 * i + (lane >> 3)) * ld_src + c0 + 4 * (lane & 7));
#pragma unroll
        for (int i = 0; i < 8; ++i) { LAS float* d = scr + (8 * i + (lane >> 3)) * 33 + 4 * (lane & 7); d[0] = tq[i].x; d[1] = tq[i].y; d[2] = tq[i].z; d[3] = tq[i].w; }
    } else {
        float tv[32];
#pragma unroll
        for (int i = 0; i < 32; ++i) { const int kk = 2 * i + (lane >> 5), n = lane & 31; tv[i] = (n < nvalid) ? src[(size_t)(k0 + kk) * ld_src + c0 + n] : 0.f; }
#pragma unroll
        for (int i = 0; i < 32; ++i) { const int kk = 2 * i + (lane >> 5), n = lane & 31; scr[kk * 33 + n] = tv[i]; }
    }
    LDS_WAIT(); asm volatile("" ::: "memory");
    const int c = lane & 7;
#pragma unroll
    for (int j = 0; j < 4; ++j) { const int n = (lane >> 3) + 8 * j; const LAS float* s = scr + (8 * c) * 33 + n;
        v4u o; o.x = pk2(s[0 * 33], s[1 * 33]); o.y = pk2(s[2 * 33], s[3 * 33]); o.z = pk2(s[4 * 33], s[5 * 33]); o.w = pk2(s[6 * 33], s[7 * 33]);
        *(GAS v4u*)(dst + (size_t)n * ldd + k0 + 8 * c) = o; }
    LDS_WAIT(); asm volatile("" ::: "memory");
}
__device__ __forceinline__ int win_src_col(int n) {
    if (n < 1152) return n;
    if (n < 1408) return 1158 + (n - 1152);
    if (n < 2944) return 1414 + (n - 1408);
    if (n < 2950) return 1152 + (n - 2944);
    return -1;
}
__device__ __forceinline__ void prologue_wave_items(const Params& p, int oz, LAS float* scr, int gw_bx, int wave_, int lane) {
    unsigned char* ws = p.ws + oz;
    constexpr int IT_WIN = 2 * 16 * 96, IT_WOUT = 2 * 16 * 32, IT_W1 = 2 * 16 * 256, IT_W2 = 2 * 64 * 32, IT_GLU = 2 * 4 * 8;
    constexpr int NITEMS = IT_WIN + IT_WOUT + IT_W1 + IT_W2 + IT_GLU;
    const int bxw = gw_bx; int it0, itn; if (bxw < 192) { itn = 8; it0 = (bxw * 8 + wave_) * 8; } else if (bxw < 224) { itn = 6; it0 = 12288 + ((bxw - 192) * 8 + wave_) * 6; } else { itn = 13; it0 = 13824 + ((bxw - 224) * 8 + wave_) * 13; }
    for (int it = it0; it < it0 + itn && it < NITEMS; ++it) {
        int r = it;
        if (r < IT_WIN) { const int l = r / (16 * 96), q = r % (16 * 96), kb = q / 96, nb = q % 96, n0 = nb * 32; const int sc = win_src_col(n0);
            int nvalid = 32; if (sc < 0) nvalid = 0; else if (n0 == 2944) nvalid = 6;
            transpose_item(p.in[I_WIN + oz] + (size_t)l * 1024 * NIN, NIN, sc < 0 ? 0 : sc, nvalid, (bf16*)(ws + WS_WIN) + ((size_t)l * 3072 + n0) * 1024, 1024, kb * 64, scr, lane); continue; }
        r -= IT_WIN;
        if (r < IT_WOUT) { const int l = r / (16 * 32), q = r % (16 * 32), kb = q / 32, nb = q % 32;
            transpose_item(p.in[I_WOUT + oz] + (size_t)l * 1024 * 1024, 1024, nb * 32, 32, (bf16*)(ws + WS_WOUT) + ((size_t)l * 1024 + nb * 32) * 1024, 1024, kb * 64, scr, lane); continue; }
        r -= IT_WOUT;
        if (r < IT_W1) {
            const int l = r / (16 * 256), q = r % (16 * 256), kb = q / 256, nb = q % 256, n0 = nb * 32; const int e = n0 / 512, j = (n0 % 512) / 256, w = n0 % 256; const bool up = w >= 128; const int f0 = j * 128 + (w % 128);
            const float* src = (up ? p.in[I_WU + oz] : p.in[I_WG + oz]) + ((size_t)l * 16 + e) * 1024 * 256;
            transpose_item(src, 256, f0, 32, (bf16*)(ws + WS_W1) + ((size_t)l * 8192 + n0) * 1024, 1024, kb * 64, scr, lane); continue; }
        r -= IT_W1;
        if (r < IT_W2) { const int l = r / (64 * 32), q = r % (64 * 32), kb = q / 32, nb = q % 32;
            transpose_item(p.in[I_WD + oz] + (size_t)l * 4096 * 1024, 1024, nb * 32, 32, (bf16*)(ws + WS_W2) + ((size_t)l * 1024 + nb * 32) * 4096, 4096, kb * 64, scr, lane); continue; }
        r -= IT_W2;
        { const int l = r / 32, q = r % 32, kb = q / 8, nb = q % 8;
            transpose_item(p.in[I_GLUW + oz] + (size_t)l * 65536, 256, nb * 32, 32, (bf16*)(ws + WS_GLU) + ((size_t)l * 256 + nb * 32) * 256, 256, kb * 64, scr, lane); }
    }
    if (gw_bx == 255 && wave_ == 0) { float* lb = (float*)(ws + WS_LB); for (int j = lane; j < 384; j += 64) { const float a = p.in[I_LBL + oz][j], b = p.in[I_LBL + oz][384 + j], m = fmaxf(a, b), ea = __expf(a - m), eb = __expf(b - m); lb[j] = 0.f; lb[384 + j] = eb / (ea + eb); } }
}
__device__ __forceinline__ void prologue_mod_item(const Params& p, int oz, int item, LAS float* lds, int tid, int lane, int wave) {
    LAS float* cact = lds; LAS float* part = lds + 8192;
    const int l = item / 96, nb = item % 96, n = nb * 64 + lane; const float* W = p.in[I_ADAW + oz] + ((size_t)l * 1024 + wave * 128) * 6144 + n;
    float acc[8];
#pragma unroll
    for (int b = 0; b < 8; ++b) acc[b] = 0.f;
    for (int k0 = 0; k0 < 128; k0 += 16) { float w[16];
#pragma unroll
        for (int u = 0; u < 16; ++u) w[u] = W[(size_t)(k0 + u) * 6144];
#pragma unroll
        for (int u = 0; u < 16; ++u)
#pragma unroll
            for (int b = 0; b < 8; ++b) acc[b] += cact[b * 1024 + wave * 128 + k0 + u] * w[u]; }
#pragma unroll
    for (int b = 0; b < 8; ++b) part[(wave * 8 + b) * 64 + lane] = acc[b];
    __syncthreads();
    { const int b = tid >> 6; float s = 0.f;
#pragma unroll
        for (int w = 0; w < 8; ++w) s += part[(w * 8 + b) * 64 + lane];
        ((float*)(p.ws + oz + WS_MOD))[(l * 8 + b) * 6144 + n] = s + p.in[I_ADAB + oz][l * 6144 + n]; }
    __syncthreads();
}
__device__ __forceinline__ void prologue_s5_item(const Params& p, int oz, int l, int g, LAS float* lds, int tid) {
    LAS float* apr = lds;
    LAS float* api = lds + 17 * 64;
    LAS float* bbr = lds + 34 * 64;
    LAS float* bbi = bbr + 1024;
    LAS float* ccr = bbi + 1024;
    LAS float* cci = ccr + 1024;
    LAS float* Kt = cci + 1024;
    unsigned char* ws = p.ws + oz;
    if (tid < 64) { const int q = tid; const float dt = __expf(p.in[I_LOGDT + oz][l * 16 + g]); const float lr = p.in[I_ARE + oz][(l * 16 + g) * 64 + q], li = p.in[I_AIM + oz][(l * 16 + g) * 64 + q];
        for (int tau = 0; tau <= 16; ++tau) { const float er = expf(lr * dt * tau); float sn, cs; sincosf(li * dt * tau, &sn, &cs); apr[tau * 64 + q] = er * cs; api[tau * 64 + q] = er * sn; }
        const float ar = apr[64 + q], ai = api[64 + q]; const float nr = ar - 1.f, ni = ai, den = lr * lr + li * li; const float fr = (nr * lr + ni * li) / den, fi = (ni * lr - nr * li) / den;
        for (int c = 0; c < 16; ++c) { const float br = p.in[I_BRE + oz][((l * 16 + g) * 64 + q) * 16 + c], bi = p.in[I_BIM + oz][((l * 16 + g) * 64 + q) * 16 + c]; bbr[q * 16 + c] = fr * br - fi * bi; bbi[q * 16 + c] = fr * bi + fi * br;
            ccr[c * 64 + q] = p.in[I_CRE + oz][((l * 16 + g) * 16 + c) * 64 + q]; cci[c * 64 + q] = p.in[I_CIM + oz][((l * 16 + g) * 16 + c) * 64 + q]; }
        float* al = (float*)(ws + WS_S5AL) + ((l * 16 + g) * 64 + q) * 2; al[0] = apr[16 * 64 + q]; al[1] = api[16 * 64 + q];
    }
    __syncthreads();
    for (int idx = tid; idx < 4096; idx += NTHR) { const int tau = idx >> 8, c = (idx >> 4) & 15, c2 = idx & 15; float acc = 0.f;
        for (int q = 0; q < 64; ++q) { const float mr = ccr[c * 64 + q] * apr[tau * 64 + q] - cci[c * 64 + q] * api[tau * 64 + q], mi = ccr[c * 64 + q] * api[tau * 64 + q] + cci[c * 64 + q] * apr[tau * 64 + q];
            acc += mr * bbr[q * 16 + c2] - mi * bbi[q * 16 + c2]; }
        if (tau == 0 && c == c2) acc += p.in[I_S5D + oz][(l * 16 + g) * 16 + c];
        Kt[idx] = acc; }
    __syncthreads();
    bf16* WO = (bf16*)(ws + WS_S5WO) + (size_t)(l * 16 + g) * 256 * 384; bf16* WL = (bf16*)(ws + WS_S5WL) + (size_t)(l * 16 + g) * 256 * 256;
    for (int ch = tid; ch < 256 * 48; ch += NTHR) { const int n = ch / 48, k0 = (ch % 48) * 8, j = n >> 4, c = n & 15; float v[8];
#pragma unroll
        for (int e = 0; e < 8; ++e) { const int k = k0 + e; float val;
            if (k < 256) { const int i = k >> 4, c2 = k & 15; val = (j >= i) ? Kt[((j - i) << 8) + (c << 4) + c2] : 0.f; }
            else { const int q = (k - 256) & 63; const float pr = apr[(j + 1) * 64 + q], pi = api[(j + 1) * 64 + q], cr = ccr[c * 64 + q], ci = cci[c * 64 + q];
                val = (k - 256 < 64) ? (cr * pr - ci * pi) : -(cr * pi + ci * pr); }
            v[e] = val; }
        v4u o; o.x = pk2(v[0], v[1]); o.y = pk2(v[2], v[3]); o.z = pk2(v[4], v[5]); o.w = pk2(v[6], v[7]);
        *(GAS v4u*)(WO + (size_t)n * 384 + k0) = o; }
    for (int ch = tid; ch < 256 * 32; ch += NTHR) { const int n = ch / 32, k0 = (ch % 32) * 8; float v[8];
#pragma unroll
        for (int e = 0; e < 8; ++e) { const int k = k0 + e, i = k >> 4, c2 = k & 15; float val = 0.f;
            if (n < 128) { const int q = n & 63; const float pr = apr[(15 - i) * 64 + q], pi = api[(15 - i) * 64 + q], br = bbr[q * 16 + c2], bi = bbi[q * 16 + c2]; val = (n < 64) ? (pr * br - pi * bi) : (pr * bi + pi * br); }
            v[e] = val; }
        v4u o; o.x = pk2(v[0], v[1]); o.y = pk2(v[2], v[3]); o.z = pk2(v[4], v[5]); o.w = pk2(v[6], v[7]);
        *(GAS v4u*)(WL + (size_t)n * 256 + k0) = o; }
    __syncthreads();
}
__device__ __forceinline__ void row_load(const float* X, int m, int lane, f32x4 (&v)[4]) { const GAS f32x4* xr = (const GAS f32x4*)(X + (size_t)m * 1024) + lane;
#pragma unroll
    for (int j = 0; j < 4; ++j) v[j] = xr[64 * j]; }
__device__ __forceinline__ void row_load_bf(const bf16* X, int m, int lane, f32x4 (&v)[4]) { const GAS v2u* xr = (const GAS v2u*)(X + (size_t)m * 1024) + lane;
#pragma unroll
    for (int j = 0; j < 4; ++j) { const v2u w = xr[64 * j]; v[j] = (f32x4){bflo(w.x), bfhi(w.x), bflo(w.y), bfhi(w.y)}; } }
__device__ __forceinline__ void adaln_factors(const float* w, const float* sh, const float* sc, int lane, f32x4 (&A)[4], f32x4 (&B)[4]) {
#pragma unroll
    for (int j = 0; j < 4; ++j) { const f32x4 ww = ((const GAS f32x4*)w)[lane + 64 * j], a = ((const GAS f32x4*)sc)[lane + 64 * j]; A[j] = ww * (a + 1.f); B[j] = ((const GAS f32x4*)sh)[lane + 64 * j]; } }
__device__ __forceinline__ void norm_row_to_bf16(f32x4 (&v)[4], const f32x4 (&A)[4], const f32x4 (&B)[4], bf16* orow, int lane) {
    float s = 0.f;
#pragma unroll
    for (int j = 0; j < 4; ++j) s += (v[j].x * v[j].x + v[j].y * v[j].y) + (v[j].z * v[j].z + v[j].w * v[j].w);
    const float rstd = __builtin_amdgcn_rsqf(wave_sum(s, lane) * (1.f / 1024.f) + 1e-6f);
    GAS unsigned long long* o8 = (GAS unsigned long long*)orow + lane;
#pragma unroll
    for (int j = 0; j < 4; ++j) { const f32x4 h = (v[j] * rstd) * A[j] + B[j]; v[j] = h;
        o8[64 * j] = (unsigned long long)pk2(h.x, h.y) | ((unsigned long long)pk2(h.z, h.w) << 32); }
}
}
namespace fx {
#define XB_TMO      128
#define XB_XCNT(j)  (256  + 64 * (j))
#define XB_XSUB(j)  (1280 + 64 * (j))
#define XB_XGEN(j)  (2304 + 64 * (j))
#define XB_TOP      3328
#define XB_TOPGEN   3392
#define XCD_BAR_WORDS 3456
#define XB_SPIN_CAP (1u << 18)

__device__ __forceinline__ unsigned xb_ld(unsigned* p)              { return __hip_atomic_load(p, __ATOMIC_RELAXED, __HIP_MEMORY_SCOPE_AGENT); }
__device__ __forceinline__ unsigned xb_add(unsigned* p, unsigned v) { return __hip_atomic_fetch_add(p, v, __ATOMIC_RELAXED, __HIP_MEMORY_SCOPE_AGENT); }
__device__ __forceinline__ unsigned xb_xcc_id() { return (unsigned)__builtin_amdgcn_s_getreg((3 << 11) | 20) & 0xFu; }
#define XB_SPIN(cond, bar) do { unsigned _sp = 0; while (cond) { __builtin_amdgcn_s_sleep(1); \
    if ((++_sp & 255u) == 0u) { if (xb_ld(&(bar)[XB_TMO])) break; if (_sp > XB_SPIN_CAP) { atomicAdd(&(bar)[XB_TMO], 1u); break; } } } } while (0)

struct XcdBarrier {
    unsigned* bar; unsigned x;
    volatile LAS unsigned* st;
};

__device__ __forceinline__ XcdBarrier xcd_barrier_post(unsigned* bar, volatile LAS unsigned* st, bool leader) {
    XcdBarrier b; b.bar = bar; b.x = xb_xcc_id(); b.st = st;
    if (leader) (void)xb_add(&bar[XB_XCNT(b.x)], 1u);
    return b;
}
__device__ __forceinline__ void xcd_barrier_complete(unsigned* bar, unsigned x, unsigned& nloc, unsigned& nx) {
    const unsigned G = gridDim.x * gridDim.y * gridDim.z;
    asm volatile("" : "+s"(x));
    unsigned sum, cnt, mine, sp = 0u;
    for (;;) {
        sum = 0u; cnt = 0u; mine = 0u;
#pragma unroll
        for (unsigned j = 0; j < 16; ++j) { const unsigned c = xb_ld(&bar[XB_XCNT(j)]); sum += c; cnt += (c > 0u) ? 1u : 0u; mine = (j == x) ? c : mine; }
        if (sum == G) break;
        __builtin_amdgcn_s_sleep(1);
        if ((++sp & 255u) == 0u) { if (xb_ld(&bar[XB_TMO])) break; if (sp > XB_SPIN_CAP) { atomicAdd(&bar[XB_TMO], 1u); break; } }
    }
    nloc = mine > 0u ? mine : 1u; nx = cnt > 0u ? cnt : 1u;
}

__device__ __forceinline__ void xcd_barrier(const XcdBarrier& b, bool leader) {
    asm volatile("s_waitcnt vmcnt(0)" ::: "memory");
    __syncthreads();
    if (leader) {
        unsigned* bar = b.bar;
        __builtin_amdgcn_s_waitcnt(0);
        unsigned nloc = b.st[0], nx = b.st[1];
        if (nloc == 0u) { xcd_barrier_complete(bar, b.x, nloc, nx); b.st[0] = nloc; b.st[1] = nx; }
        const unsigned old = xb_add(&bar[XB_XSUB(b.x)], 1u);
        const unsigned gen = old / nloc;
        if (old + 1u == (gen + 1u) * nloc) {
            __builtin_amdgcn_fence(__ATOMIC_RELEASE, "agent");
            asm volatile("s_waitcnt vmcnt(0)" ::: "memory");
            const unsigned og = xb_add(&bar[XB_TOP], 1u);
            const unsigned tg = og / nx;
            if (og + 1u == (tg + 1u) * nx) xb_add(&bar[XB_TOPGEN], 1u);
            else XB_SPIN(xb_ld(&bar[XB_TOPGEN]) == tg, bar);
            __builtin_amdgcn_fence(__ATOMIC_ACQUIRE, "agent");
            xb_add(&bar[XB_XGEN(b.x)], 1u);
            asm volatile("s_waitcnt vmcnt(0)" ::: "memory");
        } else {
            XB_SPIN(xb_ld(&bar[XB_XGEN(b.x)]) == gen, bar);
            __builtin_amdgcn_fence(__ATOMIC_ACQUIRE, "agent");
            asm volatile("s_waitcnt vmcnt(0)" ::: "memory");
        }
    }
    __syncthreads();
}

}
namespace pg8 {
#define PG8_LAS __attribute__((address_space(3)))
typedef unsigned short bf16_t;
typedef short bf16x8 __attribute__((ext_vector_type(8)));
typedef float f32x4 __attribute__((ext_vector_type(4)));
typedef unsigned u32x4 __attribute__((ext_vector_type(4)));
constexpr int BM = 256, BK = 64, HALF = 128, HTB = HALF * BK * 2  , STAGE_BYTES = 8 * HTB, NXCD = 8, WGM = 8;

__host__ __device__ __forceinline__ int lds_byte(int r, int c) { const int st = (r >> 4) * 2 + (c >> 5), rr = r & 15, cc = c & 31, ob = rr * 64 + cc * 2; return st * 1024 + (ob ^ (((ob >> 9) & 1) << 5)); }
__host__ __device__ __forceinline__ void stage_rc(int b, int& R, int& C) { const int st = b / 1024, sb = b % 1024, swz = sb ^ (((sb >> 9) & 1) << 5); R = (st >> 1) * 16 + swz / 64; C = (st & 1) * 32 + (swz % 64) / 2; }
__host__ __device__ __forceinline__ int perm32(int rho) { const int n = rho >> 4, i = rho & 15; return 8 * (i >> 2) + 4 * n + (i & 3); }

struct Unit { int pm, pn; int k0, k1; };
struct Gemm { const bf16_t* A; const bf16_t* Bt; int M, N, K, lda, ldb; const int* rowidx; };

struct StaticOrder {
    int nM, nN, nwg, G, c;
    __host__ __device__ void init(int M, int N, int G_, int c_) { nM = M / BM; nN = N / BM; nwg = nM * nN; G = G_; c = c_; }
    __host__ __device__ bool next(int i, Unit& u) const {
        const long L = (long)i * G + c; if (L >= nwg) return false;
        int wgid = (int)L; { const int q = nwg / NXCD, r = nwg % NXCD, xcd = wgid % NXCD, off = wgid / NXCD; wgid = (xcd < r ? xcd * (q + 1) : r * (q + 1) + (xcd - r) * q) + off; }
        const int nig = WGM * nN, gid = wgid / nig, fm = gid * WGM, gsz = (nM - fm) < WGM ? (nM - fm) : WGM;
        u.pm = fm + ((wgid % nig) % gsz); u.pn = (wgid % nig) / gsz; return true;
    }
    __device__ __forceinline__ void a_ready(const Unit&) const {}
    __device__ __forceinline__ void done(const Unit&) const {}
};

__device__ __forceinline__ unsigned cvt_pk_bf16(float lo, float hi) { unsigned r; asm volatile("v_cvt_pk_bf16_f32 %0, %1, %2" : "=v"(r) : "v"(lo), "v"(hi)); return r; }
typedef float f32x2 __attribute__((ext_vector_type(2)));
__device__ __forceinline__ f32x2 gelu_pk(f32x2 v) {
    const f32x2 av = __builtin_elementwise_abs(v), d = av * 0.2316418882f + 1.0f;
    f32x2 t; t.x = __builtin_amdgcn_rcpf(d.x); t.y = __builtin_amdgcn_rcpf(d.y);
    f32x2 q = t * 0.5307027145f + (-0.7265760135f); q = q * t + 0.7107068705f; q = q * t + (-0.142248368f); q = q * t + 0.127414796f; q = q * t;
    const f32x2 s = (v * v) * (-0.72134752044f);
    f32x2 e; e.x = __builtin_amdgcn_exp2f(s.x); e.y = __builtin_amdgcn_exp2f(s.y);
    const f32x2 m = v * (q * e), r = v - m;
    f32x2 o; o.x = v.x < 0.f ? m.x : r.x; o.y = v.y < 0.f ? m.y : r.y; return o;
}

template <int ACT  > struct EpiBf16 {
    static constexpr bool PERM = true, AFTER_DRAIN = false; static_assert(ACT == 0 || ACT == 1, "EpiBf16: ACT is 0 (none) or 1 (gelu_pk)");
    bf16_t* O; int ldc; const float* bias; int split_cols; size_t split_stride; float scale0;
    __device__ __forceinline__ void operator()(const f32x4 (&acc)[2][2][4][2], const Unit& u, int wr, int wc, int fr, int fq) const {
        const int row0 = u.pm * BM + wr * 64 + fr; int colt = u.pn * BM; bf16_t* base = O;
        float sc = 1.f; if (split_cols) { const int t = colt / split_cols; base += (size_t)t * split_stride; colt -= t * split_cols; if (t == 0) sc = scale0; }
        const int col0 = colt + wc * 32 + 8 * fq, bcol0 = u.pn * BM + wc * 32 + 8 * fq;
        f32x4 bv[2][2];
#pragma unroll
        for (int bj = 0; bj < 2; ++bj)
#pragma unroll
            for (int n = 0; n < 2; ++n) bv[bj][n] = bias ? *(const f32x4*)(bias + bcol0 + bj * HALF + 4 * n) : (f32x4){0.f, 0.f, 0.f, 0.f};
#pragma unroll
        for (int ai = 0; ai < 2; ++ai)
#pragma unroll
            for (int m = 0; m < 4; ++m) { bf16_t* rowp = base + (size_t)(row0 + ai * HALF + m * 16) * ldc + col0;
#pragma unroll
                for (int bj = 0; bj < 2; ++bj) { f32x4 v0 = acc[ai][bj][m][0] + bv[bj][0], v1 = acc[ai][bj][m][1] + bv[bj][1];
                    if (ACT == 1) { f32x2 a = gelu_pk((f32x2){v0[0], v0[1]}), b = gelu_pk((f32x2){v0[2], v0[3]}), c = gelu_pk((f32x2){v1[0], v1[1]}), d = gelu_pk((f32x2){v1[2], v1[3]});
                        v0 = (f32x4){a.x, a.y, b.x, b.y}; v1 = (f32x4){c.x, c.y, d.x, d.y}; }
                    v0 = v0 * sc; v1 = v1 * sc; u32x4 w; w.x = cvt_pk_bf16(v0[0], v0[1]); w.y = cvt_pk_bf16(v0[2], v0[3]); w.z = cvt_pk_bf16(v1[0], v1[1]); w.w = cvt_pk_bf16(v1[2], v1[3]);
                    *(u32x4*)(rowp + bj * HALF) = w; } }
    }
};

struct PanelStats {
    unsigned* xbuf;
    unsigned* cnt;
    unsigned* tmo;
    int ntn; float eps;
    unsigned code;
    __device__ __forceinline__ bool run(const f32x4 (&v)[2][2][4][2], const Unit& u, int wr, int wc, int fr, int fq, PG8_LAS unsigned char* lds, int wid, int lane) const {
        typedef float f32x2v __attribute__((ext_vector_type(2)));
        PG8_LAS f32x2v* P = (PG8_LAS f32x2v*)lds;
        PG8_LAS f32x2v* S = (PG8_LAS f32x2v*)(lds + 8192);
        PG8_LAS unsigned* flag = (PG8_LAS unsigned*)(lds + 8192 + 2048);
#pragma unroll
        for (int ai = 0; ai < 2; ++ai)
#pragma unroll
            for (int m = 0; m < 4; ++m) {
                float s = 0.f;
#pragma unroll
                for (int bj = 0; bj < 2; ++bj)
#pragma unroll
                    for (int n = 0; n < 2; ++n) { const f32x4 x = v[ai][bj][m][n]; s += (x[0] + x[1]) + (x[2] + x[3]); }
                s += __shfl_xor(s, 16); s += __shfl_xor(s, 32);
                const float mw = s * (1.0f / 64.0f); float q = 0.f;
#pragma unroll
                for (int bj = 0; bj < 2; ++bj)
#pragma unroll
                    for (int n = 0; n < 2; ++n) { const f32x4 d = v[ai][bj][m][n] - mw; q += (d[0] * d[0] + d[1] * d[1]) + (d[2] * d[2] + d[3] * d[3]); }
                q += __shfl_xor(q, 16); q += __shfl_xor(q, 32);
                if (fq == 0) P[(ai * HALF + wr * 64 + m * 16 + fr) * 4 + wc] = (f32x2v){mw, q};
            }
        asm volatile("s_waitcnt lgkmcnt(0)" ::: "memory"); __builtin_amdgcn_s_barrier(); asm volatile("" ::: "memory");
#if defined(BROKEN_EXCHANGE_NO_WAIT)
#warning BROKEN CONTROL BUILD: the row-statistics exchange does not wait; results are wrong by design
        if (blockIdx.x >= 64) { const long long t0_ = clock64(); while (clock64() - t0_ < 60000) __builtin_amdgcn_s_sleep(8); }
#endif
        const int row = wid * 32 + (lane & 31);
        if (lane < 32) {
            const f32x2v a = P[row * 4 + 0], b = P[row * 4 + 1], c = P[row * 4 + 2], d = P[row * 4 + 3];
            const float mt = (a.x + b.x + c.x + d.x) * 0.25f;
            const float da = a.x - mt, db = b.x - mt, dc = c.x - mt, dd = d.x - mt;
            const float m2 = (a.y + b.y) + (c.y + d.y) + 64.0f * ((da * da + db * db) + (dc * dc + dd * dd));
            unsigned long long* slot = (unsigned long long*)xbuf + ((size_t)(u.pm * BM + row) * 4 + u.pn);
            __hip_atomic_store(slot, ((unsigned long long)__float_as_uint(m2) << 32) | __float_as_uint(mt), __ATOMIC_RELAXED, __HIP_MEMORY_SCOPE_AGENT);
        }
        asm volatile("s_waitcnt vmcnt(0)" ::: "memory");
        if (lane == 0) __hip_atomic_fetch_add(cnt + 64 * u.pm, 1u, __ATOMIC_RELAXED, __HIP_MEMORY_SCOPE_AGENT);
        if (wid == 0) {
            bool dead = false; const unsigned long long t0 = __builtin_amdgcn_s_memrealtime(); const unsigned want = 8u * (unsigned)ntn;
            for (;;) {
#if defined(BROKEN_EXCHANGE_NO_WAIT)
                break;
#endif
                if ((unsigned)__builtin_amdgcn_readfirstlane(__hip_atomic_load(cnt + 64 * u.pm, __ATOMIC_RELAXED, __HIP_MEMORY_SCOPE_AGENT)) >= want) break;
                if (__builtin_amdgcn_s_memrealtime() - t0 > 2000000ull) {
                    if (lane == 0) { unsigned expect = 0u; __hip_atomic_compare_exchange_strong(tmo + 1, &expect, code | (unsigned)(u.pm & 0xff), __ATOMIC_RELAXED, __ATOMIC_RELAXED, __HIP_MEMORY_SCOPE_AGENT);
                                     __hip_atomic_store(tmo, 1u, __ATOMIC_RELAXED, __HIP_MEMORY_SCOPE_AGENT); }
                    dead = true; break; }
                __builtin_amdgcn_s_sleep(2);
            }
            __builtin_amdgcn_fence(__ATOMIC_ACQUIRE, "agent");
            if (lane == 0) flag[0] = dead ? 1u : 0u;
        }
        asm volatile("s_waitcnt vmcnt(0) lgkmcnt(0)" ::: "memory"); __builtin_amdgcn_s_barrier(); asm volatile("" ::: "memory");
        const bool bad = flag[0] != 0u;
        if (lane < 32) {
            const unsigned long long* slot = (const unsigned long long*)xbuf + (size_t)(u.pm * BM + row) * 4; float mt[4], m2[4]; float ms = 0.f;
#pragma unroll
            for (int t = 0; t < 4; ++t) { if (t < ntn) { const unsigned long long w = __hip_atomic_load(slot + t, __ATOMIC_RELAXED, __HIP_MEMORY_SCOPE_AGENT); mt[t] = __uint_as_float((unsigned)w); m2[t] = __uint_as_float((unsigned)(w >> 32)); } else { mt[t] = 0.f; m2[t] = 0.f; } ms += mt[t]; }
            const float mean = ms / (float)ntn; float q = 0.f;
#pragma unroll
            for (int t = 0; t < 4; ++t) if (t < ntn) { const float dm = mt[t] - mean; q += m2[t] + 256.0f * dm * dm; }
            S[row] = (f32x2v){mean, 1.0f / sqrtf(q / (256.0f * (float)ntn) + eps)};
        }
        asm volatile("s_waitcnt lgkmcnt(0)" ::: "memory"); __builtin_amdgcn_s_barrier(); asm volatile("" ::: "memory");
        return bad;
    }
};
struct EpiLnRes {
    static constexpr bool PERM = false, AFTER_DRAIN = true;
    const float* base; float* out; int ldc; const float* bias; PanelStats st; unsigned poison;
    __device__ __forceinline__ void fused(f32x4 (&acc)[2][2][4][2], const Unit& u, int wr, int wc, int fr, int fq, PG8_LAS unsigned char* lds, int wid, int lane) const {
        typedef float f32x2v __attribute__((ext_vector_type(2)));
        const PG8_LAS f32x2v* S = (const PG8_LAS f32x2v*)(lds + 8192);
        const int col0 = u.pn * BM + wc * 32 + 4 * fq;
#pragma unroll
        for (int bj = 0; bj < 2; ++bj)
#pragma unroll
            for (int n = 0; n < 2; ++n) { const f32x4 bv = bias ? *(const f32x4*)(bias + col0 + bj * HALF + n * 16) : (f32x4){0.f, 0.f, 0.f, 0.f};
#pragma unroll
                for (int ai = 0; ai < 2; ++ai)
#pragma unroll
                    for (int m = 0; m < 4; ++m) acc[ai][bj][m][n] += bv; }
        f32x4 pre[4][2][2];
#pragma unroll
        for (int m = 0; m < 4; ++m) { const size_t off = (size_t)(u.pm * BM + wr * 64 + m * 16 + fr) * ldc + col0;
#pragma unroll
            for (int bj = 0; bj < 2; ++bj)
#pragma unroll
                for (int n = 0; n < 2; ++n) pre[m][bj][n] = *(const f32x4*)(base + off + bj * HALF + n * 16); }
        const bool bad = st.run(acc, u, wr, wc, fr, fq, lds, wid, lane) || poison != 0u;
        const float qnan = __builtin_nanf("");
#pragma unroll
        for (int ai = 0; ai < 2; ++ai)
#pragma unroll
            for (int m = 0; m < 4; ++m) { const int r = ai * HALF + wr * 64 + m * 16 + fr; const f32x2v sr = S[r]; const size_t off = (size_t)(u.pm * BM + r) * ldc + col0;
#pragma unroll
                for (int bj = 0; bj < 2; ++bj)
#pragma unroll
                    for (int n = 0; n < 2; ++n) { const f32x4 bs = ai == 0 ? pre[m][bj][n] : *(const f32x4*)(base + off + bj * HALF + n * 16); f32x4 o = bs + (acc[ai][bj][m][n] - sr.x) * sr.y;
                        if (bad) o = (f32x4){qnan, qnan, qnan, qnan}; *(f32x4*)(out + off + bj * HALF + n * 16) = o; }
                if (m & 1) asm volatile("" ::: "memory"); }
    }
};
struct EpiLnResLn {
    static constexpr bool PERM = false, AFTER_DRAIN = true;
    const float* base; float* out; bf16_t* xn; int ldc; const float* bias; PanelStats st1, st2; unsigned poison;
    __device__ __forceinline__ void fused(f32x4 (&acc)[2][2][4][2], const Unit& u, int wr, int wc, int fr, int fq, PG8_LAS unsigned char* lds, int wid, int lane) const {
        typedef float f32x2v __attribute__((ext_vector_type(2))); typedef unsigned u32x2v __attribute__((ext_vector_type(2)));
        const PG8_LAS f32x2v* S = (const PG8_LAS f32x2v*)(lds + 8192);
        const int col0 = u.pn * BM + wc * 32 + 4 * fq;
#pragma unroll
        for (int bj = 0; bj < 2; ++bj)
#pragma unroll
            for (int n = 0; n < 2; ++n) { const f32x4 bv = bias ? *(const f32x4*)(bias + col0 + bj * HALF + n * 16) : (f32x4){0.f, 0.f, 0.f, 0.f};
#pragma unroll
                for (int ai = 0; ai < 2; ++ai)
#pragma unroll
                    for (int m = 0; m < 4; ++m) acc[ai][bj][m][n] += bv; }
        bool bad = st1.run(acc, u, wr, wc, fr, fq, lds, wid, lane) || poison != 0u;
        const float qnan = __builtin_nanf("");
#pragma unroll
        for (int ai = 0; ai < 2; ++ai)
#pragma unroll
            for (int m = 0; m < 4; ++m) { const int r = ai * HALF + wr * 64 + m * 16 + fr; const f32x2v sr = S[r]; const size_t off = (size_t)(u.pm * BM + r) * ldc + col0;
#pragma unroll
                for (int bj = 0; bj < 2; ++bj)
#pragma unroll
                    for (int n = 0; n < 2; ++n) { const f32x4 bs = *(const f32x4*)(base + off + bj * HALF + n * 16); acc[ai][bj][m][n] = bs + (acc[ai][bj][m][n] - sr.x) * sr.y; }
                asm volatile("" : "+v"(acc[ai][0][m][0]), "+v"(acc[ai][0][m][1]), "+v"(acc[ai][1][m][0]), "+v"(acc[ai][1][m][1]));
                if (m & 1) asm volatile("" ::: "memory"); }
        const bool bad1 = bad;
        bad = st2.run(acc, u, wr, wc, fr, fq, lds, wid, lane) || bad;
#pragma unroll
        for (int ai = 0; ai < 2; ++ai)
#pragma unroll
            for (int m = 0; m < 4; ++m) { const int r = ai * HALF + wr * 64 + m * 16 + fr; const f32x2v sr = S[r]; const size_t off = (size_t)(u.pm * BM + r) * ldc + col0;
#pragma unroll
                for (int bj = 0; bj < 2; ++bj)
#pragma unroll
                    for (int n = 0; n < 2; ++n) { const f32x4 x1 = acc[ai][bj][m][n]; *(f32x4*)(out + off + bj * HALF + n * 16) = bad1 ? (f32x4){qnan, qnan, qnan, qnan} : x1;
                        const f32x4 o = (x1 - sr.x) * sr.y; u32x2v w; w.x = cvt_pk_bf16(o[0], o[1]); w.y = cvt_pk_bf16(o[2], o[3]);
                        if (bad) { w.x = 0x7fc07fc0u; w.y = 0x7fc07fc0u; } *(u32x2v*)(xn + off + bj * HALF + n * 16) = w; }
                asm volatile("" ::: "memory"); }
    }
};

template <class Epi, class Sched, bool ALIGN_EPI = false, bool SP2 = false, bool KSPLIT = false, bool INDIRECT = false>
__device__ __forceinline__ void gemm_phase(PG8_LAS unsigned char* lds, const Gemm g, const Sched& S, const Epi& E, const int wave0) {
    int wv0_ = wave0; asm volatile("" : "+s"(wv0_));
    int z0_ = 0; asm volatile("" : "+v"(z0_)); const int tid_ = wv0_ * 64 + (int)__builtin_amdgcn_mbcnt_hi(~0u, __builtin_amdgcn_mbcnt_lo(~0u, (unsigned)z0_));
    const int tid = tid_, wid = __builtin_amdgcn_readfirstlane(tid >> 6), lane = tid & 63, wr = wid >> 2, wc = wid & 3, fr = lane & 15, fq = lane >> 4;
    const int K = g.K, nt = K / BK;
    unsigned voffA[2], voffB[2]; int rcA[2];
#pragma unroll
    for (int i = 0; i < 2; ++i) { int R, C; stage_rc(tid * 16 + i * 8192, R, C); const int Rb = Epi::PERM ? ((R & ~31) + perm32(R & 31)) : R;
        voffA[i] = (unsigned)(R * g.lda + C) * 2u; voffB[i] = (unsigned)(Rb * g.ldb + C) * 2u; rcA[i] = (R << 8) | C; }
    const unsigned kstep = (unsigned)(BK * 2);
    const unsigned hstepA = INDIRECT ? 0u : (unsigned)HALF * g.lda * 2, hstepB = (unsigned)HALF * g.ldb * 2;
    const unsigned tstepA = 2 * hstepA, tstepB = 2 * hstepB;
    const char* const baseA = (const char*)g.A; const char* const baseB = (const char*)g.Bt;
    const unsigned ldsw = (unsigned)wid * 1024u;
    const int aoff = lds_byte(wr * 64 + fr, fq * 8), boff = lds_byte(wc * 32 + fr, fq * 8);
#define PG8_SA(b, h) (((b) * 2 + (h)) * HTB)
#define PG8_SB(b, h) ((4 + (b) * 2 + (h)) * HTB)
#define PG8_STAGE_X(bufoff, base, soff, voff) do { _Pragma("unroll") for (int _i = 0; _i < 2; ++_i) \
        __builtin_amdgcn_global_load_lds((const unsigned*)((base) + (unsigned)((soff) + (voff)[_i])), (PG8_LAS unsigned*)(lds + (bufoff) + ldsw + _i * 8192), 16, 0, 0); } while (0)
#define PG8_USWITCH do { if constexpr (INDIRECT) { if (last) { uA[0][0] = uN[0][0]; uA[0][1] = uN[0][1]; uA[1][0] = uN[1][0]; uA[1][1] = uN[1][1]; } } } while (0)
#define PG8_STAGE_A(bufoff, soff, h) do { if constexpr (INDIRECT) { PG8_STAGE_X(bufoff, baseA, soff, uA[h]); } else { PG8_STAGE_X(bufoff, baseA, soff, voffA); } } while (0)
#define PG8_LOADU(U, unit) do { _Pragma("unroll") for (int h_ = 0; h_ < 2; ++h_) _Pragma("unroll") for (int i_ = 0; i_ < 2; ++i_) { int t_ = ((const __attribute__((address_space(1))) int*)g.rowidx)[(unit).pm * 256 + h_ * 128 + (rcA[i_] >> 8)]; t_ = t_ < 0 ? 0 : t_; \
        U[h_][i_] = (unsigned)t_ * (unsigned)(g.lda * 2) + (unsigned)((rcA[i_] & 255) * 2); } } while (0)
#define PG8_LDA(dst, b, h) do { _Pragma("unroll") for (int m = 0; m < 4; ++m) _Pragma("unroll") for (int k = 0; k < 2; ++k) dst[m][k] = *(const PG8_LAS bf16x8*)(lds + PG8_SA(b, h) + aoff + m * 2048 + k * 1024); } while (0)
#define PG8_LDB(dst, b, h) do { _Pragma("unroll") for (int n = 0; n < 2; ++n) _Pragma("unroll") for (int k = 0; k < 2; ++k) dst[n][k] = *(const PG8_LAS bf16x8*)(lds + PG8_SB(b, h) + boff + n * 2048 + k * 1024); } while (0)
#define PG8_MMA(ai, bj, At, Bt) do { __builtin_amdgcn_s_setprio(1); _Pragma("unroll") for (int m = 0; m < 4; ++m) _Pragma("unroll") for (int n = 0; n < 2; ++n) _Pragma("unroll") for (int k = 0; k < 2; ++k) \
        acc[ai][bj][m][n] = __builtin_amdgcn_mfma_f32_16x16x32_bf16(Bt[n][k], At[m][k], acc[ai][bj][m][n], 0, 0, 0); __builtin_amdgcn_s_setprio(0); } while (0)
#define PG8_WAIT_V(n) asm volatile("s_waitcnt vmcnt(" #n ")" ::: "memory")
#define PG8_WAIT_L(n) asm volatile("s_waitcnt lgkmcnt(" #n ")" ::: "memory")
#define PG8_BAR __builtin_amdgcn_s_barrier()
#define PG8_SCHED __builtin_amdgcn_sched_barrier(0)
    Unit cur, nxt; int ui = 0;
    if (!S.next(0, cur)) return;
    f32x4 acc[2][2][4][2];
#pragma unroll
    for (int a = 0; a < 2; ++a)
#pragma unroll
        for (int b = 0; b < 2; ++b)
#pragma unroll
            for (int m = 0; m < 4; ++m)
#pragma unroll
                for (int n = 0; n < 2; ++n) acc[a][b][m][n] = (f32x4){0.f, 0.f, 0.f, 0.f};
    bf16x8 At[4][2], B0[2][2], B1[2][2];
    unsigned cA = (unsigned)cur.pm * tstepA; unsigned cB = (unsigned)cur.pn * tstepB + (KSPLIT ? (unsigned)cur.k0 * 2u : 0u);
    unsigned sB = KSPLIT ? (unsigned)cur.pn * tstepB + (unsigned)cur.k1 * 2u - (unsigned)(nt / 2) * kstep : cB;
    S.a_ready(cur);
    unsigned uA[2][2] = {}, uN[2][2] = {};
    if constexpr (INDIRECT) PG8_LOADU(uA, cur);
    if constexpr (SP2) {
        PG8_STAGE_X(PG8_SB(0, 0), baseB, cB, voffB); PG8_STAGE_X(PG8_SB(0, 1), baseB, cB + hstepB, voffB); PG8_STAGE_A(PG8_SA(0, 0), cA, 0); PG8_STAGE_A(PG8_SA(0, 1), cA + hstepA, 1);
        if (wr == 1) PG8_BAR;
        PG8_WAIT_V(2); PG8_BAR;
        PG8_STAGE_X(PG8_SB(1, 0), baseB, cB + kstep, voffB); PG8_STAGE_A(PG8_SA(1, 0), cA + kstep, 0); PG8_STAGE_X(PG8_SB(1, 1), baseB, cB + hstepB + kstep, voffB);
        PG8_WAIT_V(6); PG8_BAR;
    } else {
        PG8_STAGE_X(PG8_SB(0, 0), baseB, cB, voffB); PG8_STAGE_A(PG8_SA(0, 0), cA, 0); PG8_STAGE_X(PG8_SB(0, 1), baseB, cB + hstepB, voffB); PG8_STAGE_A(PG8_SA(0, 1), cA + hstepA, 1);
        if (wr == 1) PG8_BAR;
        PG8_WAIT_V(4); PG8_BAR;
        PG8_STAGE_X(PG8_SB(1, 0), baseB, cB + kstep, voffB); PG8_STAGE_A(PG8_SA(1, 0), cA + kstep, 0); PG8_STAGE_X(PG8_SB(1, 1), baseB, cB + hstepB + kstep, voffB);
        PG8_WAIT_V(6); PG8_BAR;
    }
    for (;;) {
        const bool has_next = S.next(ui + 1, nxt);
        const unsigned nA = has_next ? (unsigned)nxt.pm * tstepA : cA; const unsigned nB = has_next ? (unsigned)nxt.pn * tstepB + (KSPLIT ? (unsigned)nxt.k0 * 2u : 0u) : cB;
        const unsigned nsB = (KSPLIT && has_next) ? (unsigned)nxt.pn * tstepB + (unsigned)nxt.k1 * 2u - (unsigned)(nt / 2) * kstep : sB;
        for (int t = 0; t < nt; t += 2) {
            const bool last = (t == nt - 2);
            const unsigned a1 = cA + (unsigned)(t + 1) * kstep;
            const unsigned a2 = last ? nA : cA + (unsigned)(t + 2) * kstep; const unsigned b2 = last ? nB : ((KSPLIT && (t + 2) >= nt / 2) ? sB : cB) + (unsigned)(t + 2) * kstep;
            const unsigned a3 = a2 + kstep; const unsigned b3 = b2 + kstep;
            if (last && has_next) S.a_ready(nxt);
            if constexpr (INDIRECT) { if (last) { if (has_next) PG8_LOADU(uN, nxt); else { uN[0][0] = uA[0][0]; uN[0][1] = uA[0][1]; uN[1][0] = uA[1][0]; uN[1][1] = uA[1][1]; } } }
            if constexpr (SP2) {
            PG8_LDB(B0, 0, 0); PG8_LDB(B1, 0, 1); PG8_SCHED; PG8_LDA(At, 0, 0); PG8_STAGE_A(PG8_SA(1, 1), a1 + hstepA, 1); PG8_USWITCH;
            PG8_WAIT_V(8); PG8_WAIT_L(0); PG8_BAR; PG8_MMA(0, 0, At, B0); PG8_MMA(0, 1, At, B1); PG8_BAR; PG8_SCHED;
            PG8_LDA(At, 0, 1); PG8_STAGE_X(PG8_SB(0, 0), baseB, b2, voffB); PG8_STAGE_X(PG8_SB(0, 1), baseB, b2 + hstepB, voffB); PG8_STAGE_A(PG8_SA(0, 0), a2, 0);
            PG8_WAIT_V(8); PG8_WAIT_L(0); PG8_BAR; PG8_MMA(1, 0, At, B0); PG8_MMA(1, 1, At, B1); PG8_BAR; PG8_SCHED;
            PG8_LDB(B0, 1, 0); PG8_LDB(B1, 1, 1); PG8_SCHED; PG8_LDA(At, 1, 0); PG8_STAGE_A(PG8_SA(0, 1), a2 + hstepA, 1);
            PG8_WAIT_V(8); PG8_WAIT_L(0); PG8_BAR; PG8_MMA(0, 0, At, B0); PG8_MMA(0, 1, At, B1); PG8_BAR; PG8_SCHED;
            PG8_LDA(At, 1, 1); PG8_STAGE_X(PG8_SB(1, 0), baseB, b3, voffB); PG8_STAGE_X(PG8_SB(1, 1), baseB, b3 + hstepB, voffB); PG8_STAGE_A(PG8_SA(1, 0), a3, 0);
            PG8_WAIT_V(8); PG8_WAIT_L(0); PG8_BAR; PG8_MMA(1, 0, At, B0); PG8_MMA(1, 1, At, B1); PG8_BAR; PG8_SCHED;
            } else {
            PG8_LDB(B0, 0, 0); PG8_SCHED; PG8_LDA(At, 0, 0); PG8_STAGE_A(PG8_SA(1, 1), a1 + hstepA, 1); PG8_USWITCH;
            PG8_WAIT_L(8); PG8_BAR; PG8_WAIT_L(0); PG8_MMA(0, 0, At, B0); PG8_BAR; PG8_SCHED;
            PG8_LDB(B1, 0, 1); PG8_STAGE_X(PG8_SB(0, 0), baseB, b2, voffB);
            PG8_BAR; PG8_WAIT_L(0); PG8_MMA(0, 1, At, B1); PG8_BAR;
            PG8_LDA(At, 0, 1); PG8_STAGE_A(PG8_SA(0, 0), a2, 0);
            PG8_BAR; PG8_WAIT_L(0); PG8_MMA(1, 0, At, B0); PG8_BAR; PG8_SCHED;
            PG8_STAGE_X(PG8_SB(0, 1), baseB, b2 + hstepB, voffB);
            PG8_WAIT_V(6); PG8_BAR; PG8_MMA(1, 1, At, B1); PG8_BAR;
            PG8_LDB(B0, 1, 0); PG8_SCHED; PG8_LDA(At, 1, 0); PG8_STAGE_A(PG8_SA(0, 1), a2 + hstepA, 1);
            PG8_WAIT_L(8); PG8_BAR; PG8_WAIT_L(0); PG8_MMA(0, 0, At, B0); PG8_BAR; PG8_SCHED;
            PG8_LDB(B1, 1, 1); PG8_STAGE_X(PG8_SB(1, 0), baseB, b3, voffB);
            PG8_BAR; PG8_WAIT_L(0); PG8_MMA(0, 1, At, B1); PG8_BAR;
            PG8_LDA(At, 1, 1); PG8_STAGE_A(PG8_SA(1, 0), a3, 0);
            PG8_BAR; PG8_WAIT_L(0); PG8_MMA(1, 0, At, B0); PG8_BAR; PG8_SCHED;
            PG8_STAGE_X(PG8_SB(1, 1), baseB, b3 + hstepB, voffB);
            PG8_WAIT_V(6); PG8_BAR; PG8_MMA(1, 1, At, B1); PG8_BAR;
            }
        }
        if constexpr (ALIGN_EPI) { if (wr == 0) PG8_BAR; }
        if constexpr (!Epi::AFTER_DRAIN) { E(acc, cur, wr, wc, fr, fq); S.done(cur); }
        if (!has_next) break;
#pragma unroll
        for (int a = 0; a < 2; ++a)
#pragma unroll
            for (int b = 0; b < 2; ++b)
#pragma unroll
                for (int m = 0; m < 4; ++m)
#pragma unroll
                    for (int n = 0; n < 2; ++n) acc[a][b][m][n] = (f32x4){0.f, 0.f, 0.f, 0.f};
        cur = nxt; cA = nA; cB = nB; sB = nsB; ++ui;
        if constexpr (ALIGN_EPI) { if (wr == 1) PG8_BAR; }
    }
    PG8_WAIT_V(0);
    if constexpr (!ALIGN_EPI) { if (wr == 0) PG8_BAR; }
    PG8_BAR;
    if constexpr (Epi::AFTER_DRAIN) { E.fused(acc, cur, wr, wc, fr, fq, lds, wid, lane); S.done(cur); }
#undef PG8_SA
#undef PG8_SB
#undef PG8_STAGE_X
#undef PG8_STAGE_A
#undef PG8_LOADU
#undef PG8_USWITCH
#undef PG8_LDA
#undef PG8_LDB
#undef PG8_MMA
#undef PG8_WAIT_V
#undef PG8_WAIT_L
#undef PG8_BAR
#undef PG8_SCHED
}
}
namespace attn_body {
using bf16=__hip_bfloat16;
using bf16x8=__attribute__((ext_vector_type(8)))short;
using s16x4=__attribute__((ext_vector_type(4)))short;
using f32x16=__attribute__((ext_vector_type(16)))float;
using u32x4=__attribute__((ext_vector_type(4)))unsigned;
constexpr int BATCH=8,NHEAD=6,SEQ=4096,D=64,DM=3072;
constexpr int NW=8,QBLK=32,QB=QBLK*NW,KVBLK=64,NQB=SEQ/QB;
constexpr int ATTN_PITCH=DM, ATTN_UNIT_ROWS=QB;
__device__ __forceinline__ int crow(int r,int hi){return (r&3)+8*(r>>2)+4*hi;}
#define SBAR() __builtin_amdgcn_sched_barrier(0)
__device__ __forceinline__ void cmask(f32x16&p0,f32x16&p1,int jb,int qrel,int hi){
  const float NEG=-INFINITY; int kb=64*jb+4*hi;
  #pragma unroll
  for(int r=0;r<16;++r){int kv=kb+(r&3)+8*(r>>2); if(kv>qrel)p0[r]=NEG; if(kv+32>qrel)p1[r]=NEG;}
}

constexpr int NSLOT=3, SLOTB=8192;
constexpr int LDS_K=0, LDS_V=NSLOT*SLOTB, LDS_WS=2*NSLOT*SLOTB, LDS_OST=LDS_WS+NW*64*4, LDS_G=LDS_OST+NW*4096, LDS_BYTES=LDS_G+SEQ*4;
constexpr float C2=0.125f*1.4426950408889634f;
__device__ __forceinline__ void glds16(const void*gsrc,unsigned lds_dst){unsigned keep;
  asm volatile("s_mov_b32 %0, m0\n\ts_mov_b32 m0, %2\n\ts_nop 0\n\tglobal_load_lds_dwordx4 %1, off\n\ts_mov_b32 m0, %0":"=&s"(keep):"v"(gsrc),"s"(lds_dst):"memory");}
__device__ __forceinline__ float max3f(float a,float b,float c){float r;asm("v_max3_f32 %0, %1, %2, %3":"=v"(r):"v"(a),"v"(b),"v"(c));return r;}
__device__ __forceinline__ float max2f(float a,float b){float r;asm("v_max_f32_e32 %0, %1, %2":"=v"(r):"v"(a),"v"(b));return r;}
__device__ __forceinline__ float fadd_s(float a,float b){float r;asm("v_add_f32_e32 %0, %1, %2":"=v"(r):"v"(a),"v"(b));return r;}
__device__ __forceinline__ float fsub_s(float a,float b){float r;asm("v_sub_f32_e32 %0, %1, %2":"=v"(r):"v"(a),"v"(b));return r;}
typedef float f32x2_t __attribute__((ext_vector_type(2))); typedef __bf16 bf16x2_t __attribute__((ext_vector_type(2)));
__device__ __forceinline__ unsigned cvtpk_s(float lo,float hi){f32x2_t v={lo,hi};bf16x2_t b=__builtin_convertvector(v,bf16x2_t);return __builtin_bit_cast(unsigned,b);}
#define WAIT_BAR(N) asm volatile("s_waitcnt vmcnt(" #N ") lgkmcnt(0)\n\ts_barrier":::"memory")

__device__ __forceinline__ void qkt(f32x16&p0,f32x16&p1,const char*Kslot,const bf16x8*qr,const f32x16&negm,int r32,int hi){
  const char*kb=Kslot+hi*1024+r32*16;
  #pragma unroll
  for(int d0=0;d0<4;++d0){
    const bf16x8 b0=*reinterpret_cast<const bf16x8*>(kb+d0*2048);
    const bf16x8 b1=*reinterpret_cast<const bf16x8*>(kb+d0*2048+512);
    if(d0==0){p0=__builtin_amdgcn_mfma_f32_32x32x16_bf16(b0,qr[0],negm,0,0,0);p1=__builtin_amdgcn_mfma_f32_32x32x16_bf16(b1,qr[0],negm,0,0,0);}
    else{p0=__builtin_amdgcn_mfma_f32_32x32x16_bf16(b0,qr[d0],p0,0,0,0);p1=__builtin_amdgcn_mfma_f32_32x32x16_bf16(b1,qr[d0],p1,0,0,0);}}
}
typedef __attribute__((address_space(3))) const char* lds_cptr;
typedef short v4i16_t __attribute__((ext_vector_type(4)));
__device__ __forceinline__ void kload8(bf16x8*kf,lds_cptr kp){
  kf[0]=*(const __attribute__((address_space(3))) bf16x8*)(kp);      kf[1]=*(const __attribute__((address_space(3))) bf16x8*)(kp+512);
  kf[2]=*(const __attribute__((address_space(3))) bf16x8*)(kp+2048); kf[3]=*(const __attribute__((address_space(3))) bf16x8*)(kp+2560);
  kf[4]=*(const __attribute__((address_space(3))) bf16x8*)(kp+4096); kf[5]=*(const __attribute__((address_space(3))) bf16x8*)(kp+4608);
  kf[6]=*(const __attribute__((address_space(3))) bf16x8*)(kp+6144); kf[7]=*(const __attribute__((address_space(3))) bf16x8*)(kp+6656);
}
__device__ __forceinline__ void kload2(bf16x8*kf,lds_cptr kp,int j){ kf[2*j]=*(const __attribute__((address_space(3))) bf16x8*)(kp+j*2048); kf[2*j+1]=*(const __attribute__((address_space(3))) bf16x8*)(kp+j*2048+512); }
__device__ __forceinline__ s16x4 vtr(lds_cptr p){ return __builtin_bit_cast(s16x4,__builtin_amdgcn_ds_read_tr16_b64_v4i16((__attribute__((address_space(3))) v4i16_t*)p)); }
__device__ __forceinline__ float rowmax(const f32x16&p0,const f32x16&p1){
  float a=max3f(p0[0],p0[1],p1[0]),b=max3f(p0[2],p0[3],p1[1]);a=max3f(a,p1[2],p1[3]);
  #pragma unroll
  for(int r=4;r<16;r+=4){a=max3f(a,p0[r],p0[r+1]);b=max3f(b,p0[r+2],p0[r+3]);a=max3f(a,p1[r],p1[r+1]);b=max3f(b,p1[r+2],p1[r+3]);}
  const float m=max2f(a,b);
  auto rr=__builtin_amdgcn_permlane32_swap(__float_as_uint(m),__float_as_uint(m),false,false);
  return max2f(__uint_as_float(rr[0]),__uint_as_float(rr[1]));
}
__device__ __forceinline__ void pv(f32x16*o,int vb,bf16x8 pa0,bf16x8 pa1,bf16x8 pa2,bf16x8 pa3){
  #pragma unroll
  for(int d0=0;d0<2;++d0){s16x4 lo[4],hi[4];
    #pragma unroll
    for(int ks=0;ks<4;++ks){
      asm volatile("ds_read_b64_tr_b16 %0,%1 offset:%c2":"=&v"(lo[ks]):"v"(vb),"i"(d0*4096+ks*1024):"memory");
      asm volatile("ds_read_b64_tr_b16 %0,%1 offset:%c2":"=&v"(hi[ks]):"v"(vb),"i"(d0*4096+ks*1024+512):"memory");}
    asm volatile("s_waitcnt lgkmcnt(0)":::"memory");SBAR();
    #define PK(k) (bf16x8){lo[k][0],lo[k][1],lo[k][2],lo[k][3],hi[k][0],hi[k][1],hi[k][2],hi[k][3]}
    o[d0]=__builtin_amdgcn_mfma_f32_32x32x16_bf16(pa0,PK(0),o[d0],0,0,0);
    o[d0]=__builtin_amdgcn_mfma_f32_32x32x16_bf16(pa1,PK(1),o[d0],0,0,0);
    o[d0]=__builtin_amdgcn_mfma_f32_32x32x16_bf16(pa2,PK(2),o[d0],0,0,0);
    o[d0]=__builtin_amdgcn_mfma_f32_32x32x16_bf16(pa3,PK(3),o[d0],0,0,0);
    #undef PK
  }
}

#ifndef ATTN_STORE16
#define ATTN_STORE16(p,v) (*(u32x4*)(p)=(v))
#endif
template<int THRL> __device__ __forceinline__ void attn_unit(int b,int h,int qb,const bf16*Q,const bf16*__restrict__ K,const bf16*__restrict__ V,bf16*O,const float*Gbh,char*shm,const int wave0,const int ts,const bool do_store=true){
  int wv0_=wave0; asm volatile("":"+s"(wv0_)); int z0_=0; asm volatile("":"+v"(z0_)); const int tid=wv0_*64+(int)__builtin_amdgcn_mbcnt_hi(~0u,__builtin_amdgcn_mbcnt_lo(~0u,(unsigned)z0_)),lane=tid&63,r32=lane&31,hi=lane>>5; const int wid=__builtin_amdgcn_readfirstlane(tid>>6);
  const long rowbase=(long)b*SEQ; const int q0=qb*QB;
  const bf16*Qw=Q+(rowbase+q0+wid*QBLK)*DM+h*D;
  const bf16*Kh=K+(rowbase+(long)ts*KVBLK)*DM+h*D,*Vh=V+(rowbase+(long)ts*KVBLK)*DM+h*D;
  const int q0r=q0-ts*KVBLK; Gbh+=ts*KVBLK;
  const unsigned lds0=(unsigned)(uintptr_t)shm;
  float*wsf=(float*)(shm+LDS_WS)+wid*64;
  const bf16*ksrc=Kh+(long)lane*DM+wid*8;
  const bf16*vsrc=Vh+(long)(16*(wid&3)+(lane>>2))*DM+(wid>>2)*32+(lane&3)*8;
  const unsigned kdst=lds0+LDS_K+wid*1024, vdst=lds0+LDS_V+wid*1024;
  #define DMA_K(t,slot) glds16(ksrc+(long)(t)*KVBLK*DM,(unsigned)__builtin_amdgcn_readfirstlane(kdst+(slot)))
  #define DMA_V(t,slot) glds16(vsrc+(long)(t)*KVBLK*DM,(unsigned)__builtin_amdgcn_readfirstlane(vdst+(slot)))
  const int vb0=(int)(lds0+LDS_V)+((lane>>4)&1)*32+(lane&3)*8+(4*hi+((lane&15)>>2))*64;
  const char*Kbase=shm+LDS_K; bf16x8 kf[8];
  const lds_cptr shm3=(lds_cptr)shm; const lds_cptr kp0=shm3+LDS_K+hi*1024+r32*16; const lds_cptr vp0=shm3+LDS_V+((lane>>4)&1)*32+(lane&3)*8+(4*hi+((lane&15)>>2))*64;
  const int NT=(q0r+QB)/KVBLK;
  typedef float f32x4v __attribute__((ext_vector_type(4)));
  { float*gl=(float*)(shm+LDS_G); const int ng4=(q0r+QB)>>2; for(int i=tid;i<ng4;i+=NW*64){ *(f32x4v*)(gl+4*i)=*(const f32x4v*)(Gbh+4*i); } }
  DMA_K(0,0);DMA_V(0,0);DMA_K(1,SLOTB);
  bf16x8 qr[4];
  #pragma unroll
  for(int d0=0;d0<4;++d0)qr[d0]=*reinterpret_cast<const bf16x8*>(&Qw[(long)r32*DM+d0*16+hi*8]);
  float mhat=0.f,l_reg=0.f;f32x16 o[2];o[0]=f32x16{};o[1]=f32x16{};f32x16 negm=f32x16{};asm volatile("":"+v"(negm));
  const int qrel=wid*QBLK+r32;
  #define CMASK(P0,P1,t) do{int jb_=(t)-(NT-4); if(jb_>=0)cmask(P0,P1,jb_,qrel,hi);}while(0)
  #define KBIAS(P0,P1,t) do{ const float*gp_=(const float*)(shm+LDS_G)+64*(t)+4*hi; \
    _Pragma("unroll") for(int j_=0;j_<4;++j_){ { const f32x4v a_=*(const f32x4v*)(gp_+8*j_); P0[4*j_]+=a_.x; P0[4*j_+1]+=a_.y; P0[4*j_+2]+=a_.z; P0[4*j_+3]+=a_.w; } SBAR(); \
      { const f32x4v c_=*(const f32x4v*)(gp_+32+8*j_); P1[4*j_]+=c_.x; P1[4*j_+1]+=c_.y; P1[4*j_+2]+=c_.z; P1[4*j_+3]+=c_.w; } SBAR(); } }while(0)
  bool resc=false;
  #define START(P0,P1) do{ const float rm=rowmax(P0,P1); resc=false; \
    { const float dl=__builtin_fmaxf(rm,0.f); mhat=fadd_s(mhat,dl); \
      _Pragma("unroll") for(int r=0;r<16;++r){P0[r]=fsub_s(P0[r],dl);P1[r]=fsub_s(P1[r],dl);} \
      _Pragma("unroll") for(int r=0;r<16;++r)negm[r]=-mhat; asm volatile("":"+v"(negm)); } \
    _Pragma("unroll") for(int r=0;r<16;++r)P0[r]=__builtin_amdgcn_exp2f(P0[r]); }while(0)
  #define RESC() do{ if(resc){ asm volatile("s_waitcnt lgkmcnt(0)":::"memory"); \
      _Pragma("unroll") for(int d_=0;d_<2;++d_) _Pragma("unroll") for(int r=0;r<16;++r)o[d_][r]*=wsf[crow(r,hi)]; } }while(0)
  f32x16 pA0,pA1,pB0,pB1;
  int sl_prev=0,sl_cur=0,sl_next=SLOTB;
  #define ROT() do{sl_prev=sl_cur;sl_cur=sl_next;sl_next=(sl_next==(NSLOT-1)*SLOTB)?0:sl_next+SLOTB;}while(0)
  DMA_K(2,2*SLOTB);
  WAIT_BAR(3);
  { const float*gl=(const float*)(shm+LDS_G); mhat=gl[q0r+qrel]; _Pragma("unroll") for(int r=0;r<16;++r)negm[r]=-mhat; asm volatile("":"+v"(negm)); }
  qkt(pA0,pA1,Kbase,qr,negm,r32,hi);asm volatile("s_nop 15\n\ts_nop 7":"+v"(pA0),"+v"(pA1));KBIAS(pA0,pA1,0);CMASK(pA0,pA1,0);
  START(pA0,pA1);
  _Pragma("unroll") for(int r=0;r<16;++r)pA1[r]=__builtin_amdgcn_exp2f(pA1[r]);
  WAIT_BAR(0);
  DMA_K(3,0);DMA_V(1,SLOTB);
  ROT();
  kload8(kf,kp0+sl_cur);
  WAIT_BAR(2);
  s16x4 vlo[8],vhi[8]; u32x4 pw0,pw1,pw2,pw3;
  #define PKW(P,B) cvtpk_s(P[B],P[B+1])
  #define PAF(k) __builtin_bit_cast(bf16x8,pw##k)
  #define VFR(i) (bf16x8){vlo[i][0],vlo[i][1],vlo[i][2],vlo[i][3],vhi[i][0],vhi[i][1],vhi[i][2],vhi[i][3]}
  #define PIN(x) asm volatile("":"+v"(x))
  #define MX3(a,b,c) __builtin_fmaxf(__builtin_fmaxf((a),(b)),(c))
  #define GAPA(MF,A0,A1,A2,A3,W0,W1,PW) do{ MF; sacc+=A0; sacc+=A1; sacc+=A2; sacc+=A3; PIN(sacc); W0; W1; PIN(PW); SBAR(); }while(0)
  #define EX(v) __builtin_amdgcn_exp2f(v)
  #define GAPB(MF,X,B) do{ MF; X[B]=EX(X[B]); X[B+1]=EX(X[B+1]); X[B+2]=EX(X[B+2]); X[B+3]=EX(X[B+3]); PIN(X); SBAR(); }while(0)
  #define VRD(i) do{ vlo[i]=vtr(vp_+(((i)>>2)*4096+((i)&3)*1024)); vhi[i]=vtr(vp_+(((i)>>2)*4096+((i)&3)*1024+512)); }while(0)
  #define KRD(G,j) do{ if(G){ kload2(kf,kp0+sl_next,j); SBAR(); } }while(0)
  #define STEP(C0,C1,P0,P1,t,GK,GV,GL) do{ SBAR(); \
    const lds_cptr vp_=vp0+sl_prev; \
    VRD(0); SBAR(); float sacc=(P0[0]+P0[1]); \
    GAPA(C0=__builtin_amdgcn_mfma_f32_32x32x16_bf16(kf[0],qr[0],negm,0,0,0), P0[2],P0[3],P0[4],P0[5],     pw0[0]=PKW(P0,0), pw0[1]=PKW(P0,2), pw0); \
    VRD(4); SBAR(); GAPA(C1=__builtin_amdgcn_mfma_f32_32x32x16_bf16(kf[1],qr[0],negm,0,0,0), P0[6],P0[7],P0[8],P0[9],     pw0[2]=PKW(P0,4), pw0[3]=PKW(P0,6), pw0); \
    VRD(1); SBAR(); GAPA(C0=__builtin_amdgcn_mfma_f32_32x32x16_bf16(kf[2],qr[1],C0,0,0,0),   P0[10],P0[11],P0[12],P0[13], pw1[0]=PKW(P0,8), pw1[1]=PKW(P0,10), pw1); \
    VRD(5); SBAR(); GAPA(C1=__builtin_amdgcn_mfma_f32_32x32x16_bf16(kf[3],qr[1],C1,0,0,0),   P0[14],P0[15],P1[0],P1[1],   pw1[2]=PKW(P0,12),pw1[3]=PKW(P0,14), pw1); \
    VRD(2); SBAR(); GAPA(C0=__builtin_amdgcn_mfma_f32_32x32x16_bf16(kf[4],qr[2],C0,0,0,0),   P1[2],P1[3],P1[4],P1[5],     pw2[0]=PKW(P1,0), pw2[1]=PKW(P1,2), pw2); \
    VRD(6); SBAR(); GAPA(C1=__builtin_amdgcn_mfma_f32_32x32x16_bf16(kf[5],qr[2],C1,0,0,0),   P1[6],P1[7],P1[8],P1[9],     pw2[2]=PKW(P1,4), pw2[3]=PKW(P1,6), pw2); \
    VRD(3); SBAR(); GAPA(C0=__builtin_amdgcn_mfma_f32_32x32x16_bf16(kf[6],qr[3],C0,0,0,0),   P1[10],P1[11],P1[12],P1[13], pw3[0]=PKW(P1,8), pw3[1]=PKW(P1,10), pw3); \
    VRD(7); SBAR(); GAPA(C1=__builtin_amdgcn_mfma_f32_32x32x16_bf16(kf[7],qr[3],C1,0,0,0),   P1[14],P1[15],0.f,0.f,       pw3[2]=PKW(P1,12),pw3[3]=PKW(P1,14), pw3); \
    l_reg+=sacc; \
    if(GK){DMA_K((t)+3,sl_cur);} if(GV){DMA_V((t)+1,sl_next);} \
    KBIAS(C0,C1,t); CMASK(C0,C1,t); \
    { float a=MX3(C0[0],C0[1],C1[0]),b=MX3(C0[2],C0[3],C1[1]); a=MX3(a,C1[2],C1[3]); \
      _Pragma("unroll") for(int r=4;r<16;r+=4){a=MX3(a,C0[r],C0[r+1]);b=MX3(b,C0[r+2],C0[r+3]);a=MX3(a,C1[r],C1[r+1]);b=MX3(b,C1[r+2],C1[r+3]);} \
      float rm=__builtin_fmaxf(a,b); { auto rr=__builtin_amdgcn_permlane32_swap(__float_as_uint(rm),__float_as_uint(rm),false,false); rm=__builtin_fmaxf(__uint_as_float(rr[0]),__uint_as_float(rr[1])); } \
      resc=false; \
      if(__builtin_expect(__any(rm>(float)THRL),0)){ const float dl=__builtin_fmaxf(rm,0.f); mhat+=dl; \
        _Pragma("unroll") for(int r=0;r<16;++r){C0[r]-=dl;C1[r]-=dl;} \
        _Pragma("unroll") for(int r=0;r<16;++r)negm[r]=-mhat; asm volatile("":"+v"(negm)); \
        const float f=__builtin_amdgcn_exp2f(-dl); l_reg*=f; if(hi==0)wsf[r32]=f; resc=true; } } \
    SBAR(); \
    GAPB(o[0]=__builtin_amdgcn_mfma_f32_32x32x16_bf16(PAF(0),VFR(0),o[0],0,0,0), C0,0); \
    GAPB(o[1]=__builtin_amdgcn_mfma_f32_32x32x16_bf16(PAF(0),VFR(4),o[1],0,0,0), C0,4); \
    KRD(GL,0); GAPB(o[0]=__builtin_amdgcn_mfma_f32_32x32x16_bf16(PAF(1),VFR(1),o[0],0,0,0), C0,8); \
    KRD(GL,1); GAPB(o[1]=__builtin_amdgcn_mfma_f32_32x32x16_bf16(PAF(1),VFR(5),o[1],0,0,0), C0,12); \
    KRD(GL,2); GAPB(o[0]=__builtin_amdgcn_mfma_f32_32x32x16_bf16(PAF(2),VFR(2),o[0],0,0,0), C1,0); \
    KRD(GL,3); GAPB(o[1]=__builtin_amdgcn_mfma_f32_32x32x16_bf16(PAF(2),VFR(6),o[1],0,0,0), C1,4); \
    GAPB(o[0]=__builtin_amdgcn_mfma_f32_32x32x16_bf16(PAF(3),VFR(3),o[0],0,0,0), C1,8); \
    GAPB(o[1]=__builtin_amdgcn_mfma_f32_32x32x16_bf16(PAF(3),VFR(7),o[1],0,0,0), C1,12); \
    }while(0)
  int t=1;
  #undef CMASK
  #define CMASK(P0,P1,t) do{}while(0)
  for(;t+5<NT;t+=2){
    STEP(pB0,pB1,pA0,pA1,t,true,true,true);     WAIT_BAR(2); RESC(); ROT();
    STEP(pA0,pA1,pB0,pB1,t+1,true,true,true);   WAIT_BAR(2); RESC(); ROT();
  }
  #undef CMASK
  #define CMASK(P0,P1,t) do{int jb_=(t)-(NT-4); if(jb_>=0)cmask(P0,P1,jb_,qrel,hi);}while(0)
  #define ENDW(tt) do{ if((tt)+3<NT){WAIT_BAR(2);} else if((tt)+2<NT){WAIT_BAR(1);} else {WAIT_BAR(0);} }while(0)
  for(;t+1<NT;t+=2){
    STEP(pB0,pB1,pA0,pA1,t,(t+3<NT),(t+1<NT),(t+1<NT));       ENDW(t);   RESC(); ROT();
    STEP(pA0,pA1,pB0,pB1,t+1,(t+4<NT),(t+2<NT),(t+2<NT));     ENDW(t+1); RESC(); ROT();
  }
  STEP(pB0,pB1,pA0,pA1,NT-1,false,false,false); RESC();
  { float sacc=pB0[0]+pB0[1]; _Pragma("unroll") for(int r=2;r<16;++r)sacc+=pB0[r]; _Pragma("unroll") for(int r=0;r<16;++r)sacc+=pB1[r]; l_reg+=sacc;
    pw0=(u32x4){PKW(pB0,0),PKW(pB0,2),PKW(pB0,4),PKW(pB0,6)};pw1=(u32x4){PKW(pB0,8),PKW(pB0,10),PKW(pB0,12),PKW(pB0,14)};pw2=(u32x4){PKW(pB1,0),PKW(pB1,2),PKW(pB1,4),PKW(pB1,6)};pw3=(u32x4){PKW(pB1,8),PKW(pB1,10),PKW(pB1,12),PKW(pB1,14)};
    SBAR(); pv(o,vb0+sl_cur,PAF(0),PAF(1),PAF(2),PAF(3)); }
  #undef PKW
  #undef PAF
  #undef VFR
  #undef PIN
  #undef MX3
  #undef GAPA
  #undef GAPB
  #undef EX
  #undef VRD
  #undef KRD
  #undef STEP
  #undef ENDW
  {auto rr=__builtin_amdgcn_permlane32_swap(__float_as_uint(l_reg),__float_as_uint(l_reg),false,false);l_reg=__uint_as_float(rr[0])+__uint_as_float(rr[1]);}
  if(hi==0)wsf[32+r32]=l_reg;asm volatile("s_waitcnt lgkmcnt(0)":::"memory");
  float rli[16];
  #pragma unroll
  for(int r=0;r<16;++r)rli[r]=__builtin_amdgcn_rcpf(wsf[32+crow(r,hi)]);
  bf16*Ow=O+(rowbase+q0+wid*QBLK)*DM+h*D;
  { bf16*stg=(bf16*)(shm+LDS_OST)+wid*2048;
    #pragma unroll
    for(int r=0;r<16;++r){const int orow=crow(r,hi);
      #pragma unroll
      for(int d0=0;d0<2;++d0)stg[orow*64+d0*32+r32]=__float2bfloat16(o[d0][r]*rli[r]);}
    asm volatile("s_waitcnt lgkmcnt(0)":::"memory");
    #pragma unroll
    for(int i=0;i<4;++i){const int row=i*8+(lane>>3),ch=lane&7; const u32x4 v=*(const u32x4*)(stg+row*64+ch*8); if(do_store)ATTN_STORE16(Ow+(long)row*DM+ch*8,v);} }
  asm volatile("s_waitcnt lgkmcnt(0)\n\ts_barrier":::"memory");
  #undef DMA_K
  #undef DMA_V
  #undef CMASK
  #undef KBIAS
  #undef START
  #undef RESC
  #undef ROT
}
constexpr int ATTN_LDS_BYTES=LDS_BYTES;
struct AttnTensors { const bf16* Q; const bf16* K; const bf16* V; bf16* O; const float* G; };
struct AttnUnit { int bh; int qb; };
struct StaticOrder {
  int vcu;
  __device__ __forceinline__ explicit StaticOrder(int grid,int block):vcu((block%8)*(grid/8)+block/8){}
  __device__ __forceinline__ bool next(int i,AttnUnit&u)const{ if(i>=4)return false; const int s=vcu&7; u.bh=vcu>>3; u.qb=(i==0)?s:(i==1)?15-s:(i==2)?16+s:31-s; return true; }
  __device__ __forceinline__ void a_ready(const AttnUnit&)const{}
  __device__ __forceinline__ void done(const AttnUnit&)const{}
};
template<class Sched,int THRL=8> __device__ __forceinline__ void attn_phase(char*lds,const AttnTensors&T,const Sched&S){
  AttnUnit u;
  for(int i=0;S.next(i,u);++i){ S.a_ready(u); attn_unit<THRL>(u.bh/NHEAD,u.bh%NHEAD,u.qb,T.Q,T.K,T.V,T.O,T.G+(long)u.bh*SEQ,lds); S.done(u); }
}
#undef SBAR
#undef WAIT_BAR
}
namespace fx {
struct EpiZ {
    static constexpr bool PERM = true, AFTER_DRAIN = false;
    bf16* Z; bf16* UP; float* NLF; const float* fbias;
    __device__ __forceinline__ void operator()(const pg8::f32x4 (&acc)[2][2][4][2], const pg8::Unit& u, int wr, int wc, int fr_, int fq_) const {
        int z_ = 0; asm volatile("" : "+v"(z_)); const int ln_ = __builtin_amdgcn_mbcnt_hi(~0u, __builtin_amdgcn_mbcnt_lo(~0u, z_)); const int fr = ln_ & 15, fq = ln_ >> 4; (void)fr_; (void)fq_;
        const int row0 = u.pm * 256 + wr * 64 + fr, col0 = wc * 32 + 8 * fq;
#pragma unroll
        for (int bj = 0; bj < 2; ++bj) {
            const int hb = u.pn * 2 + bj;
            const float sc = (hb < 3) ? C2 : 1.f;
            bf16* base = Z + ((size_t)row0 * NZ + hb * 128 + col0); size_t stride = (size_t)16 * NZ;
            if (hb == 9 || hb == 10) { const int sidx = (hb - 9) * 128 + col0, g = sidx >> 4, ch0 = sidx & 15;
                base = UP + ((size_t)(g * 2048 + (row0 >> 4)) * 384 + (row0 & 15) * 16 + ch0); stride = 384; }
#pragma unroll
            for (int ai = 0; ai < 2; ++ai)
#pragma unroll
                for (int m = 0; m < 4; ++m) { const pg8::f32x4 v0 = acc[ai][bj][m][0] * sc, v1 = acc[ai][bj][m][1] * sc;
                    v4u w; w.x = pk2(v0[0], v0[1]); w.y = pk2(v0[2], v0[3]); w.z = pk2(v1[0], v1[1]); w.w = pk2(v1[2], v1[3]);
                    *(GAS v4u*)(base + (size_t)(ai * 8 + m) * stride) = w; }
        }
        if (u.pn == 11 && col0 == 0) {
#pragma unroll
            for (int ai = 0; ai < 2; ++ai)
#pragma unroll
                for (int m = 0; m < 4; ++m) { const int r = row0 + ai * 128 + m * 16, b = r >> 12, t = r & 4095; float* o = NLF + (size_t)(b * 6) * 4096 + t;
                    o[0 * 4096] = nlf1(acc[ai][1][m][0][0] + fbias[0]); o[1 * 4096] = nlf1(acc[ai][1][m][0][1] + fbias[1]); o[2 * 4096] = nlf1(acc[ai][1][m][0][2] + fbias[2]);
                    o[3 * 4096] = nlf1(acc[ai][1][m][0][3] + fbias[3]); o[4 * 4096] = nlf1(acc[ai][1][m][1][0] + fbias[4]); o[5 * 4096] = nlf1(acc[ai][1][m][1][1] + fbias[5]); }
        }
    }
    static __device__ __forceinline__ float nlf1(float x) { return -LOG2E * (fminf(x, 0.f) - __logf(1.f + __expf(-fabsf(x)))); }
};
template <bool XF32> struct EpiRes {
    static constexpr bool PERM = true, AFTER_DRAIN = false;
    const void* X; bf16* out; const float* gate;
    __device__ __forceinline__ void operator()(const pg8::f32x4 (&acc)[2][2][4][2], const pg8::Unit& u, int wr, int wc, int fr_, int fq_) const {
        int z_ = 0; asm volatile("" : "+v"(z_)); const int ln_ = __builtin_amdgcn_mbcnt_hi(~0u, __builtin_amdgcn_mbcnt_lo(~0u, z_)); const int fr = ln_ & 15, fq = ln_ >> 4; (void)fr_; (void)fq_;
        const int row0 = u.pm * 256 + wr * 64 + fr, col0 = u.pn * 256 + wc * 32 + 8 * fq;
        const float* gb = gate + (size_t)(row0 >> 12) * 6144;
#pragma unroll
        for (int bj = 0; bj < 2; ++bj) { const int c = col0 + bj * 128; const pg8::f32x4 g0 = *(const GAS pg8::f32x4*)(gb + c), g1 = *(const GAS pg8::f32x4*)(gb + c + 4);
#pragma unroll
            for (int hq = 0; hq < 2; ++hq) {
                pg8::f32x4 x0[4], x1[4];
#pragma unroll
                for (int m = 0; m < 4; ++m) { const size_t off = (size_t)(row0 + hq * 128 + m * 16) * 1024 + c;
                    if (XF32) { x0[m] = *(const GAS pg8::f32x4*)((const float*)X + off); x1[m] = *(const GAS pg8::f32x4*)((const float*)X + off + 4); }
                    else { const v4u w = *(const GAS v4u*)((const bf16*)X + off); x0[m] = (pg8::f32x4){bflo(w.x), bfhi(w.x), bflo(w.y), bfhi(w.y)}; x1[m] = (pg8::f32x4){bflo(w.z), bfhi(w.z), bflo(w.w), bfhi(w.w)}; } }
                asm volatile("" ::: "memory");
#pragma unroll
                for (int m = 0; m < 4; ++m) { const size_t off = (size_t)(row0 + hq * 128 + m * 16) * 1024 + c;
                    const pg8::f32x4 o0 = x0[m] + g0 * acc[hq][bj][m][0], o1 = x1[m] + g1 * acc[hq][bj][m][1];
                    v4u ow; ow.x = pk2(o0[0], o0[1]); ow.y = pk2(o0[2], o0[3]); ow.z = pk2(o1[0], o1[1]); ow.w = pk2(o1[2], o1[3]); *(GAS v4u*)(out + off) = ow; }
                asm volatile("" ::: "memory"); } }
    }
};
}
namespace fx {
constexpr int MOE_ROWS = 40960, MOE_TILES = MOE_ROWS / 256, NCLS = 24;
constexpr size_t WS_TOKINFO = WS_HLOC + 8 * MiB;
constexpr size_t WS_CNT = WS_TOKINFO + (size_t)M * 16;
constexpr size_t WS_ROWTOK = WS_CNT + 256 * 32 * 4;
constexpr size_t WS_ROWW = WS_ROWTOK + (size_t)MOE_ROWS * 4;
constexpr size_t WS_TILECLS = WS_ROWW + (size_t)MOE_ROWS * 8;
constexpr size_t WS_H2S = WS_Z;
constexpr size_t WS_HID = WS_Z + (size_t)MOE_ROWS * 1024 * 2;
static_assert(WS_TILECLS + (MOE_TILES + 1) * 4 <= WS_END, "moe scratch fits");
static_assert(WS_HID + (size_t)MOE_ROWS * 512 * 2 <= WS_UP, "H2S + HID fit in the Z region");

__device__ __forceinline__ void cls_experts(int cls, int& e_lo, int& e_hi) {
    const int g = cls / 6, pr = cls % 6; const int lo = (pr < 3) ? 0 : (pr < 5 ? 1 : 2); const int hi = (pr < 3) ? pr + 1 : (pr < 5 ? pr - 1 : 3);
    e_lo = g * 4 + lo; e_hi = g * 4 + hi;
}
__device__ __forceinline__ void moe_route(const Params& p, int oz, int l, LAS unsigned char* lds, int tid, int lane, int wave, int bx, int G) {
    unsigned char* ws = p.ws + oz; constexpr int WP = 1032;
    LAS unsigned short* Whi = (LAS unsigned short*)lds; LAS unsigned short* Wlo = (LAS unsigned short*)(lds + 33024); LAS float* rstds = (LAS float*)(lds + 66048); LAS float* SR = (LAS float*)(lds + 66560); LAS int* hist = (LAS int*)(lds + 66624);
    const int tpw = M / G, t0 = bx * tpw, b = t0 >> 12; const float* mod = (const float*)(ws + WS_MOD) + l * 8 * 6144 + b * 6144; const float* nw = p.in[I_NFW + oz] + l * 1024; const float* rw = p.in[I_RW + oz]; const float* rb = p.in[I_RB + oz];
    for (int k = tid; k < 1024; k += NTHR) { const float a = nw[k] * (1.f + mod[4096 + k]);
#pragma unroll
        for (int q = 0; q < 4; ++q) { const f32x4 w4 = ((const GAS f32x4*)rw)[k * 4 + q];
#pragma unroll
            for (int e = 0; e < 4; ++e) { const float v = a * w4[e]; const unsigned hi = f2bf(v); const float r = v - __builtin_bit_cast(float, hi << 16); Whi[(4 * q + e) * WP + k] = (unsigned short)hi; Wlo[(4 * q + e) * WP + k] = (unsigned short)f2bf(r); } } }
    if (tid < 32) hist[tid] = 0;
    { float s0 = 0.f, s1 = 0.f;
        for (int k = lane; k < 1024; k += 64) { const float bv = mod[3072 + k]; s0 += bv * rw[k * 16 + 2 * wave]; s1 += bv * rw[k * 16 + 2 * wave + 1]; }
        s0 = wave_sum(s0, lane); s1 = wave_sum(s1, lane); if (lane == 0) { SR[2 * wave] = s0 + rb[2 * wave]; SR[2 * wave + 1] = s1 + rb[2 * wave + 1]; } }
    const bf16* X1 = (const bf16*)(ws + WS_XB); bf16* H = (bf16*)(ws + WS_H);
    f32x4 A[4], B[4]; adaln_factors(nw, mod + 3072, mod + 4096, lane, A, B);
    f32x4 v[4] = {}; if (wave < tpw) row_load_bf(X1, t0 + wave, lane, v);
    for (int r = wave; r < tpw; r += NWAVES) {
        const int row = t0 + r;
        f32x4 nxt[4] = {}; if (r + NWAVES < tpw) row_load_bf(X1, row + NWAVES, lane, nxt);
        float s = 0.f;
#pragma unroll
        for (int j = 0; j < 4; ++j) s += (v[j].x * v[j].x + v[j].y * v[j].y) + (v[j].z * v[j].z + v[j].w * v[j].w);
        const float rstd = __builtin_amdgcn_rsqf(wave_sum(s, lane) * (1.f / 1024.f) + 1e-6f); if (lane == 0) rstds[r] = rstd;
        GAS unsigned long long* o8 = (GAS unsigned long long*)(H + (size_t)row * 1024) + lane;
#pragma unroll
        for (int j = 0; j < 4; ++j) { const f32x4 h = (v[j] * rstd) * A[j] + B[j]; o8[64 * j] = (unsigned long long)pk2(h.x, h.y) | ((unsigned long long)pk2(h.z, h.w) << 32); }
#pragma unroll
        for (int j = 0; j < 4; ++j) v[j] = nxt[j];
    }
    __syncthreads();
    typedef short rbf16x8 __attribute__((ext_vector_type(8)));
    const int n = lane & 15, q = lane >> 4, tok = t0 + 16 * wave + n;
    f32x4 acc = {0.f, 0.f, 0.f, 0.f};
    const GAS rbf16x8* xrow = (const GAS rbf16x8*)(X1 + (size_t)tok * 1024 + 8 * q);
    const LAS unsigned short* ahi = Whi + n * WP + 8 * q; const LAS unsigned short* alo = Wlo + n * WP + 8 * q;
#pragma unroll 1
    for (int k0 = 0; k0 < 32; k0 += 8) { rbf16x8 xb[8];
#pragma unroll
        for (int u = 0; u < 8; ++u) xb[u] = xrow[(k0 + u) * 4];
#pragma unroll
        for (int u = 0; u < 8; ++u) { const rbf16x8 a1 = *(const LAS rbf16x8*)(ahi + (k0 + u) * 32), a2 = *(const LAS rbf16x8*)(alo + (k0 + u) * 32);
            acc = __builtin_amdgcn_mfma_f32_16x16x32_bf16(a1, xb[u], acc, 0, 0, 0); acc = __builtin_amdgcn_mfma_f32_16x16x32_bf16(a2, xb[u], acc, 0, 0, 0); } }
    const float rs = rstds[16 * wave + n]; float lg[4];
#pragma unroll
    for (int e = 0; e < 4; ++e) lg[e] = acc[e] * rs + SR[4 * q + e];
    float mx = fmaxf(fmaxf(lg[0], lg[1]), fmaxf(lg[2], lg[3])); mx = fmaxf(mx, lane_get(mx, lane ^ 16)); mx = fmaxf(mx, lane_get(mx, lane ^ 32));
    float sum = 0.f;
#pragma unroll
    for (int e = 0; e < 4; ++e) { lg[e] = __expf(lg[e] - mx); sum += lg[e]; }
    sum += lane_get(sum, lane ^ 16); sum += lane_get(sum, lane ^ 32); const float inv = 1.f / sum;
#pragma unroll
    for (int e = 0; e < 4; ++e) lg[e] *= inv;
    int i1 = 0; float v1 = lg[0];
#pragma unroll
    for (int i = 1; i < 4; ++i) if (lg[i] > v1) { v1 = lg[i]; i1 = i; }
    int i2 = -1; float v2 = -1.f;
#pragma unroll
    for (int i = 0; i < 4; ++i) if (i != i1 && lg[i] > v2) { v2 = lg[i]; i2 = i; }
    const float sc = v1 + v2;
    float bs = sc; int bq = q;
    { const float os = lane_get(bs, lane ^ 16); const int oq = __builtin_amdgcn_ds_bpermute((lane ^ 16) << 2, bq); if (os > bs || (os == bs && oq < bq)) { bs = os; bq = oq; } }
    { const float os = lane_get(bs, lane ^ 32); const int oq = __builtin_amdgcn_ds_bpermute((lane ^ 32) << 2, bq); if (os > bs || (os == bs && oq < bq)) { bs = os; bq = oq; } }
    if (bq == q) {
        const int lo = i1 < i2 ? i1 : i2, hi = i1 < i2 ? i2 : i1; const float w1 = v1 / (v1 + v2), w2 = v2 / (v1 + v2);
        const int cls = q * 6 + (lo * (7 - lo)) / 2 + (hi - lo - 1);
        const int rank = __hip_atomic_fetch_add(hist + cls, 1, __ATOMIC_RELAXED, __HIP_MEMORY_SCOPE_WORKGROUP);
        GAS f32x4* ti = (GAS f32x4*)(ws + WS_TOKINFO) + tok;
        *ti = (f32x4){__builtin_bit_cast(float, cls | (rank << 8)), i1 < i2 ? w1 : w2, i1 < i2 ? w2 : w1, 0.f};
    }
    __syncthreads();
    if (tid < 32) ((int*)(ws + WS_CNT))[bx * 32 + tid] = (tid < NCLS) ? hist[tid] : 0;
}
__device__ __forceinline__ void moe_gather(const Params& p, int oz, LAS unsigned char* lds, int tid, int lane, int wave, int bx, int G) {
    unsigned char* ws = p.ws + oz; LAS int* cl = (LAS int*)lds; LAS int* base = (LAS int*)(lds + 32768); LAS int* off = base + 32; LAS int* tot = off + 32;
    const int* cnt = (const int*)(ws + WS_CNT);
    for (int i = tid; i < G * 32; i += NTHR) cl[i] = cnt[i];
    __syncthreads();
    { LAS int* ps = tot + 32; const int c = tid & 31, part = tid >> 5; int s = 0, mine = 0; for (int w = part * (G / 16); w < (part + 1) * (G / 16); ++w) { if (w < bx) mine += cl[w * 32 + c]; s += cl[w * 32 + c]; } ps[part * 32 + c] = s; ps[512 + part * 32 + c] = mine; }
    __syncthreads();
    if (tid < NCLS) { LAS int* ps = tot + 32; int s = 0, mine = 0; for (int q = 0; q < 16; ++q) { s += ps[q * 32 + tid]; mine += ps[512 + q * 32 + tid]; } tot[tid] = s; off[tid] = mine; }
    __syncthreads();
    if (tid == 0) { int b = 0; for (int c = 0; c < NCLS; ++c) { base[c] = b; b += (tot[c] + 255) & ~255; } base[NCLS] = b; }
    __syncthreads();
    int* rowtok = (int*)(ws + WS_ROWTOK); float* roww = (float*)(ws + WS_ROWW);
    if (bx < NCLS) { const int c = bx, b0 = base[c], n = tot[c], b1 = base[c + 1];
        for (int r = b0 + n + tid; r < b1; r += NTHR) { rowtok[r] = -1; roww[2 * r] = (float)oz; roww[2 * r + 1] = (float)oz; }
        int* tc = (int*)(ws + WS_TILECLS); for (int t = b0 / 256 + tid; t < b1 / 256; t += NTHR) tc[t] = c;
        if (c == NCLS - 1 && tid == 0) tc[MOE_TILES] = b1 / 256; }
    const int tpw = M / G, t0 = bx * tpw;
    for (int r = tid; r < tpw; r += NTHR) { const int row = t0 + r; const f32x4 ti = ((const GAS f32x4*)(ws + WS_TOKINFO))[row]; const int cr = __builtin_bit_cast(int, ti.x), cls = cr & 255, rank = cr >> 8;
        const int pos = base[cls] + off[cls] + rank;
        rowtok[pos] = row; roww[2 * pos] = ti.y; roww[2 * pos + 1] = ti.z; }
}
struct ListOrder {
    const LAS int* list; int n;
    __device__ __forceinline__ bool next(int i, pg8::Unit& u) const { if (i >= n) return false; typedef int v4i_ __attribute__((ext_vector_type(4))); const v4i_ q = *(const LAS v4i_*)(list + 4 * i);
        u.pm = __builtin_amdgcn_readfirstlane(q.x); u.pn = __builtin_amdgcn_readfirstlane(q.y); u.k0 = __builtin_amdgcn_readfirstlane(q.z); u.k1 = __builtin_amdgcn_readfirstlane(q.w); return true; }
    __device__ __forceinline__ void a_ready(const pg8::Unit&) const {}
    __device__ __forceinline__ void done(const pg8::Unit&) const {}
};
template <bool DOWN>
__device__ __forceinline__ int moe_build_list(unsigned char* ws, LAS int* list, int tid, int bx, int G) {
    const int* tc = (const int*)(ws + WS_TILECLS);
    const int ntiles = __builtin_amdgcn_readfirstlane(((const GAS int*)tc)[MOE_TILES]); const int nunits = ntiles * 4; int n = 0;
    for (int L = bx; L < nunits; L += G) ++n;
    if (tid < n) { const int L = bx + tid * G, tile = L >> 2, j = L & 3; const int cls = ((const GAS int*)tc)[tile]; int e_lo, e_hi; cls_experts(cls, e_lo, e_hi);
        if (DOWN) { list[4 * tid] = tile; list[4 * tid + 1] = j; list[4 * tid + 2] = e_lo * 256; list[4 * tid + 3] = e_hi * 256; }
        else { list[4 * tid] = tile; list[4 * tid + 1] = (j < 2 ? e_lo : e_hi) * 2 + (j & 1); list[4 * tid + 2] = j; list[4 * tid + 3] = 0; } }
    __syncthreads();
    return n;
}
struct EpiHid {
    static constexpr bool PERM = true, AFTER_DRAIN = false;
    bf16* HID; const float* roww;
    __device__ __forceinline__ void operator()(const pg8::f32x4 (&acc)[2][2][4][2], const pg8::Unit& u, int wr, int wc, int fr_, int fq_) const {
        int z_ = 0; asm volatile("" : "+v"(z_)); const int ln_ = __builtin_amdgcn_mbcnt_hi(~0u, __builtin_amdgcn_mbcnt_lo(~0u, z_)); const int fr = ln_ & 15, fq = ln_ >> 4; (void)fr_; (void)fq_;
        const int row0 = u.pm * 256 + wr * 64 + fr, j = u.k0, col0 = j * 128 + wc * 32 + 8 * fq;
        float wq[8];
#pragma unroll
        for (int q = 0; q < 8; ++q) wq[q] = ((const GAS float*)roww)[2 * (row0 + (q >> 2) * 128 + (q & 3) * 16) + (j >> 1)];
        asm volatile("" ::: "memory");
#pragma unroll
        for (int ai = 0; ai < 2; ++ai)
#pragma unroll
            for (int m = 0; m < 4; ++m) { const int pos = row0 + ai * 128 + m * 16; const float w = wq[ai * 4 + m];
                float h[8];
#pragma unroll
                for (int n = 0; n < 2; ++n)
#pragma unroll
                    for (int e = 0; e < 4; ++e) { const float gt = acc[ai][0][m][n][e], up = acc[ai][1][m][n][e]; h[4 * n + e] = gt * fsigmoid(gt) * up * w; }
                v4u o; o.x = pk2(h[0], h[1]); o.y = pk2(h[2], h[3]); o.z = pk2(h[4], h[5]); o.w = pk2(h[6], h[7]);
                *(GAS v4u*)(HID + (size_t)pos * 512 + col0) = o; }
    }
};
struct EpiMoeOut {
    static constexpr bool PERM = true, AFTER_DRAIN = false;
    bf16* out; const float* gate; const int* rowtok;
    __device__ __forceinline__ void operator()(const pg8::f32x4 (&acc)[2][2][4][2], const pg8::Unit& u, int wr, int wc, int fr_, int fq_) const {
        int z_ = 0; asm volatile("" : "+v"(z_)); const int ln_ = __builtin_amdgcn_mbcnt_hi(~0u, __builtin_amdgcn_mbcnt_lo(~0u, z_)); const int fr = ln_ & 15, fq = ln_ >> 4; (void)fr_; (void)fq_;
        const int row0 = u.pm * 256 + wr * 64 + fr, col0 = u.pn * 256 + wc * 32 + 8 * fq;
        int tok[8];
#pragma unroll
        for (int q = 0; q < 8; ++q) tok[q] = ((const GAS int*)rowtok)[row0 + (q >> 2) * 128 + (q & 3) * 16];
#pragma unroll
        for (int hq = 0; hq < 2; ++hq)
#pragma unroll
            for (int bj = 0; bj < 2; ++bj) { const int c = col0 + bj * 128;
                v4u w[4] = {};
#pragma unroll
                for (int m = 0; m < 4; ++m) { const int tk = tok[hq * 4 + m]; if (tk >= 0) w[m] = *(const GAS v4u*)(out + (size_t)tk * 1024 + c); }
                asm volatile("" ::: "memory");
#pragma unroll
                for (int m = 0; m < 4; ++m) { const int tk = tok[hq * 4 + m];
                    if (tk >= 0) { const float* gb = gate + (size_t)(tk >> 12) * 6144 + c; const pg8::f32x4 g0 = *(const GAS pg8::f32x4*)gb, g1 = *(const GAS pg8::f32x4*)(gb + 4);
                        const pg8::f32x4 o0 = (pg8::f32x4){bflo(w[m].x), bfhi(w[m].x), bflo(w[m].y), bfhi(w[m].y)} + g0 * acc[hq][bj][m][0], o1 = (pg8::f32x4){bflo(w[m].z), bfhi(w[m].z), bflo(w[m].w), bfhi(w[m].w)} + g1 * acc[hq][bj][m][1];
                        v4u ow; ow.x = pk2(o0[0], o0[1]); ow.y = pk2(o0[2], o0[3]); ow.z = pk2(o1[0], o1[1]); ow.w = pk2(o1[2], o1[3]); *(GAS v4u*)(out + (size_t)tk * 1024 + c) = ow; } }
                asm volatile("" ::: "memory"); }
    }
};
}
namespace fx {
struct EpiS5Loc {
    static constexpr bool PERM = false, AFTER_DRAIN = false;
    float* LOC;
    __device__ __forceinline__ void operator()(const pg8::f32x4 (&acc)[2][2][4][2], const pg8::Unit& u, int wr, int wc, int fr_, int fq_) const {
        int z_ = 0; asm volatile("" : "+v"(z_)); const int ln_ = __builtin_amdgcn_mbcnt_hi(~0u, __builtin_amdgcn_mbcnt_lo(~0u, z_)); const int fr = ln_ & 15, fq = ln_ >> 4; (void)fr_; (void)fq_;
        const int row0 = u.pm * 256 + wr * 64 + fr, col0 = wc * 32 + 4 * fq;
#pragma unroll
        for (int n = 0; n < 2; ++n)
#pragma unroll
            for (int ai = 0; ai < 2; ++ai)
#pragma unroll
                for (int m = 0; m < 4; ++m) *(GAS pg8::f32x4*)(LOC + (size_t)(row0 + ai * 128 + m * 16) * 128 + col0 + n * 16) = acc[ai][0][m][n];
    }
};
__device__ __forceinline__ float gelu_tanh_f(float x) { const float u = 0.7978845608028654f * (x + 0.044715f * x * x * x); const float e = __builtin_amdgcn_exp2f(-2.f * LOG2E * u); return x * __builtin_amdgcn_rcpf(1.f + e); }
struct EpiS5Y {
    static constexpr bool PERM = true, AFTER_DRAIN = false;
    bf16* Y;
    __device__ __forceinline__ void operator()(const pg8::f32x4 (&acc)[2][2][4][2], const pg8::Unit& u, int wr, int wc, int fr_, int fq_) const {
        int z_ = 0; asm volatile("" : "+v"(z_)); const int ln_ = __builtin_amdgcn_mbcnt_hi(~0u, __builtin_amdgcn_mbcnt_lo(~0u, z_)); const int fr = ln_ & 15, fq = ln_ >> 4; (void)fr_; (void)fq_;
        const int g = u.pn, b = u.pm & 7, c0 = wr * 64 + fr;
#pragma unroll
        for (int bj = 0; bj < 2; ++bj) { const int n0 = bj * 128 + wc * 32 + 8 * fq, j = n0 >> 4, ch0 = n0 & 15;
#pragma unroll
            for (int ai = 0; ai < 2; ++ai)
#pragma unroll
                for (int m = 0; m < 4; ++m) { const int c = c0 + ai * 128 + m * 16; const pg8::f32x4 v0 = acc[ai][bj][m][0], v1 = acc[ai][bj][m][1];
                    v4u w; w.x = pk2(gelu_tanh_f(v0[0]), gelu_tanh_f(v0[1])); w.y = pk2(gelu_tanh_f(v0[2]), gelu_tanh_f(v0[3])); w.z = pk2(gelu_tanh_f(v1[0]), gelu_tanh_f(v1[1])); w.w = pk2(gelu_tanh_f(v1[2]), gelu_tanh_f(v1[3]));
                    *(GAS v4u*)(Y + ((size_t)(b * 4096 + c * 16 + j) * 256 + g * 16 + ch0)) = w; } }
    }
};
struct OneUnit { int pm, pn;
    __device__ __forceinline__ bool next(int i, pg8::Unit& u) const { if (i >= 1) return false; u.pm = pm; u.pn = pn; u.k0 = 0; u.k1 = 0; return true; }
    __device__ __forceinline__ void a_ready(const pg8::Unit&) const {}
    __device__ __forceinline__ void done(const pg8::Unit&) const {} };
__device__ __forceinline__ void s5_scan(unsigned char* ws, int l, int g, int b, int tid, LAS float* lds) {
    const int q = tid & 63, w = tid >> 6; const float* al = (const float*)(ws + WS_S5AL) + ((l * 16 + g) * 64 + q) * 2; const float ar = al[0], ai = al[1];
    const float* loc = (const float*)(ws + WS_LOC) + (size_t)(g * 2048 + b * 256 + 32 * w) * 128; bf16* up = (bf16*)(ws + WS_UP) + (size_t)(g * 2048 + b * 256 + 32 * w) * 384 + 256;
    float lr[32], li[32];
#pragma unroll
    for (int k = 0; k < 32; ++k) { lr[k] = loc[(size_t)k * 128 + q]; li[k] = loc[(size_t)k * 128 + 64 + q]; }
    float sr = 0.f, si = 0.f;
#pragma unroll
    for (int k = 0; k < 32; ++k) { const float nr = ar * sr - ai * si + lr[k], ni = ar * si + ai * sr + li[k]; lr[k] = sr; li[k] = si; sr = nr; si = ni; }
    lds[w * 128 + q] = sr; lds[w * 128 + 64 + q] = si;
    float pr = ar, pi = ai;
#pragma unroll
    for (int s = 0; s < 5; ++s) { const float nr = pr * pr - pi * pi, ni = 2.f * pr * pi; pr = nr; pi = ni; }
    __syncthreads();
    float br = 0.f, bi = 0.f;
    for (int w2 = 0; w2 < w; ++w2) { const float er = lds[w2 * 128 + q], ei = lds[w2 * 128 + 64 + q]; const float nr = pr * br - pi * bi + er, ni = pr * bi + pi * br + ei; br = nr; bi = ni; }
#pragma unroll
    for (int k = 0; k < 32; ++k) { up[(size_t)k * 384 + q] = (bf16)f2bf(lr[k] + br); up[(size_t)k * 384 + 64 + q] = (bf16)f2bf(li[k] + bi);
        const float nr = ar * br - ai * bi, ni = ar * bi + ai * br; br = nr; bi = ni; }
    asm volatile("s_waitcnt vmcnt(0)" ::: "memory");
    __syncthreads();
}
struct EpiGlu {
    static constexpr bool PERM = true, AFTER_DRAIN = true;
    const bf16* Y; const float* gb; const float* bnw; bf16* MIX;
    __device__ __forceinline__ void fused(pg8::f32x4 (&acc)[2][2][4][2], const pg8::Unit& u, int wr, int wc, int fr_, int fq_, PG8_LAS unsigned char* lds, int wid, int lane_) const {
        int z_ = 0; asm volatile("" : "+v"(z_)); const int ln_ = __builtin_amdgcn_mbcnt_hi(~0u, __builtin_amdgcn_mbcnt_lo(~0u, z_)); const int fr = ln_ & 15, fq = ln_ >> 4; (void)fr_; (void)fq_; (void)wid; (void)lane_;
        PG8_LAS float* P = (PG8_LAS float*)lds;
        const int row0 = u.pm * 256 + wr * 64 + fr, col0 = wc * 32 + 8 * fq;
        pg8::f32x4 bv[2][2];
#pragma unroll
        for (int bj = 0; bj < 2; ++bj) { bv[bj][0] = *(const GAS pg8::f32x4*)(gb + col0 + bj * 128); bv[bj][1] = *(const GAS pg8::f32x4*)(gb + col0 + bj * 128 + 4); }
#pragma unroll
        for (int ai = 0; ai < 2; ++ai)
#pragma unroll
            for (int m = 0; m < 4; ++m) { const int r = row0 + ai * 128 + m * 16; float s = 0.f;
#pragma unroll
                for (int bj = 0; bj < 2; ++bj) { const v4u yw = *(const GAS v4u*)(Y + (size_t)r * 256 + col0 + bj * 128);
                    pg8::f32x4 a0 = acc[ai][bj][m][0] + bv[bj][0], a1 = acc[ai][bj][m][1] + bv[bj][1];
                    a0[0] = bflo(yw.x) * fsigmoid(a0[0]); a0[1] = bfhi(yw.x) * fsigmoid(a0[1]); a0[2] = bflo(yw.y) * fsigmoid(a0[2]); a0[3] = bfhi(yw.y) * fsigmoid(a0[3]);
                    a1[0] = bflo(yw.z) * fsigmoid(a1[0]); a1[1] = bfhi(yw.z) * fsigmoid(a1[1]); a1[2] = bflo(yw.w) * fsigmoid(a1[2]); a1[3] = bfhi(yw.w) * fsigmoid(a1[3]);
                    acc[ai][bj][m][0] = a0; acc[ai][bj][m][1] = a1;
                    s += ((a0[0] * a0[0] + a0[1] * a0[1]) + (a0[2] * a0[2] + a0[3] * a0[3])) + ((a1[0] * a1[0] + a1[1] * a1[1]) + (a1[2] * a1[2] + a1[3] * a1[3])); }
                s += lane_get(s, ln_ ^ 16); s += lane_get(s, ln_ ^ 32);
                if (fq == 0) P[(wr * 64 + ai * 128 + m * 16 + fr) * 4 + wc] = s; }
        asm volatile("s_waitcnt lgkmcnt(0)" ::: "memory"); __builtin_amdgcn_s_barrier(); asm volatile("" ::: "memory");
        pg8::f32x4 wv[2][2];
#pragma unroll
        for (int bj = 0; bj < 2; ++bj) { wv[bj][0] = *(const GAS pg8::f32x4*)(bnw + col0 + bj * 128); wv[bj][1] = *(const GAS pg8::f32x4*)(bnw + col0 + bj * 128 + 4); }
        asm volatile("" ::: "memory");
#pragma unroll
        for (int ai = 0; ai < 2; ++ai)
#pragma unroll
            for (int m = 0; m < 4; ++m) { const int rl = wr * 64 + ai * 128 + m * 16 + fr, r = u.pm * 256 + rl; const PG8_LAS pg8::f32x4* pp = (const PG8_LAS pg8::f32x4*)(P + rl * 4); const pg8::f32x4 ps = *pp;
                const float rstd = __builtin_amdgcn_rsqf(((ps[0] + ps[1]) + (ps[2] + ps[3])) * (1.f / 256.f) + 1e-6f);
#pragma unroll
                for (int bj = 0; bj < 2; ++bj) { const pg8::f32x4 o0 = acc[ai][bj][m][0] * rstd * wv[bj][0], o1 = acc[ai][bj][m][1] * rstd * wv[bj][1];
                    v4u w; w.x = pk2(o0[0], o0[1]); w.y = pk2(o0[2], o0[3]); w.z = pk2(o1[0], o1[1]); w.w = pk2(o1[2], o1[3]); *(GAS v4u*)(MIX + (size_t)r * 1024 + 384 + col0 + bj * 128) = w; } }
    }
};
}
namespace fx {
constexpr int HG_NSEG = 8, HG_SEGTOK = SEQ / HG_NSEG, HG_CT = 32, HG_NCH = HG_SEGTOK / HG_CT;
constexpr size_t WS_HD = WS_HLOC + 7 * MiB;
typedef short hbf16x8 __attribute__((ext_vector_type(8)));
typedef float hf32x16 __attribute__((ext_vector_type(16)));
constexpr int HL_QT = 0, HL_KT = 4608, HL_KH = 9216, HL_VT = 14336, HL_PP = 19456, HL_ST = 22016, HL_DD = 31232, HL_TOT = 31488, HL_OO = 32512, HL_END = 41216;
constexpr int HP_QK = 72, HP_T = 40, HP_OO = 68;
__device__ __forceinline__ int hcrow(int r, int hi) { return (r & 3) + 8 * (r >> 2) + 4 * hi; }

template <bool FULL>
__device__ __forceinline__ void hgrn_pair(unsigned char* ws, const float* nw_l, int l, int u0, LAS unsigned char* lds_wg, const int wave00) {
    int wave0 = wave00; asm volatile("" : "+s"(wave0));
    const int lane = lane_now(), r32 = lane & 31, hi = lane >> 5, half = wave0 >> 2, hw = wave0 & 3, htid = hw * 64 + lane;
    constexpr int NS = FULL ? HG_NSEG : HG_NSEG - 1;
    const int unit = u0 + half, bh = unit / NS, seg = unit % NS, b = bh / 6, h = bh % 6; const int d = lane, sg = hw;
    LAS unsigned char* lds = lds_wg + half * HL_END;
    const bf16* Zb = (const bf16*)(ws + WS_Z) + (size_t)(b * SEQ + seg * HG_SEGTOK) * NZ + h * 64;
    const float lbv = ((const float*)(ws + WS_LB))[l * 384 + h * 64 + d], oml = 1.f - lbv;
    LAS unsigned short* QT = (LAS unsigned short*)(lds + HL_QT); LAS unsigned short* KT = (LAS unsigned short*)(lds + HL_KT);
    LAS unsigned short* KH = (LAS unsigned short*)(lds + HL_KH); LAS unsigned short* VT = (LAS unsigned short*)(lds + HL_VT);
    LAS unsigned short* PP = (LAS unsigned short*)(lds + HL_PP); LAS unsigned short* ST = (LAS unsigned short*)(lds + HL_ST);
    LAS float* DD = (LAS float*)(lds + HL_DD); LAS float* TOT = (LAS float*)(lds + HL_TOT); LAS float* OO = (LAS float*)(lds + HL_OO);
    const int dt = hw >> 1, vt = hw & 1;
    hf32x16 S;
#pragma unroll
    for (int r = 0; r < 16; ++r) S[r] = 0.f;
    if (FULL) {
        for (int j = 0; j < seg; ++j) { const float* loc = (const float*)(ws + WS_HLOC) + (size_t)(bh * HG_NSEG + j) * 4096; const float* hd = (const float*)(ws + WS_HD) + (bh * HG_NSEG + j) * 64;
#pragma unroll
            for (int r = 0; r < 16; ++r) { const int dd = 32 * dt + hcrow(r, hi); S[r] = S[r] * hd[dd] + loc[dd * 64 + 32 * vt + r32]; } }
#pragma unroll
        for (int j = 0; j < 4; ++j) { v2u w; w.x = pk2(S[4 * j], S[4 * j + 1]); w.y = pk2(S[4 * j + 2], S[4 * j + 3]); *(LAS v2u*)(ST + (32 * vt + r32) * HP_QK + 32 * dt + 8 * j + 4 * hi) = w; }
    }
    float lsum = 0.f;
    unsigned short rf[8] = {}, rv[8] = {}, rq[8] = {}; v4u rg = {};
    { const bf16* zr = Zb + (size_t)(8 * sg) * NZ;
#pragma unroll
        for (int i = 0; i < 8; ++i) { rf[i] = zr[(size_t)i * NZ + ZC_HF + d]; rv[i] = zr[(size_t)i * NZ + ZC_HI + d]; if (FULL) rq[i] = zr[(size_t)i * NZ + ZC_HQ + d]; }
        if (FULL) rg = *(const GAS v4u*)(Zb + (size_t)(htid >> 3) * NZ + ZC_HG + 8 * (htid & 7)); }
    for (int ch = 0; ch < HG_NCH; ++ch) {
        float lf[8], kk[8], qq[8], vv[8];
#pragma unroll
        for (int i = 0; i < 8; ++i) { const float z = bf2f(rf[i]); const float s1 = fsigmoid(z); lf[i] = __logf(lbv + oml * s1); kk[i] = oml * (1.f - s1);
            vv[i] = bf2f(rv[i]); if (FULL) qq[i] = fsilu(bf2f(rq[i])); }
        const v4u gw_ = rg;
        if (ch + 1 < HG_NCH) { const bf16* zr = Zb + (size_t)((ch + 1) * HG_CT + 8 * sg) * NZ;
#pragma unroll
            for (int i = 0; i < 8; ++i) { rf[i] = zr[(size_t)i * NZ + ZC_HF + d]; rv[i] = zr[(size_t)i * NZ + ZC_HI + d]; if (FULL) rq[i] = zr[(size_t)i * NZ + ZC_HQ + d]; }
            if (FULL) rg = *(const GAS v4u*)(Zb + (size_t)((ch + 1) * HG_CT + (htid >> 3)) * NZ + ZC_HG + 8 * (htid & 7)); }
#pragma unroll
        for (int i = 1; i < 8; ++i) lf[i] += lf[i - 1];
        TOT[sg * 64 + d] = lf[7];
        __syncthreads();
        float base = 0.f, blast = 0.f;
#pragma unroll
        for (int s2 = 0; s2 < 4; ++s2) { const float tv = TOT[s2 * 64 + d]; blast += tv; if (s2 < sg) base += tv; }
        lsum += blast;
        { float kh[8];
#pragma unroll
            for (int i = 0; i < 8; ++i) { const float bi = base + lf[i]; kh[i] = kk[i] * __expf(blast - bi);
                if (FULL) { const int t = 8 * sg + i; QT[t * HP_QK + d] = (unsigned short)f2bf(qq[i] * __expf(bi)); KT[t * HP_QK + d] = (unsigned short)f2bf(kk[i] * __expf(-bi)); } }
            v4u w; w.x = pk2(kh[0], kh[1]); w.y = pk2(kh[2], kh[3]); w.z = pk2(kh[4], kh[5]); w.w = pk2(kh[6], kh[7]); *(LAS v4u*)(KH + d * HP_T + 8 * sg) = w;
            v4u wv; wv.x = pk2(vv[0], vv[1]); wv.y = pk2(vv[2], vv[3]); wv.z = pk2(vv[4], vv[5]); wv.w = pk2(vv[6], vv[7]); *(LAS v4u*)(VT + d * HP_T + 8 * sg) = wv;
            if (sg == 0) DD[d] = __expf(blast); }
        __syncthreads();
        if (FULL && hw == 0) { hf32x16 c;
#pragma unroll
            for (int r = 0; r < 16; ++r) c[r] = 0.f;
#pragma unroll
            for (int ks = 0; ks < 4; ++ks) { const hbf16x8 a = *(const LAS hbf16x8*)(QT + r32 * HP_QK + 16 * ks + 8 * hi), bb = *(const LAS hbf16x8*)(KT + r32 * HP_QK + 16 * ks + 8 * hi); c = __builtin_amdgcn_mfma_f32_32x32x16_bf16(a, bb, c, 0, 0, 0); }
#pragma unroll
            for (int r = 0; r < 16; ++r) { const int t = hcrow(r, hi); PP[t * HP_T + r32] = (unsigned short)f2bf(r32 <= t ? c[r] : 0.f); } }
        {
#pragma unroll
            for (int r = 0; r < 16; ++r) S[r] *= DD[32 * dt + hcrow(r, hi)];
#pragma unroll
            for (int ks = 0; ks < 2; ++ks) { const hbf16x8 a = *(const LAS hbf16x8*)(KH + (32 * dt + r32) * HP_T + 16 * ks + 8 * hi), bb = *(const LAS hbf16x8*)(VT + (32 * vt + r32) * HP_T + 16 * ks + 8 * hi); S = __builtin_amdgcn_mfma_f32_32x32x16_bf16(a, bb, S, 0, 0, 0); } }
        if (FULL) {
            __syncthreads();
            if (hw == 1 || hw == 2) { const int ov = hw - 1; hf32x16 c;
#pragma unroll
                for (int r = 0; r < 16; ++r) c[r] = 0.f;
#pragma unroll
                for (int ks = 0; ks < 2; ++ks) { const hbf16x8 a = *(const LAS hbf16x8*)(PP + r32 * HP_T + 16 * ks + 8 * hi), bb = *(const LAS hbf16x8*)(VT + (32 * ov + r32) * HP_T + 16 * ks + 8 * hi); c = __builtin_amdgcn_mfma_f32_32x32x16_bf16(a, bb, c, 0, 0, 0); }
#pragma unroll
                for (int ks = 0; ks < 4; ++ks) { const hbf16x8 a = *(const LAS hbf16x8*)(QT + r32 * HP_QK + 16 * ks + 8 * hi), bb = *(const LAS hbf16x8*)(ST + (32 * ov + r32) * HP_QK + 16 * ks + 8 * hi); c = __builtin_amdgcn_mfma_f32_32x32x16_bf16(a, bb, c, 0, 0, 0); }
#pragma unroll
                for (int r = 0; r < 16; ++r) OO[hcrow(r, hi) * HP_OO + 32 * ov + r32] = c[r]; }
            __syncthreads();
#pragma unroll
            for (int j = 0; j < 4; ++j) { v2u w; w.x = pk2(S[4 * j], S[4 * j + 1]); w.y = pk2(S[4 * j + 2], S[4 * j + 3]); *(LAS v2u*)(ST + (32 * vt + r32) * HP_QK + 32 * dt + 8 * j + 4 * hi) = w; }
            { const int t = htid >> 3, vg = htid & 7; const f32x4 o0 = *(const LAS f32x4*)(OO + t * HP_OO + 8 * vg), o1 = *(const LAS f32x4*)(OO + t * HP_OO + 8 * vg + 4);
                float s = ((o0.x * o0.x + o0.y * o0.y) + (o0.z * o0.z + o0.w * o0.w)) + ((o1.x * o1.x + o1.y * o1.y) + (o1.z * o1.z + o1.w * o1.w));
                s += lane_get(s, lane ^ 1); s += lane_get(s, lane ^ 2); s += lane_get(s, lane ^ 4);
                const float rstd = __builtin_amdgcn_rsqf(s * (1.f / 64.f) + 1e-6f); const size_t row = (size_t)(b * SEQ + seg * HG_SEGTOK + ch * HG_CT + t);
                const f32x4 w0 = *(const GAS f32x4*)(nw_l + 8 * vg), w1 = *(const GAS f32x4*)(nw_l + 8 * vg + 4);
                v4u w; w.x = pk2(o0.x * rstd * w0.x * fsilu(bflo(gw_.x)), o0.y * rstd * w0.y * fsilu(bfhi(gw_.x))); w.y = pk2(o0.z * rstd * w0.z * fsilu(bflo(gw_.y)), o0.w * rstd * w0.w * fsilu(bfhi(gw_.y)));
                w.z = pk2(o1.x * rstd * w1.x * fsilu(bflo(gw_.z)), o1.y * rstd * w1.y * fsilu(bfhi(gw_.z))); w.w = pk2(o1.z * rstd * w1.z * fsilu(bflo(gw_.w)), o1.w * rstd * w1.w * fsilu(bfhi(gw_.w)));
                *(GAS v4u*)((bf16*)(ws + WS_H) + row * 1024 + 640 + h * 64 + 8 * vg) = w; }
        }
    }
    if (!FULL) {
        { float* loc = (float*)(ws + WS_HLOC) + (size_t)(bh * HG_NSEG + seg) * 4096;
#pragma unroll
            for (int r = 0; r < 16; ++r) loc[(32 * dt + hcrow(r, hi)) * 64 + 32 * vt + r32] = S[r]; }
        if (sg == 0) ((float*)(ws + WS_HD))[(bh * HG_NSEG + seg) * 64 + d] = __expf(lsum);
    }
    __syncthreads();
}
}
namespace fx {
constexpr int LDS_BYTES = 147456;
constexpr int RING_BYTES = 131072, LDSCTL_OFF = RING_BYTES, MISC_OFF = LDSCTL_OFF + 320;
constexpr int PH_PRO = 0, PH_FINAL = 21, NPH = 22;

struct QueueOrder {
    unsigned* ctr; LAS unsigned* slot;
    __device__ __forceinline__ bool next(int, attn_body::AttnUnit& u) const {
        if (threadIdx.x == 0) *slot = __hip_atomic_fetch_add(ctr, 1u, __ATOMIC_RELAXED, __HIP_MEMORY_SCOPE_AGENT);
        __syncthreads(); const unsigned v = *slot; __syncthreads();
        if (v >= 768u) return false; u.bh = (int)(v >> 4); u.qb = 15 - (int)(v & 15u); return true; }
    __device__ __forceinline__ void a_ready(const attn_body::AttnUnit&) const {}
    __device__ __forceinline__ void done(const attn_body::AttnUnit&) const {}
};

__global__ void __launch_bounds__(NTHR, 2) mk_fwd(Params p) {
    extern __shared__ __attribute__((aligned(16))) unsigned char lds_raw[];
    LAS unsigned char* lds = (LAS unsigned char*)lds_raw;
    const int wave0 = __builtin_amdgcn_readfirstlane(threadIdx.x >> 6);
    for (int u = threadIdx.x; u < (LDS_BYTES - LDSCTL_OFF) / 4; u += NTHR) ((LAS unsigned*)(lds + LDSCTL_OFF))[u] = 0u;
    __syncthreads();
    const XcdBarrier bar = xcd_barrier_post((unsigned*)(p.ws + WS_CTL) + 8192 + p.li * 4096, (volatile LAS unsigned*)(lds + MISC_OFF) + 8, threadIdx.x == 0);
#ifdef EXTRA_BARS
    for (int eb = 0; eb < EXTRA_BARS; ++eb) xcd_barrier(bar, wave0 == 0 && lane_now() == 0);
#endif
    for (int ph = p.ph_lo; ph < p.ph_hi; ++ph) {
#ifdef DUP_MASK
      for (int rep = (((DUP_MASK) >> ph) & 1u) ? 0 : 1; rep < 2; ++rep) {
#else
      { const int rep = 1;
#endif
#ifdef PROBE_MASK
        if (blockIdx.x == 0 && wave0 == 0 && lane_now() == 0) __hip_atomic_store((unsigned long long*)(p.ws + WS_CTL + 512 * 1024) + ph, __builtin_amdgcn_s_memrealtime(), __ATOMIC_RELAXED, __HIP_MEMORY_SCOPE_AGENT);
#endif
        int oz = 0; asm volatile("" : "+s"(oz));
        const int G = gridDim.x, bx = blockIdx.x + oz;
#define PHASE_IDS int wv_ = wave0; asm volatile("" : "+s"(wv_)); const int lane = lane_now(), wave = wv_, tid = wv_ * 64 + lane; \
        const int vcu = (G % 8 == 0) ? (bx % 8) * (G / 8) + bx / 8 : bx; const int gw = vcu * NWAVES + wave, ngw = G * NWAVES; (void)tid; (void)lane; (void)gw; (void)ngw;
        unsigned char* ws = p.ws + oz;
#define PIN(i) (p.in[(i) + oz])
        const int l = (ph - 1) / 10, sub = (ph - 1) % 10;
#ifndef EXP_NO_PRO
        if (ph == PH_PRO) { PHASE_IDS
            { LAS float* cact = (LAS float*)lds; const float* c = PIN(I_C); for (int i = tid; i < 8192; i += NTHR) { const float cv = c[i]; cact[i] = cv * fsigmoid(cv); } __syncthreads();
              for (int it = bx; it < 192; it += G) prologue_mod_item(p, oz, it, (LAS float*)lds, tid, lane, wave); }
            __syncthreads();
            for (int it = (G >= 224 ? bx - 192 : bx); it >= 0 && it < 32; it += G) prologue_s5_item(p, oz, it / 16, it % 16, (LAS float*)lds, tid);
            __syncthreads();
            prologue_wave_items(p, oz, (LAS float*)(lds + wave * 16384), bx, wave, lane);
        } else
#endif
        if (ph == PH_FINAL) { PHASE_IDS
            float* X = p.out + oz; const bf16* XBp = (const bf16*)(ws + WS_XB); const float* w = PIN(I_FINW);
#ifdef PROBE_MASK
            float pscale = 1.f; { unsigned long long* tsb = (unsigned long long*)(ws + WS_CTL + 512 * 1024); unsigned long long t0 = __hip_atomic_load(tsb, __ATOMIC_RELAXED, __HIP_MEMORY_SCOPE_AGENT), tl = __hip_atomic_load(tsb + PH_FINAL, __ATOMIC_RELAXED, __HIP_MEMORY_SCOPE_AGENT); unsigned long long acc = 0;
#pragma unroll 1
                for (int k = 0; k < PH_FINAL; ++k) if ((PROBE_MASK >> k) & 1u) acc += __hip_atomic_load(tsb + k + 1, __ATOMIC_RELAXED, __HIP_MEMORY_SCOPE_AGENT) - __hip_atomic_load(tsb + k, __ATOMIC_RELAXED, __HIP_MEMORY_SCOPE_AGENT);
                pscale = 1.f + (float)acc / (float)(tl - t0); }
#endif
            f32x4 W4[4];
#pragma unroll
            for (int j = 0; j < 4; ++j) W4[j] = ((const GAS f32x4*)w)[lane + 64 * j];
            f32x4 v[4] = {}; if (gw < M) row_load_bf(XBp, gw, lane, v);
            for (int m = gw; m < M; m += ngw) { GAS f32x4* xr = (GAS f32x4*)(X + (size_t)m * 1024) + lane; f32x4 nxt[4] = {}; const int mn = m + ngw; if (mn < M) row_load_bf(XBp, mn, lane, nxt); float s = 0.f;
#pragma unroll
                for (int j = 0; j < 4; ++j) s += (v[j].x * v[j].x + v[j].y * v[j].y) + (v[j].z * v[j].z + v[j].w * v[j].w);
                const float rstd = __builtin_amdgcn_rsqf(wave_sum(s, lane) * (1.f / 1024.f) + 1e-6f);
#pragma unroll
                for (int j = 0; j < 4; ++j) { f32x4 o = (v[j] * rstd) * W4[j];
#ifdef PROBE_MASK
                    o = o * pscale;
#endif
                    xr[64 * j] = o; }
#pragma unroll
                for (int j = 0; j < 4; ++j) v[j] = nxt[j]; }
        }
#ifndef EXP_NO_ROW
        else if (sub == 0) { PHASE_IDS
            const float* X = PIN(I_X); const float* mod = (const float*)(ws + WS_MOD) + l * 8 * 6144;
            const int tpw = M / G, t0 = bx * tpw, b = t0 >> 12; f32x4 A[4], B[4]; adaln_factors(PIN(I_NMW) + l * 1024, mod + b * 6144, mod + b * 6144 + 1024, lane, A, B);
            const bf16* XBp = (const bf16*)(ws + WS_XB);
            f32x4 cur[4] = {}; if (wave < tpw) { if (l == 0) row_load(X, t0 + wave, lane, cur); else row_load_bf(XBp, t0 + wave, lane, cur); }
            for (int r = wave; r < tpw; r += NWAVES) { f32x4 nxt[4] = {}; if (r + NWAVES < tpw) { if (l == 0) row_load(X, t0 + r + NWAVES, lane, nxt); else row_load_bf(XBp, t0 + r + NWAVES, lane, nxt); }
                norm_row_to_bf16(cur, A, B, (bf16*)(ws + WS_H) + (size_t)(t0 + r) * 1024, lane);
#pragma unroll
                for (int j = 0; j < 4; ++j) cur[j] = nxt[j]; }
        }
#endif
        else if (sub == 1) {
            pg8::Gemm g{(const pg8::bf16_t*)(ws + WS_H), (const pg8::bf16_t*)(ws + WS_WIN) + (size_t)l * 3072 * 1024, M, NZ, 1024, 1024, 1024};
            pg8::StaticOrder S; S.init(M, NZ, G, bx);
            EpiZ E{(bf16*)(ws + WS_Z), (bf16*)(ws + WS_UP), (float*)(ws + WS_NLF), PIN(I_FOXB) + l * 6};
#ifdef EXP_EPI_BF16
            pg8::EpiBf16<0> E2{(bf16*)(ws + WS_Z), NZ, nullptr, 0, 0, 1.f};
            pg8::gemm_phase<pg8::EpiBf16<0>, pg8::StaticOrder, true, true>(lds, g, S, E2);
#else
            pg8::gemm_phase<EpiZ, pg8::StaticOrder, true, true>(lds, g, S, E, wave0);
#endif
        }
        else if (sub == 2) {
            unsigned* qctr = (unsigned*)(ws + WS_CTL) + 1024 + ph * 64 + rep * 32; LAS unsigned* qslot = (LAS unsigned*)(lds + MISC_OFF);
            constexpr unsigned NHL = 48u * (HG_NSEG - 1) / 2u;
            for (;;) {
                int ozq = 0; asm volatile("" : "+s"(ozq)); unsigned char* wsq = p.ws + ozq;
                if (wave0 == 0 && lane_now() == 0) *qslot = __hip_atomic_fetch_add(qctr, 1u, __ATOMIC_RELAXED, __HIP_MEMORY_SCOPE_AGENT);
                __syncthreads(); const unsigned v = __builtin_amdgcn_readfirstlane(*qslot); __syncthreads();
                if (v >= NHL + 128u + 48u + 768u) break;
                if (v < NHL) { hgrn_pair<false>(wsq, p.in[I_HNW + ozq] + l * 64, l, (int)(2u * v), lds, wave0); }
                else if (v < NHL + 128u) { const int u5 = (int)(v - NHL); const OneUnit S5{u5, u5 >> 3};
                    pg8::Gemm g5{(const pg8::bf16_t*)(wsq + WS_UP), (const pg8::bf16_t*)(wsq + WS_S5WL) + (size_t)l * 16 * 256 * 256, 16 * 2048, 16 * 256, 256, 384, 256}; EpiS5Loc E5{(float*)(wsq + WS_LOC)}; pg8::gemm_phase<EpiS5Loc, OneUnit, false, true>(lds, g5, S5, E5, wave0); __syncthreads(); }
                else if (v >= NHL + 128u + 48u) {
                    const int u = (int)(v - NHL - 128u - 48u), bh = u >> 4, qb = u & 15, b = bh / 6, h = bh % 6; int wv_ = wave0; asm volatile("" : "+s"(wv_)); const int lane = lane_now();
                    const bf16* Zr = (const bf16*)(wsq + WS_Z) + (size_t)(b * SEQ + qb * 256 + wv_ * 32) * NZ + h * 64; float kmax = 0.f, qmax = 0.f;
#pragma unroll
                    for (int i = 0; i < 8; ++i) { const bf16* rp = Zr + (size_t)(4 * i + (lane >> 4)) * NZ + 4 * (lane & 15); const v2u kw = *(const GAS v2u*)(rp + ZC_FK), qw = *(const GAS v2u*)(rp + ZC_FQ);
                        float ks = (bflo(kw.x) * bflo(kw.x) + bfhi(kw.x) * bfhi(kw.x)) + (bflo(kw.y) * bflo(kw.y) + bfhi(kw.y) * bfhi(kw.y)), qs = (bflo(qw.x) * bflo(qw.x) + bfhi(qw.x) * bfhi(qw.x)) + (bflo(qw.y) * bflo(qw.y) + bfhi(qw.y) * bfhi(qw.y));
                        ks += lane_get(ks, lane ^ 1); qs += lane_get(qs, lane ^ 1); ks += lane_get(ks, lane ^ 2); qs += lane_get(qs, lane ^ 2); ks += lane_get(ks, lane ^ 4); qs += lane_get(qs, lane ^ 4); ks += lane_get(ks, lane ^ 8); qs += lane_get(qs, lane ^ 8);
                        kmax = fmaxf(kmax, ks); qmax = fmaxf(qmax, qs); }
                    kmax = fmaxf(kmax, lane_get(kmax, lane ^ 16)); qmax = fmaxf(qmax, lane_get(qmax, lane ^ 16)); kmax = fmaxf(kmax, lane_get(kmax, lane ^ 32)); qmax = fmaxf(qmax, lane_get(qmax, lane ^ 32));
                    LAS float* red = (LAS float*)lds; if (lane == 0) { red[wv_] = kmax; red[8 + wv_] = qmax; }
                    __syncthreads();
                    if (wv_ == 0 && lane < 4) ((float*)(wsq + WS_KN))[bh * 64 + qb * 4 + lane] = fmaxf(red[2 * lane], red[2 * lane + 1]) * 1.02f;
                    if (wv_ == 0 && lane == 4) { float m = red[8]; for (int w = 1; w < 8; ++w) m = fmaxf(m, red[8 + w]); ((float*)(wsq + WS_QN))[bh * 16 + qb] = m * 1.02f; }
                    __syncthreads(); }
                else { const int bh = (int)(v - NHL - 128u); int wv_ = wave0; asm volatile("" : "+s"(wv_)); const int lane = lane_now(), wave = wv_, tid = wv_ * 64 + lane; LAS float* wsum = (LAS float*)lds;
                    const float* src = (const float*)(wsq + WS_NLF) + (size_t)bh * SEQ + tid * 8; float v8[8]; float s = 0.f;
                    const f32x4 a = *(const GAS f32x4*)src, b4 = *(const GAS f32x4*)(src + 4);
                    v8[0] = a.x; v8[1] = a.y; v8[2] = a.z; v8[3] = a.w; v8[4] = b4.x; v8[5] = b4.y; v8[6] = b4.z; v8[7] = b4.w;
#pragma unroll
                    for (int i = 0; i < 8; ++i) { s += v8[i]; v8[i] = s; }
                    float incl = s;
#pragma unroll
                    for (int o = 1; o < 64; o <<= 1) { const float n = lane_get(incl, lane - o); if (lane >= o) incl += n; }
                    if (lane == 63) wsum[wave] = incl;
                    __syncthreads();
                    float base = incl - s;
                    for (int w = 0; w < wave; ++w) base += wsum[w];
                    float* dst = (float*)(wsq + WS_G) + (size_t)bh * SEQ + tid * 8;
                    *(GAS f32x4*)dst = (f32x4){v8[0] + base, v8[1] + base, v8[2] + base, v8[3] + base}; *(GAS f32x4*)(dst + 4) = (f32x4){v8[4] + base, v8[5] + base, v8[6] + base, v8[7] + base};
                    __syncthreads(); }
            }
        }
        else if (sub == 3) {
            unsigned* qctr = (unsigned*)(ws + WS_CTL) + 1024 + ph * 64 + rep * 32; LAS unsigned* qslot = (LAS unsigned*)(lds + MISC_OFF);
            for (;;) {
                int ozq = 0; asm volatile("" : "+s"(ozq)); unsigned char* wsq = p.ws + ozq;
                if (wave0 == 0 && lane_now() == 0) *qslot = __hip_atomic_fetch_add(qctr, 1u, __ATOMIC_RELAXED, __HIP_MEMORY_SCOPE_AGENT);
                __syncthreads(); const unsigned v = __builtin_amdgcn_readfirstlane(*qslot); __syncthreads();
                constexpr unsigned NHF = 48u * HG_NSEG / 2u;
                if (v >= NHF + 128u + 768u) break;
#ifdef DUP_MASK
#ifndef DUP_CSEL
                if (rep == 0 && v >= NHF + 128u) break;
#else
                if (rep == 0 && DUP_CSEL != 3 && v >= NHF + 128u) break;
#endif
#ifdef DUP_CSEL
                if (rep == 0 && DUP_CSEL == 1 && v >= NHF) break;
                if (rep == 0 && DUP_CSEL == 2 && v < NHF) continue;
                if (rep == 0 && DUP_CSEL == 3 && v < NHF + 128u) continue;
#endif
#endif
                if (v < NHF) { hgrn_pair<true>(wsq, p.in[I_HNW + ozq] + l * 64, l, (int)(2u * v), lds, wave0); }
                else if (v < NHF + 128u) { const unsigned v5 = v - NHF;
                    s5_scan(wsq, l, (int)(v5 >> 3), (int)(v5 & 7u), wave0 * 64 + lane_now(), (LAS float*)lds);
                    pg8::Gemm g5{(const pg8::bf16_t*)(wsq + WS_UP), (const pg8::bf16_t*)(wsq + WS_S5WO) + (size_t)l * 16 * 256 * 384, 16 * 2048, 16 * 256, 384, 384, 384}; EpiS5Y E5{(bf16*)(wsq + WS_Y)};
                    const OneUnit S5{(int)v5, (int)(v5 >> 3)}; pg8::gemm_phase<EpiS5Y, OneUnit, false, false>(lds, g5, S5, E5, wave0); __syncthreads(); }
                else { const unsigned a = v - NHF - 128u; const int bh = (int)(a >> 4), qb = 15 - (int)(a & 15u);
                    const attn_body::bf16* Zq = (const attn_body::bf16*)(wsq + WS_Z);
                    int ts; { const int ln = lane_now(); const float* Gb = (const float*)(wsq + WS_G) + (size_t)bh * SEQ; const float* KN = (const float*)(wsq + WS_KN) + bh * 64; const float qn = ((const float*)(wsq + WS_QN))[bh * 16 + qb];
                        const float kd = fmaxf(fmaxf(KN[4 * qb], KN[4 * qb + 1]), fmaxf(KN[4 * qb + 2], KN[4 * qb + 3])); const float ub = __builtin_sqrtf(qn * KN[ln]) + Gb[64 * ln + 63] - Gb[256 * qb] + __builtin_sqrtf(qn * kd);
                        const unsigned long long need = __ballot((ln < 4 * qb) && !(ub < -36.f)); const int first = need ? (int)__builtin_ctzll(need) : 4 * qb; ts = __builtin_amdgcn_readfirstlane(first & ~1); }
                    attn_body::attn_unit<8>(bh / 6, bh % 6, qb, Zq + ZC_FQ, Zq + ZC_FK, Zq + ZC_FV, (attn_body::bf16*)(wsq + WS_Z) + ZC_FQ, (const float*)(wsq + WS_G) + (long)bh * SEQ, (char*)lds_raw, wave0, ts, rep != 0); }
            }
        }
        else if (sub == 4) { PHASE_IDS
            if (bx < 128) {
                pg8::Gemm gg{(const pg8::bf16_t*)(ws + WS_Y), (const pg8::bf16_t*)(ws + WS_GLU) + (size_t)l * 256 * 256, M, 256, 256, 256, 256};
                const OneUnit SG{bx, 0}; EpiGlu EG{(const bf16*)(ws + WS_Y), PIN(I_GLUB) + l * 256, PIN(I_BNS) + l * 256, (bf16*)(ws + WS_H)};
                pg8::gemm_phase<EpiGlu, OneUnit, false, true>(lds, gg, SG, EG, wave0);
            } else {
            const int gw2 = (bx - 128) * NWAVES + wave, ngw2 = (G - 128) * NWAVES;
            const bf16* Zb = (const bf16*)(ws + WS_Z); bf16* MIX = (bf16*)(ws + WS_H); const float* w = PIN(I_BNF) + l * 384;
            float wl[6];
#pragma unroll
            for (int i = 0; i < 6; ++i) wl[i] = w[lane * 6 + i];
            for (int m = gw2; m < M; m += ngw2) {
                const GAS unsigned* src = (const GAS unsigned*)(Zb + (size_t)m * NZ) + lane * 3; const unsigned a = src[0], b2 = src[1], c = src[2];
                float v[6] = {bflo(a), bfhi(a), bflo(b2), bfhi(b2), bflo(c), bfhi(c)}; float s = 0.f;
#pragma unroll
                for (int i = 0; i < 6; ++i) s += v[i] * v[i];
                const float rstd = __builtin_amdgcn_rsqf(wave_sum(s, lane) * (1.f / 384.f) + 1e-6f);
                GAS unsigned* dst = (GAS unsigned*)(MIX + (size_t)m * 1024) + lane * 3;
                dst[0] = pk2(v[0] * rstd * wl[0], v[1] * rstd * wl[1]); dst[1] = pk2(v[2] * rstd * wl[2], v[3] * rstd * wl[3]); dst[2] = pk2(v[4] * rstd * wl[4], v[5] * rstd * wl[5]);
            }
            }
        }
        else if (sub == 5) {
            pg8::Gemm g{(const pg8::bf16_t*)(ws + WS_H), (const pg8::bf16_t*)(ws + WS_WOUT) + (size_t)l * 1024 * 1024, M, 1024, 1024, 1024, 1024};
            pg8::StaticOrder S; S.init(M, 1024, G, bx);
            const float* gm = (const float*)(ws + WS_MOD) + l * 8 * 6144 + 2048;
            if (l == 0) { EpiRes<true> E{PIN(I_X), (bf16*)(ws + WS_XB), gm}; pg8::gemm_phase<EpiRes<true>, pg8::StaticOrder, true, true>(lds, g, S, E, wave0); }
            else { EpiRes<false> E{ws + WS_XB, (bf16*)(ws + WS_XB), gm}; pg8::gemm_phase<EpiRes<false>, pg8::StaticOrder, true, true>(lds, g, S, E, wave0); }
        }
        else if (sub == 6) { PHASE_IDS moe_route(p, oz, l, lds, tid, lane, wave, bx, G);
        }
        else if (sub == 7) { PHASE_IDS moe_gather(p, oz, lds, tid, lane, wave, bx, G);
        }
        else if (sub == 8) { PHASE_IDS
            LAS int* list = (LAS int*)(lds + RING_BYTES + 1024); const int n = moe_build_list<false>(ws, list, tid, bx, G);
            pg8::Gemm g{(const pg8::bf16_t*)(ws + WS_H), (const pg8::bf16_t*)(ws + WS_W1) + (size_t)l * 8192 * 1024, MOE_ROWS, 8192, 1024, 1024, 1024, (const int*)(ws + WS_ROWTOK)};
            ListOrder S{list, n}; EpiHid E{(bf16*)(ws + WS_HID), (const float*)(ws + WS_ROWW)};
            pg8::gemm_phase<EpiHid, ListOrder, true, true, false, true>(lds, g, S, E, wave0);
        }
        else if (sub == 9) { PHASE_IDS
            LAS int* list = (LAS int*)(lds + RING_BYTES + 1024); const int n = moe_build_list<true>(ws, list, tid, bx, G);
            pg8::Gemm g{(const pg8::bf16_t*)(ws + WS_HID), (const pg8::bf16_t*)(ws + WS_W2) + (size_t)l * 1024 * 4096, MOE_ROWS, 1024, 512, 512, 4096};
            ListOrder S{list, n}; EpiMoeOut E{(bf16*)(ws + WS_XB), (const float*)(ws + WS_MOD) + l * 8 * 6144 + 5 * 1024, (const int*)(ws + WS_ROWTOK)};
            pg8::gemm_phase<EpiMoeOut, ListOrder, false, true, true>(lds, g, S, E, wave0);
        }
        if (ph + 1 < p.ph_hi || rep == 0) xcd_barrier(bar, wave0 == 0 && lane_now() == 0); else __syncthreads();
      }
    }
}

static int g_grid = 0;
inline bool mk_setup() {
    if (g_grid) return g_grid > 0;
    int dev = 0, cus = 0;
    if (hipGetDevice(&dev) != hipSuccess || hipDeviceGetAttribute(&cus, hipDeviceAttributeMultiprocessorCount, dev) != hipSuccess) { g_grid = -1; return false; }
    if (hipFuncSetAttribute((const void*)mk_fwd, hipFuncAttributeMaxDynamicSharedMemorySize, LDS_BYTES) != hipSuccess) { fprintf(stderr, "hipFuncSetAttribute failed\n"); g_grid = -1; return false; }
    g_grid = cus; return true;
}
inline void mk_zero_ctl(void* d_ws, hipStream_t st) { (void)hipMemsetAsync((char*)d_ws + WS_CTL, 0, CTL_ZERO_BYTES, st); }
inline void mk_launch(void* const* d_in, void* d_out, void* d_ws, hipStream_t st, int lo, int hi, int li = 0) {
    if (!mk_setup()) return;
    Params p{}; for (int i = 0; i < 29; ++i) p.in[i] = (const float*)d_in[i]; p.out = (float*)d_out; p.ws = (unsigned char*)d_ws; p.ph_lo = lo; p.ph_hi = hi; p.li = li;
    hipLaunchKernelGGL(mk_fwd, dim3(g_grid), dim3(NTHR), LDS_BYTES, st, p);
}
}
extern "C" void kernel_launch(void* const* d_in, const int* in_sizes, int n_in, void* d_out, int out_size, void* d_ws, size_t ws_size, hipStream_t stream) {
    fx::mk_zero_ctl(d_ws, stream);
    fx::mk_launch(d_in, d_out, d_ws, stream, 0, 22, 0);
}
```
